# Optimizing an MI355X kernel written in HIP

```python
import math
import jax, jax.numpy as jnp
from jax import lax
import numpy as np

D_MODEL = 2048
BATCH = 2
SEQ = 16384
DEPTH = 2

S5_WIDTH = D_MODEL // 4
S5_GROUP = 16
S5_GROUPS = S5_WIDTH // S5_GROUP
S5_STATE = 64
HEAD_DIM = 64
ATTN_HEADS = 8
ATTN_KV_HEADS = 2
ATTN_WIDTH = ATTN_HEADS * HEAD_DIM
IDX_HEADS = 4
IDX_DIM = 64
TOPK_MAX = 256
Q_BLOCK = 128
SSD_WIDTH = D_MODEL // 2
SSD_HEAD_DIM = 64
SSD_HEADS = SSD_WIDTH // SSD_HEAD_DIM
SSD_GROUPS = 2
SSD_STATE = 128
SSD_CONV = 4
SSD_CHUNK = 128
SSD_XBC = SSD_WIDTH + 2 * SSD_GROUPS * SSD_STATE
MEM_LEN = 256
MEM_HEADS = 4
MEM_WIDTH = MEM_HEADS * HEAD_DIM
N_BRANCH = 4
ROPE_THETA = 500000.0
ROPE_DIM = HEAD_DIM // 4
DEEPNORM_ALPHA = (2 * DEPTH) ** 0.25
DEEPNORM_BETA = (8 * DEPTH) ** -0.25
LN_EPS = 1e-5
RMS_EPS = 1e-5

SPLITS = (
    ('s5_u', S5_WIDTH), ('s5_z', S5_WIDTH),
    ('att_q', ATTN_WIDTH), ('att_k', ATTN_KV_HEADS * HEAD_DIM), ('att_v', ATTN_KV_HEADS * HEAD_DIM), ('att_z', ATTN_WIDTH),
    ('idx_q', IDX_HEADS * IDX_DIM), ('idx_k', IDX_DIM), ('idx_w', IDX_HEADS),
    ('ssd_z', SSD_WIDTH), ('ssd_xbc', SSD_XBC), ('ssd_dt', SSD_HEADS),
    ('mem_q', MEM_WIDTH), ('mem_z', MEM_WIDTH),
    ('gates', N_BRANCH * D_MODEL),
)
IN_WIDTH = sum(w for _, w in SPLITS)

kernel_name = "hybrid_s5_dsa_ssd_deepnorm"


def split_columns(h):
    offs = np.cumsum([w for _, w in SPLITS])[:-1].tolist()
    return dict(zip([n for n, _ in SPLITS], jnp.split(h, offs, axis=-1)))


def layer_norm(x, g, b):
    xf = x.astype(jnp.float32)
    mu = jnp.mean(xf, -1, keepdims=True)
    var = jnp.mean(jnp.square(xf - mu), -1, keepdims=True)
    return ((xf - mu) * lax.rsqrt(var + LN_EPS) * g + b).astype(x.dtype)


def partial_rope(x, pos):
    half = ROPE_DIM // 2
    inv = ROPE_THETA ** (-jnp.arange(half, dtype=jnp.float32) * 2.0 / ROPE_DIM)
    ang = pos.astype(jnp.float32)[:, :, None, None] * inv
    cos, sin = jnp.cos(ang), jnp.sin(ang)
    xr = x[..., :ROPE_DIM].astype(jnp.float32)
    x1, x2 = xr[..., :half], xr[..., half:]
    rot = jnp.concatenate([x1 * cos - x2 * sin, x2 * cos + x1 * sin], -1).astype(x.dtype)
    return jnp.concatenate([rot, x[..., ROPE_DIM:]], -1)


def _complex_affine_combine(e1, e2):
    a1r, a1i, b1r, b1i = e1
    a2r, a2i, b2r, b2i = e2
    ar = a2r * a1r - a2i * a1i
    ai = a2r * a1i + a2i * a1r
    br = a2r * b1r - a2i * b1i + b2r
    bi = a2r * b1i + a2i * b1r + b2i
    return (ar, ai, br, bi)


def s5_mixer(u, lam_re, lam_im, log_dt, b_re, b_im, c_re, c_im, d_skip, w_glu, b_glu):
    bsz, L, _ = u.shape
    f32 = jnp.float32
    uf = u.reshape(bsz, L, S5_GROUPS, S5_GROUP).astype(f32)
    dt = jnp.exp(log_dt.astype(f32))[:, None]
    lr, li = lam_re.astype(f32), lam_im.astype(f32)
    mag = jnp.exp(lr * dt)
    ar, ai = mag * jnp.cos(li * dt), mag * jnp.sin(li * dt)
    den = lr * lr + li * li
    nr, ni = ar - 1.0, ai
    fr, fi = (nr * lr + ni * li) / den, (ni * lr - nr * li) / den
    bbr = fr[..., None] * b_re - fi[..., None] * b_im
    bbi = fr[..., None] * b_im + fi[..., None] * b_re
    bu_r = jnp.einsum('blgh,gph->blgp', uf, bbr.astype(f32))
    bu_i = jnp.einsum('blgh,gph->blgp', uf, bbi.astype(f32))
    a_r = jnp.broadcast_to(ar, bu_r.shape)
    a_i = jnp.broadcast_to(ai, bu_r.shape)
    _, _, s_r, s_i = lax.associative_scan(_complex_affine_combine, (a_r, a_i, bu_r, bu_i), axis=1)
    y = (jnp.einsum('blgp,ghp->blgh', s_r, c_re.astype(f32))
         - jnp.einsum('blgp,ghp->blgh', s_i, c_im.astype(f32))
         + d_skip.astype(f32) * uf)
    y = jax.nn.gelu(y.reshape(bsz, L, S5_WIDTH))
    y = y * jax.nn.sigmoid(y @ w_glu.astype(f32) + b_glu.astype(f32))
    return y.astype(u.dtype)


def dsa_attention(q, k, v, qi, ki, wi):
    bsz, L = q.shape[:2]
    f32 = jnp.float32
    topk = min(TOPK_MAX, L // 4)
    nb = L // Q_BLOCK
    grp = ATTN_HEADS // ATTN_KV_HEADS
    key_pos = jnp.arange(L)
    kif = ki.astype(f32)

    def blockify(t):
        return jnp.moveaxis(t.reshape((bsz, nb, Q_BLOCK) + t.shape[2:]), 1, 0)

    def block(args):
        qb, qib, wib, start = args
        qpos = start + jnp.arange(Q_BLOCK)
        visible = key_pos[None, :] <= qpos[:, None]
        s = jax.nn.relu(jnp.einsum('bqhd,bsd->bqhs', qib.astype(f32), kif))
        score = jnp.einsum('bqhs,bqh->bqs', s, wib.astype(f32))
        score = jnp.where(visible[None], score, -jnp.inf)
        _, sel = lax.top_k(score, topk)
        valid = sel <= qpos[None, :, None]
        kg = jax.vmap(lambda kk, ii: kk[ii])(k, sel)
        vg = jax.vmap(lambda vv, ii: vv[ii])(v, sel)
        qg = qb.reshape(bsz, Q_BLOCK, ATTN_KV_HEADS, grp, HEAD_DIM)
        logits = jnp.einsum('bqgjd,bqkgd->bqgjk', qg, kg).astype(f32) * (HEAD_DIM ** -0.5)
        logits = jnp.where(valid[:, :, None, None, :], logits, -jnp.inf)
        p = jax.nn.softmax(logits, axis=-1).astype(vg.dtype)
        o = jnp.einsum('bqgjk,bqkgd->bqgjd', p, vg)
        return o.reshape(bsz, Q_BLOCK, ATTN_WIDTH)

    starts = jnp.arange(nb) * Q_BLOCK
    out = lax.map(block, (blockify(q), blockify(qi), blockify(wi), starts))
    return jnp.moveaxis(out, 0, 1).reshape(bsz, L, ATTN_WIDTH)


def causal_depthwise_conv(x, w, b):
    y = lax.conv_general_dilated(x, w[:, None, :].astype(x.dtype), window_strides=(1,),
                                 padding=[(SSD_CONV - 1, 0)], dimension_numbers=('NWC', 'WIO', 'NWC'),
                                 feature_group_count=x.shape[-1])
    return y + b


def ssd_mixer(z, xbc, dt_raw, conv_w, conv_b, dt_bias, a_log, d_skip, norm_g):
    bsz, L, _ = xbc.shape
    f32 = jnp.float32
    hpg = SSD_HEADS // SSD_GROUPS
    nc = L // SSD_CHUNK
    xbc = jax.nn.silu(causal_depthwise_conv(xbc, conv_w, conv_b))
    xs, bm, cm = jnp.split(xbc, [SSD_WIDTH, SSD_WIDTH + SSD_GROUPS * SSD_STATE], axis=-1)
    x5 = xs.reshape(bsz, nc, SSD_CHUNK, SSD_GROUPS, hpg, SSD_HEAD_DIM).astype(f32)
    bm = bm.reshape(bsz, nc, SSD_CHUNK, SSD_GROUPS, SSD_STATE).astype(f32)
    cm = cm.reshape(bsz, nc, SSD_CHUNK, SSD_GROUPS, SSD_STATE).astype(f32)
    dt = jax.nn.softplus(dt_raw.astype(f32) + dt_bias.astype(f32))
    dt = dt.reshape(bsz, nc, SSD_CHUNK, SSD_GROUPS, hpg)
    a = -jnp.exp(a_log.astype(f32)).reshape(SSD_GROUPS, hpg)
    acs = jnp.cumsum(jnp.moveaxis(dt * a, 2, -1), axis=-1)
    xdt = x5 * dt[..., None]
    idx = jnp.arange(SSD_CHUNK)
    causal = idx[:, None] >= idx[None, :]
    seg = acs[..., :, None] - acs[..., None, :]
    lmat = jnp.exp(jnp.where(causal, seg, -jnp.inf))
    cb = jnp.einsum('bclgn,bcsgn->bcgls', cm, bm)
    y_diag = jnp.einsum('bcgls,bcgjls,bcsgjp->bclgjp', cb, lmat, xdt)
    decay_states = jnp.exp(acs[..., -1:] - acs)
    states = jnp.einsum('bclgn,bcgjl,bclgjp->bcgjpn', bm, decay_states, xdt)
    chunk_decay = jnp.exp(acs[..., -1])

    def step(h, inp):
        st, dec = inp
        return h * dec[..., None, None] + st, h

    h0 = jnp.zeros_like(states[:, 0])
    _, prev = lax.scan(step, h0, (jnp.moveaxis(states, 1, 0), jnp.moveaxis(chunk_decay, 1, 0)))
    prev = jnp.moveaxis(prev, 0, 1)
    y_off = jnp.einsum('bclgn,bcgjpn,bcgjl->bclgjp', cm, prev, jnp.exp(acs))
    y = y_diag + y_off + x5 * d_skip.astype(f32).reshape(SSD_GROUPS, hpg)[..., None]
    y = y.reshape(bsz, L, SSD_WIDTH) * jax.nn.silu(z.astype(f32))
    yg = y.reshape(bsz, L, SSD_GROUPS, SSD_WIDTH // SSD_GROUPS)
    yg = yg * lax.rsqrt(jnp.mean(yg * yg, -1, keepdims=True) + RMS_EPS)
    return (yg.reshape(bsz, L, SSD_WIDTH) * norm_g.astype(f32)).astype(z.dtype)


def memory_attention(q, k, v):
    logits = jnp.einsum('blhd,bmhd->bhlm', q, k).astype(jnp.float32) * (HEAD_DIM ** -0.5)
    p = jax.nn.softmax(logits, axis=-1).astype(v.dtype)
    return jnp.einsum('bhlm,bmhd->blhd', p, v)


def nrm(k, shape, scale):
    return jax.random.normal(k, shape, jnp.float32) * scale


def setup_inputs(seed: int = 0) -> dict:
    key = jax.random.key(seed)
    ks = list(jax.random.split(key, 32))
    nd = DEPTH
    G, P, H = S5_GROUPS, S5_STATE, S5_GROUP
    x = nrm(ks[0], (BATCH, SEQ, D_MODEL), 1.0)
    mem = nrm(ks[1], (BATCH, MEM_LEN, D_MODEL), 1.0)
    positions = (jax.random.randint(ks[2], (BATCH, 1), 0, 4096) + jnp.arange(SEQ)[None, :]).astype(jnp.int32)
    w_in = nrm(ks[3], (nd, D_MODEL, IN_WIDTH), D_MODEL ** -0.5)
    b_gate = nrm(ks[4], (nd, N_BRANCH * D_MODEL), 0.02)
    s5_lam_re = -0.5 + nrm(ks[5], (nd, G, P), 0.01)
    s5_lam_im = math.pi * jnp.arange(P, dtype=jnp.float32) + nrm(ks[6], (nd, G, P), 0.01)
    s5_log_dt = jax.random.uniform(ks[7], (nd, G), jnp.float32, math.log(1e-3), math.log(1e-1))
    s5_b_re = nrm(ks[8], (nd, G, P, H), (2 * H) ** -0.5)
    s5_b_im = nrm(ks[9], (nd, G, P, H), (2 * H) ** -0.5)
    s5_c_re = nrm(ks[10], (nd, G, H, P), (2 * P) ** -0.5)
    s5_c_im = nrm(ks[11], (nd, G, H, P), (2 * P) ** -0.5)
    s5_d = nrm(ks[12], (nd, G, H), 1.0)
    s5_w_glu = nrm(ks[13], (nd, S5_WIDTH, S5_WIDTH), S5_WIDTH ** -0.5)
    s5_b_glu = nrm(ks[14], (nd, S5_WIDTH), 0.02)
    ssd_conv_w = nrm(ks[15], (nd, SSD_CONV, SSD_XBC), SSD_CONV ** -0.5)
    ssd_conv_b = nrm(ks[16], (nd, SSD_XBC), 0.02)
    dt0 = jnp.exp(jax.random.uniform(ks[17], (nd, SSD_HEADS), jnp.float32, math.log(1e-3), math.log(1e-1)))
    ssd_dt_bias = dt0 + jnp.log(-jnp.expm1(-dt0))
    ssd_a_log = jnp.log(jax.random.uniform(ks[18], (nd, SSD_HEADS), jnp.float32, 1.0, 16.0))
    ssd_d = 1.0 + nrm(ks[19], (nd, SSD_HEADS), 0.1)
    ssd_norm_g = 1.0 + nrm(ks[20], (nd, SSD_WIDTH), 0.02)
    mem_w_kv = nrm(ks[21], (nd, D_MODEL, 2 * MEM_WIDTH), D_MODEL ** -0.5)
    w_br_s5 = nrm(ks[22], (nd, S5_WIDTH, D_MODEL), S5_WIDTH ** -0.5)
    w_br_attn = nrm(ks[23], (nd, ATTN_WIDTH, D_MODEL), ATTN_WIDTH ** -0.5)
    w_br_ssd = nrm(ks[24], (nd, SSD_WIDTH, D_MODEL), SSD_WIDTH ** -0.5)
    w_br_mem = nrm(ks[25], (nd, MEM_WIDTH, D_MODEL), MEM_WIDTH ** -0.5)
    w_out = nrm(ks[26], (nd, D_MODEL, D_MODEL), DEEPNORM_BETA * D_MODEL ** -0.5)
    ln_g = 1.0 + nrm(ks[27], (nd, D_MODEL), 0.02)
    ln_b = nrm(ks[28], (nd, D_MODEL), 0.02)
    return {"x": x, "mem": mem, "positions": positions, "w_in": w_in, "b_gate": b_gate,
            "s5_lam_re": s5_lam_re, "s5_lam_im": s5_lam_im, "s5_log_dt": s5_log_dt,
            "s5_b_re": s5_b_re, "s5_b_im": s5_b_im, "s5_c_re": s5_c_re, "s5_c_im": s5_c_im,
            "s5_d": s5_d, "s5_w_glu": s5_w_glu, "s5_b_glu": s5_b_glu,
            "ssd_conv_w": ssd_conv_w, "ssd_conv_b": ssd_conv_b, "ssd_dt_bias": ssd_dt_bias,
            "ssd_a_log": ssd_a_log, "ssd_d": ssd_d, "ssd_norm_g": ssd_norm_g,
            "mem_w_kv": mem_w_kv, "w_br_s5": w_br_s5, "w_br_attn": w_br_attn,
            "w_br_ssd": w_br_ssd, "w_br_mem": w_br_mem, "w_out": w_out,
            "ln_g": ln_g, "ln_b": ln_b}


def reference(x, mem, positions, w_in, b_gate, s5_lam_re, s5_lam_im, s5_log_dt, s5_b_re, s5_b_im,
              s5_c_re, s5_c_im, s5_d, s5_w_glu, s5_b_glu, ssd_conv_w, ssd_conv_b, ssd_dt_bias,
              ssd_a_log, ssd_d, ssd_norm_g, mem_w_kv, w_br_s5, w_br_attn, w_br_ssd, w_br_mem,
              w_out, ln_g, ln_b):
    bsz, L, _ = x.shape
    idx_scale = (IDX_HEADS ** -0.5) * (IDX_DIM ** -0.5)
    for i in range(DEPTH):
        p = split_columns(x @ w_in[i])
        y_s5 = s5_mixer(p['s5_u'], s5_lam_re[i], s5_lam_im[i], s5_log_dt[i], s5_b_re[i], s5_b_im[i],
                        s5_c_re[i], s5_c_im[i], s5_d[i], s5_w_glu[i], s5_b_glu[i])
        y_s5 = y_s5 * jax.nn.silu(p['s5_z'])
        q = partial_rope(p['att_q'].reshape(bsz, L, ATTN_HEADS, HEAD_DIM), positions)
        k = partial_rope(p['att_k'].reshape(bsz, L, ATTN_KV_HEADS, HEAD_DIM), positions)
        v = p['att_v'].reshape(bsz, L, ATTN_KV_HEADS, HEAD_DIM)
        qi = partial_rope(p['idx_q'].reshape(bsz, L, IDX_HEADS, IDX_DIM), positions)
        ki = partial_rope(p['idx_k'].reshape(bsz, L, 1, IDX_DIM), positions)[:, :, 0]
        wi = p['idx_w'] * idx_scale
        y_att = dsa_attention(q, k, v, qi, ki, wi) * jax.nn.silu(p['att_z'])
        y_ssd = ssd_mixer(p['ssd_z'], p['ssd_xbc'], p['ssd_dt'], ssd_conv_w[i], ssd_conv_b[i],
                          ssd_dt_bias[i], ssd_a_log[i], ssd_d[i], ssd_norm_g[i])
        mk, mv = jnp.split(mem @ mem_w_kv[i], 2, axis=-1)
        y_mem = memory_attention(p['mem_q'].reshape(bsz, L, MEM_HEADS, HEAD_DIM),
                                 mk.reshape(bsz, MEM_LEN, MEM_HEADS, HEAD_DIM),
                                 mv.reshape(bsz, MEM_LEN, MEM_HEADS, HEAD_DIM)).reshape(bsz, L, MEM_WIDTH)
        y_mem = y_mem * jax.nn.silu(p['mem_z'])
        g = jax.nn.sigmoid(p['gates'] + b_gate[i]).reshape(bsz, L, N_BRANCH, D_MODEL)
        merged = (g[:, :, 0] * (y_s5 @ w_br_s5[i]) + g[:, :, 1] * (y_att @ w_br_attn[i])
                  + g[:, :, 2] * (y_ssd @ w_br_ssd[i]) + g[:, :, 3] * (y_mem @ w_br_mem[i]))
        out = merged @ w_out[i]
        x = layer_norm(DEEPNORM_ALPHA * x + out, ln_g[i], ln_b[i])
    return x
```

```cpp
#include <hip/hip_runtime.h>
#include <hip/hip_cooperative_groups.h>
#include <cstdio>
#include <cmath>
namespace cg = cooperative_groups;

#ifndef MK_COOP
#define MK_COOP 1
#endif

typedef unsigned short bf;
typedef short bf16x8 __attribute__((ext_vector_type(8)));
typedef float f32x16 __attribute__((ext_vector_type(16)));
typedef float f32x4 __attribute__((ext_vector_type(4)));

#define TT 32768
#define LSEQ 16384
#define DM 2048
#define INW 13908
#define PW 5760
#define C_S5U 0
#define C_S5Z 512
#define C_ATQ 1024
#define C_ATK 1536
#define C_ATV 1664
#define C_ATZ 1792
#define C_IDQ 2304
#define C_IDK 2560
#define C_IDW 2624
#define C_SSZ 2640
#define C_XBC 3664
#define C_SDT 5200
#define C_MEQ 5216
#define C_MEZ 5472
#define YW 2304
#define Y_S5 0
#define Y_ATT 512
#define Y_SSD 1024
#define Y_MEM 2048
#define CAP 448

struct Params {
  const float *x, *mem; const int* pos;
  const float *w_in, *b_gate, *lam_re, *lam_im, *log_dt, *b_re, *b_im, *c_re, *c_im, *s5_d, *w_glu, *b_glu,
      *conv_w, *conv_b, *dt_bias, *a_log, *ssd_d, *norm_g, *mem_w_kv, *w_br_s5, *w_br_attn, *w_br_ssd, *w_br_mem,
      *w_out, *ln_g, *ln_b;
  float* out;
  bf *WinT, *WbrT, *WoutT, *WgluT, *WmemT, *memb, *xb, *P, *Y, *YG, *KIF, *MK, *MVT, *CM;
  float *ST, *CS, *END, *CD, *SB, *SA;
  float inv[8];
};

__device__ __forceinline__ int otid() { int t = threadIdx.x; asm volatile("" : "+v"(t)); return t; }
__device__ __forceinline__ float bf2f(bf v) { return __uint_as_float(((unsigned)v) << 16); }
__device__ __forceinline__ float bflo(unsigned u) { return __uint_as_float(u << 16); }
__device__ __forceinline__ float bfhi(unsigned u) { return __uint_as_float(u & 0xFFFF0000u); }
__device__ __forceinline__ unsigned pk2(float lo, float hi) {
  unsigned r; asm("v_cvt_pk_bf16_f32 %0, %1, %2" : "=v"(r) : "v"(lo), "v"(hi)); return r;
}
__device__ __forceinline__ bf f2bf(float f) { return (bf)(pk2(f, 0.f) & 0xFFFFu); }
__device__ __forceinline__ float sigmoidf_(float x) { return 1.f / (1.f + __expf(-x)); }
__device__ __forceinline__ float siluf_(float x) { return x / (1.f + __expf(-x)); }
__device__ __forceinline__ float geluf_(float x) {
  float u = 0.7978845608028654f * (x + 0.044715f * x * x * x);
  float t = 1.f - 2.f / (1.f + __expf(2.f * u));
  return 0.5f * x * (1.f + t);
}
__device__ __forceinline__ f32x16 mfma32(bf16x8 a, bf16x8 b, f32x16 c) { return __builtin_amdgcn_mfma_f32_32x32x16_bf16(a, b, c, 0, 0, 0); }
__device__ __forceinline__ f32x4 mfma16(bf16x8 a, bf16x8 b, f32x4 c) { return __builtin_amdgcn_mfma_f32_16x16x32_bf16(a, b, c, 0, 0, 0); }

__device__ __forceinline__ bool tile_map(int L, int nMt, int nNt, int SM, int SN, int& tm, int& tn) {
  int per = SM * SN; int x = L & 7; int jj = L >> 3; int sl = jj / per; int j = jj - sl * per; int S = sl * 8 + x;
  int nSn = nNt / SN; int NS = (nMt / SM) * nSn;
  if (S >= NS) return false;
  int mg = S / nSn, ng = S - mg * nSn;
  tm = mg * SM + j / SN; tn = ng * SN + j % SN; return true;
}

__device__ __forceinline__ void gemm_acc(const bf* __restrict__ A, int lda, const bf* __restrict__ Bt, int ldb, int K,
                                         f32x16 (&acc)[2][2], char* sm) {
  const int tid = otid(), lane = tid & 63, w = tid >> 6, wr = w >> 1, wc = w & 1, r32 = lane & 31, h5 = lane >> 5;
  const int lrow = tid >> 2, lch = tid & 3;
  const bf* ga = A + (size_t)lrow * lda + lch * 8;
  const bf* gb = Bt + (size_t)lrow * ldb + lch * 8;
  const size_t a64 = (size_t)64 * lda, b64 = (size_t)64 * ldb;
  uint4 ra0 = *(const uint4*)ga, ra1 = *(const uint4*)(ga + a64);
  uint4 rb0 = *(const uint4*)gb, rb1 = *(const uint4*)(gb + b64);
  char* sA = sm; char* sB = sm + 20480;
  const int woff = lrow * 80 + lch * 16;
  *(uint4*)(sA + woff) = ra0; *(uint4*)(sA + woff + 5120) = ra1;
  *(uint4*)(sB + woff) = rb0; *(uint4*)(sB + woff + 5120) = rb1;
  __syncthreads();
  const int nk = K >> 5;
  const int aoff = (wr * 64 + r32) * 80 + h5 * 16, boff = (wc * 64 + r32) * 80 + h5 * 16;
  for (int kt = 0; kt < nk; kt++) {
    const int cur = (kt & 1) * 10240;
    const bool more = (kt + 1 < nk);
    if (more) {
      ga += 32; gb += 32;
      ra0 = *(const uint4*)ga; ra1 = *(const uint4*)(ga + a64);
      rb0 = *(const uint4*)gb; rb1 = *(const uint4*)(gb + b64);
    }
#pragma unroll
    for (int ks = 0; ks < 2; ks++) {
      bf16x8 a0 = *(const bf16x8*)(sA + cur + aoff + ks * 32);
      bf16x8 a1 = *(const bf16x8*)(sA + cur + aoff + 2560 + ks * 32);
      bf16x8 b0 = *(const bf16x8*)(sB + cur + boff + ks * 32);
      bf16x8 b1 = *(const bf16x8*)(sB + cur + boff + 2560 + ks * 32);
      acc[0][0] = mfma32(b0, a0, acc[0][0]);
      acc[0][1] = mfma32(b1, a0, acc[0][1]);
      acc[1][0] = mfma32(b0, a1, acc[1][0]);
      acc[1][1] = mfma32(b1, a1, acc[1][1]);
    }
    if (more) {
      const int nxt = 10240 - cur;
      *(uint4*)(sA + nxt + woff) = ra0; *(uint4*)(sA + nxt + woff + 5120) = ra1;
      *(uint4*)(sB + nxt + woff) = rb0; *(uint4*)(sB + nxt + woff + 5120) = rb1;
    }
    __syncthreads();
  }
}
#define ZERO_ACC(a) { for (int i_ = 0; i_ < 2; i_++) for (int j_ = 0; j_ < 2; j_++) for (int r_ = 0; r_ < 16; r_++) a[i_][j_][r_] = 0.f; }

__device__ void transpose_tile(const float* __restrict__ src, int R, int C, bf* __restrict__ dst, int ldd, int off, int tile, bf* sm) {
  const int tilesC = (C + 63) >> 6;
  const int tr = tile / tilesC, tc = tile - tr * tilesC;
  const int r0 = tr * 64, c0 = tc * 64;
  const int tid = otid();
#pragma unroll
  for (int i = 0; i < 4; i++) {
    int r = (tid >> 4) + 16 * i; int c = (tid & 15) * 4;
    float4 v = make_float4(0.f, 0.f, 0.f, 0.f);
    if (c0 + c < C) v = *(const float4*)(src + (size_t)(r0 + r) * C + c0 + c);
    sm[(c + 0) * 66 + r] = f2bf(v.x); sm[(c + 1) * 66 + r] = f2bf(v.y);
    sm[(c + 2) * 66 + r] = f2bf(v.z); sm[(c + 3) * 66 + r] = f2bf(v.w);
  }
  __syncthreads();
  {
    int c = tid >> 2, ch = (tid & 3) * 16;
    if (c0 + c < C) {
      unsigned wv[8];
#pragma unroll
      for (int k = 0; k < 8; k++) wv[k] = *(const unsigned*)(sm + c * 66 + ch + 2 * k);
      bf* d = dst + (size_t)(c0 + c) * ldd + off + r0 + ch;
      *(uint4*)d = make_uint4(wv[0], wv[1], wv[2], wv[3]);
      *(uint4*)(d + 8) = make_uint4(wv[4], wv[5], wv[6], wv[7]);
    }
  }
  __syncthreads();
}

__device__ __forceinline__ bool try_tr(int& t, const float* src, int R, int C, bf* dst, int ldd, int off, bf* sm) {
  int nt = (R >> 6) * ((C + 63) >> 6);
  if (t < nt) { transpose_tile(src, R, C, dst, ldd, off, t, sm); return true; }
  t -= nt; return false;
}

__device__ void phase0(const Params& p, char* smc) {
  bf* sm = (bf*)smc;
  const int perLayer = 32 * 218 + 256 + 256 + 512 + 128 + 1024 + 64 + 256;
  for (int task = blockIdx.x; task < 2 * perLayer; task += gridDim.x) {
    int layer = task / perLayer; int t = task - layer * perLayer;
    bf* WbrL = p.WbrT + (size_t)layer * 2048 * YW;
    if (try_tr(t, p.w_in + (size_t)layer * DM * INW, 2048, INW, p.WinT + (size_t)layer * INW * 2048, 2048, 0, sm)) continue;
    if (try_tr(t, p.w_br_s5 + (size_t)layer * 512 * 2048, 512, 2048, WbrL, YW, 0, sm)) continue;
    if (try_tr(t, p.w_br_attn + (size_t)layer * 512 * 2048, 512, 2048, WbrL, YW, 512, sm)) continue;
    if (try_tr(t, p.w_br_ssd + (size_t)layer * 1024 * 2048, 1024, 2048, WbrL, YW, 1024, sm)) continue;
    if (try_tr(t, p.w_br_mem + (size_t)layer * 256 * 2048, 256, 2048, WbrL, YW, 2048, sm)) continue;
    if (try_tr(t, p.w_out + (size_t)layer * 2048 * 2048, 2048, 2048, p.WoutT + (size_t)layer * 2048 * 2048, 2048, 0, sm)) continue;
    if (try_tr(t, p.w_glu + (size_t)layer * 512 * 512, 512, 512, p.WgluT + (size_t)layer * 512 * 512, 512, 0, sm)) continue;
    if (try_tr(t, p.mem_w_kv + (size_t)layer * 2048 * 512, 2048, 512, p.WmemT + (size_t)layer * 512 * 2048, 2048, 0, sm)) continue;
  }
  const size_t gtid = (size_t)blockIdx.x * 256 + otid(), gstr = (size_t)gridDim.x * 256;
  for (size_t i = gtid; i < (size_t)TT * DM / 8; i += gstr) {
    float4 a = *(const float4*)(p.x + i * 8), b = *(const float4*)(p.x + i * 8 + 4);
    *(uint4*)(p.xb + i * 8) = make_uint4(pk2(a.x, a.y), pk2(a.z, a.w), pk2(b.x, b.y), pk2(b.z, b.w));
  }
  for (size_t i = gtid; i < (size_t)512 * DM / 8; i += gstr) {
    float4 a = *(const float4*)(p.mem + i * 8), b = *(const float4*)(p.mem + i * 8 + 4);
    *(uint4*)(p.memb + i * 8) = make_uint4(pk2(a.x, a.y), pk2(a.z, a.w), pk2(b.x, b.y), pk2(b.z, b.w));
  }
  for (size_t i = gtid; i < (size_t)TT * 8; i += gstr) {
    int t = (int)(i >> 3), j = (int)(i & 7);
    float ang = (float)p.pos[t] * p.inv[j];
    float s, c; sincosf(ang, &s, &c);
    p.CS[(size_t)t * 16 + j] = c; p.CS[(size_t)t * 16 + 8 + j] = s;
  }
  for (size_t i = gtid; i < 2 * 32 * 64; i += gstr) {
    int pp = (int)(i & 63), g = (int)((i >> 6) & 31), layer = (int)(i >> 11);
    float dt = expf(p.log_dt[layer * 32 + g]);
    float lr = p.lam_re[i], li = p.lam_im[i];
    float mag = expf(lr * dt);
    float sn, cs; sincosf(li * dt, &sn, &cs);
    float ar = mag * cs, ai = mag * sn;
    float den = lr * lr + li * li;
    float nr = ar - 1.f, ni = ai;
    float fr = (nr * lr + ni * li) / den, fi = (ni * lr - nr * li) / den;
    float* sb = p.SB + i * 32;
    const float* bre = p.b_re + i * 16; const float* bim = p.b_im + i * 16;
    for (int h = 0; h < 16; h++) {
      float br = bre[h], bi = bim[h];
      sb[h] = fr * br - fi * bi; sb[16 + h] = fr * bi + fi * br;
    }
    float pr = ar, pi = ai;
    for (int k = 0; k < 7; k++) { float nr2 = pr * pr - pi * pi, ni2 = 2.f * pr * pi; pr = nr2; pi = ni2; }
    p.SA[i * 4 + 0] = ar; p.SA[i * 4 + 1] = ai; p.SA[i * 4 + 2] = pr; p.SA[i * 4 + 3] = pi;
    for (int h = 0; h < 16; h++) {
      size_t ci = ((size_t)(layer * 32 + g) * 16 + h);
      p.CM[ci * 128 + pp] = f2bf(p.c_re[ci * 64 + pp]);
      p.CM[ci * 128 + 64 + pp] = f2bf(-p.c_im[ci * 64 + pp]);
    }
  }
}

__device__ void phaseA(const Params& p, int layer, char* sm) {
  const int tid = otid(), lane = tid & 63, w = tid >> 6, wr = w >> 1, wc = w & 1, r32 = lane & 31, h5 = lane >> 5;
  const bf* Wl = p.WinT + (size_t)layer * INW * 2048;
  const int total = 36 * 8 * 40;
  for (int L = blockIdx.x; L < total; L += gridDim.x) {
    int tm, tn; if (!tile_map(L, 256, 45, 8, 5, tm, tn)) continue;
    f32x16 acc[2][2]; ZERO_ACC(acc);
    gemm_acc(p.xb + (size_t)tm * 128 * 2048, 2048, Wl + (size_t)tn * 128 * 2048, 2048, 2048, acc, sm);
    const int m0 = tm * 128, n0 = tn * 128;
#pragma unroll
    for (int i = 0; i < 2; i++) {
      const int tok = m0 + wr * 64 + i * 32 + r32;
#pragma unroll
      for (int j = 0; j < 2; j++) {
        const int nb = n0 + wc * 64 + j * 32;
        if (j == 0 && ((nb >= C_ATQ && nb < C_ATV) || (nb >= C_IDQ && nb < C_IDW))) {
          f32x4 cs = *(const f32x4*)(p.CS + (size_t)tok * 16 + 4 * h5);
          f32x4 sn = *(const f32x4*)(p.CS + (size_t)tok * 16 + 8 + 4 * h5);
#pragma unroll
          for (int e = 0; e < 4; e++) {
            float x1 = acc[i][j][e], x2 = acc[i][j][4 + e];
            acc[i][j][e] = x1 * cs[e] - x2 * sn[e];
            acc[i][j][4 + e] = x2 * cs[e] + x1 * sn[e];
          }
        }
#pragma unroll
        for (int q = 0; q < 4; q++) {
          const int n = nb + q * 8 + h5 * 4;
          if (n < 5716) {
            const int dn = n + (n >= 2628 ? 12 : 0);
            uint2 v = make_uint2(pk2(acc[i][j][4 * q], acc[i][j][4 * q + 1]), pk2(acc[i][j][4 * q + 2], acc[i][j][4 * q + 3]));
            *(uint2*)(p.P + (size_t)tok * PW + dn) = v;
            if (n >= C_IDK && n < C_IDW) {
              const int d = n - C_IDK; const int b = tok >> 14, li = tok & 16383;
              size_t o = ((((size_t)(b * 512 + (li >> 5)) * 4 + (d >> 4)) * 64 + ((d >> 3) & 1) * 32 + (li & 31)) * 8) + (d & 7);
              *(uint2*)(p.KIF + o) = v;
            }
          }
        }
      }
    }
  }
  if (layer == 0) {
    for (int L = blockIdx.x; L < 32; L += gridDim.x) {
      const int ly = L >> 4, tm = (L >> 2) & 3, tn = L & 3;
      f32x16 acc[2][2]; ZERO_ACC(acc);
      gemm_acc(p.memb + (size_t)tm * 128 * 2048, 2048, p.WmemT + ((size_t)ly * 512 + tn * 128) * 2048, 2048, 2048, acc, sm);
#pragma unroll
      for (int i = 0; i < 2; i++) {
        const int row = tm * 128 + wr * 64 + i * 32 + r32; const int b = row >> 8, m = row & 255;
#pragma unroll
        for (int j = 0; j < 2; j++)
#pragma unroll
          for (int q = 0; q < 4; q++) {
            const int n = tn * 128 + wc * 64 + j * 32 + q * 8 + h5 * 4;
#pragma unroll
            for (int e = 0; e < 4; e++) {
              const int nn = n + e; const float v = acc[i][j][4 * q + e];
              if (nn < 256) { int h = nn >> 6, d = nn & 63; p.MK[((((size_t)ly * 2 + b) * 4 + h) * 256 + m) * 64 + d] = f2bf(v); }
              else { int h = (nn - 256) >> 6, d = nn & 63; p.MVT[((((size_t)ly * 2 + b) * 4 + h) * 64 + d) * 256 + m] = f2bf(v); }
            }
          }
      }
    }
  }
}

__device__ __forceinline__ float softplusf_(float x) { return x > 15.f ? x : log1pf(__expf(x)); }

__device__ __forceinline__ void ssd_dt_acs(const Params& p, int layer, size_t tok0, int gg, float* sAcs, float* sDt) {
  const int tid = otid(), lane = tid & 63, w = tid >> 6;
#pragma unroll
  for (int k = 0; k < 2; k++) {
    const int hh = 2 * w + k, hd = gg * 8 + hh;
    const float bias = p.dt_bias[layer * 16 + hd], a = -__expf(p.a_log[layer * 16 + hd]);
    const int l0 = 2 * lane;
    float d0 = softplusf_(bf2f(p.P[(tok0 + l0) * PW + C_SDT + hd]) + bias);
    float d1 = softplusf_(bf2f(p.P[(tok0 + l0 + 1) * PW + C_SDT + hd]) + bias);
    float s0 = d0 * a, s1 = s0 + d1 * a;
    float xs = s1;
#pragma unroll
    for (int off = 1; off < 64; off <<= 1) { float v = __shfl_up(xs, off); if (lane >= off) xs += v; }
    float ex = xs - s1;
    sAcs[l0 * 8 + hh] = ex + s0; sAcs[(l0 + 1) * 8 + hh] = ex + s1;
    sDt[l0 * 8 + hh] = d0; sDt[(l0 + 1) * 8 + hh] = d1;
  }
}

struct Conv2 { float w0[4], w1[4], b0, b1, h0[3], h1[3]; };
__device__ __forceinline__ void conv_init(const Params& p, int layer, size_t tokb, int l, int ch, Conv2& c) {
  const float* cw = p.conv_w + (size_t)layer * 4 * 1536 + ch;
#pragma unroll
  for (int k = 0; k < 4; k++) { c.w0[k] = cw[k * 1536]; c.w1[k] = cw[k * 1536 + 1]; }
  c.b0 = p.conv_b[layer * 1536 + ch]; c.b1 = p.conv_b[layer * 1536 + ch + 1];
#pragma unroll
  for (int k = 0; k < 3; k++) {
    int ll = l - 3 + k; unsigned u = 0;
    if (ll >= 0) u = *(const unsigned*)(p.P + (tokb + ll) * PW + C_XBC + ch);
    c.h0[k] = bflo(u); c.h1[k] = bfhi(u);
  }
}
__device__ __forceinline__ void conv_step(const Params& p, size_t tokb, int l, int ch, Conv2& c, float& o0, float& o1) {
  unsigned u = *(const unsigned*)(p.P + (tokb + l) * PW + C_XBC + ch);
  float x0 = bflo(u), x1 = bfhi(u);
  float a0 = c.b0 + c.w0[0] * c.h0[0] + c.w0[1] * c.h0[1] + c.w0[2] * c.h0[2] + c.w0[3] * x0;
  float a1 = c.b1 + c.w1[0] * c.h1[0] + c.w1[1] * c.h1[1] + c.w1[2] * c.h1[2] + c.w1[3] * x1;
  c.h0[0] = c.h0[1]; c.h0[1] = c.h0[2]; c.h0[2] = x0;
  c.h1[0] = c.h1[1]; c.h1[1] = c.h1[2]; c.h1[2] = x1;
  o0 = siluf_(a0); o1 = siluf_(a1);
}

__device__ void ssd_pass1(const Params& p, int layer, int task, char* sm) {
  const int tid = otid(), lane = tid & 63, w = tid >> 6, r32 = lane & 31, h5 = lane >> 5;
  const int gg = task & 1, c = (task >> 1) & 127, b = task >> 8;
  const size_t tokb = (size_t)b * LSEQ; const int lc0 = c * 128; const size_t tok0 = tokb + lc0;
  float* sAcs = (float*)sm; float* sDt = (float*)(sm + 4096);
  bf* sBT = (bf*)(sm + 8192); bf* sXT = (bf*)(sm + 43008);
  __syncthreads();
  ssd_dt_acs(p, layer, tok0, gg, sAcs, sDt);
  {
    const int cp = tid & 63, tg = tid >> 6; const int ch = 1024 + gg * 128 + 2 * cp;
    Conv2 cv; conv_init(p, layer, tokb, lc0 + tg * 32, ch, cv);
    for (int l = tg * 32; l < tg * 32 + 32; l += 2) {
      float a0, a1, b0, b1;
      conv_step(p, tokb, lc0 + l, ch, cv, a0, a1);
      conv_step(p, tokb, lc0 + l + 1, ch, cv, b0, b1);
      *(unsigned*)(sBT + (2 * cp) * 136 + l) = pk2(a0, b0);
      *(unsigned*)(sBT + (2 * cp + 1) * 136 + l) = pk2(a1, b1);
    }
  }
  __syncthreads();
  if (tid < 8) p.CD[((size_t)(b * 128 + c)) * 16 + gg * 8 + tid] = __expf(sAcs[127 * 8 + tid]);
  for (int hh = 0; hh < 8; hh++) {
    const int hd = gg * 8 + hh;
    if (hh) __syncthreads();
    {
      const int cp = tid & 31, tg = tid >> 5; const int ch = gg * 512 + hh * 64 + 2 * cp;
      const float aend = sAcs[127 * 8 + hh];
      Conv2 cv; conv_init(p, layer, tokb, lc0 + tg * 16, ch, cv);
      for (int l = tg * 16; l < tg * 16 + 16; l += 2) {
        float a0, a1, b0, b1;
        conv_step(p, tokb, lc0 + l, ch, cv, a0, a1);
        conv_step(p, tokb, lc0 + l + 1, ch, cv, b0, b1);
        float sa = sDt[l * 8 + hh] * __expf(aend - sAcs[l * 8 + hh]);
        float sb = sDt[(l + 1) * 8 + hh] * __expf(aend - sAcs[(l + 1) * 8 + hh]);
        *(unsigned*)(sXT + (2 * cp) * 136 + l) = pk2(a0 * sa, b0 * sb);
        *(unsigned*)(sXT + (2 * cp + 1) * 136 + l) = pk2(a1 * sa, b1 * sb);
      }
    }
    __syncthreads();
    f32x16 acc[2];
#pragma unroll
    for (int r = 0; r < 16; r++) { acc[0][r] = 0.f; acc[1][r] = 0.f; }
#pragma unroll
    for (int ks = 0; ks < 8; ks++) {
      bf16x8 bfr = *(const bf16x8*)(sBT + (32 * w + r32) * 136 + ks * 16 + 8 * h5);
      bf16x8 x0 = *(const bf16x8*)(sXT + (r32) * 136 + ks * 16 + 8 * h5);
      bf16x8 x1 = *(const bf16x8*)(sXT + (32 + r32) * 136 + ks * 16 + 8 * h5);
      acc[0] = mfma32(x0, bfr, acc[0]);
      acc[1] = mfma32(x1, bfr, acc[1]);
    }
    float* st = p.ST + ((size_t)(b * 128 + c) * 16 + hd) * 64 * 128;
#pragma unroll
    for (int pi = 0; pi < 2; pi++)
#pragma unroll
      for (int r = 0; r < 16; r++) {
        int pp = 32 * pi + 8 * (r >> 2) + 4 * h5 + (r & 3);
        st[pp * 128 + 32 * w + r32] = acc[pi][r];
      }
  }
}

__device__ void ssd_statepass(const Params& p, int task) {
  const int idx = task * 256 + otid();
  const int b = idx >> 15, e4 = idx & 32767;
  const int hd = e4 >> 11;
  float4 carry = make_float4(0.f, 0.f, 0.f, 0.f);
  float* base = p.ST + (size_t)b * 128 * 131072 + (size_t)e4 * 4;
  const float* cd = p.CD + (size_t)b * 128 * 16 + hd;
  for (int c0 = 0; c0 < 128; c0 += 4) {
    float4 v[4]; float d[4];
#pragma unroll
    for (int k = 0; k < 4; k++) { v[k] = *(const float4*)(base + (size_t)(c0 + k) * 131072); d[k] = cd[(c0 + k) * 16]; }
#pragma unroll
    for (int k = 0; k < 4; k++) {
      *(float4*)(base + (size_t)(c0 + k) * 131072) = carry;
      carry.x = carry.x * d[k] + v[k].x; carry.y = carry.y * d[k] + v[k].y;
      carry.z = carry.z * d[k] + v[k].z; carry.w = carry.w * d[k] + v[k].w;
    }
  }
}

__device__ void ssd_pass2(const Params& p, int layer, int task, char* sm) {
  const int tid = otid(), lane = tid & 63, w = tid >> 6, r32 = lane & 31, h5 = lane >> 5;
  const int lh = task & 1, gg = (task >> 1) & 1, c = (task >> 2) & 127, b = task >> 9;
  const size_t tokb = (size_t)b * LSEQ; const int lc0 = c * 128; const size_t tok0 = tokb + lc0;
  float* sAcs = (float*)sm; float* sDt = (float*)(sm + 4096);
  bf* sC = (bf*)(sm + 8192); bf* sB = (bf*)(sm + 25600); bf* sM = (bf*)(sm + 25600); bf* sXT = (bf*)(sm + 43008);
  float* sSsq = (float*)(sm + 60416);
  const int wr = w >> 1, wc = w & 1;
  const int nS = 64 * (lh + 1);
  __syncthreads();
  ssd_dt_acs(p, layer, tok0, gg, sAcs, sDt);
  if (tid < 64) sSsq[tid] = 0.f;
  {
    const int cp = tid & 63, tg = tid >> 6;
    {
      const int ch = 1280 + gg * 128 + 2 * cp;
      const int lst = 64 * lh + tg * 16;
      Conv2 cv; conv_init(p, layer, tokb, lc0 + lst, ch, cv);
      for (int l = lst; l < lst + 16; l++) {
        float a0, a1; conv_step(p, tokb, lc0 + l, ch, cv, a0, a1);
        *(unsigned*)(sC + (l - 64 * lh) * 136 + 2 * cp) = pk2(a0, a1);
      }
    }
    {
      const int ch = 1024 + gg * 128 + 2 * cp;
      const int per = nS >> 2; const int lst = tg * per;
      Conv2 cv; conv_init(p, layer, tokb, lc0 + lst, ch, cv);
      for (int l = lst; l < lst + per; l++) {
        float a0, a1; conv_step(p, tokb, lc0 + l, ch, cv, a0, a1);
        *(unsigned*)(sB + l * 136 + 2 * cp) = pk2(a0, a1);
      }
    }
  }
  __syncthreads();
  f32x16 cb[2];
#pragma unroll
  for (int r = 0; r < 16; r++) { cb[0][r] = 0.f; cb[1][r] = 0.f; }
  if (64 * wc < nS) {
#pragma unroll
    for (int ks = 0; ks < 8; ks++) {
      bf16x8 af = *(const bf16x8*)(sC + (32 * wr + r32) * 136 + ks * 16 + 8 * h5);
      bf16x8 b0 = *(const bf16x8*)(sB + (64 * wc + r32) * 136 + ks * 16 + 8 * h5);
      bf16x8 b1 = *(const bf16x8*)(sB + (64 * wc + 32 + r32) * 136 + ks * 16 + 8 * h5);
      cb[0] = mfma32(af, b0, cb[0]);
      cb[1] = mfma32(af, b1, cb[1]);
    }
  }
  __syncthreads();
  const int wc2 = w & 1;
  for (int hh = 0; hh < 8; hh++) {
    const int hd = gg * 8 + hh;
    if (hh) __syncthreads();
    {
      const float dsk = p.ssd_d[layer * 16 + hd];
#pragma unroll
      for (int j = 0; j < 2; j++) {
        const int s = 64 * wc + 32 * j + r32;
        if (s < nS) {
          const float as = sAcs[s * 8 + hh];
#pragma unroll
          for (int r = 0; r < 16; r++) {
            const int lp = 32 * wr + 8 * (r >> 2) + 4 * h5 + (r & 3); const int l = 64 * lh + lp;
            float v = 0.f;
            if (s <= l) v = cb[j][r] * __expf(sAcs[l * 8 + hh] - as);
            if (s == l) v += dsk / sDt[l * 8 + hh];
            sM[lp * 136 + s] = f2bf(v);
          }
        }
      }
    }
    {
      const int cp = tid & 31, tg = tid >> 5; const int ch = gg * 512 + hh * 64 + 2 * cp;
      const int per = nS >> 3; const int lst = tg * per;
      Conv2 cv; conv_init(p, layer, tokb, lc0 + lst, ch, cv);
      for (int l = lst; l < lst + per; l += 2) {
        float a0, a1, b0, b1;
        conv_step(p, tokb, lc0 + l, ch, cv, a0, a1);
        conv_step(p, tokb, lc0 + l + 1, ch, cv, b0, b1);
        float sa = sDt[l * 8 + hh], sb = sDt[(l + 1) * 8 + hh];
        *(unsigned*)(sXT + (2 * cp) * 136 + l) = pk2(a0 * sa, b0 * sb);
        *(unsigned*)(sXT + (2 * cp + 1) * 136 + l) = pk2(a1 * sa, b1 * sb);
      }
    }
    __syncthreads();
    f32x16 yd, yo;
#pragma unroll
    for (int r = 0; r < 16; r++) { yd[r] = 0.f; yo[r] = 0.f; }
    const int nks = nS >> 4;
    for (int ks = 0; ks < nks; ks++) {
      bf16x8 xf = *(const bf16x8*)(sXT + (32 * wc2 + r32) * 136 + ks * 16 + 8 * h5);
      bf16x8 mf = *(const bf16x8*)(sM + (32 * wr + r32) * 136 + ks * 16 + 8 * h5);
      yd = mfma32(xf, mf, yd);
    }
    {
      const float* pv = p.ST + (((size_t)(b * 128 + c) * 16 + hd) * 64 + 32 * wc2 + r32) * 128 + 8 * h5;
#pragma unroll
      for (int ks = 0; ks < 8; ks++) {
        float4 u0 = *(const float4*)(pv + ks * 16), u1 = *(const float4*)(pv + ks * 16 + 4);
        bf16x8 pf;
        unsigned q0 = pk2(u0.x, u0.y), q1 = pk2(u0.z, u0.w), q2 = pk2(u1.x, u1.y), q3 = pk2(u1.z, u1.w);
        pf[0] = (short)(q0 & 0xFFFF); pf[1] = (short)(q0 >> 16); pf[2] = (short)(q1 & 0xFFFF); pf[3] = (short)(q1 >> 16);
        pf[4] = (short)(q2 & 0xFFFF); pf[5] = (short)(q2 >> 16); pf[6] = (short)(q3 & 0xFFFF); pf[7] = (short)(q3 >> 16);
        bf16x8 cf = *(const bf16x8*)(sC + (32 * wr + r32) * 136 + ks * 16 + 8 * h5);
        yo = mfma32(pf, cf, yo);
      }
    }
    {
      const int lp = 32 * wr + r32; const int l = 64 * lh + lp; const size_t tok = tok0 + l;
      const float eo = __expf(sAcs[l * 8 + hh]);
      float ss = 0.f;
#pragma unroll
      for (int q = 0; q < 4; q++) {
        const int pp = 32 * wc2 + 8 * q + 4 * h5;
        uint2 zz = *(const uint2*)(p.P + tok * PW + C_SSZ + hd * 64 + pp);
        float v0 = (yd[4 * q] + eo * yo[4 * q]) * siluf_(bflo(zz.x));
        float v1 = (yd[4 * q + 1] + eo * yo[4 * q + 1]) * siluf_(bfhi(zz.x));
        float v2 = (yd[4 * q + 2] + eo * yo[4 * q + 2]) * siluf_(bflo(zz.y));
        float v3 = (yd[4 * q + 3] + eo * yo[4 * q + 3]) * siluf_(bfhi(zz.y));
        ss += v0 * v0 + v1 * v1 + v2 * v2 + v3 * v3;
        *(uint2*)(p.Y + tok * YW + Y_SSD + hd * 64 + pp) = make_uint2(pk2(v0, v1), pk2(v2, v3));
      }
      atomicAdd(&sSsq[lp], ss);
    }
  }
  __syncthreads();
  {
    const int lp = tid >> 2, part = tid & 3; const size_t tok = tok0 + 64 * lh + lp;
    const float rs = rsqrtf(sSsq[lp] * (1.f / 512.f) + 1e-5f);
    bf* yp = p.Y + tok * YW + Y_SSD + gg * 512 + part * 128;
    const float* ng = p.norm_g + layer * 1024 + gg * 512 + part * 128;
#pragma unroll 4
    for (int i = 0; i < 16; i++) {
      uint4 u = *(const uint4*)(yp + i * 8);
      float4 g0 = *(const float4*)(ng + i * 8), g1 = *(const float4*)(ng + i * 8 + 4);
      u.x = pk2(bflo(u.x) * rs * g0.x, bfhi(u.x) * rs * g0.y);
      u.y = pk2(bflo(u.y) * rs * g0.z, bfhi(u.y) * rs * g0.w);
      u.z = pk2(bflo(u.z) * rs * g1.x, bfhi(u.z) * rs * g1.y);
      u.w = pk2(bflo(u.w) * rs * g1.z, bfhi(u.w) * rs * g1.w);
      *(uint4*)(yp + i * 8) = u;
    }
  }
}

__device__ __forceinline__ void s5_load_u(const Params& p, size_t tok, int g, float* dst) {
  const uint4* src = (const uint4*)(p.P + tok * PW + C_S5U + g * 16);
  uint4 a = src[0], b = src[1];
  *(float4*)(dst + 0) = make_float4(bflo(a.x), bfhi(a.x), bflo(a.y), bfhi(a.y));
  *(float4*)(dst + 4) = make_float4(bflo(a.z), bfhi(a.z), bflo(a.w), bfhi(a.w));
  *(float4*)(dst + 8) = make_float4(bflo(b.x), bfhi(b.x), bflo(b.y), bfhi(b.y));
  *(float4*)(dst + 12) = make_float4(bflo(b.z), bfhi(b.z), bflo(b.w), bfhi(b.w));
}
#define S5_STEP(uu)                                                                     \
  {                                                                                     \
    float4 u0 = *(const float4*)((uu)), u1 = *(const float4*)((uu) + 4), u2 = *(const float4*)((uu) + 8), u3 = *(const float4*)((uu) + 12); \
    float br = Br[0] * u0.x, bi = Bi[0] * u0.x;                                         \
    br += Br[1] * u0.y; bi += Bi[1] * u0.y; br += Br[2] * u0.z; bi += Bi[2] * u0.z; br += Br[3] * u0.w; bi += Bi[3] * u0.w; \
    br += Br[4] * u1.x; bi += Bi[4] * u1.x; br += Br[5] * u1.y; bi += Bi[5] * u1.y; br += Br[6] * u1.z; bi += Bi[6] * u1.z; br += Br[7] * u1.w; bi += Bi[7] * u1.w; \
    br += Br[8] * u2.x; bi += Bi[8] * u2.x; br += Br[9] * u2.y; bi += Bi[9] * u2.y; br += Br[10] * u2.z; bi += Bi[10] * u2.z; br += Br[11] * u2.w; bi += Bi[11] * u2.w; \
    br += Br[12] * u3.x; bi += Bi[12] * u3.x; br += Br[13] * u3.y; bi += Bi[13] * u3.y; br += Br[14] * u3.z; bi += Bi[14] * u3.z; br += Br[15] * u3.w; bi += Bi[15] * u3.w; \
    float nr_ = ar * sr - ai * si + br; float ni_ = ar * si + ai * sr + bi; sr = nr_; si = ni_; \
  }

__device__ void s5_pass1(const Params& p, int layer, int task, char* sm) {
  const int tid = otid(), lane = tid & 63, w = tid >> 6;
  const int gq = task & 7, c = (task >> 3) & 127, b = task >> 10;
  const int g = gq * 4 + w;
  const size_t tok0 = (size_t)b * LSEQ + c * 128;
  float* sU = (float*)(sm + w * 8192);
  __syncthreads();
  s5_load_u(p, tok0 + lane, g, sU + lane * 16);
  s5_load_u(p, tok0 + 64 + lane, g, sU + (64 + lane) * 16);
  const size_t pi = ((size_t)(layer * 32 + g)) * 64 + lane;
  float Br[16], Bi[16];
#pragma unroll
  for (int h = 0; h < 16; h++) { Br[h] = p.SB[pi * 32 + h]; Bi[h] = p.SB[pi * 32 + 16 + h]; }
  const float ar = p.SA[pi * 4], ai = p.SA[pi * 4 + 1];
  float sr = 0.f, si = 0.f;
  __builtin_amdgcn_wave_barrier();
  for (int l = 0; l < 128; l++) S5_STEP(sU + l * 16)
  *(float2*)(p.END + (((size_t)(b * 128 + c) * 32 + g) * 64 + lane) * 2) = make_float2(sr, si);
}

__device__ void s5_carry(const Params& p, int layer, int task) {
  const int idx = task * 256 + otid();
  const int b = idx >> 11, gp = idx & 2047;
  const size_t pi = (size_t)layer * 2048 + gp;
  const float a128r = p.SA[pi * 4 + 2], a128i = p.SA[pi * 4 + 3];
  float sr = 0.f, si = 0.f;
  float2* e = (float2*)p.END + (size_t)b * 128 * 2048 + gp;
  for (int c0 = 0; c0 < 128; c0 += 4) {
    float2 v[4];
#pragma unroll
    for (int k = 0; k < 4; k++) v[k] = e[(size_t)(c0 + k) * 2048];
#pragma unroll
    for (int k = 0; k < 4; k++) {
      e[(size_t)(c0 + k) * 2048] = make_float2(sr, si);
      float nr = a128r * sr - a128i * si + v[k].x, ni = a128r * si + a128i * sr + v[k].y; sr = nr; si = ni;
    }
  }
}

__device__ void s5_pass2(const Params& p, int layer, int task, char* sm) {
  const int tid = otid(), lane = tid & 63, w = tid >> 6;
  const int c = task & 127, b = task >> 7;
  const size_t tok0 = (size_t)b * LSEQ + c * 128;
  float* sU = (float*)(sm + w * 10752); bf* sS = (bf*)(sm + w * 10752 + 2048);
  __syncthreads();
  for (int gi = 0; gi < 8; gi++) {
    const int g = w * 8 + gi;
    const size_t pi = ((size_t)(layer * 32 + g)) * 64 + lane;
    float Br[16], Bi[16];
#pragma unroll
    for (int h = 0; h < 16; h++) { Br[h] = p.SB[pi * 32 + h]; Bi[h] = p.SB[pi * 32 + 16 + h]; }
    const float ar = p.SA[pi * 4], ai = p.SA[pi * 4 + 1];
    float2 s0 = *(const float2*)(p.END + (((size_t)(b * 128 + c) * 32 + g) * 64 + lane) * 2);
    float sr = s0.x, si = s0.y;
    bf16x8 cf[4];
    {
      const bf* cm = p.CM + (((size_t)(layer * 32 + g)) * 16 + (lane & 15)) * 128 + 8 * (lane >> 4);
#pragma unroll
      for (int ks = 0; ks < 4; ks++) cf[ks] = *(const bf16x8*)(cm + ks * 32);
    }
    const float dsk = p.s5_d[(layer * 32 + g) * 16 + (lane & 15)];
    for (int sub = 0; sub < 4; sub++) {
      __builtin_amdgcn_wave_barrier();
      if (lane < 32) s5_load_u(p, tok0 + sub * 32 + lane, g, sU + lane * 16);
      __builtin_amdgcn_wave_barrier();
      for (int l = 0; l < 32; l++) {
        S5_STEP(sU + l * 16)
        sS[l * 136 + lane] = f2bf(sr); sS[l * 136 + 64 + lane] = f2bf(si);
      }
      __builtin_amdgcn_wave_barrier();
#pragma unroll
      for (int mb = 0; mb < 2; mb++) {
        f32x4 acc = {0.f, 0.f, 0.f, 0.f};
#pragma unroll
        for (int ks = 0; ks < 4; ks++) {
          bf16x8 af = *(const bf16x8*)(sS + (16 * mb + (lane & 15)) * 136 + ks * 32 + 8 * (lane >> 4));
          acc = mfma16(af, cf[ks], acc);
        }
#pragma unroll
        for (int r = 0; r < 4; r++) {
          const int l = 16 * mb + 4 * (lane >> 4) + r;
          float y = acc[r] + dsk * sU[l * 16 + (lane & 15)];
          p.YG[(tok0 + sub * 32 + l) * 512 + g * 16 + (lane & 15)] = f2bf(geluf_(y));
        }
      }
    }
  }
  __syncthreads();
  const int wr = w >> 1, wc = w & 1, r32 = lane & 31, h5 = lane >> 5;
  for (int tn = 0; tn < 4; tn++) {
    f32x16 acc[2][2]; ZERO_ACC(acc);
    gemm_acc(p.YG + tok0 * 512, 512, p.WgluT + ((size_t)layer * 512 + tn * 128) * 512, 512, 512, acc, sm);
#pragma unroll
    for (int i = 0; i < 2; i++) {
      const size_t tok = tok0 + wr * 64 + i * 32 + r32;
#pragma unroll
      for (int j = 0; j < 2; j++)
#pragma unroll
        for (int q = 0; q < 4; q++) {
          const int n = tn * 128 + wc * 64 + j * 32 + q * 8 + h5 * 4;
          float4 bg = *(const float4*)(p.b_glu + layer * 512 + n);
          uint2 yy = *(const uint2*)(p.YG + tok * 512 + n);
          uint2 zz = *(const uint2*)(p.P + tok * PW + C_S5Z + n);
          float o0 = bflo(yy.x) * sigmoidf_(acc[i][j][4 * q] + bg.x) * siluf_(bflo(zz.x));
          float o1 = bfhi(yy.x) * sigmoidf_(acc[i][j][4 * q + 1] + bg.y) * siluf_(bfhi(zz.x));
          float o2 = bflo(yy.y) * sigmoidf_(acc[i][j][4 * q + 2] + bg.z) * siluf_(bflo(zz.y));
          float o3 = bfhi(yy.y) * sigmoidf_(acc[i][j][4 * q + 3] + bg.w) * siluf_(bfhi(zz.y));
          *(uint2*)(p.Y + tok * YW + Y_S5 + n) = make_uint2(pk2(o0, o1), pk2(o2, o3));
        }
    }
  }
}

__device__ void mem_attn(const Params& p, int layer, int task) {
  const int tid = otid(), lane = tid & 63, h = tid >> 6;
  const int n16 = lane & 15, kq = lane >> 4;
  const size_t tok0 = (size_t)task * 16; const int b = (int)(tok0 >> 14);
  const bf* mk = p.MK + (((size_t)layer * 2 + b) * 4 + h) * 256 * 64;
  const bf* mvt = p.MVT + (((size_t)layer * 2 + b) * 4 + h) * 64 * 256;
  bf16x8 qf[2];
  {
    const bf* qp = p.P + (tok0 + n16) * PW + C_MEQ + h * 64 + 8 * kq;
    qf[0] = *(const bf16x8*)qp; qf[1] = *(const bf16x8*)(qp + 32);
  }
  f32x4 st[16];
#pragma unroll
  for (int kb = 0; kb < 16; kb++) {
    const bf* kp = mk + (size_t)(16 * kb + n16) * 64 + 8 * kq;
    bf16x8 a0 = *(const bf16x8*)kp, a1 = *(const bf16x8*)(kp + 32);
    f32x4 acc = {0.f, 0.f, 0.f, 0.f};
    acc = mfma16(a0, qf[0], acc); acc = mfma16(a1, qf[1], acc);
    st[kb] = acc * 0.125f;
  }
  float mx = -3.0e38f;
#pragma unroll
  for (int kb = 0; kb < 16; kb++)
#pragma unroll
    for (int r = 0; r < 4; r++) mx = fmaxf(mx, st[kb][r]);
  mx = fmaxf(mx, __shfl_xor(mx, 16)); mx = fmaxf(mx, __shfl_xor(mx, 32));
  float sum = 0.f;
#pragma unroll
  for (int kb = 0; kb < 16; kb++)
#pragma unroll
    for (int r = 0; r < 4; r++) { float e = __expf(st[kb][r] - mx); st[kb][r] = e; sum += e; }
  sum += __shfl_xor(sum, 16); sum += __shfl_xor(sum, 32);
  const float rinv = 1.f / sum;
  f32x4 o[4];
#pragma unroll
  for (int mb = 0; mb < 4; mb++) o[mb] = (f32x4){0.f, 0.f, 0.f, 0.f};
#pragma unroll
  for (int k2 = 0; k2 < 8; k2++) {
    bf16x8 pf;
    unsigned q0 = pk2(st[2 * k2][0], st[2 * k2][1]), q1 = pk2(st[2 * k2][2], st[2 * k2][3]);
    unsigned q2 = pk2(st[2 * k2 + 1][0], st[2 * k2 + 1][1]), q3 = pk2(st[2 * k2 + 1][2], st[2 * k2 + 1][3]);
    pf[0] = (short)(q0 & 0xFFFF); pf[1] = (short)(q0 >> 16); pf[2] = (short)(q1 & 0xFFFF); pf[3] = (short)(q1 >> 16);
    pf[4] = (short)(q2 & 0xFFFF); pf[5] = (short)(q2 >> 16); pf[6] = (short)(q3 & 0xFFFF); pf[7] = (short)(q3 >> 16);
#pragma unroll
    for (int mb = 0; mb < 4; mb++) {
      const bf* vp = mvt + (size_t)(16 * mb + n16) * 256 + 32 * k2 + 4 * kq;
      uint2 v0 = *(const uint2*)vp, v1 = *(const uint2*)(vp + 16);
      bf16x8 af;
      af[0] = (short)(v0.x & 0xFFFF); af[1] = (short)(v0.x >> 16); af[2] = (short)(v0.y & 0xFFFF); af[3] = (short)(v0.y >> 16);
      af[4] = (short)(v1.x & 0xFFFF); af[5] = (short)(v1.x >> 16); af[6] = (short)(v1.y & 0xFFFF); af[7] = (short)(v1.y >> 16);
      o[mb] = mfma16(af, pf, o[mb]);
    }
  }
  const size_t tok = tok0 + n16;
#pragma unroll
  for (int mb = 0; mb < 4; mb++) {
    const int d = 16 * mb + 4 * kq;
    uint2 zz = *(const uint2*)(p.P + tok * PW + C_MEZ + h * 64 + d);
    float v0 = o[mb][0] * rinv * siluf_(bflo(zz.x)), v1 = o[mb][1] * rinv * siluf_(bfhi(zz.x));
    float v2 = o[mb][2] * rinv * siluf_(bflo(zz.y)), v3 = o[mb][3] * rinv * siluf_(bfhi(zz.y));
    *(uint2*)(p.Y + tok * YW + Y_MEM + h * 64 + d) = make_uint2(pk2(v0, v1), pk2(v2, v3));
  }
}

__device__ void dsa_wave(const Params& p, int rank, char* sm) {
  const int tid = otid(), lane = tid & 63, w = tid >> 6, r32 = lane & 31, h5 = lane >> 5;
  const int b = rank & 1, qg = 2047 - (rank >> 1), l0 = qg * 8;
  const size_t tokb = (size_t)b * LSEQ;
  unsigned* cand = (unsigned*)(sm + w * (8 * CAP * 4));
  bf* Pb = (bf*)(sm + 4 * 8 * CAP * 4 + w * 2048);
  bf16x8 aq[4];
  {
    const bf* qp = p.P + (tokb + l0 + (r32 >> 2)) * PW + C_IDQ + (r32 & 3) * 64 + 8 * h5;
#pragma unroll
    for (int ks = 0; ks < 4; ks++) aq[ks] = *(const bf16x8*)(qp + ks * 16);
  }
  float wv[4][4]; int ql[4];
#pragma unroll
  for (int g = 0; g < 4; g++) {
    ql[g] = l0 + 2 * g + h5;
    uint2 u = *(const uint2*)(p.P + (tokb + ql[g]) * PW + C_IDW);
    wv[g][0] = bflo(u.x) * 0.0625f; wv[g][1] = bfhi(u.x) * 0.0625f; wv[g][2] = bflo(u.y) * 0.0625f; wv[g][3] = bfhi(u.y) * 0.0625f;
  }
  unsigned Tg[4] = {0u, 0u, 0u, 0u};
  unsigned Tq = 0u; int cntv = 0;
  const int ntile = (l0 + 7) / 32 + 1;
  const bf* kif = p.KIF + (size_t)b * 512 * 2048 + lane * 8;
  bf16x8 bk[4];
#pragma unroll
  for (int ks = 0; ks < 4; ks++) bk[ks] = *(const bf16x8*)(kif + ks * 512);
  const unsigned ltmask = (1u << r32) - 1u;
  for (int tile = 0; tile < ntile; tile++) {
    bf16x8 bc[4];
#pragma unroll
    for (int ks = 0; ks < 4; ks++) bc[ks] = bk[ks];
    if (tile + 1 < ntile) {
#pragma unroll
      for (int ks = 0; ks < 4; ks++) bk[ks] = *(const bf16x8*)(kif + (size_t)(tile + 1) * 2048 + ks * 512);
    }
    unsigned long long over = __ballot(lane < 8 && cntv > CAP - 32);
    if (over) {
      while (over) {
        const int q = __builtin_ctzll(over); over &= over - 1;
        const int n = __builtin_amdgcn_readlane(cntv, q);
        unsigned* cb_ = cand + q * CAP;
        unsigned e[7];
#pragma unroll
        for (int i = 0; i < 7; i++) e[i] = (i * 64 + lane < n) ? cb_[i * 64 + lane] : 0u;
        unsigned T = 0u;
        for (int bit = 31; bit >= 0; bit--) {
          const unsigned cnd = T | (1u << bit); int cc = 0;
#pragma unroll
          for (int i = 0; i < 7; i++) cc += __popcll(__ballot(e[i] >= cnd));
          if (cc >= 256) T = cnd;
        }
        int pos = 0;
#pragma unroll
        for (int i = 0; i < 7; i++) {
          const bool keep = e[i] >= T; const unsigned long long m = __ballot(keep);
          if (keep) cb_[pos + __popcll(m & ((1ull << lane) - 1ull))] = e[i];
          pos += __popcll(m);
        }
        if (lane == q) { cntv = pos; Tq = T; }
      }
#pragma unroll
      for (int g = 0; g < 4; g++) {
        unsigned tlo = __builtin_amdgcn_readlane(Tq, 2 * g), thi = __builtin_amdgcn_readlane(Tq, 2 * g + 1);
        Tg[g] = h5 ? thi : tlo;
      }
    }
    f32x16 acc;
#pragma unroll
    for (int r = 0; r < 16; r++) acc[r] = 0.f;
#pragma unroll
    for (int ks = 0; ks < 4; ks++) acc = mfma32(aq[ks], bc[ks], acc);
    const int kidx = tile * 32 + r32;
#pragma unroll
    for (int g = 0; g < 4; g++) {
      float sc = fmaxf(acc[4 * g], 0.f) * wv[g][0] + fmaxf(acc[4 * g + 1], 0.f) * wv[g][1] +
                 fmaxf(acc[4 * g + 2], 0.f) * wv[g][2] + fmaxf(acc[4 * g + 3], 0.f) * wv[g][3];
      sc += 0.f;
      unsigned u = __float_as_uint(sc); u ^= (u >> 31) ? 0xFFFFFFFFu : 0x80000000u;
      const unsigned pk = (u & 0xFFFFC000u) | (unsigned)(16383 - kidx);
      const bool pass = (kidx <= ql[g]) && (pk > Tg[g]);
      const unsigned long long m = __ballot(pass);
      if (m) {
        const unsigned lo = (unsigned)m, hi = (unsigned)(m >> 32);
        const int cA = __builtin_amdgcn_readlane(cntv, 2 * g), cB = __builtin_amdgcn_readlane(cntv, 2 * g + 1);
        if (pass) {
          const int base = h5 ? cB : cA; const unsigned mm = h5 ? hi : lo;
          cand[(2 * g + h5) * CAP + base + __popc(mm & ltmask)] = pk;
        }
        if (lane == 2 * g) cntv += __popc(lo);
        if (lane == 2 * g + 1) cntv += __popc(hi);
      }
    }
  }
  {
    unsigned long long over = __ballot(lane < 8 && cntv > 256);
    while (over) {
      const int q = __builtin_ctzll(over); over &= over - 1;
      const int n = __builtin_amdgcn_readlane(cntv, q);
      unsigned* cb_ = cand + q * CAP;
      unsigned e[7];
#pragma unroll
      for (int i = 0; i < 7; i++) e[i] = (i * 64 + lane < n) ? cb_[i * 64 + lane] : 0u;
      unsigned T = 0u;
      for (int bit = 31; bit >= 0; bit--) {
        const unsigned cnd = T | (1u << bit); int cc = 0;
#pragma unroll
        for (int i = 0; i < 7; i++) cc += __popcll(__ballot(e[i] >= cnd));
        if (cc >= 256) T = cnd;
      }
      int pos = 0;
#pragma unroll
      for (int i = 0; i < 7; i++) {
        const bool keep = e[i] >= T; const unsigned long long m = __ballot(keep);
        if (keep) cb_[pos + __popcll(m & ((1ull << lane) - 1ull))] = e[i];
        pos += __popcll(m);
      }
      if (lane == q) { cntv = pos; Tq = T; }
    }
  }
  __builtin_amdgcn_wave_barrier();
  const int n16 = lane & 15, kq = lane >> 4;
  for (int q = 0; q < 8; q++) {
    const int n = __builtin_amdgcn_readlane(cntv, q);
    const unsigned* sel = cand + q * CAP;
    const size_t tq = tokb + l0 + q;
    for (int grp = 0; grp < 2; grp++) {
      bf16x8 qa0, qa1;
#pragma unroll
      for (int k = 0; k < 8; k++) { qa0[k] = 0; qa1[k] = 0; }
      if (n16 < 4) {
        const bf* qp = p.P + tq * PW + C_ATQ + (grp * 4 + n16) * 64 + 8 * kq;
        qa0 = *(const bf16x8*)qp; qa1 = *(const bf16x8*)(qp + 32);
      }
      f32x4 lg[16];
#pragma unroll
      for (int t = 0; t < 16; t++) {
        const int slot = t * 16 + n16; const bool valid = slot < n;
        const int key = valid ? (16383 - (int)(sel[slot] & 0x3FFFu)) : 0;
        const bf* kp = p.P + (tokb + key) * PW + C_ATK + grp * 64 + 8 * kq;
        bf16x8 b0 = *(const bf16x8*)kp, b1 = *(const bf16x8*)(kp + 32);
        f32x4 cc = {0.f, 0.f, 0.f, 0.f};
        cc = mfma16(qa0, b0, cc); cc = mfma16(qa1, b1, cc);
        const bool ok = valid && (kq == 0);
#pragma unroll
        for (int r = 0; r < 4; r++) lg[t][r] = ok ? cc[r] * 0.125f : -3.0e38f;
      }
      float mx[4], sm4[4];
#pragma unroll
      for (int r = 0; r < 4; r++) {
        float m = lg[0][r];
#pragma unroll
        for (int t = 1; t < 16; t++) m = fmaxf(m, lg[t][r]);
#pragma unroll
        for (int off = 1; off < 64; off <<= 1) m = fmaxf(m, __shfl_xor(m, off));
        mx[r] = m;
      }
#pragma unroll
      for (int r = 0; r < 4; r++) {
        float s = 0.f;
#pragma unroll
        for (int t = 0; t < 16; t++) { float e = (lg[t][r] > -1.0e38f) ? __expf(lg[t][r] - mx[r]) : 0.f; lg[t][r] = e; s += e; }
#pragma unroll
        for (int off = 1; off < 64; off <<= 1) s += __shfl_xor(s, off);
        sm4[r] = s;
      }
      __builtin_amdgcn_wave_barrier();
      if (kq == 0) {
#pragma unroll
        for (int t = 0; t < 16; t++)
          *(uint2*)(Pb + (t * 16 + n16) * 4) = make_uint2(pk2(lg[t][0], lg[t][1]), pk2(lg[t][2], lg[t][3]));
      }
      __builtin_amdgcn_wave_barrier();
      float o[32];
#pragma unroll
      for (int i = 0; i < 32; i++) o[i] = 0.f;
      const int ksg = lane >> 3, dc = lane & 7;
#pragma unroll 4
      for (int stp = 0; stp < 32; stp++) {
        const int slot = stp * 8 + ksg;
        const int key = (slot < n) ? (16383 - (int)(sel[slot] & 0x3FFFu)) : 0;
        uint2 pp = *(const uint2*)(Pb + slot * 4);
        uint4 vv = *(const uint4*)(p.P + (tokb + key) * PW + C_ATV + grp * 64 + dc * 8);
        float ph[4] = {bflo(pp.x), bfhi(pp.x), bflo(pp.y), bfhi(pp.y)};
        float vf[8] = {bflo(vv.x), bfhi(vv.x), bflo(vv.y), bfhi(vv.y), bflo(vv.z), bfhi(vv.z), bflo(vv.w), bfhi(vv.w)};
#pragma unroll
        for (int hh = 0; hh < 4; hh++)
#pragma unroll
          for (int d = 0; d < 8; d++) o[hh * 8 + d] += ph[hh] * vf[d];
      }
      const bool b5 = (lane >> 5) & 1, b4 = (lane >> 4) & 1, b3 = (lane >> 3) & 1;
      float o16[16], o8[8], o4[4];
#pragma unroll
      for (int i = 0; i < 16; i++) { float lo = o[i], hi = o[16 + i]; float snd = b5 ? lo : hi; float kp = b5 ? hi : lo; o16[i] = kp + __shfl_xor(snd, 32); }
#pragma unroll
      for (int i = 0; i < 8; i++) { float lo = o16[i], hi = o16[8 + i]; float snd = b4 ? lo : hi; float kp = b4 ? hi : lo; o8[i] = kp + __shfl_xor(snd, 16); }
#pragma unroll
      for (int i = 0; i < 4; i++) { float lo = o8[i], hi = o8[4 + i]; float snd = b3 ? lo : hi; float kp = b3 ? hi : lo; o4[i] = kp + __shfl_xor(snd, 8); }
      const int hsel = (b5 ? 2 : 0) + (b4 ? 1 : 0);
      const float ssum = b5 ? (b4 ? sm4[3] : sm4[2]) : (b4 ? sm4[1] : sm4[0]);
      const float rinv = 1.f / ssum;
      const int col = (grp * 4 + hsel) * 64 + dc * 8 + (b3 ? 4 : 0);
      uint2 zz = *(const uint2*)(p.P + tq * PW + C_ATZ + col);
      float v0 = o4[0] * rinv * siluf_(bflo(zz.x)), v1 = o4[1] * rinv * siluf_(bfhi(zz.x));
      float v2 = o4[2] * rinv * siluf_(bflo(zz.y)), v3 = o4[3] * rinv * siluf_(bfhi(zz.y));
      *(uint2*)(p.Y + tq * YW + Y_ATT + col) = make_uint2(pk2(v0, v1), pk2(v2, v3));
    }
  }
}

__device__ void phaseB(const Params& p, int layer, char* sm) {
  const int total = 512 + 2048 + 2048;
  for (int t = blockIdx.x; t < total; t += gridDim.x) {
    if (t < 512) ssd_pass1(p, layer, t, sm);
    else if (t < 2560) s5_pass1(p, layer, t - 512, sm);
    else mem_attn(p, layer, t - 2560);
  }
}
__device__ void phaseC(const Params& p, int layer, char* sm) {
  const int G = gridDim.x;
  const int total = 1024 + 256 + 16;
  for (int i = blockIdx.x; i < total; i += G) {
    if (i < 1024) {
      int rr = i / G, pos = i - rr * G; int idx = i;
      if ((rr & 1) && (rr * G + G <= 1024)) idx = rr * G + (G - 1 - pos);
      __syncthreads();
      dsa_wave(p, idx * 4 + (otid() >> 6), sm);
    } else if (i < 1280) ssd_statepass(p, i - 1024);
    else s5_carry(p, layer, i - 1280);
  }
}
__device__ void phaseD(const Params& p, int layer, char* sm) {
  const int total = 256 + 1024;
  for (int t = blockIdx.x; t < total; t += gridDim.x) {
    if (t < 256) s5_pass2(p, layer, t, sm);
    else ssd_pass2(p, layer, t - 256, sm);
  }
}

__device__ void phaseE(const Params& p, int layer, char* sm) {
  const int tid = otid(), lane = tid & 63, w = tid >> 6, wr = w >> 1, wc = w & 1, r32 = lane & 31, h5 = lane >> 5;
  const bf* Wl = p.WinT + (size_t)layer * INW * 2048;
  const bf* Wb = p.WbrT + (size_t)layer * 2048 * YW;
  bf* merged = p.P;
  const int total = 8 * 8 * 64;
  for (int L = blockIdx.x; L < total; L += gridDim.x) {
    int tm, tn; if (!tile_map(L, 256, 16, 8, 8, tm, tn)) continue;
    const int m0 = tm * 128, n0 = tn * 128;
    f32x16 mer[2][2]; ZERO_ACC(mer);
    for (int br = 0; br < 4; br++) {
      unsigned gp[2][2][8];
      {
        f32x16 acc[2][2]; ZERO_ACC(acc);
        gemm_acc(p.xb + (size_t)m0 * 2048, 2048, Wl + (size_t)(5716 + br * 2048 + n0) * 2048, 2048, 2048, acc, sm);
#pragma unroll
        for (int i = 0; i < 2; i++)
#pragma unroll
          for (int j = 0; j < 2; j++)
#pragma unroll
            for (int q = 0; q < 4; q++) {
              const int n = n0 + wc * 64 + j * 32 + q * 8 + h5 * 4;
              float4 bg = *(const float4*)(p.b_gate + (size_t)layer * 8192 + br * 2048 + n);
              gp[i][j][2 * q] = pk2(sigmoidf_(acc[i][j][4 * q] + bg.x), sigmoidf_(acc[i][j][4 * q + 1] + bg.y));
              gp[i][j][2 * q + 1] = pk2(sigmoidf_(acc[i][j][4 * q + 2] + bg.z), sigmoidf_(acc[i][j][4 * q + 3] + bg.w));
            }
      }
      const int koff = br == 0 ? 0 : (br == 1 ? 512 : (br == 2 ? 1024 : 2048));
      const int kb = br == 2 ? 1024 : (br == 3 ? 256 : 512);
      f32x16 acc[2][2]; ZERO_ACC(acc);
      gemm_acc(p.Y + (size_t)m0 * YW + koff, YW, Wb + (size_t)n0 * YW + koff, YW, kb, acc, sm);
#pragma unroll
      for (int i = 0; i < 2; i++)
#pragma unroll
        for (int j = 0; j < 2; j++)
#pragma unroll
          for (int r = 0; r < 16; r += 2) {
            mer[i][j][r] += bflo(gp[i][j][r >> 1]) * acc[i][j][r];
            mer[i][j][r + 1] += bfhi(gp[i][j][r >> 1]) * acc[i][j][r + 1];
          }
    }
#pragma unroll
    for (int i = 0; i < 2; i++) {
      const size_t tok = m0 + wr * 64 + i * 32 + r32;
#pragma unroll
      for (int j = 0; j < 2; j++)
#pragma unroll
        for (int q = 0; q < 4; q++) {
          const int n = n0 + wc * 64 + j * 32 + q * 8 + h5 * 4;
          *(uint2*)(merged + tok * 2048 + n) = make_uint2(pk2(mer[i][j][4 * q], mer[i][j][4 * q + 1]), pk2(mer[i][j][4 * q + 2], mer[i][j][4 * q + 3]));
        }
    }
  }
}

__device__ void phaseF(const Params& p, int layer, char* sm) {
  const int tid = otid(), lane = tid & 63, w = tid >> 6, wr = w >> 1, wc = w & 1, r32 = lane & 31, h5 = lane >> 5;
  const bf* merged = p.P;
  const float* xres = layer == 0 ? p.x : p.out;
  const int total = 8 * 8 * 64;
  for (int L = blockIdx.x; L < total; L += gridDim.x) {
    int tm, tn; if (!tile_map(L, 256, 16, 8, 8, tm, tn)) continue;
    const int m0 = tm * 128, n0 = tn * 128;
    f32x16 acc[2][2]; ZERO_ACC(acc);
    gemm_acc(merged + (size_t)m0 * 2048, 2048, p.WoutT + ((size_t)layer * 2048 + n0) * 2048, 2048, 2048, acc, sm);
#pragma unroll
    for (int i = 0; i < 2; i++) {
      const size_t tok = m0 + wr * 64 + i * 32 + r32;
#pragma unroll
      for (int j = 0; j < 2; j++)
#pragma unroll
        for (int q = 0; q < 4; q++) {
          const int n = n0 + wc * 64 + j * 32 + q * 8 + h5 * 4;
          float4 xr = *(const float4*)(xres + tok * 2048 + n);
          float4 o;
          o.x = 1.41421356237f * xr.x + acc[i][j][4 * q]; o.y = 1.41421356237f * xr.y + acc[i][j][4 * q + 1];
          o.z = 1.41421356237f * xr.z + acc[i][j][4 * q + 2]; o.w = 1.41421356237f * xr.w + acc[i][j][4 * q + 3];
          *(float4*)(p.out + tok * 2048 + n) = o;
        }
    }
  }
}

__device__ void phaseG(const Params& p, int layer) {
  const int lane = otid() & 63, w = otid() >> 6;
  const float* g = p.ln_g + layer * 2048; const float* bb = p.ln_b + layer * 2048;
  for (int t = blockIdx.x; t < TT / 4; t += gridDim.x) {
    const size_t row = (size_t)t * 4 + w;
    float* xp = p.out + row * 2048;
    float4 v[8]; float s = 0.f;
#pragma unroll
    for (int i = 0; i < 8; i++) { v[i] = *(const float4*)(xp + (i * 64 + lane) * 4); s += v[i].x + v[i].y + v[i].z + v[i].w; }
#pragma unroll
    for (int off = 1; off < 64; off <<= 1) s += __shfl_xor(s, off);
    const float mu = s * (1.f / 2048.f);
    float q = 0.f;
#pragma unroll
    for (int i = 0; i < 8; i++) {
      float a = v[i].x - mu, b = v[i].y - mu, c = v[i].z - mu, d = v[i].w - mu; q += a * a + b * b + c * c + d * d;
    }
#pragma unroll
    for (int off = 1; off < 64; off <<= 1) q += __shfl_xor(q, off);
    const float rs = rsqrtf(q * (1.f / 2048.f) + 1e-5f);
#pragma unroll
    for (int i = 0; i < 8; i++) {
      const int col = (i * 64 + lane) * 4;
      float4 gg = *(const float4*)(g + col), bv = *(const float4*)(bb + col);
      float4 o;
      o.x = (v[i].x - mu) * rs * gg.x + bv.x; o.y = (v[i].y - mu) * rs * gg.y + bv.y;
      o.z = (v[i].z - mu) * rs * gg.z + bv.z; o.w = (v[i].w - mu) * rs * gg.w + bv.w;
      *(float4*)(xp + col) = o;
      if (layer == 0) *(uint2*)(p.xb + row * 2048 + col) = make_uint2(pk2(o.x, o.y), pk2(o.z, o.w));
    }
  }
}

__device__ __forceinline__ void run_phase(const Params& p, int ph, char* sm) {
  if (ph == 0) { phase0(p, sm); return; }
  const int layer = (ph - 1) / 7, s = (ph - 1) % 7;
  switch (s) {
    case 0: phaseA(p, layer, sm); break;
    case 1: phaseB(p, layer, sm); break;
    case 2: phaseC(p, layer, sm); break;
    case 3: phaseD(p, layer, sm); break;
    case 4: phaseE(p, layer, sm); break;
    case 5: phaseF(p, layer, sm); break;
    default: phaseG(p, layer); break;
  }
}

#if MK_COOP
__global__ void __launch_bounds__(256, 2) mega_kernel(Params p) {
  __shared__ __attribute__((aligned(16))) char sm[65536];
  cg::grid_group grid = cg::this_grid();
  phase0(p, sm); grid.sync();
#pragma unroll 1
  for (int layer = 0; layer < 2; layer++) {
    phaseA(p, layer, sm); grid.sync();
    phaseB(p, layer, sm); grid.sync();
    phaseC(p, layer, sm); grid.sync();
    phaseD(p, layer, sm); grid.sync();
    phaseE(p, layer, sm); grid.sync();
    phaseF(p, layer, sm); grid.sync();
    phaseG(p, layer);
    if (layer == 0) grid.sync();
  }
}
#else
__global__ void __launch_bounds__(256, 2) phase_kernel(Params p, int ph) {
  __shared__ __attribute__((aligned(16))) char sm[65536];
  run_phase(p, ph, sm);
}
#endif

extern "C" void kernel_launch(void* const* d_in, const int* in_sizes, int n_in, void* d_out, int out_size, void* d_ws,
                              size_t ws_size, hipStream_t stream) {
  Params p{};
  p.x = (const float*)d_in[0]; p.mem = (const float*)d_in[1]; p.pos = (const int*)d_in[2];
  p.w_in = (const float*)d_in[3]; p.b_gate = (const float*)d_in[4]; p.lam_re = (const float*)d_in[5];
  p.lam_im = (const float*)d_in[6]; p.log_dt = (const float*)d_in[7]; p.b_re = (const float*)d_in[8];
  p.b_im = (const float*)d_in[9]; p.c_re = (const float*)d_in[10]; p.c_im = (const float*)d_in[11];
  p.s5_d = (const float*)d_in[12]; p.w_glu = (const float*)d_in[13]; p.b_glu = (const float*)d_in[14];
  p.conv_w = (const float*)d_in[15]; p.conv_b = (const float*)d_in[16]; p.dt_bias = (const float*)d_in[17];
  p.a_log = (const float*)d_in[18]; p.ssd_d = (const float*)d_in[19]; p.norm_g = (const float*)d_in[20];
  p.mem_w_kv = (const float*)d_in[21]; p.w_br_s5 = (const float*)d_in[22]; p.w_br_attn = (const float*)d_in[23];
  p.w_br_ssd = (const float*)d_in[24]; p.w_br_mem = (const float*)d_in[25]; p.w_out = (const float*)d_in[26];
  p.ln_g = (const float*)d_in[27]; p.ln_b = (const float*)d_in[28];
  p.out = (float*)d_out;
  char* ws = (char*)d_ws; size_t off = 0;
  auto carve = [&](size_t bytes) { char* r = ws + off; off += (bytes + 255) & ~(size_t)255; return r; };
  p.WinT = (bf*)carve((size_t)2 * INW * 2048 * 2);
  p.WbrT = (bf*)carve((size_t)2 * 2048 * YW * 2);
  p.WoutT = (bf*)carve((size_t)2 * 2048 * 2048 * 2);
  p.WgluT = (bf*)carve((size_t)2 * 512 * 512 * 2);
  p.WmemT = (bf*)carve((size_t)2 * 512 * 2048 * 2);
  p.memb = (bf*)carve((size_t)512 * 2048 * 2);
  p.xb = (bf*)carve((size_t)TT * 2048 * 2);
  p.P = (bf*)carve((size_t)TT * PW * 2);
  p.Y = (bf*)carve((size_t)TT * YW * 2);
  p.YG = (bf*)carve((size_t)TT * 512 * 2);
  p.KIF = (bf*)carve((size_t)TT * 64 * 2);
  p.MK = (bf*)carve((size_t)2 * 2 * 4 * 256 * 64 * 2);
  p.MVT = (bf*)carve((size_t)2 * 2 * 4 * 256 * 64 * 2);
  p.CM = (bf*)carve((size_t)2 * 32 * 16 * 128 * 2);
  p.ST = (float*)carve((size_t)2 * 128 * 131072 * 4);
  p.CS = (float*)carve((size_t)TT * 16 * 4);
  p.END = (float*)carve((size_t)2 * 128 * 32 * 64 * 2 * 4);
  p.CD = (float*)carve((size_t)2 * 128 * 16 * 4);
  p.SB = (float*)carve((size_t)2 * 32 * 64 * 32 * 4);
  p.SA = (float*)carve((size_t)2 * 32 * 64 * 4 * 4);
  if (off > ws_size) { fprintf(stderr, "workspace too small: need %zu have %zu\n", off, ws_size); return; }
  for (int j = 0; j < 8; j++) p.inv[j] = (float)pow(500000.0, -(double)j / 8.0);
#if MK_COOP
  static int grid_blocks = 0;
  if (!grid_blocks) {
    int dev = 0, cus = 0, per_cu = 0;
    hipGetDevice(&dev);
    hipDeviceGetAttribute(&cus, hipDeviceAttributeMultiprocessorCount, dev);
    hipOccupancyMaxActiveBlocksPerMultiprocessor(&per_cu, mega_kernel, 256, 0);
    if (per_cu > 2) per_cu = 2;
    grid_blocks = cus * per_cu;
    grid_blocks -= grid_blocks % 8;
  }
  void* args[] = {&p};
  hipError_t e = hipLaunchCooperativeKernel((void*)mega_kernel, dim3(grid_blocks), dim3(256), args, 0, stream);
  if (e != hipSuccess) fprintf(stderr, "cooperative launch failed: %s (grid %d)\n", hipGetErrorString(e), grid_blocks);
#else
  for (int ph = 0; ph < 15; ph++) phase_kernel<<<512, 256, 0, stream>>>(p, ph);
#endif
}
```

```cpp
#include <hip/hip_runtime.h>
#include <hip/hip_cooperative_groups.h>
#include <cstdio>
#include <cmath>
namespace cg = cooperative_groups;

#ifndef MK_COOP
#define MK_COOP 1
#endif
#ifndef PROBE_MASK
#define PROBE_MASK 0
#endif

typedef unsigned short bf;
typedef short bf16x8 __attribute__((ext_vector_type(8)));
typedef float f32x16 __attribute__((ext_vector_type(16)));
typedef float f32x4 __attribute__((ext_vector_type(4)));

#define TT 32768
#define LSEQ 16384
#define DM 2048
#define INW 13908
#define PW 5760
#define C_S5U 0
#define C_S5Z 512
#define C_ATQ 1024
#define C_ATK 1536
#define C_ATV 1664
#define C_ATZ 1792
#define C_IDQ 2304
#define C_IDK 2560
#define C_IDW 2624
#define C_SSZ 2640
#define C_XBC 3664
#define C_SDT 5200
#define C_MEQ 5216
#define C_MEZ 5472
#define YW 2304
#define Y_S5 0
#define Y_ATT 512
#define Y_SSD 1024
#define Y_MEM 2048
#define CAP 448

struct Params {
  const float *x, *mem; const int* pos;
  const float *w_in, *b_gate, *lam_re, *lam_im, *log_dt, *b_re, *b_im, *c_re, *c_im, *s5_d, *w_glu, *b_glu,
      *conv_w, *conv_b, *dt_bias, *a_log, *ssd_d, *norm_g, *mem_w_kv, *w_br_s5, *w_br_attn, *w_br_ssd, *w_br_mem,
      *w_out, *ln_g, *ln_b;
  float* out;
  bf *WinT, *WbrT, *WoutT, *WgluT, *WmemT, *memb, *xb, *P, *Y, *YG, *KIF, *MK, *MVT, *CM, *KVC, *GS;
  float *ST, *CS, *END, *CD, *SB, *SA;
  float inv[8];
};

__device__ __forceinline__ float ozero() { float z = 0.f; asm volatile("" : "+v"(z)); return z; }
__device__ __forceinline__ int otid_full() { int t = threadIdx.x; asm volatile("" : "+v"(t)); return t; }
__device__ __forceinline__ int otid() { return otid_full() & 255; }
#define HB (otid_full() >> 8)
#define VB ((int)blockIdx.x * 2 + HB)
#define G2 ((int)gridDim.x * 2)
__device__ __forceinline__ float bf2f(bf v) { return __uint_as_float(((unsigned)v) << 16); }
__device__ __forceinline__ float bflo(unsigned u) { return __uint_as_float(u << 16); }
__device__ __forceinline__ float bfhi(unsigned u) { return __uint_as_float(u & 0xFFFF0000u); }
__device__ __forceinline__ unsigned pk2(float lo, float hi) {
  unsigned r; asm("v_cvt_pk_bf16_f32 %0, %1, %2" : "=v"(r) : "v"(lo), "v"(hi)); return r;
}
__device__ __forceinline__ bf f2bf(float f) { return (bf)(pk2(f, 0.f) & 0xFFFFu); }
__device__ __forceinline__ float sigmoidf_(float x) { return 1.f / (1.f + __expf(-x)); }
__device__ __forceinline__ float siluf_(float x) { return x / (1.f + __expf(-x)); }
__device__ __forceinline__ float geluf_(float x) {
  float u = 0.7978845608028654f * (x + 0.044715f * x * x * x);
  float t = 1.f - 2.f / (1.f + __expf(2.f * u));
  return 0.5f * x * (1.f + t);
}
__device__ __forceinline__ f32x16 mfma32(bf16x8 a, bf16x8 b, f32x16 c) { return __builtin_amdgcn_mfma_f32_32x32x16_bf16(a, b, c, 0, 0, 0); }
__device__ __forceinline__ f32x4 mfma16(bf16x8 a, bf16x8 b, f32x4 c) { return __builtin_amdgcn_mfma_f32_16x16x32_bf16(a, b, c, 0, 0, 0); }

__device__ __forceinline__ bool tile_map(int L, int nMt, int nNt, int SM, int SN, int& tm, int& tn) {
  int per = SM * SN; int x = L & 7; int jj = L >> 3; int sl = jj / per; int j = jj - sl * per; int S = sl * 8 + x;
  int nSn = nNt / SN; int NS = (nMt / SM) * nSn;
  if (S >= NS) return false;
  int mg = S / nSn, ng = S - mg * nSn;
  tm = mg * SM + j / SN; tn = ng * SN + j % SN; return true;
}

typedef unsigned u32x4 __attribute__((ext_vector_type(4)));
struct GStage { u32x4 a0, a1, b0, b1; };
#define G_LOAD(S, ko) { S.a0 = *(const u32x4*)(ga + (ko)); S.a1 = *(const u32x4*)(ga + a64 + (ko)); S.b0 = *(const u32x4*)(gb + (ko)); S.b1 = *(const u32x4*)(gb + b64 + (ko)); }
#define G_WRITE(S, base) { *(u32x4*)(sA + (base) + woff) = S.a0; *(u32x4*)(sA + (base) + woff + 5120) = S.a1; *(u32x4*)(sB + (base) + woff) = S.b0; *(u32x4*)(sB + (base) + woff + 5120) = S.b1; }
#define G_ITER(kt, cur, S)                                                          \
  {                                                                                 \
    _Pragma("unroll") for (int ks = 0; ks < 2; ks++) {                              \
      bf16x8 a0 = *(const bf16x8*)(sA + (cur) + aoff + ks * 32);                    \
      bf16x8 a1 = *(const bf16x8*)(sA + (cur) + aoff + 2560 + ks * 32);             \
      bf16x8 b0 = *(const bf16x8*)(sB + (cur) + boff + ks * 32);                    \
      bf16x8 b1 = *(const bf16x8*)(sB + (cur) + boff + 2560 + ks * 32);             \
      acc[0][0] = mfma32(b0, a0, acc[0][0]);                                        \
      acc[0][1] = mfma32(b1, a0, acc[0][1]);                                        \
      acc[1][0] = mfma32(b0, a1, acc[1][0]);                                        \
      acc[1][1] = mfma32(b1, a1, acc[1][1]);                                        \
    }                                                                               \
    if ((kt) + 1 < nk) {                                                            \
      G_WRITE(S, 10240 - (cur))                                                     \
      if ((kt) + 1 + D < nk) G_LOAD(S, ((kt) + 1 + D) * 32)                         \
    }                                                                               \
    __syncthreads();                                                                \
  }
template <int D>
__device__ __forceinline__ void gemm_acc(const bf* __restrict__ A, int lda, const bf* __restrict__ Bt, int ldb, int K,
                                         f32x16 (&acc)[2][2], char* sm) {
  const int tid = otid(), lane = tid & 63, w = tid >> 6, wr = w >> 1, wc = w & 1, r32 = lane & 31, h5 = lane >> 5;
  const int lrow = tid >> 2, lch = tid & 3;
  const bf* ga = A + (size_t)lrow * lda + lch * 8;
  const bf* gb = Bt + (size_t)lrow * ldb + lch * 8;
  const size_t a64 = (size_t)64 * lda, b64 = (size_t)64 * ldb;
  const int nk = K >> 5;
  char* sA = sm; char* sB = sm + 20480;
  const int woff = lrow * 80 + lch * 16;
  const int aoff = (wr * 64 + r32) * 80 + h5 * 16, boff = (wc * 64 + r32) * 80 + h5 * 16;
  GStage S0, S1, S2, S3;
  G_LOAD(S0, 0) G_LOAD(S1, 32)
  if (D == 4) { G_LOAD(S2, 64) G_LOAD(S3, 96) }
  G_WRITE(S0, 0)
  if (D < nk) G_LOAD(S0, D * 32)
  __syncthreads();
  for (int kt0 = 0; kt0 < nk; kt0 += D) {
    if (D == 4) {
      G_ITER(kt0, 0, S1) G_ITER(kt0 + 1, 10240, S2) G_ITER(kt0 + 2, 0, S3) G_ITER(kt0 + 3, 10240, S0)
    } else {
      G_ITER(kt0, 0, S1) G_ITER(kt0 + 1, 10240, S0)
    }
  }
}
#define ZERO_ACC(a) { const float z_ = ozero(); for (int i_ = 0; i_ < 2; i_++) for (int j_ = 0; j_ < 2; j_++) for (int r_ = 0; r_ < 16; r_++) a[i_][j_][r_] = z_; }


extern __shared__ __attribute__((aligned(16))) char dynsm[];
#define G8_HT (128 * 64)
#define G8_SA(b, h) ((bf*)dynsm + ((b) * 2 + (h)) * G8_HT)
#define G8_SB(b, h) ((bf*)dynsm + (4 + (b) * 2 + (h)) * G8_HT)
__device__ __forceinline__ int g8_lds_byte(int r, int c) {
  int st = (r >> 4) * 2 + (c >> 5), rr = r & 15, cc = c & 31, ob = rr * 64 + cc * 2;
  return st * 1024 + (ob ^ (((ob >> 9) & 1) << 5));
}
__device__ __forceinline__ void g8_stage_rc(int b, int& R, int& C) {
  int st = b / 1024, sb = b % 1024, swz = sb ^ (((sb >> 9) & 1) << 5);
  R = (st >> 1) * 16 + swz / 64; C = (st & 1) * 32 + (swz % 64) / 2;
}
#define G8_LAS __attribute__((address_space(3)))
#define G8_HTB (128 * 64 * 2)
#define G8_OSA(b, h) (((b) * 2 + (h)) * G8_HTB)
#define G8_OSB(b, h) ((4 + (b) * 2 + (h)) * G8_HTB)
#define G8_STAGE(bufoff, gbase, voff) do { _Pragma("unroll") for (int _i = 0; _i < 2; ++_i) \
    __builtin_amdgcn_global_load_lds((const unsigned*)((const char*)(gbase) + (voff)[_i]), (G8_LAS unsigned*)(lds + (bufoff) + ldsw + _i * 8192), 16, 0, 0); } while (0)
#define G8_LDA(dst, b, h) do { _Pragma("unroll") for (int m = 0; m < 4; ++m) _Pragma("unroll") for (int k = 0; k < 2; ++k) dst[m][k] = *(const G8_LAS bf16x8*)(lds + G8_OSA(b, h) + aoff + m * 2048 + k * 1024); } while (0)
#define G8_LDB(dst, b, h) do { _Pragma("unroll") for (int n = 0; n < 2; ++n) _Pragma("unroll") for (int k = 0; k < 2; ++k) dst[n][k] = *(const G8_LAS bf16x8*)(lds + G8_OSB(b, h) + boff + n * 2048 + k * 1024); } while (0)
#define G8_MMA(ai, bj, At_, Bt_) do { __builtin_amdgcn_s_setprio(1);                                                 \
    _Pragma("unroll") for (int m = 0; m < 4; ++m) _Pragma("unroll") for (int n = 0; n < 2; ++n) _Pragma("unroll") for (int k = 0; k < 2; ++k) \
      acc[ai][bj][m][n] = __builtin_amdgcn_mfma_f32_16x16x32_bf16(Bt_[n][k], At_[m][k], acc[ai][bj][m][n], 0, 0, 0); \
    __builtin_amdgcn_s_setprio(0); } while (0)
#define G8_WAIT_V(n) asm volatile("s_waitcnt vmcnt(" #n ")" ::: "memory")
#define G8_WAIT_L(n) asm volatile("s_waitcnt lgkmcnt(" #n ")" ::: "memory")
#define G8_BAR __builtin_amdgcn_s_barrier()
#define G8_SCHED __builtin_amdgcn_sched_barrier(0)

__device__ __forceinline__ void gemm256(const bf* __restrict__ A, int lda, const bf* __restrict__ Bt, int ldb, int K,
                                        int brow, int bcol, f32x4 (&acc)[2][2][4][2]) {
  G8_LAS unsigned char* lds = (G8_LAS unsigned char*)dynsm;
  const int tid = otid_full(), wid = __builtin_amdgcn_readfirstlane(tid >> 6), lane = tid & 63, wr = wid >> 2, wc = wid & 3, fr = lane & 15, fq = lane >> 4;
  unsigned voffA[2], voffB[2];
#pragma unroll
  for (int i = 0; i < 2; ++i) { int R, C; g8_stage_rc(tid * 16 + i * 8192, R, C); voffA[i] = (unsigned)(R * lda + C) * 2u; voffB[i] = (unsigned)(R * ldb + C) * 2u; }
  const size_t kstep = 128;
  const size_t hstepA = (size_t)128 * lda * 2, hstepB = (size_t)128 * ldb * 2;
  const unsigned ldsw = (unsigned)wid * 1024u;
  const int aoff = g8_lds_byte(wr * 64 + fr, fq * 8), boff = g8_lds_byte(wc * 32 + fr, fq * 8);
  const char* cA = (const char*)A + (size_t)brow * lda * 2; const char* cB = (const char*)Bt + (size_t)bcol * ldb * 2;
  bf16x8 At[4][2], B0[2][2], B1[2][2];
  const int nt = K / 64;
  __syncthreads();
  G8_STAGE(G8_OSB(0, 0), cB, voffB); G8_STAGE(G8_OSA(0, 0), cA, voffA); G8_STAGE(G8_OSB(0, 1), cB + hstepB, voffB); G8_STAGE(G8_OSA(0, 1), cA + hstepA, voffA);
  if (wr == 1) G8_BAR;
  G8_WAIT_V(4); G8_BAR;
  G8_STAGE(G8_OSB(1, 0), cB + kstep, voffB); G8_STAGE(G8_OSA(1, 0), cA + kstep, voffA); G8_STAGE(G8_OSB(1, 1), cB + hstepB + kstep, voffB);
  G8_WAIT_V(6); G8_BAR;
  for (int t = 0; t < nt - 2; t += 2) {
    const char* a1 = cA + (size_t)(t + 1) * kstep;
    const char* a2 = cA + (size_t)(t + 2) * kstep; const char* b2 = cB + (size_t)(t + 2) * kstep;
    const char* a3 = a2 + kstep; const char* b3 = b2 + kstep;
    G8_LDB(B0, 0, 0); G8_SCHED; G8_LDA(At, 0, 0); G8_STAGE(G8_OSA(1, 1), a1 + hstepA, voffA);
    G8_WAIT_L(8); G8_BAR; G8_WAIT_L(0); G8_MMA(0, 0, At, B0); G8_BAR; G8_SCHED;
    G8_LDB(B1, 0, 1); G8_STAGE(G8_OSB(0, 0), b2, voffB);
    G8_BAR; G8_WAIT_L(0); G8_MMA(0, 1, At, B1); G8_BAR;
    G8_LDA(At, 0, 1); G8_STAGE(G8_OSA(0, 0), a2, voffA);
    G8_BAR; G8_WAIT_L(0); G8_MMA(1, 0, At, B0); G8_BAR; G8_SCHED;
    G8_STAGE(G8_OSB(0, 1), b2 + hstepB, voffB);
    G8_WAIT_V(6); G8_BAR; G8_MMA(1, 1, At, B1); G8_BAR;
    G8_LDB(B0, 1, 0); G8_SCHED; G8_LDA(At, 1, 0); G8_STAGE(G8_OSA(0, 1), a2 + hstepA, voffA);
    G8_WAIT_L(8); G8_BAR; G8_WAIT_L(0); G8_MMA(0, 0, At, B0); G8_BAR; G8_SCHED;
    G8_LDB(B1, 1, 1); G8_STAGE(G8_OSB(1, 0), b3, voffB);
    G8_BAR; G8_WAIT_L(0); G8_MMA(0, 1, At, B1); G8_BAR;
    G8_LDA(At, 1, 1); G8_STAGE(G8_OSA(1, 0), a3, voffA);
    G8_BAR; G8_WAIT_L(0); G8_MMA(1, 0, At, B0); G8_BAR; G8_SCHED;
    G8_STAGE(G8_OSB(1, 1), b3 + hstepB, voffB);
    G8_WAIT_V(6); G8_BAR; G8_MMA(1, 1, At, B1); G8_BAR;
  }
  { const char* a1 = cA + (size_t)(nt - 1) * kstep;
    G8_LDB(B0, 0, 0); G8_LDA(At, 0, 0); G8_STAGE(G8_OSA(1, 1), a1 + hstepA, voffA);
    G8_BAR; G8_WAIT_L(0); G8_MMA(0, 0, At, B0); G8_BAR;
    G8_LDB(B1, 0, 1); G8_BAR; G8_WAIT_L(0); G8_MMA(0, 1, At, B1); G8_BAR;
    G8_LDA(At, 0, 1); G8_WAIT_V(4); G8_BAR; G8_WAIT_L(0); G8_MMA(1, 0, At, B0); G8_MMA(1, 1, At, B1); G8_BAR; }
  { G8_LDB(B0, 1, 0); G8_LDA(At, 1, 0); G8_WAIT_V(2); G8_BAR; G8_WAIT_L(0); G8_MMA(0, 0, At, B0); G8_BAR;
    G8_LDB(B1, 1, 1); G8_WAIT_V(0); G8_BAR; G8_WAIT_L(0); G8_MMA(0, 1, At, B1); G8_BAR;
    G8_LDA(At, 1, 1); G8_BAR; G8_WAIT_L(0); G8_MMA(1, 0, At, B0); G8_MMA(1, 1, At, B1); G8_BAR; }
  if (wr == 0) G8_BAR;
}
#define ZERO_ACC8(a) { float z_ = 0.f; asm volatile("" : "+v"(z_)); _Pragma("unroll") for (int i_ = 0; i_ < 2; i_++) _Pragma("unroll") for (int j_ = 0; j_ < 2; j_++) _Pragma("unroll") for (int m_ = 0; m_ < 4; m_++) _Pragma("unroll") for (int n_ = 0; n_ < 2; n_++) a[i_][j_][m_][n_] = (f32x4){z_, z_, z_, z_}; }
__device__ __forceinline__ bool tile_order(int L, int nM, int nN, int& pm, int& pn) {
  const int nwg = nM * nN; if (L >= nwg) return false;
  int wgid = L; { const int q = nwg / 8, r = nwg % 8, xcd = wgid % 8, off = wgid / 8; wgid = (xcd < r ? xcd * (q + 1) : r * (q + 1) + (xcd - r) * q) + off; }
  const int nig = 8 * nN, gid = wgid / nig, fm = gid * 8, gsz = (nM - fm) < 8 ? (nM - fm) : 8;
  pm = fm + ((wgid % nig) % gsz); pn = (wgid % nig) / gsz; return true;
}

__device__ __forceinline__ void transpose_tile(const float* __restrict__ src, int R, int C, bf* __restrict__ dst, int ldd, int off, int tile, bf* sm) {
  const int tilesC = (C + 63) >> 6;
  const int tr = tile / tilesC, tc = tile - tr * tilesC;
  const int r0 = tr * 64, c0 = tc * 64;
  const int tid = otid();
#pragma unroll
  for (int i = 0; i < 4; i++) {
    int r = (tid >> 4) + 16 * i; int c = (tid & 15) * 4;
    const float zt_ = ozero(); float4 v = make_float4(zt_, zt_, zt_, zt_);
    if (c0 + c < C) v = *(const float4*)(src + (size_t)(r0 + r) * C + c0 + c);
    sm[(c + 0) * 66 + r] = f2bf(v.x); sm[(c + 1) * 66 + r] = f2bf(v.y);
    sm[(c + 2) * 66 + r] = f2bf(v.z); sm[(c + 3) * 66 + r] = f2bf(v.w);
  }
  __syncthreads();
  {
    int c = tid >> 2, ch = (tid & 3) * 16;
    if (c0 + c < C) {
      unsigned wv[8];
#pragma unroll
      for (int k = 0; k < 8; k++) wv[k] = *(const unsigned*)(sm + c * 66 + ch + 2 * k);
      bf* d = dst + (size_t)(c0 + c) * ldd + off + r0 + ch;
      *(uint4*)d = make_uint4(wv[0], wv[1], wv[2], wv[3]);
      *(uint4*)(d + 8) = make_uint4(wv[4], wv[5], wv[6], wv[7]);
    }
  }
  __syncthreads();
}

__device__ __forceinline__ bool try_tr(int& t, const float* src, int R, int C, bf* dst, int ldd, int off, bf* sm) {
  int nt = (R >> 6) * ((C + 63) >> 6);
  if (t < nt) { transpose_tile(src, R, C, dst, ldd, off, t, sm); return true; }
  t -= nt; return false;
}

__device__ __forceinline__ void phase0(const Params& p, char* smc) {
  bf* sm = (bf*)(smc + HB * 65536);
  const int perLayer = 32 * 218 + 256 + 256 + 512 + 128 + 1024 + 64 + 256;
  for (int task = VB; task < 2 * perLayer; task += G2) {
    int layer = task / perLayer; int t = task - layer * perLayer;
    bf* WbrL = p.WbrT + (size_t)layer * 2048 * YW;
    if (try_tr(t, p.w_in + (size_t)layer * DM * INW, 2048, INW, p.WinT + (size_t)layer * INW * 2048, 2048, 0, sm)) continue;
    if (try_tr(t, p.w_br_s5 + (size_t)layer * 512 * 2048, 512, 2048, WbrL, YW, 0, sm)) continue;
    if (try_tr(t, p.w_br_attn + (size_t)layer * 512 * 2048, 512, 2048, WbrL, YW, 512, sm)) continue;
    if (try_tr(t, p.w_br_ssd + (size_t)layer * 1024 * 2048, 1024, 2048, WbrL, YW, 1024, sm)) continue;
    if (try_tr(t, p.w_br_mem + (size_t)layer * 256 * 2048, 256, 2048, WbrL, YW, 2048, sm)) continue;
    if (try_tr(t, p.w_out + (size_t)layer * 2048 * 2048, 2048, 2048, p.WoutT + (size_t)layer * 2048 * 2048, 2048, 0, sm)) continue;
    if (try_tr(t, p.w_glu + (size_t)layer * 512 * 512, 512, 512, p.WgluT + (size_t)layer * 512 * 512, 512, 0, sm)) continue;
    if (try_tr(t, p.mem_w_kv + (size_t)layer * 2048 * 512, 2048, 512, p.WmemT + (size_t)layer * 512 * 2048, 2048, 0, sm)) continue;
  }
  const size_t gtid = (size_t)blockIdx.x * 512 + otid_full(), gstr = (size_t)gridDim.x * 512;
  for (size_t i = gtid; i < (size_t)TT * DM / 8; i += gstr) {
    float4 a = *(const float4*)(p.x + i * 8), b = *(const float4*)(p.x + i * 8 + 4);
    *(uint4*)(p.xb + i * 8) = make_uint4(pk2(a.x, a.y), pk2(a.z, a.w), pk2(b.x, b.y), pk2(b.z, b.w));
  }
  for (size_t i = gtid; i < (size_t)512 * DM / 8; i += gstr) {
    float4 a = *(const float4*)(p.mem + i * 8), b = *(const float4*)(p.mem + i * 8 + 4);
    *(uint4*)(p.memb + i * 8) = make_uint4(pk2(a.x, a.y), pk2(a.z, a.w), pk2(b.x, b.y), pk2(b.z, b.w));
  }
  for (size_t i = gtid; i < (size_t)TT; i += gstr) {
    const float ps = (float)p.pos[i];
#pragma unroll
    for (int j = 0; j < 8; j++) {
      float ang = ps * p.inv[j];
      float s, c; sincosf(ang, &s, &c);
      p.CS[i * 16 + j] = c; p.CS[i * 16 + 8 + j] = s;
    }
  }
  for (size_t i = gtid; i < 2 * 32 * 64; i += gstr) {
    int pp = (int)(i & 63), g = (int)((i >> 6) & 31), layer = (int)(i >> 11);
    float dt = expf(p.log_dt[layer * 32 + g]);
    float lr = p.lam_re[i], li = p.lam_im[i];
    float mag = expf(lr * dt);
    float sn, cs; sincosf(li * dt, &sn, &cs);
    float ar = mag * cs, ai = mag * sn;
    float den = lr * lr + li * li;
    float nr = ar - 1.f, ni = ai;
    float fr = (nr * lr + ni * li) / den, fi = (ni * lr - nr * li) / den;
    float* sb = p.SB + i * 32;
    const float* bre = p.b_re + i * 16; const float* bim = p.b_im + i * 16;
    for (int h = 0; h < 16; h++) {
      float br = bre[h], bi = bim[h];
      sb[h] = fr * br - fi * bi; sb[16 + h] = fr * bi + fi * br;
    }
    float pr = ar, pi = ai;
    for (int k = 0; k < 7; k++) { float nr2 = pr * pr - pi * pi, ni2 = 2.f * pr * pi; pr = nr2; pi = ni2; }
    p.SA[i * 4 + 0] = ar; p.SA[i * 4 + 1] = ai; p.SA[i * 4 + 2] = pr; p.SA[i * 4 + 3] = pi;
    for (int h = 0; h < 16; h++) {
      size_t ci = ((size_t)(layer * 32 + g) * 16 + h);
      p.CM[ci * 128 + pp] = f2bf(p.c_re[ci * 64 + pp]);
      p.CM[ci * 128 + 64 + pp] = f2bf(-p.c_im[ci * 64 + pp]);
    }
  }
}

__device__ __forceinline__ void phaseA(const Params& p, int layer) {
  const int tidf = otid_full();
  const int wid = __builtin_amdgcn_readfirstlane(tidf >> 6), lane = tidf & 63, wr = wid >> 2, wc = wid & 3, fr = lane & 15, fq = lane >> 4;
  const bf* Wl = p.WinT + (size_t)layer * INW * 2048;
  const int nA = 128 * 23;
  const int total = nA + (layer == 0 ? 8 : 0);
  for (int L = blockIdx.x; L < total; L += gridDim.x) {
    f32x4 acc[2][2][4][2]; ZERO_ACC8(acc);
    if (L < nA) {
      int pm, pn; tile_order(L, 128, 23, pm, pn);
      const int brow = pm * 256, bcol = pn * 256;
      gemm256(p.xb, 2048, Wl, 2048, 2048, brow, bcol, acc);
#pragma unroll
      for (int ai = 0; ai < 2; ai++)
#pragma unroll
        for (int m = 0; m < 4; m++) {
          const int tok = brow + ai * 128 + wr * 64 + m * 16 + fr;
#pragma unroll
          for (int bj = 0; bj < 2; bj++)
#pragma unroll
            for (int n = 0; n < 2; n++) {
              const int cb = bcol + bj * 128 + wc * 32 + n * 16;
              f32x4 v = acc[ai][bj][m][n];
              if (n == 0 && (wc & 1) == 0 && ((cb >= C_ATQ && cb < C_ATV) || (cb >= C_IDQ && cb < C_IDW))) {
                f32x4 cs = *(const f32x4*)(p.CS + (size_t)tok * 16 + 4 * (fq & 1));
                f32x4 sn = *(const f32x4*)(p.CS + (size_t)tok * 16 + 8 + 4 * (fq & 1));
#pragma unroll
                for (int e = 0; e < 4; e++) {
                  float o = __shfl_xor(v[e], 32);
                  v[e] = (fq < 2) ? (v[e] * cs[e] - o * sn[e]) : (v[e] * cs[e] + o * sn[e]);
                }
              }
              const int nn = cb + fq * 4;
              if (nn < 5716) {
                const int dn = nn + (nn >= 2628 ? 12 : 0);
                uint2 pv = make_uint2(pk2(v[0], v[1]), pk2(v[2], v[3]));
                *(uint2*)(p.P + (size_t)tok * PW + dn) = pv;
                if (nn >= C_IDK && nn < C_IDW) {
                  const int d = nn - C_IDK; const int b = tok >> 14, li = tok & 16383;
                  size_t o = ((((size_t)(b * 512 + (li >> 5)) * 4 + (d >> 4)) * 64 + ((d >> 3) & 1) * 32 + (li & 31)) * 8) + (d & 7);
                  *(uint2*)(p.KIF + o) = pv;
                }
                if (nn >= C_ATK && nn < C_ATZ) *(uint2*)(p.KVC + (size_t)tok * 256 + (nn - C_ATK)) = pv;
              }
            }
        }
    } else {
      const int t8 = L - nA; const int ly = t8 >> 2, tm = (t8 >> 1) & 1, tn = t8 & 1;
      gemm256(p.memb, 2048, p.WmemT + (size_t)ly * 512 * 2048, 2048, 2048, tm * 256, tn * 256, acc);
#pragma unroll
      for (int ai = 0; ai < 2; ai++)
#pragma unroll
        for (int m = 0; m < 4; m++) {
          const int row = tm * 256 + ai * 128 + wr * 64 + m * 16 + fr; const int b = row >> 8, mm = row & 255;
#pragma unroll
          for (int bj = 0; bj < 2; bj++)
#pragma unroll
            for (int n = 0; n < 2; n++)
#pragma unroll
              for (int e = 0; e < 4; e++) {
                const int nn = tn * 256 + bj * 128 + wc * 32 + n * 16 + fq * 4 + e; const float v = acc[ai][bj][m][n][e];
                if (nn < 256) { int h = nn >> 6, d = nn & 63; p.MK[((((size_t)ly * 2 + b) * 4 + h) * 256 + mm) * 64 + d] = f2bf(v); }
                else { int h = (nn - 256) >> 6, d = nn & 63; p.MVT[((((size_t)ly * 2 + b) * 4 + h) * 64 + d) * 256 + mm] = f2bf(v); }
              }
        }
    }
  }
}

__device__ __forceinline__ float softplusf_(float x) { return x > 15.f ? x : log1pf(__expf(x)); }

__device__ __forceinline__ void ssd_dt_acs(const Params& p, int layer, size_t tok0, int gg, float* sAcs, float* sDt) {
  const int tid = otid(), lane = tid & 63, w = tid >> 6;
#pragma unroll
  for (int k = 0; k < 2; k++) {
    const int hh = 2 * w + k, hd = gg * 8 + hh;
    const float bias = p.dt_bias[layer * 16 + hd], a = -__expf(p.a_log[layer * 16 + hd]);
    const int l0 = 2 * lane;
    float d0 = softplusf_(bf2f(p.P[(tok0 + l0) * PW + C_SDT + hd]) + bias);
    float d1 = softplusf_(bf2f(p.P[(tok0 + l0 + 1) * PW + C_SDT + hd]) + bias);
    float s0 = d0 * a, s1 = s0 + d1 * a;
    float xs = s1;
#pragma unroll
    for (int off = 1; off < 64; off <<= 1) { float v = __shfl_up(xs, off); if (lane >= off) xs += v; }
    float ex = xs - s1;
    sAcs[l0 * 8 + hh] = ex + s0; sAcs[(l0 + 1) * 8 + hh] = ex + s1;
    sDt[l0 * 8 + hh] = d0; sDt[(l0 + 1) * 8 + hh] = d1;
  }
}

struct Conv2 { float w0[4], w1[4], b0, b1, h0[3], h1[3]; };
__device__ __forceinline__ void conv_init(const Params& p, int layer, size_t tokb, int l, int ch, Conv2& c) {
  const float* cw = p.conv_w + (size_t)layer * 4 * 1536 + ch;
#pragma unroll
  for (int k = 0; k < 4; k++) { c.w0[k] = cw[k * 1536]; c.w1[k] = cw[k * 1536 + 1]; }
  c.b0 = p.conv_b[layer * 1536 + ch]; c.b1 = p.conv_b[layer * 1536 + ch + 1];
#pragma unroll
  for (int k = 0; k < 3; k++) {
    int ll = l - 3 + k; unsigned u = 0;
    if (ll >= 0) u = *(const unsigned*)(p.P + (tokb + ll) * PW + C_XBC + ch);
    c.h0[k] = bflo(u); c.h1[k] = bfhi(u);
  }
}
__device__ __forceinline__ void conv_step(const Params& p, size_t tokb, int l, int ch, Conv2& c, float& o0, float& o1) {
  unsigned u = *(const unsigned*)(p.P + (tokb + l) * PW + C_XBC + ch);
  float x0 = bflo(u), x1 = bfhi(u);
  float a0 = c.b0 + c.w0[0] * c.h0[0] + c.w0[1] * c.h0[1] + c.w0[2] * c.h0[2] + c.w0[3] * x0;
  float a1 = c.b1 + c.w1[0] * c.h1[0] + c.w1[1] * c.h1[1] + c.w1[2] * c.h1[2] + c.w1[3] * x1;
  c.h0[0] = c.h0[1]; c.h0[1] = c.h0[2]; c.h0[2] = x0;
  c.h1[0] = c.h1[1]; c.h1[1] = c.h1[2]; c.h1[2] = x1;
  o0 = siluf_(a0); o1 = siluf_(a1);
}

__device__ __forceinline__ void ssd_pass1(const Params& p, int layer, int task, char* sm) {
  const int tid = otid(), lane = tid & 63, w = tid >> 6, r32 = lane & 31, h5 = lane >> 5;
  const int gg = task & 1, c = (task >> 1) & 127, b = task >> 8;
  const size_t tokb = (size_t)b * LSEQ; const int lc0 = c * 128; const size_t tok0 = tokb + lc0;
  float* sAcs = (float*)sm; float* sDt = (float*)(sm + 4096);
  bf* sBT = (bf*)(sm + 8192); bf* sXT = (bf*)(sm + 43008);
  __syncthreads();
  ssd_dt_acs(p, layer, tok0, gg, sAcs, sDt);
  {
    const int cp = tid & 63, tg = tid >> 6; const int ch = 1024 + gg * 128 + 2 * cp;
    Conv2 cv; conv_init(p, layer, tokb, lc0 + tg * 32, ch, cv);
    for (int l = tg * 32; l < tg * 32 + 32; l += 2) {
      float a0, a1, b0, b1;
      conv_step(p, tokb, lc0 + l, ch, cv, a0, a1);
      conv_step(p, tokb, lc0 + l + 1, ch, cv, b0, b1);
      *(unsigned*)(sBT + (2 * cp) * 136 + l) = pk2(a0, b0);
      *(unsigned*)(sBT + (2 * cp + 1) * 136 + l) = pk2(a1, b1);
    }
  }
  __syncthreads();
  if (tid < 8) p.CD[((size_t)(b * 128 + c)) * 16 + gg * 8 + tid] = __expf(sAcs[127 * 8 + tid]);
  for (int hh = 0; hh < 8; hh++) {
    const int hd = gg * 8 + hh;
    if (hh) __syncthreads();
    {
      const int cp = tid & 31, tg = tid >> 5; const int ch = gg * 512 + hh * 64 + 2 * cp;
      const float aend = sAcs[127 * 8 + hh];
      Conv2 cv; conv_init(p, layer, tokb, lc0 + tg * 16, ch, cv);
      for (int l = tg * 16; l < tg * 16 + 16; l += 2) {
        float a0, a1, b0, b1;
        conv_step(p, tokb, lc0 + l, ch, cv, a0, a1);
        conv_step(p, tokb, lc0 + l + 1, ch, cv, b0, b1);
        float sa = sDt[l * 8 + hh] * __expf(aend - sAcs[l * 8 + hh]);
        float sb = sDt[(l + 1) * 8 + hh] * __expf(aend - sAcs[(l + 1) * 8 + hh]);
        *(unsigned*)(sXT + (2 * cp) * 136 + l) = pk2(a0 * sa, b0 * sb);
        *(unsigned*)(sXT + (2 * cp + 1) * 136 + l) = pk2(a1 * sa, b1 * sb);
      }
    }
    __syncthreads();
    f32x16 acc[2];
#pragma unroll
    for (int r = 0; r < 16; r++) { const float z_ = ozero(); acc[0][r] = z_; acc[1][r] = z_; }
#pragma unroll
    for (int ks = 0; ks < 8; ks++) {
      bf16x8 bfr = *(const bf16x8*)(sBT + (32 * w + r32) * 136 + ks * 16 + 8 * h5);
      bf16x8 x0 = *(const bf16x8*)(sXT + (r32) * 136 + ks * 16 + 8 * h5);
      bf16x8 x1 = *(const bf16x8*)(sXT + (32 + r32) * 136 + ks * 16 + 8 * h5);
      acc[0] = mfma32(x0, bfr, acc[0]);
      acc[1] = mfma32(x1, bfr, acc[1]);
    }
    float* st = p.ST + ((size_t)(b * 128 + c) * 16 + hd) * 64 * 128;
#pragma unroll
    for (int pi = 0; pi < 2; pi++)
#pragma unroll
      for (int r = 0; r < 16; r++) {
        int pp = 32 * pi + 8 * (r >> 2) + 4 * h5 + (r & 3);
        st[pp * 128 + 32 * w + r32] = acc[pi][r];
      }
  }
}

__device__ __forceinline__ void ssd_statepass(const Params& p, int task) {
  const int idx = task * 256 + otid();
  const int b = idx >> 15, e4 = idx & 32767;
  const int hd = e4 >> 11;
  const float zc_ = ozero(); float4 carry = make_float4(zc_, zc_, zc_, zc_);
  float* base = p.ST + (size_t)b * 128 * 131072 + (size_t)e4 * 4;
  const float* cd = p.CD + (size_t)b * 128 * 16 + hd;
  for (int c0 = 0; c0 < 128; c0 += 4) {
    float4 v[4]; float d[4];
#pragma unroll
    for (int k = 0; k < 4; k++) { v[k] = *(const float4*)(base + (size_t)(c0 + k) * 131072); d[k] = cd[(c0 + k) * 16]; }
#pragma unroll
    for (int k = 0; k < 4; k++) {
      *(float4*)(base + (size_t)(c0 + k) * 131072) = carry;
      carry.x = carry.x * d[k] + v[k].x; carry.y = carry.y * d[k] + v[k].y;
      carry.z = carry.z * d[k] + v[k].z; carry.w = carry.w * d[k] + v[k].w;
    }
  }
}

__device__ __forceinline__ void ssd_pass2(const Params& p, int layer, int task, char* sm) {
  const int tid = otid(), lane = tid & 63, w = tid >> 6, r32 = lane & 31, h5 = lane >> 5;
  const int lh = task & 1, gg = (task >> 1) & 1, c = (task >> 2) & 127, b = task >> 9;
  const size_t tokb = (size_t)b * LSEQ; const int lc0 = c * 128; const size_t tok0 = tokb + lc0;
  float* sAcs = (float*)sm; float* sDt = (float*)(sm + 4096);
  bf* sC = (bf*)(sm + 8192); bf* sB = (bf*)(sm + 25600); bf* sM = (bf*)(sm + 25600); bf* sXT = (bf*)(sm + 43008);
  float* sSsq = (float*)(sm + 60416);
  const int wr = w >> 1, wc = w & 1;
  const int nS = 64 * (lh + 1);
  __syncthreads();
  ssd_dt_acs(p, layer, tok0, gg, sAcs, sDt);
  if (tid < 64) sSsq[tid] = 0.f;
  {
    const int cp = tid & 63, tg = tid >> 6;
    {
      const int ch = 1280 + gg * 128 + 2 * cp;
      const int lst = 64 * lh + tg * 16;
      Conv2 cv; conv_init(p, layer, tokb, lc0 + lst, ch, cv);
      for (int l = lst; l < lst + 16; l++) {
        float a0, a1; conv_step(p, tokb, lc0 + l, ch, cv, a0, a1);
        *(unsigned*)(sC + (l - 64 * lh) * 136 + 2 * cp) = pk2(a0, a1);
      }
    }
    {
      const int ch = 1024 + gg * 128 + 2 * cp;
      const int per = nS >> 2; const int lst = tg * per;
      Conv2 cv; conv_init(p, layer, tokb, lc0 + lst, ch, cv);
      for (int l = lst; l < lst + per; l++) {
        float a0, a1; conv_step(p, tokb, lc0 + l, ch, cv, a0, a1);
        *(unsigned*)(sB + l * 136 + 2 * cp) = pk2(a0, a1);
      }
    }
  }
  __syncthreads();
  f32x16 cb[2];
#pragma unroll
  for (int r = 0; r < 16; r++) { const float z_ = ozero(); cb[0][r] = z_; cb[1][r] = z_; }
  if (64 * wc < nS) {
#pragma unroll
    for (int ks = 0; ks < 8; ks++) {
      bf16x8 af = *(const bf16x8*)(sC + (32 * wr + r32) * 136 + ks * 16 + 8 * h5);
      bf16x8 b0 = *(const bf16x8*)(sB + (64 * wc + r32) * 136 + ks * 16 + 8 * h5);
      bf16x8 b1 = *(const bf16x8*)(sB + (64 * wc + 32 + r32) * 136 + ks * 16 + 8 * h5);
      cb[0] = mfma32(af, b0, cb[0]);
      cb[1] = mfma32(af, b1, cb[1]);
    }
  }
  __syncthreads();
  const int wc2 = w & 1;
  for (int hh = 0; hh < 8; hh++) {
    const int hd = gg * 8 + hh;
    if (hh) __syncthreads();
    {
      const float dsk = p.ssd_d[layer * 16 + hd];
#pragma unroll
      for (int j = 0; j < 2; j++) {
        const int s = 64 * wc + 32 * j + r32;
        if (s < nS) {
          const float as = sAcs[s * 8 + hh];
#pragma unroll
          for (int r = 0; r < 16; r++) {
            const int lp = 32 * wr + 8 * (r >> 2) + 4 * h5 + (r & 3); const int l = 64 * lh + lp;
            float v = 0.f;
            if (s <= l) v = cb[j][r] * __expf(sAcs[l * 8 + hh] - as);
            if (s == l) v += dsk / sDt[l * 8 + hh];
            sM[lp * 136 + s] = f2bf(v);
          }
        }
      }
    }
    {
      const int cp = tid & 31, tg = tid >> 5; const int ch = gg * 512 + hh * 64 + 2 * cp;
      const int per = nS >> 3; const int lst = tg * per;
      Conv2 cv; conv_init(p, layer, tokb, lc0 + lst, ch, cv);
      for (int l = lst; l < lst + per; l += 2) {
        float a0, a1, b0, b1;
        conv_step(p, tokb, lc0 + l, ch, cv, a0, a1);
        conv_step(p, tokb, lc0 + l + 1, ch, cv, b0, b1);
        float sa = sDt[l * 8 + hh], sb = sDt[(l + 1) * 8 + hh];
        *(unsigned*)(sXT + (2 * cp) * 136 + l) = pk2(a0 * sa, b0 * sb);
        *(unsigned*)(sXT + (2 * cp + 1) * 136 + l) = pk2(a1 * sa, b1 * sb);
      }
    }
    __syncthreads();
    f32x16 yd, yo;
#pragma unroll
    for (int r = 0; r < 16; r++) { const float z_ = ozero(); yd[r] = z_; yo[r] = z_; }
    const int nks = nS >> 4;
    for (int ks = 0; ks < nks; ks++) {
      bf16x8 xf = *(const bf16x8*)(sXT + (32 * wc2 + r32) * 136 + ks * 16 + 8 * h5);
      bf16x8 mf = *(const bf16x8*)(sM + (32 * wr + r32) * 136 + ks * 16 + 8 * h5);
      yd = mfma32(xf, mf, yd);
    }
    {
      const float* pv = p.ST + (((size_t)(b * 128 + c) * 16 + hd) * 64 + 32 * wc2 + r32) * 128 + 8 * h5;
#pragma unroll
      for (int ks = 0; ks < 8; ks++) {
        float4 u0 = *(const float4*)(pv + ks * 16), u1 = *(const float4*)(pv + ks * 16 + 4);
        bf16x8 pf;
        unsigned q0 = pk2(u0.x, u0.y), q1 = pk2(u0.z, u0.w), q2 = pk2(u1.x, u1.y), q3 = pk2(u1.z, u1.w);
        pf[0] = (short)(q0 & 0xFFFF); pf[1] = (short)(q0 >> 16); pf[2] = (short)(q1 & 0xFFFF); pf[3] = (short)(q1 >> 16);
        pf[4] = (short)(q2 & 0xFFFF); pf[5] = (short)(q2 >> 16); pf[6] = (short)(q3 & 0xFFFF); pf[7] = (short)(q3 >> 16);
        bf16x8 cf = *(const bf16x8*)(sC + (32 * wr + r32) * 136 + ks * 16 + 8 * h5);
        yo = mfma32(pf, cf, yo);
      }
    }
    {
      const int lp = 32 * wr + r32; const int l = 64 * lh + lp; const size_t tok = tok0 + l;
      const float eo = __expf(sAcs[l * 8 + hh]);
      float ss = 0.f;
#pragma unroll
      for (int q = 0; q < 4; q++) {
        const int pp = 32 * wc2 + 8 * q + 4 * h5;
        uint2 zz = *(const uint2*)(p.P + tok * PW + C_SSZ + hd * 64 + pp);
        float v0 = (yd[4 * q] + eo * yo[4 * q]) * siluf_(bflo(zz.x));
        float v1 = (yd[4 * q + 1] + eo * yo[4 * q + 1]) * siluf_(bfhi(zz.x));
        float v2 = (yd[4 * q + 2] + eo * yo[4 * q + 2]) * siluf_(bflo(zz.y));
        float v3 = (yd[4 * q + 3] + eo * yo[4 * q + 3]) * siluf_(bfhi(zz.y));
        ss += v0 * v0 + v1 * v1 + v2 * v2 + v3 * v3;
        *(uint2*)(p.Y + tok * YW + Y_SSD + hd * 64 + pp) = make_uint2(pk2(v0, v1), pk2(v2, v3));
      }
      atomicAdd(&sSsq[lp], ss);
    }
  }
  __syncthreads();
  {
    const int lp = tid >> 2, part = tid & 3; const size_t tok = tok0 + 64 * lh + lp;
    const float rs = rsqrtf(sSsq[lp] * (1.f / 512.f) + 1e-5f);
    bf* yp = p.Y + tok * YW + Y_SSD + gg * 512 + part * 128;
    const float* ng = p.norm_g + layer * 1024 + gg * 512 + part * 128;
#pragma unroll 4
    for (int i = 0; i < 16; i++) {
      uint4 u = *(const uint4*)(yp + i * 8);
      float4 g0 = *(const float4*)(ng + i * 8), g1 = *(const float4*)(ng + i * 8 + 4);
      u.x = pk2(bflo(u.x) * rs * g0.x, bfhi(u.x) * rs * g0.y);
      u.y = pk2(bflo(u.y) * rs * g0.z, bfhi(u.y) * rs * g0.w);
      u.z = pk2(bflo(u.z) * rs * g1.x, bfhi(u.z) * rs * g1.y);
      u.w = pk2(bflo(u.w) * rs * g1.z, bfhi(u.w) * rs * g1.w);
      *(uint4*)(yp + i * 8) = u;
    }
  }
}

__device__ __forceinline__ void s5_load_u(const Params& p, size_t tok, int g, float* dst) {
  const uint4* src = (const uint4*)(p.P + tok * PW + C_S5U + g * 16);
  uint4 a = src[0], b = src[1];
  *(float4*)(dst + 0) = make_float4(bflo(a.x), bfhi(a.x), bflo(a.y), bfhi(a.y));
  *(float4*)(dst + 4) = make_float4(bflo(a.z), bfhi(a.z), bflo(a.w), bfhi(a.w));
  *(float4*)(dst + 8) = make_float4(bflo(b.x), bfhi(b.x), bflo(b.y), bfhi(b.y));
  *(float4*)(dst + 12) = make_float4(bflo(b.z), bfhi(b.z), bflo(b.w), bfhi(b.w));
}
#define S5_STEP(uu)                                                                     \
  {                                                                                     \
    float4 u0 = *(const float4*)((uu)), u1 = *(const float4*)((uu) + 4), u2 = *(const float4*)((uu) + 8), u3 = *(const float4*)((uu) + 12); \
    float br = Br[0] * u0.x, bi = Bi[0] * u0.x;                                         \
    br += Br[1] * u0.y; bi += Bi[1] * u0.y; br += Br[2] * u0.z; bi += Bi[2] * u0.z; br += Br[3] * u0.w; bi += Bi[3] * u0.w; \
    br += Br[4] * u1.x; bi += Bi[4] * u1.x; br += Br[5] * u1.y; bi += Bi[5] * u1.y; br += Br[6] * u1.z; bi += Bi[6] * u1.z; br += Br[7] * u1.w; bi += Bi[7] * u1.w; \
    br += Br[8] * u2.x; bi += Bi[8] * u2.x; br += Br[9] * u2.y; bi += Bi[9] * u2.y; br += Br[10] * u2.z; bi += Bi[10] * u2.z; br += Br[11] * u2.w; bi += Bi[11] * u2.w; \
    br += Br[12] * u3.x; bi += Bi[12] * u3.x; br += Br[13] * u3.y; bi += Bi[13] * u3.y; br += Br[14] * u3.z; bi += Bi[14] * u3.z; br += Br[15] * u3.w; bi += Bi[15] * u3.w; \
    float nr_ = ar * sr - ai * si + br; float ni_ = ar * si + ai * sr + bi; sr = nr_; si = ni_; \
  }

__device__ __forceinline__ void s5_pass1(const Params& p, int layer, int task, char* sm) {
  const int tid = otid(), lane = tid & 63, w = tid >> 6;
  const int gq = task & 7, c = (task >> 3) & 127, b = task >> 10;
  const int g = gq * 4 + w;
  const size_t tok0 = (size_t)b * LSEQ + c * 128;
  float* sU = (float*)(sm + w * 8192);
  __syncthreads();
  s5_load_u(p, tok0 + lane, g, sU + lane * 16);
  s5_load_u(p, tok0 + 64 + lane, g, sU + (64 + lane) * 16);
  const size_t pi = ((size_t)(layer * 32 + g)) * 64 + lane;
  float Br[16], Bi[16];
#pragma unroll
  for (int h = 0; h < 16; h++) { Br[h] = p.SB[pi * 32 + h]; Bi[h] = p.SB[pi * 32 + 16 + h]; }
  const float ar = p.SA[pi * 4], ai = p.SA[pi * 4 + 1];
  float sr = 0.f, si = 0.f;
  __builtin_amdgcn_wave_barrier();
  for (int l = 0; l < 128; l++) S5_STEP(sU + l * 16)
  *(float2*)(p.END + (((size_t)(b * 128 + c) * 32 + g) * 64 + lane) * 2) = make_float2(sr, si);
}

__device__ __forceinline__ void s5_carry(const Params& p, int layer, int task) {
  const int idx = task * 256 + otid();
  const int b = idx >> 11, gp = idx & 2047;
  const size_t pi = (size_t)layer * 2048 + gp;
  const float a128r = p.SA[pi * 4 + 2], a128i = p.SA[pi * 4 + 3];
  float sr = ozero(), si = ozero();
  float2* e = (float2*)p.END + (size_t)b * 128 * 2048 + gp;
  for (int c0 = 0; c0 < 128; c0 += 4) {
    float2 v[4];
#pragma unroll
    for (int k = 0; k < 4; k++) v[k] = e[(size_t)(c0 + k) * 2048];
#pragma unroll
    for (int k = 0; k < 4; k++) {
      e[(size_t)(c0 + k) * 2048] = make_float2(sr, si);
      float nr = a128r * sr - a128i * si + v[k].x, ni = a128r * si + a128i * sr + v[k].y; sr = nr; si = ni;
    }
  }
}

__device__ __forceinline__ void s5_pass2(const Params& p, int layer, int task, char* sm) {
  const int tid = otid(), lane = tid & 63, w = tid >> 6;
  const int c = task & 127, b = task >> 7;
  const size_t tok0 = (size_t)b * LSEQ + c * 128;
  float* sU = (float*)(sm + w * 10752); bf* sS = (bf*)(sm + w * 10752 + 2048);
  __syncthreads();
  for (int gi = 0; gi < 8; gi++) {
    const int g = w * 8 + gi;
    const size_t pi = ((size_t)(layer * 32 + g)) * 64 + lane;
    float Br[16], Bi[16];
#pragma unroll
    for (int h = 0; h < 16; h++) { Br[h] = p.SB[pi * 32 + h]; Bi[h] = p.SB[pi * 32 + 16 + h]; }
    const float ar = p.SA[pi * 4], ai = p.SA[pi * 4 + 1];
    float2 s0 = *(const float2*)(p.END + (((size_t)(b * 128 + c) * 32 + g) * 64 + lane) * 2);
    float sr = s0.x, si = s0.y;
    bf16x8 cf[4];
    {
      const bf* cm = p.CM + (((size_t)(layer * 32 + g)) * 16 + (lane & 15)) * 128 + 8 * (lane >> 4);
#pragma unroll
      for (int ks = 0; ks < 4; ks++) cf[ks] = *(const bf16x8*)(cm + ks * 32);
    }
    const float dsk = p.s5_d[(layer * 32 + g) * 16 + (lane & 15)];
    for (int sub = 0; sub < 4; sub++) {
      __builtin_amdgcn_wave_barrier();
      if (lane < 32) s5_load_u(p, tok0 + sub * 32 + lane, g, sU + lane * 16);
      __builtin_amdgcn_wave_barrier();
      for (int l = 0; l < 32; l++) {
        S5_STEP(sU + l * 16)
        sS[l * 136 + lane] = f2bf(sr); sS[l * 136 + 64 + lane] = f2bf(si);
      }
      __builtin_amdgcn_wave_barrier();
#pragma unroll
      for (int mb = 0; mb < 2; mb++) {
        const float z_ = ozero(); f32x4 acc = {z_, z_, z_, z_};
#pragma unroll
        for (int ks = 0; ks < 4; ks++) {
          bf16x8 af = *(const bf16x8*)(sS + (16 * mb + (lane & 15)) * 136 + ks * 32 + 8 * (lane >> 4));
          acc = mfma16(af, cf[ks], acc);
        }
#pragma unroll
        for (int r = 0; r < 4; r++) {
          const int l = 16 * mb + 4 * (lane >> 4) + r;
          float y = acc[r] + dsk * sU[l * 16 + (lane & 15)];
          p.YG[(tok0 + sub * 32 + l) * 512 + g * 16 + (lane & 15)] = f2bf(geluf_(y));
        }
      }
    }
  }
  __syncthreads();
  const int wr = w >> 1, wc = w & 1, r32 = lane & 31, h5 = lane >> 5;
  for (int tn = 0; tn < 4; tn++) {
    f32x16 acc[2][2]; ZERO_ACC(acc);
    gemm_acc<4>(p.YG + tok0 * 512, 512, p.WgluT + ((size_t)layer * 512 + tn * 128) * 512, 512, 512, acc, sm);
#pragma unroll
    for (int i = 0; i < 2; i++) {
      const size_t tok = tok0 + wr * 64 + i * 32 + r32;
#pragma unroll
      for (int j = 0; j < 2; j++)
#pragma unroll
        for (int q = 0; q < 4; q++) {
          const int n = tn * 128 + wc * 64 + j * 32 + q * 8 + h5 * 4;
          float4 bg = *(const float4*)(p.b_glu + layer * 512 + n);
          uint2 yy = *(const uint2*)(p.YG + tok * 512 + n);
          uint2 zz = *(const uint2*)(p.P + tok * PW + C_S5Z + n);
          float o0 = bflo(yy.x) * sigmoidf_(acc[i][j][4 * q] + bg.x) * siluf_(bflo(zz.x));
          float o1 = bfhi(yy.x) * sigmoidf_(acc[i][j][4 * q + 1] + bg.y) * siluf_(bfhi(zz.x));
          float o2 = bflo(yy.y) * sigmoidf_(acc[i][j][4 * q + 2] + bg.z) * siluf_(bflo(zz.y));
          float o3 = bfhi(yy.y) * sigmoidf_(acc[i][j][4 * q + 3] + bg.w) * siluf_(bfhi(zz.y));
          *(uint2*)(p.Y + tok * YW + Y_S5 + n) = make_uint2(pk2(o0, o1), pk2(o2, o3));
        }
    }
  }
}

__device__ __forceinline__ void mem_attn(const Params& p, int layer, int task) {
  const int tid = otid(), lane = tid & 63, h = tid >> 6;
  const int n16 = lane & 15, kq = lane >> 4;
  const size_t tok0 = (size_t)task * 16; const int b = (int)(tok0 >> 14);
  const bf* mk = p.MK + (((size_t)layer * 2 + b) * 4 + h) * 256 * 64;
  const bf* mvt = p.MVT + (((size_t)layer * 2 + b) * 4 + h) * 64 * 256;
  bf16x8 qf[2];
  {
    const bf* qp = p.P + (tok0 + n16) * PW + C_MEQ + h * 64 + 8 * kq;
    qf[0] = *(const bf16x8*)qp; qf[1] = *(const bf16x8*)(qp + 32);
  }
  f32x4 st[16];
#pragma unroll
  for (int kb = 0; kb < 16; kb++) {
    const bf* kp = mk + (size_t)(16 * kb + n16) * 64 + 8 * kq;
    bf16x8 a0 = *(const bf16x8*)kp, a1 = *(const bf16x8*)(kp + 32);
    const float z_ = ozero(); f32x4 acc = {z_, z_, z_, z_};
    acc = mfma16(a0, qf[0], acc); acc = mfma16(a1, qf[1], acc);
    st[kb] = acc * 0.125f;
  }
  float mx = -3.0e38f;
#pragma unroll
  for (int kb = 0; kb < 16; kb++)
#pragma unroll
    for (int r = 0; r < 4; r++) mx = fmaxf(mx, st[kb][r]);
  mx = fmaxf(mx, __shfl_xor(mx, 16)); mx = fmaxf(mx, __shfl_xor(mx, 32));
  float sum = 0.f;
#pragma unroll
  for (int kb = 0; kb < 16; kb++)
#pragma unroll
    for (int r = 0; r < 4; r++) { float e = __expf(st[kb][r] - mx); st[kb][r] = e; sum += e; }
  sum += __shfl_xor(sum, 16); sum += __shfl_xor(sum, 32);
  const float rinv = 1.f / sum;
  f32x4 o[4];
#pragma unroll
  for (int mb = 0; mb < 4; mb++) { const float z_ = ozero(); o[mb] = (f32x4){z_, z_, z_, z_}; }
#pragma unroll
  for (int k2 = 0; k2 < 8; k2++) {
    bf16x8 pf;
    unsigned q0 = pk2(st[2 * k2][0], st[2 * k2][1]), q1 = pk2(st[2 * k2][2], st[2 * k2][3]);
    unsigned q2 = pk2(st[2 * k2 + 1][0], st[2 * k2 + 1][1]), q3 = pk2(st[2 * k2 + 1][2], st[2 * k2 + 1][3]);
    pf[0] = (short)(q0 & 0xFFFF); pf[1] = (short)(q0 >> 16); pf[2] = (short)(q1 & 0xFFFF); pf[3] = (short)(q1 >> 16);
    pf[4] = (short)(q2 & 0xFFFF); pf[5] = (short)(q2 >> 16); pf[6] = (short)(q3 & 0xFFFF); pf[7] = (short)(q3 >> 16);
#pragma unroll
    for (int mb = 0; mb < 4; mb++) {
      const bf* vp = mvt + (size_t)(16 * mb + n16) * 256 + 32 * k2 + 4 * kq;
      uint2 v0 = *(const uint2*)vp, v1 = *(const uint2*)(vp + 16);
      bf16x8 af;
      af[0] = (short)(v0.x & 0xFFFF); af[1] = (short)(v0.x >> 16); af[2] = (short)(v0.y & 0xFFFF); af[3] = (short)(v0.y >> 16);
      af[4] = (short)(v1.x & 0xFFFF); af[5] = (short)(v1.x >> 16); af[6] = (short)(v1.y & 0xFFFF); af[7] = (short)(v1.y >> 16);
      o[mb] = mfma16(af, pf, o[mb]);
    }
  }
  const size_t tok = tok0 + n16;
#pragma unroll
  for (int mb = 0; mb < 4; mb++) {
    const int d = 16 * mb + 4 * kq;
    uint2 zz = *(const uint2*)(p.P + tok * PW + C_MEZ + h * 64 + d);
    float v0 = o[mb][0] * rinv * siluf_(bflo(zz.x)), v1 = o[mb][1] * rinv * siluf_(bfhi(zz.x));
    float v2 = o[mb][2] * rinv * siluf_(bflo(zz.y)), v3 = o[mb][3] * rinv * siluf_(bfhi(zz.y));
    *(uint2*)(p.Y + tok * YW + Y_MEM + h * 64 + d) = make_uint2(pk2(v0, v1), pk2(v2, v3));
  }
}

__device__ __forceinline__ void dsa_wave(const Params& p, int rank, char* sm) {
  const int tid = otid(), lane = tid & 63, w = tid >> 6, r32 = lane & 31, h5 = lane >> 5;
  const int b = rank & 1, qg = 2047 - (rank >> 1), l0 = qg * 8;
  const size_t tokb = (size_t)b * LSEQ;
  unsigned* cand = (unsigned*)(sm + w * (8 * CAP * 4));
  bf* Pb = (bf*)(sm + 4 * 8 * CAP * 4 + w * 2048);
  bf16x8 aq[4];
  {
    const bf* qp = p.P + (tokb + l0 + (r32 >> 2)) * PW + C_IDQ + (r32 & 3) * 64 + 8 * h5;
#pragma unroll
    for (int ks = 0; ks < 4; ks++) aq[ks] = *(const bf16x8*)(qp + ks * 16);
  }
  float wv[4][4]; int ql[4];
#pragma unroll
  for (int g = 0; g < 4; g++) {
    ql[g] = l0 + 2 * g + h5;
    uint2 u = *(const uint2*)(p.P + (tokb + ql[g]) * PW + C_IDW);
    wv[g][0] = bflo(u.x) * 0.0625f; wv[g][1] = bfhi(u.x) * 0.0625f; wv[g][2] = bflo(u.y) * 0.0625f; wv[g][3] = bfhi(u.y) * 0.0625f;
  }
  unsigned Tg[4] = {0u, 0u, 0u, 0u};
  unsigned Tq = 0u; int cntv = 0;
  const int ntile = (l0 + 7) / 32 + 1;
  const bf* kif = p.KIF + (size_t)b * 512 * 2048 + lane * 8;
  bf16x8 bk[4];
#pragma unroll
  for (int ks = 0; ks < 4; ks++) bk[ks] = *(const bf16x8*)(kif + ks * 512);
  const unsigned ltmask = (1u << r32) - 1u;
  for (int tile = 0; tile < ntile; tile++) {
    bf16x8 bc[4];
#pragma unroll
    for (int ks = 0; ks < 4; ks++) bc[ks] = bk[ks];
    if (tile + 1 < ntile) {
#pragma unroll
      for (int ks = 0; ks < 4; ks++) bk[ks] = *(const bf16x8*)(kif + (size_t)(tile + 1) * 2048 + ks * 512);
    }
    unsigned long long over = __ballot(lane < 8 && cntv > CAP - 32);
    if (over) {
      while (over) {
        const int q = __builtin_ctzll(over); over &= over - 1;
        const int n = __builtin_amdgcn_readlane(cntv, q);
        unsigned* cb_ = cand + q * CAP;
        unsigned e[7];
#pragma unroll
        for (int i = 0; i < 7; i++) e[i] = (i * 64 + lane < n) ? cb_[i * 64 + lane] : 0u;
        unsigned T = 0u;
        for (int bit = 31; bit >= 0; bit--) {
          const unsigned cnd = T | (1u << bit); int cc = 0;
#pragma unroll
          for (int i = 0; i < 7; i++) cc += __popcll(__ballot(e[i] >= cnd));
          if (cc >= 256) T = cnd;
        }
        int pos = 0;
#pragma unroll
        for (int i = 0; i < 7; i++) {
          const bool keep = e[i] >= T; const unsigned long long m = __ballot(keep);
          if (keep) cb_[pos + __popcll(m & ((1ull << lane) - 1ull))] = e[i];
          pos += __popcll(m);
        }
        if (lane == q) { cntv = pos; Tq = T; }
      }
#pragma unroll
      for (int g = 0; g < 4; g++) {
        unsigned tlo = __builtin_amdgcn_readlane(Tq, 2 * g), thi = __builtin_amdgcn_readlane(Tq, 2 * g + 1);
        Tg[g] = h5 ? thi : tlo;
      }
    }
    f32x16 acc;
    { const float z_ = ozero();
#pragma unroll
    for (int r = 0; r < 16; r++) acc[r] = z_; }
#pragma unroll
    for (int ks = 0; ks < 4; ks++) acc = mfma32(aq[ks], bc[ks], acc);
    const int kidx = tile * 32 + r32;
#pragma unroll
    for (int g = 0; g < 4; g++) {
      float sc = fmaxf(acc[4 * g], 0.f) * wv[g][0] + fmaxf(acc[4 * g + 1], 0.f) * wv[g][1] +
                 fmaxf(acc[4 * g + 2], 0.f) * wv[g][2] + fmaxf(acc[4 * g + 3], 0.f) * wv[g][3];
      sc += 0.f;
      unsigned u = __float_as_uint(sc); u ^= (u >> 31) ? 0xFFFFFFFFu : 0x80000000u;
      const unsigned pk = (u & 0xFFFFC000u) | (unsigned)(16383 - kidx);
      const bool pass = (kidx <= ql[g]) && (pk > Tg[g]);
      const unsigned long long m = __ballot(pass);
      if (m) {
        const unsigned lo = (unsigned)m, hi = (unsigned)(m >> 32);
        const int cA = __builtin_amdgcn_readlane(cntv, 2 * g), cB = __builtin_amdgcn_readlane(cntv, 2 * g + 1);
        if (pass) {
          const int base = h5 ? cB : cA; const unsigned mm = h5 ? hi : lo;
          cand[(2 * g + h5) * CAP + base + __popc(mm & ltmask)] = pk;
        }
        if (lane == 2 * g) cntv += __popc(lo);
        if (lane == 2 * g + 1) cntv += __popc(hi);
      }
    }
  }
  {
    unsigned long long over = __ballot(lane < 8 && cntv > 256);
    while (over) {
      const int q = __builtin_ctzll(over); over &= over - 1;
      const int n = __builtin_amdgcn_readlane(cntv, q);
      unsigned* cb_ = cand + q * CAP;
      unsigned e[7];
#pragma unroll
      for (int i = 0; i < 7; i++) e[i] = (i * 64 + lane < n) ? cb_[i * 64 + lane] : 0u;
      unsigned T = 0u;
      for (int bit = 31; bit >= 0; bit--) {
        const unsigned cnd = T | (1u << bit); int cc = 0;
#pragma unroll
        for (int i = 0; i < 7; i++) cc += __popcll(__ballot(e[i] >= cnd));
        if (cc >= 256) T = cnd;
      }
      int pos = 0;
#pragma unroll
      for (int i = 0; i < 7; i++) {
        const bool keep = e[i] >= T; const unsigned long long m = __ballot(keep);
        if (keep) cb_[pos + __popcll(m & ((1ull << lane) - 1ull))] = e[i];
        pos += __popcll(m);
      }
      if (lane == q) { cntv = pos; Tq = T; }
    }
  }
  __builtin_amdgcn_wave_barrier();
  const int n16 = lane & 15, kq = lane >> 4;
  for (int q = 0; q < 8; q++) {
    const int n = __builtin_amdgcn_readlane(cntv, q);
    const unsigned* sel = cand + q * CAP;
    const size_t tq = tokb + l0 + q;
    for (int grp = 0; grp < 2; grp++) {
      bf16x8 qa0, qa1;
#pragma unroll
      for (int k = 0; k < 8; k++) { int zi_ = 0; asm volatile("" : "+v"(zi_)); qa0[k] = (short)zi_; qa1[k] = (short)zi_; }
      if (n16 < 4) {
        const bf* qp = p.P + tq * PW + C_ATQ + (grp * 4 + n16) * 64 + 8 * kq;
        qa0 = *(const bf16x8*)qp; qa1 = *(const bf16x8*)(qp + 32);
      }
      f32x4 lg[16];
#pragma unroll
      for (int t = 0; t < 16; t++) {
        const int slot = t * 16 + n16; const bool valid = slot < n;
        const int key = valid ? (16383 - (int)(sel[slot] & 0x3FFFu)) : 0;
        const bf* kp = p.P + (tokb + key) * PW + C_ATK + grp * 64 + 8 * kq;
        bf16x8 b0 = *(const bf16x8*)kp, b1 = *(const bf16x8*)(kp + 32);
        const float zc_ = ozero(); f32x4 cc = {zc_, zc_, zc_, zc_};
        cc = mfma16(qa0, b0, cc); cc = mfma16(qa1, b1, cc);
        const bool ok = valid && (kq == 0);
#pragma unroll
        for (int r = 0; r < 4; r++) lg[t][r] = ok ? cc[r] * 0.125f : -3.0e38f;
      }
      float mx[4], sm4[4];
#pragma unroll
      for (int r = 0; r < 4; r++) {
        float m = lg[0][r];
#pragma unroll
        for (int t = 1; t < 16; t++) m = fmaxf(m, lg[t][r]);
#pragma unroll
        for (int off = 1; off < 64; off <<= 1) m = fmaxf(m, __shfl_xor(m, off));
        mx[r] = m;
      }
#pragma unroll
      for (int r = 0; r < 4; r++) {
        float s = 0.f;
#pragma unroll
        for (int t = 0; t < 16; t++) { float e = (lg[t][r] > -1.0e38f) ? __expf(lg[t][r] - mx[r]) : 0.f; lg[t][r] = e; s += e; }
#pragma unroll
        for (int off = 1; off < 64; off <<= 1) s += __shfl_xor(s, off);
        sm4[r] = s;
      }
      __builtin_amdgcn_wave_barrier();
      if (kq == 0) {
#pragma unroll
        for (int t = 0; t < 16; t++)
          *(uint2*)(Pb + (t * 16 + n16) * 4) = make_uint2(pk2(lg[t][0], lg[t][1]), pk2(lg[t][2], lg[t][3]));
      }
      __builtin_amdgcn_wave_barrier();
      float o[32];
#pragma unroll
      for (int i = 0; i < 32; i++) o[i] = ozero();
      const int ksg = lane >> 3, dc = lane & 7;
#pragma unroll 4
      for (int stp = 0; stp < 32; stp++) {
        const int slot = stp * 8 + ksg;
        const int key = (slot < n) ? (16383 - (int)(sel[slot] & 0x3FFFu)) : 0;
        uint2 pp = *(const uint2*)(Pb + slot * 4);
        uint4 vv = *(const uint4*)(p.P + (tokb + key) * PW + C_ATV + grp * 64 + dc * 8);
        float ph[4] = {bflo(pp.x), bfhi(pp.x), bflo(pp.y), bfhi(pp.y)};
        float vf[8] = {bflo(vv.x), bfhi(vv.x), bflo(vv.y), bfhi(vv.y), bflo(vv.z), bfhi(vv.z), bflo(vv.w), bfhi(vv.w)};
#pragma unroll
        for (int hh = 0; hh < 4; hh++)
#pragma unroll
          for (int d = 0; d < 8; d++) o[hh * 8 + d] += ph[hh] * vf[d];
      }
      const bool b5 = (lane >> 5) & 1, b4 = (lane >> 4) & 1, b3 = (lane >> 3) & 1;
      float o16[16], o8[8], o4[4];
#pragma unroll
      for (int i = 0; i < 16; i++) { float lo = o[i], hi = o[16 + i]; float snd = b5 ? lo : hi; float kp = b5 ? hi : lo; o16[i] = kp + __shfl_xor(snd, 32); }
#pragma unroll
      for (int i = 0; i < 8; i++) { float lo = o16[i], hi = o16[8 + i]; float snd = b4 ? lo : hi; float kp = b4 ? hi : lo; o8[i] = kp + __shfl_xor(snd, 16); }
#pragma unroll
      for (int i = 0; i < 4; i++) { float lo = o8[i], hi = o8[4 + i]; float snd = b3 ? lo : hi; float kp = b3 ? hi : lo; o4[i] = kp + __shfl_xor(snd, 8); }
      const int hsel = (b5 ? 2 : 0) + (b4 ? 1 : 0);
      const float ssum = b5 ? (b4 ? sm4[3] : sm4[2]) : (b4 ? sm4[1] : sm4[0]);
      const float rinv = 1.f / ssum;
      const int col = (grp * 4 + hsel) * 64 + dc * 8 + (b3 ? 4 : 0);
      uint2 zz = *(const uint2*)(p.P + tq * PW + C_ATZ + col);
      float v0 = o4[0] * rinv * siluf_(bflo(zz.x)), v1 = o4[1] * rinv * siluf_(bfhi(zz.x));
      float v2 = o4[2] * rinv * siluf_(bflo(zz.y)), v3 = o4[3] * rinv * siluf_(bfhi(zz.y));
      *(uint2*)(p.Y + tq * YW + Y_ATT + col) = make_uint2(pk2(v0, v1), pk2(v2, v3));
    }
  }
}

__device__ __forceinline__ void phaseB(const Params& p, int layer, char* sm0) {
  const int total = 512 + 2048 + 2048;
  char* sm = sm0 + HB * 65536;
  for (int t = VB; t < total; t += G2) {
    if (t < 512) ssd_pass1(p, layer, t, sm);
    else if (t < 2560) s5_pass1(p, layer, t - 512, sm);
    else mem_attn(p, layer, t - 2560);
  }
}
__device__ __forceinline__ void phaseC(const Params& p, int layer, char* sm0, bool dsa_only) {
  const int G = G2;
  const int total = dsa_only ? 1024 : 1024 + 256 + 16;
  char* sm = sm0 + HB * 65536;
  for (int i = VB; i < total; i += G) {
    if (i < 1024) {
      int rr = i / G, pos = i - rr * G; int idx = i;
      if ((rr & 1) && (rr * G + G <= 1024)) idx = rr * G + (G - 1 - pos);
      __syncthreads();
      dsa_wave(p, idx * 4 + (otid() >> 6), sm);
    } else if (i < 1280) ssd_statepass(p, i - 1024);
    else s5_carry(p, layer, i - 1280);
  }
}
__device__ __forceinline__ void phaseD(const Params& p, int layer, char* sm0) {
  const int total = 256 + 1024;
  char* sm = sm0 + HB * 65536;
  for (int t = VB; t < total; t += G2) {
    if (t < 256) s5_pass2(p, layer, t, sm);
    else ssd_pass2(p, layer, t - 256, sm);
  }
}

__device__ __forceinline__ void phaseE(const Params& p, int layer) {
  const int tidf = otid_full();
  const int wid = __builtin_amdgcn_readfirstlane(tidf >> 6), lane = tidf & 63, wr = wid >> 2, wc = wid & 3, fr = lane & 15, fq = lane >> 4;
  const bf* Wl = p.WinT + (size_t)layer * INW * 2048;
  const bf* Wb = p.WbrT + (size_t)layer * 2048 * YW;
  bf* merged = p.P;
  char* gsb = (char*)p.GS + (size_t)blockIdx.x * 131072;
  const unsigned gs_lane0 = (unsigned)tidf * 16u, lane_c40 = (unsigned)fq * 16u, lane_m0 = (unsigned)(fr * 2048 + fq * 4) * 2u;
  for (int L = blockIdx.x; L < 1024; L += gridDim.x) {
    int pm, pn; tile_order(L, 128, 8, pm, pn);
    const int brow = pm * 256, bcol = pn * 256;
#pragma unroll 1
    for (int s = 0; s < 8; s++) {
      const int br = s >> 1; const bool isBr = (s & 1) != 0;
      const int koff = br == 0 ? 0 : (br == 1 ? 512 : (br == 2 ? 1024 : 2048));
      const int kb = br == 2 ? 1024 : (br == 3 ? 256 : 512);
      const bf* A_ = isBr ? p.Y + koff : p.xb; const int lda_ = isBr ? YW : 2048;
      const bf* B_ = isBr ? Wb + koff : Wl + (size_t)(5716 + br * 2048) * 2048; const int ldb_ = isBr ? YW : 2048;
      const int K_ = isBr ? kb : 2048;
      f32x4 acc[2][2][4][2]; ZERO_ACC8(acc);
      gemm256(A_, lda_, B_, ldb_, K_, brow, bcol, acc);
      unsigned gs_lane = gs_lane0, lane_c4 = lane_c40, lane_m = lane_m0;
      asm volatile("" : "+v"(gs_lane), "+v"(lane_c4), "+v"(lane_m));
      if (!isBr) {
        const char* bgb = (const char*)(p.b_gate + (size_t)layer * 8192 + br * 2048 + bcol + wc * 32);
#pragma unroll
        for (int ai = 0; ai < 2; ai++)
#pragma unroll
          for (int bj = 0; bj < 2; bj++)
#pragma unroll
            for (int m = 0; m < 4; m++) {
              unsigned q[4];
#pragma unroll
              for (int n = 0; n < 2; n++) {
                float4 bg = *(const float4*)(bgb + (bj * 128 + n * 16) * 4 + lane_c4);
                f32x4 v = acc[ai][bj][m][n];
                q[2 * n] = pk2(sigmoidf_(v[0] + bg.x), sigmoidf_(v[1] + bg.y));
                q[2 * n + 1] = pk2(sigmoidf_(v[2] + bg.z), sigmoidf_(v[3] + bg.w));
              }
              *(uint4*)(gsb + ((ai * 2 + bj) * 4 + m) * 8192 + gs_lane) = make_uint4(q[0], q[1], q[2], q[3]);
              __builtin_amdgcn_sched_barrier(0);
            }
      } else {
        char* mb = (char*)merged + ((size_t)(brow + wr * 64) * 2048 + bcol + wc * 32) * 2;
#pragma unroll
        for (int ai = 0; ai < 2; ai++)
#pragma unroll
          for (int bj = 0; bj < 2; bj++)
#pragma unroll
            for (int m = 0; m < 4; m++) {
              uint4 g = *(const uint4*)(gsb + ((ai * 2 + bj) * 4 + m) * 8192 + gs_lane);
              const unsigned gq[4] = {g.x, g.y, g.z, g.w};
#pragma unroll
              for (int n = 0; n < 2; n++) {
                f32x4 v = acc[ai][bj][m][n];
                float o0 = bflo(gq[2 * n]) * v[0], o1 = bfhi(gq[2 * n]) * v[1], o2 = bflo(gq[2 * n + 1]) * v[2], o3 = bfhi(gq[2 * n + 1]) * v[3];
                char* mp = mb + ((size_t)(ai * 128 + m * 16) * 2048 + bj * 128 + n * 16) * 2 + lane_m;
                if (br) { uint2 old = *(const uint2*)mp; o0 += bflo(old.x); o1 += bfhi(old.x); o2 += bflo(old.y); o3 += bfhi(old.y); }
                *(uint2*)mp = make_uint2(pk2(o0, o1), pk2(o2, o3));
              }
              __builtin_amdgcn_sched_barrier(0);
            }
      }
    }
  }
}

__device__ __forceinline__ void phaseF(const Params& p, int layer) {
  const int tidf = otid_full();
  const int wid = __builtin_amdgcn_readfirstlane(tidf >> 6), lane = tidf & 63, wr = wid >> 2, wc = wid & 3, fr = lane & 15, fq = lane >> 4;
  const bf* merged = p.P;
  const float* xres = layer == 0 ? p.x : p.out;
  for (int L = blockIdx.x; L < 1024; L += gridDim.x) {
    int pm, pn; tile_order(L, 128, 8, pm, pn);
    const int brow = pm * 256, bcol = pn * 256;
    f32x4 acc[2][2][4][2]; ZERO_ACC8(acc);
    gemm256(merged, 2048, p.WoutT + (size_t)layer * 2048 * 2048, 2048, 2048, brow, bcol, acc);
#pragma unroll
    for (int ai = 0; ai < 2; ai++)
#pragma unroll
      for (int m = 0; m < 4; m++) {
        const size_t tok = brow + ai * 128 + wr * 64 + m * 16 + fr;
#pragma unroll
        for (int bj = 0; bj < 2; bj++)
#pragma unroll
          for (int n = 0; n < 2; n++) {
            const int col = bcol + bj * 128 + wc * 32 + n * 16 + fq * 4;
            float4 xr = *(const float4*)(xres + tok * 2048 + col);
            f32x4 v = acc[ai][bj][m][n];
            float4 o;
            o.x = 1.41421356237f * xr.x + v[0]; o.y = 1.41421356237f * xr.y + v[1];
            o.z = 1.41421356237f * xr.z + v[2]; o.w = 1.41421356237f * xr.w + v[3];
            *(float4*)(p.out + tok * 2048 + col) = o;
          }
      }
  }
}

__device__ __forceinline__ void phaseG(const Params& p, int layer) {
  const int lane = otid() & 63, w = otid() >> 6;
  const float* g = p.ln_g + layer * 2048; const float* bb = p.ln_b + layer * 2048;
  for (int t = VB; t < TT / 4; t += G2) {
    const size_t row = (size_t)t * 4 + w;
    float* xp = p.out + row * 2048;
    float4 v[8]; float s = 0.f;
#pragma unroll
    for (int i = 0; i < 8; i++) { v[i] = *(const float4*)(xp + (i * 64 + lane) * 4); s += v[i].x + v[i].y + v[i].z + v[i].w; }
#pragma unroll
    for (int off = 1; off < 64; off <<= 1) s += __shfl_xor(s, off);
    const float mu = s * (1.f / 2048.f);
    float q = 0.f;
#pragma unroll
    for (int i = 0; i < 8; i++) {
      float a = v[i].x - mu, b = v[i].y - mu, c = v[i].z - mu, d = v[i].w - mu; q += a * a + b * b + c * c + d * d;
    }
#pragma unroll
    for (int off = 1; off < 64; off <<= 1) q += __shfl_xor(q, off);
    const float rs = rsqrtf(q * (1.f / 2048.f) + 1e-5f);
#pragma unroll
    for (int i = 0; i < 8; i++) {
      const int col = (i * 64 + lane) * 4;
      float4 gg = *(const float4*)(g + col), bv = *(const float4*)(bb + col);
      float4 o;
      o.x = (v[i].x - mu) * rs * gg.x + bv.x; o.y = (v[i].y - mu) * rs * gg.y + bv.y;
      o.z = (v[i].z - mu) * rs * gg.z + bv.z; o.w = (v[i].w - mu) * rs * gg.w + bv.w;
      *(float4*)(xp + col) = o;
      if (layer == 0) *(uint2*)(p.xb + row * 2048 + col) = make_uint2(pk2(o.x, o.y), pk2(o.z, o.w));
    }
  }
}

__global__ void __launch_bounds__(512, 2) mega_kernel(Params p) {
  char* sm = dynsm;
  cg::grid_group grid = cg::this_grid();
  phase0(p, sm); grid.sync();
#pragma unroll 1
  for (int layer = 0; layer < 2; layer++) {
    int nA = (PROBE_MASK & 1) ? 2 : 1, nB = (PROBE_MASK & 2) ? 2 : 1, nC = (PROBE_MASK & 4) ? 2 : 1, nD = (PROBE_MASK & 8) ? 2 : 1, nE = (PROBE_MASK & 16) ? 2 : 1;
    asm volatile("" : "+s"(nA), "+s"(nB), "+s"(nC), "+s"(nD), "+s"(nE));
#pragma unroll 1
    for (int r = 0; r < nA; r++) phaseA(p, layer);
    grid.sync();
#pragma unroll 1
    for (int r = 0; r < nB; r++) phaseB(p, layer, sm);
    grid.sync();
#pragma unroll 1
    for (int r = 0; r < nC; r++) phaseC(p, layer, sm, r + 1 < nC);
    grid.sync();
#pragma unroll 1
    for (int r = 0; r < nD; r++) phaseD(p, layer, sm);
    grid.sync();
#pragma unroll 1
    for (int r = 0; r < nE; r++) phaseE(p, layer);
    grid.sync();
    phaseF(p, layer); grid.sync();
    phaseG(p, layer);
    if (layer == 0) grid.sync();
  }
}

extern "C" void kernel_launch(void* const* d_in, const int* in_sizes, int n_in, void* d_out, int out_size, void* d_ws,
                              size_t ws_size, hipStream_t stream) {
  Params p{};
  p.x = (const float*)d_in[0]; p.mem = (const float*)d_in[1]; p.pos = (const int*)d_in[2];
  p.w_in = (const float*)d_in[3]; p.b_gate = (const float*)d_in[4]; p.lam_re = (const float*)d_in[5];
  p.lam_im = (const float*)d_in[6]; p.log_dt = (const float*)d_in[7]; p.b_re = (const float*)d_in[8];
  p.b_im = (const float*)d_in[9]; p.c_re = (const float*)d_in[10]; p.c_im = (const float*)d_in[11];
  p.s5_d = (const float*)d_in[12]; p.w_glu = (const float*)d_in[13]; p.b_glu = (const float*)d_in[14];
  p.conv_w = (const float*)d_in[15]; p.conv_b = (const float*)d_in[16]; p.dt_bias = (const float*)d_in[17];
  p.a_log = (const float*)d_in[18]; p.ssd_d = (const float*)d_in[19]; p.norm_g = (const float*)d_in[20];
  p.mem_w_kv = (const float*)d_in[21]; p.w_br_s5 = (const float*)d_in[22]; p.w_br_attn = (const float*)d_in[23];
  p.w_br_ssd = (const float*)d_in[24]; p.w_br_mem = (const float*)d_in[25]; p.w_out = (const float*)d_in[26];
  p.ln_g = (const float*)d_in[27]; p.ln_b = (const float*)d_in[28];
  p.out = (float*)d_out;
  char* ws = (char*)d_ws; size_t off = 0;
  auto carve = [&](size_t bytes) { char* r = ws + off; off += (bytes + 255) & ~(size_t)255; return r; };
  p.WinT = (bf*)carve((size_t)2 * INW * 2048 * 2);
  p.WbrT = (bf*)carve((size_t)2 * 2048 * YW * 2);
  p.WoutT = (bf*)carve((size_t)2 * 2048 * 2048 * 2);
  p.WgluT = (bf*)carve((size_t)2 * 512 * 512 * 2);
  p.WmemT = (bf*)carve((size_t)2 * 512 * 2048 * 2);
  p.memb = (bf*)carve((size_t)512 * 2048 * 2);
  p.xb = (bf*)carve((size_t)TT * 2048 * 2);
  p.P = (bf*)carve((size_t)TT * PW * 2);
  p.Y = (bf*)carve((size_t)TT * YW * 2);
  p.YG = (bf*)carve((size_t)TT * 512 * 2);
  p.KIF = (bf*)carve((size_t)TT * 64 * 2);
  p.MK = (bf*)carve((size_t)2 * 2 * 4 * 256 * 64 * 2);
  p.MVT = (bf*)carve((size_t)2 * 2 * 4 * 256 * 64 * 2);
  p.CM = (bf*)carve((size_t)2 * 32 * 16 * 128 * 2);
  p.ST = (float*)carve((size_t)2 * 128 * 131072 * 4);
  p.CS = (float*)carve((size_t)TT * 16 * 4);
  p.END = (float*)carve((size_t)2 * 128 * 32 * 64 * 2 * 4);
  p.CD = (float*)carve((size_t)2 * 128 * 16 * 4);
  p.SB = (float*)carve((size_t)2 * 32 * 64 * 32 * 4);
  p.SA = (float*)carve((size_t)2 * 32 * 64 * 4 * 4);
  p.KVC = (bf*)carve((size_t)TT * 256 * 2);
  p.GS = (bf*)carve((size_t)256 * 16 * 512 * 16);
  if (off > ws_size) { fprintf(stderr, "workspace too small: need %zu have %zu\n", off, ws_size); return; }
  for (int j = 0; j < 8; j++) p.inv[j] = (float)pow(500000.0, -(double)j / 8.0);
  const size_t kDynLds = 131072;
  static int grid_blocks = 0;
  if (!grid_blocks) {
    int dev = 0, cus = 0, per_cu = 0;
    (void)hipGetDevice(&dev);
    (void)hipDeviceGetAttribute(&cus, hipDeviceAttributeMultiprocessorCount, dev);
    (void)hipFuncSetAttribute((const void*)mega_kernel, hipFuncAttributeMaxDynamicSharedMemorySize, (int)kDynLds);
    (void)hipOccupancyMaxActiveBlocksPerMultiprocessor(&per_cu, mega_kernel, 512, kDynLds);
    if (per_cu > 1) per_cu = 1;
    grid_blocks = cus * per_cu;
    if (grid_blocks > 256) grid_blocks = 256;
    grid_blocks -= grid_blocks % 8;
  }
  void* args[] = {&p};
  hipError_t e = hipLaunchCooperativeKernel((void*)mega_kernel, dim3(grid_blocks), dim3(512), args, kDynLds, stream);
  if (e != hipSuccess) fprintf(stderr, "cooperative launch failed: %s (grid %d)\n", hipGetErrorString(e), grid_blocks);
}
```

```cpp
#include <hip/hip_runtime.h>
#include <hip/hip_cooperative_groups.h>
#include <cstdio>
#include <cmath>
namespace cg = cooperative_groups;

#ifndef MK_COOP
#define MK_COOP 1
#endif
#ifndef PROBE_MASK
#define PROBE_MASK 0
#endif

typedef unsigned short bf;
typedef short bf16x8 __attribute__((ext_vector_type(8)));
typedef float f32x16 __attribute__((ext_vector_type(16)));
typedef float f32x4 __attribute__((ext_vector_type(4)));

#define TT 32768
#define LSEQ 16384
#define DM 2048
#define INW 13908
#define PW 5760
#define C_S5U 0
#define C_S5Z 512
#define C_ATQ 1024
#define C_ATK 1536
#define C_ATV 1664
#define C_ATZ 1792
#define C_IDQ 2304
#define C_IDK 2560
#define C_IDW 2624
#define C_SSZ 2640
#define C_XBC 3664
#define C_SDT 5200
#define C_MEQ 5216
#define C_MEZ 5472
#define YW 2304
#define Y_S5 0
#define Y_ATT 512
#define Y_SSD 1024
#define Y_MEM 2048
#define CAP 512
#define HALF_LDS 73728

struct Params {
  const float *x, *mem; const int* pos;
  const float *w_in, *b_gate, *lam_re, *lam_im, *log_dt, *b_re, *b_im, *c_re, *c_im, *s5_d, *w_glu, *b_glu,
      *conv_w, *conv_b, *dt_bias, *a_log, *ssd_d, *norm_g, *mem_w_kv, *w_br_s5, *w_br_attn, *w_br_ssd, *w_br_mem,
      *w_out, *ln_g, *ln_b;
  float* out;
  bf *WinT, *WbrT, *WoutT, *WgluT, *WmemT, *memb, *xb, *P, *Y, *YG, *KIF, *MK, *MVT, *CM, *KVC, *GS;
  float *ST, *CS, *END, *CD, *SB, *SA;
  float inv[8];
};

__device__ __forceinline__ float ozero() { float z = 0.f; asm volatile("" : "+v"(z)); return z; }
__device__ __forceinline__ int otid_full() { int t = threadIdx.x; asm volatile("" : "+v"(t)); return t; }
__device__ __forceinline__ int otid() { return otid_full() & 255; }
#define HB (__builtin_amdgcn_readfirstlane(otid_full() >> 8))
#define VB ((int)blockIdx.x * 2 + HB)
#define G2 ((int)gridDim.x * 2)
__device__ __forceinline__ float bf2f(bf v) { return __uint_as_float(((unsigned)v) << 16); }
__device__ __forceinline__ float bflo(unsigned u) { return __uint_as_float(u << 16); }
__device__ __forceinline__ float bfhi(unsigned u) { return __uint_as_float(u & 0xFFFF0000u); }
__device__ __forceinline__ unsigned pk2(float lo, float hi) {
  unsigned r; asm("v_cvt_pk_bf16_f32 %0, %1, %2" : "=v"(r) : "v"(lo), "v"(hi)); return r;
}
__device__ __forceinline__ bf f2bf(float f) { return (bf)(pk2(f, 0.f) & 0xFFFFu); }
__device__ __forceinline__ float sigmoidf_(float x) { return 1.f / (1.f + __expf(-x)); }
__device__ __forceinline__ float siluf_(float x) { return x / (1.f + __expf(-x)); }
__device__ __forceinline__ float geluf_(float x) {
  float u = 0.7978845608028654f * (x + 0.044715f * x * x * x);
  float t = 1.f - 2.f / (1.f + __expf(2.f * u));
  return 0.5f * x * (1.f + t);
}
__device__ __forceinline__ f32x16 mfma32(bf16x8 a, bf16x8 b, f32x16 c) { return __builtin_amdgcn_mfma_f32_32x32x16_bf16(a, b, c, 0, 0, 0); }
__device__ __forceinline__ f32x4 mfma16(bf16x8 a, bf16x8 b, f32x4 c) { return __builtin_amdgcn_mfma_f32_16x16x32_bf16(a, b, c, 0, 0, 0); }

__device__ __forceinline__ bool tile_map(int L, int nMt, int nNt, int SM, int SN, int& tm, int& tn) {
  int per = SM * SN; int x = L & 7; int jj = L >> 3; int sl = jj / per; int j = jj - sl * per; int S = sl * 8 + x;
  int nSn = nNt / SN; int NS = (nMt / SM) * nSn;
  if (S >= NS) return false;
  int mg = S / nSn, ng = S - mg * nSn;
  tm = mg * SM + j / SN; tn = ng * SN + j % SN; return true;
}

typedef unsigned u32x4 __attribute__((ext_vector_type(4)));
struct GStage { u32x4 a0, a1, b0, b1; };
#define G_LOAD(S, ko) { S.a0 = *(const u32x4*)(ga + (ko)); S.a1 = *(const u32x4*)(ga + a64 + (ko)); S.b0 = *(const u32x4*)(gb + (ko)); S.b1 = *(const u32x4*)(gb + b64 + (ko)); }
#define G_WRITE(S, base) { *(u32x4*)(sA + (base) + woff) = S.a0; *(u32x4*)(sA + (base) + woff + 5120) = S.a1; *(u32x4*)(sB + (base) + woff) = S.b0; *(u32x4*)(sB + (base) + woff + 5120) = S.b1; }
#define G_ITER(kt, cur, S)                                                          \
  {                                                                                 \
    _Pragma("unroll") for (int ks = 0; ks < 2; ks++) {                              \
      bf16x8 a0 = *(const bf16x8*)(sA + (cur) + aoff + ks * 32);                    \
      bf16x8 a1 = *(const bf16x8*)(sA + (cur) + aoff + 2560 + ks * 32);             \
      bf16x8 b0 = *(const bf16x8*)(sB + (cur) + boff + ks * 32);                    \
      bf16x8 b1 = *(const bf16x8*)(sB + (cur) + boff + 2560 + ks * 32);             \
      acc[0][0] = mfma32(b0, a0, acc[0][0]);                                        \
      acc[0][1] = mfma32(b1, a0, acc[0][1]);                                        \
      acc[1][0] = mfma32(b0, a1, acc[1][0]);                                        \
      acc[1][1] = mfma32(b1, a1, acc[1][1]);                                        \
    }                                                                               \
    if ((kt) + 1 < nk) {                                                            \
      G_WRITE(S, 10240 - (cur))                                                     \
      if ((kt) + 1 + D < nk) G_LOAD(S, ((kt) + 1 + D) * 32)                         \
    }                                                                               \
    __syncthreads();                                                                \
  }
template <int D>
__device__ __forceinline__ void gemm_acc(const bf* __restrict__ A, int lda, const bf* __restrict__ Bt, int ldb, int K,
                                         f32x16 (&acc)[2][2], char* sm) {
  const int tid = otid(), lane = tid & 63, w = tid >> 6, wr = w >> 1, wc = w & 1, r32 = lane & 31, h5 = lane >> 5;
  const int lrow = tid >> 2, lch = tid & 3;
  const bf* ga = A + (size_t)lrow * lda + lch * 8;
  const bf* gb = Bt + (size_t)lrow * ldb + lch * 8;
  const size_t a64 = (size_t)64 * lda, b64 = (size_t)64 * ldb;
  const int nk = K >> 5;
  char* sA = sm; char* sB = sm + 20480;
  const int woff = lrow * 80 + lch * 16;
  const int aoff = (wr * 64 + r32) * 80 + h5 * 16, boff = (wc * 64 + r32) * 80 + h5 * 16;
  GStage S0, S1, S2, S3;
  G_LOAD(S0, 0) G_LOAD(S1, 32)
  if (D == 4) { G_LOAD(S2, 64) G_LOAD(S3, 96) }
  G_WRITE(S0, 0)
  if (D < nk) G_LOAD(S0, D * 32)
  __syncthreads();
  for (int kt0 = 0; kt0 < nk; kt0 += D) {
    if (D == 4) {
      G_ITER(kt0, 0, S1) G_ITER(kt0 + 1, 10240, S2) G_ITER(kt0 + 2, 0, S3) G_ITER(kt0 + 3, 10240, S0)
    } else {
      G_ITER(kt0, 0, S1) G_ITER(kt0 + 1, 10240, S0)
    }
  }
}
#define ZERO_ACC(a) { const float z_ = ozero(); for (int i_ = 0; i_ < 2; i_++) for (int j_ = 0; j_ < 2; j_++) for (int r_ = 0; r_ < 16; r_++) a[i_][j_][r_] = z_; }


extern __shared__ __attribute__((aligned(16))) char dynsm[];
#define G8_HT (128 * 64)
#define G8_SA(b, h) ((bf*)dynsm + ((b) * 2 + (h)) * G8_HT)
#define G8_SB(b, h) ((bf*)dynsm + (4 + (b) * 2 + (h)) * G8_HT)
__device__ __forceinline__ int g8_lds_byte(int r, int c) {
  int st = (r >> 4) * 2 + (c >> 5), rr = r & 15, cc = c & 31, ob = rr * 64 + cc * 2;
  return st * 1024 + (ob ^ (((ob >> 9) & 1) << 5));
}
__device__ __forceinline__ void g8_stage_rc(int b, int& R, int& C) {
  int st = b / 1024, sb = b % 1024, swz = sb ^ (((sb >> 9) & 1) << 5);
  R = (st >> 1) * 16 + swz / 64; C = (st & 1) * 32 + (swz % 64) / 2;
}
#define G8_LAS __attribute__((address_space(3)))
#define G8_HTB (128 * 64 * 2)
#define G8_OSA(b, h) (((b) * 2 + (h)) * G8_HTB)
#define G8_OSB(b, h) ((4 + (b) * 2 + (h)) * G8_HTB)
#define G8_STAGE(bufoff, gbase, voff) do { _Pragma("unroll") for (int _i = 0; _i < 2; ++_i) \
    __builtin_amdgcn_global_load_lds((const unsigned*)((const char*)(gbase) + (voff)[_i]), (G8_LAS unsigned*)(lds + (bufoff) + ldsw + _i * 8192), 16, 0, 0); } while (0)
#define G8_LDA(dst, b, h) do { _Pragma("unroll") for (int m = 0; m < 4; ++m) _Pragma("unroll") for (int k = 0; k < 2; ++k) dst[m][k] = *(const G8_LAS bf16x8*)(lds + G8_OSA(b, h) + aoff + m * 2048 + k * 1024); } while (0)
#define G8_LDB(dst, b, h) do { _Pragma("unroll") for (int n = 0; n < 2; ++n) _Pragma("unroll") for (int k = 0; k < 2; ++k) dst[n][k] = *(const G8_LAS bf16x8*)(lds + G8_OSB(b, h) + boff + n * 2048 + k * 1024); } while (0)
#define G8_MMA(ai, bj, At_, Bt_) do { __builtin_amdgcn_s_setprio(1);                                                 \
    _Pragma("unroll") for (int m = 0; m < 4; ++m) _Pragma("unroll") for (int n = 0; n < 2; ++n) _Pragma("unroll") for (int k = 0; k < 2; ++k) \
      acc[ai][bj][m][n] = __builtin_amdgcn_mfma_f32_16x16x32_bf16(Bt_[n][k], At_[m][k], acc[ai][bj][m][n], 0, 0, 0); \
    __builtin_amdgcn_s_setprio(0); } while (0)
#define G8_WAIT_V(n) asm volatile("s_waitcnt vmcnt(" #n ")" ::: "memory")
#define G8_WAIT_L(n) asm volatile("s_waitcnt lgkmcnt(" #n ")" ::: "memory")
#define G8_BAR __builtin_amdgcn_s_barrier()
#define G8_SCHED __builtin_amdgcn_sched_barrier(0)

__device__ __forceinline__ void gemm256(const bf* __restrict__ A, int lda, const bf* __restrict__ Bt, int ldb, int K,
                                        int brow, int bcol, f32x4 (&acc)[2][2][4][2]) {
  G8_LAS unsigned char* lds = (G8_LAS unsigned char*)dynsm;
  const int tid = otid_full(), wid = __builtin_amdgcn_readfirstlane(tid >> 6), lane = tid & 63, wr = wid >> 2, wc = wid & 3, fr = lane & 15, fq = lane >> 4;
  unsigned voffA[2], voffB[2];
#pragma unroll
  for (int i = 0; i < 2; ++i) { int R, C; g8_stage_rc(tid * 16 + i * 8192, R, C); voffA[i] = (unsigned)(R * lda + C) * 2u; voffB[i] = (unsigned)(R * ldb + C) * 2u; }
  const size_t kstep = 128;
  const size_t hstepA = (size_t)128 * lda * 2, hstepB = (size_t)128 * ldb * 2;
  const unsigned ldsw = (unsigned)wid * 1024u;
  const int aoff = g8_lds_byte(wr * 64 + fr, fq * 8), boff = g8_lds_byte(wc * 32 + fr, fq * 8);
  const char* cA = (const char*)A + (size_t)brow * lda * 2; const char* cB = (const char*)Bt + (size_t)bcol * ldb * 2;
  bf16x8 At[4][2], B0[2][2], B1[2][2];
  const int nt = K / 64;
  __syncthreads();
  G8_STAGE(G8_OSB(0, 0), cB, voffB); G8_STAGE(G8_OSA(0, 0), cA, voffA); G8_STAGE(G8_OSB(0, 1), cB + hstepB, voffB); G8_STAGE(G8_OSA(0, 1), cA + hstepA, voffA);
  if (wr == 1) G8_BAR;
  G8_WAIT_V(4); G8_BAR;
  G8_STAGE(G8_OSB(1, 0), cB + kstep, voffB); G8_STAGE(G8_OSA(1, 0), cA + kstep, voffA); G8_STAGE(G8_OSB(1, 1), cB + hstepB + kstep, voffB);
  G8_WAIT_V(6); G8_BAR;
  for (int t = 0; t < nt - 2; t += 2) {
    const char* a1 = cA + (size_t)(t + 1) * kstep;
    const char* a2 = cA + (size_t)(t + 2) * kstep; const char* b2 = cB + (size_t)(t + 2) * kstep;
    const char* a3 = a2 + kstep; const char* b3 = b2 + kstep;
    G8_LDB(B0, 0, 0); G8_SCHED; G8_LDA(At, 0, 0); G8_STAGE(G8_OSA(1, 1), a1 + hstepA, voffA);
    G8_WAIT_L(8); G8_BAR; G8_WAIT_L(0); G8_MMA(0, 0, At, B0); G8_BAR; G8_SCHED;
    G8_LDB(B1, 0, 1); G8_STAGE(G8_OSB(0, 0), b2, voffB);
    G8_BAR; G8_WAIT_L(0); G8_MMA(0, 1, At, B1); G8_BAR;
    G8_LDA(At, 0, 1); G8_STAGE(G8_OSA(0, 0), a2, voffA);
    G8_BAR; G8_WAIT_L(0); G8_MMA(1, 0, At, B0); G8_BAR; G8_SCHED;
    G8_STAGE(G8_OSB(0, 1), b2 + hstepB, voffB);
    G8_WAIT_V(6); G8_BAR; G8_MMA(1, 1, At, B1); G8_BAR;
    G8_LDB(B0, 1, 0); G8_SCHED; G8_LDA(At, 1, 0); G8_STAGE(G8_OSA(0, 1), a2 + hstepA, voffA);
    G8_WAIT_L(8); G8_BAR; G8_WAIT_L(0); G8_MMA(0, 0, At, B0); G8_BAR; G8_SCHED;
    G8_LDB(B1, 1, 1); G8_STAGE(G8_OSB(1, 0), b3, voffB);
    G8_BAR; G8_WAIT_L(0); G8_MMA(0, 1, At, B1); G8_BAR;
    G8_LDA(At, 1, 1); G8_STAGE(G8_OSA(1, 0), a3, voffA);
    G8_BAR; G8_WAIT_L(0); G8_MMA(1, 0, At, B0); G8_BAR; G8_SCHED;
    G8_STAGE(G8_OSB(1, 1), b3 + hstepB, voffB);
    G8_WAIT_V(6); G8_BAR; G8_MMA(1, 1, At, B1); G8_BAR;
  }
  { const char* a1 = cA + (size_t)(nt - 1) * kstep;
    G8_LDB(B0, 0, 0); G8_LDA(At, 0, 0); G8_STAGE(G8_OSA(1, 1), a1 + hstepA, voffA);
    G8_BAR; G8_WAIT_L(0); G8_MMA(0, 0, At, B0); G8_BAR;
    G8_LDB(B1, 0, 1); G8_BAR; G8_WAIT_L(0); G8_MMA(0, 1, At, B1); G8_BAR;
    G8_LDA(At, 0, 1); G8_WAIT_V(4); G8_BAR; G8_WAIT_L(0); G8_MMA(1, 0, At, B0); G8_MMA(1, 1, At, B1); G8_BAR; }
  { G8_LDB(B0, 1, 0); G8_LDA(At, 1, 0); G8_WAIT_V(2); G8_BAR; G8_WAIT_L(0); G8_MMA(0, 0, At, B0); G8_BAR;
    G8_LDB(B1, 1, 1); G8_WAIT_V(0); G8_BAR; G8_WAIT_L(0); G8_MMA(0, 1, At, B1); G8_BAR;
    G8_LDA(At, 1, 1); G8_BAR; G8_WAIT_L(0); G8_MMA(1, 0, At, B0); G8_MMA(1, 1, At, B1); G8_BAR; }
  if (wr == 0) G8_BAR;
}
#define ZERO_ACC8(a) { float z_ = 0.f; asm volatile("" : "+v"(z_)); _Pragma("unroll") for (int i_ = 0; i_ < 2; i_++) _Pragma("unroll") for (int j_ = 0; j_ < 2; j_++) _Pragma("unroll") for (int m_ = 0; m_ < 4; m_++) _Pragma("unroll") for (int n_ = 0; n_ < 2; n_++) a[i_][j_][m_][n_] = (f32x4){z_, z_, z_, z_}; }
__device__ __forceinline__ bool tile_order(int L, int nM, int nN, int& pm, int& pn) {
  const int nwg = nM * nN; if (L >= nwg) return false;
  int wgid = L; { const int q = nwg / 8, r = nwg % 8, xcd = wgid % 8, off = wgid / 8; wgid = (xcd < r ? xcd * (q + 1) : r * (q + 1) + (xcd - r) * q) + off; }
  const int nig = 8 * nN, gid = wgid / nig, fm = gid * 8, gsz = (nM - fm) < 8 ? (nM - fm) : 8;
  pm = fm + ((wgid % nig) % gsz); pn = (wgid % nig) / gsz; return true;
}

__device__ __forceinline__ void transpose_tile(const float* __restrict__ src, int R, int C, bf* __restrict__ dst, int ldd, int off, int tile, bf* sm) {
  const int tilesC = (C + 63) >> 6;
  const int tr = tile / tilesC, tc = tile - tr * tilesC;
  const int r0 = tr * 64, c0 = tc * 64;
  const int tid = otid();
#pragma unroll
  for (int i = 0; i < 4; i++) {
    int r = (tid >> 4) + 16 * i; int c = (tid & 15) * 4;
    const float zt_ = ozero(); float4 v = make_float4(zt_, zt_, zt_, zt_);
    if (c0 + c < C) v = *(const float4*)(src + (size_t)(r0 + r) * C + c0 + c);
    sm[(c + 0) * 66 + r] = f2bf(v.x); sm[(c + 1) * 66 + r] = f2bf(v.y);
    sm[(c + 2) * 66 + r] = f2bf(v.z); sm[(c + 3) * 66 + r] = f2bf(v.w);
  }
  __syncthreads();
  {
    int c = tid >> 2, ch = (tid & 3) * 16;
    if (c0 + c < C) {
      unsigned wv[8];
#pragma unroll
      for (int k = 0; k < 8; k++) wv[k] = *(const unsigned*)(sm + c * 66 + ch + 2 * k);
      bf* d = dst + (size_t)(c0 + c) * ldd + off + r0 + ch;
      *(uint4*)d = make_uint4(wv[0], wv[1], wv[2], wv[3]);
      *(uint4*)(d + 8) = make_uint4(wv[4], wv[5], wv[6], wv[7]);
    }
  }
  __syncthreads();
}

__device__ __forceinline__ bool try_tr(int& t, const float* src, int R, int C, bf* dst, int ldd, int off, bf* sm) {
  int nt = (R >> 6) * ((C + 63) >> 6);
  if (t < nt) { transpose_tile(src, R, C, dst, ldd, off, t, sm); return true; }
  t -= nt; return false;
}

__device__ __forceinline__ void phase0(const Params& p, char* smc) {
  bf* sm = (bf*)(smc + HB * HALF_LDS);
  const int perLayer = 32 * 218 + 256 + 256 + 512 + 128 + 1024 + 64 + 256;
  for (int task = VB; task < 2 * perLayer; task += G2) {
    int layer = task / perLayer; int t = task - layer * perLayer;
    bf* WbrL = p.WbrT + (size_t)layer * 2048 * YW;
    if (try_tr(t, p.w_in + (size_t)layer * DM * INW, 2048, INW, p.WinT + (size_t)layer * INW * 2048, 2048, 0, sm)) continue;
    if (try_tr(t, p.w_br_s5 + (size_t)layer * 512 * 2048, 512, 2048, WbrL, YW, 0, sm)) continue;
    if (try_tr(t, p.w_br_attn + (size_t)layer * 512 * 2048, 512, 2048, WbrL, YW, 512, sm)) continue;
    if (try_tr(t, p.w_br_ssd + (size_t)layer * 1024 * 2048, 1024, 2048, WbrL, YW, 1024, sm)) continue;
    if (try_tr(t, p.w_br_mem + (size_t)layer * 256 * 2048, 256, 2048, WbrL, YW, 2048, sm)) continue;
    if (try_tr(t, p.w_out + (size_t)layer * 2048 * 2048, 2048, 2048, p.WoutT + (size_t)layer * 2048 * 2048, 2048, 0, sm)) continue;
    if (try_tr(t, p.w_glu + (size_t)layer * 512 * 512, 512, 512, p.WgluT + (size_t)layer * 512 * 512, 512, 0, sm)) continue;
    if (try_tr(t, p.mem_w_kv + (size_t)layer * 2048 * 512, 2048, 512, p.WmemT + (size_t)layer * 512 * 2048, 2048, 0, sm)) continue;
  }
  const size_t gtid = (size_t)blockIdx.x * 512 + otid_full(), gstr = (size_t)gridDim.x * 512;
  for (size_t i = gtid; i < (size_t)TT * DM / 8; i += gstr) {
    float4 a = *(const float4*)(p.x + i * 8), b = *(const float4*)(p.x + i * 8 + 4);
    *(uint4*)(p.xb + i * 8) = make_uint4(pk2(a.x, a.y), pk2(a.z, a.w), pk2(b.x, b.y), pk2(b.z, b.w));
  }
  for (size_t i = gtid; i < (size_t)512 * DM / 8; i += gstr) {
    float4 a = *(const float4*)(p.mem + i * 8), b = *(const float4*)(p.mem + i * 8 + 4);
    *(uint4*)(p.memb + i * 8) = make_uint4(pk2(a.x, a.y), pk2(a.z, a.w), pk2(b.x, b.y), pk2(b.z, b.w));
  }
  for (size_t i = gtid; i < (size_t)TT; i += gstr) {
    const float ps = (float)p.pos[i];
#pragma unroll
    for (int j = 0; j < 8; j++) {
      float ang = ps * p.inv[j];
      float s, c; sincosf(ang, &s, &c);
      p.CS[i * 16 + j] = c; p.CS[i * 16 + 8 + j] = s;
    }
  }
  for (size_t i = gtid; i < 2 * 32 * 64; i += gstr) {
    int pp = (int)(i & 63), g = (int)((i >> 6) & 31), layer = (int)(i >> 11);
    float dt = expf(p.log_dt[layer * 32 + g]);
    float lr = p.lam_re[i], li = p.lam_im[i];
    float mag = expf(lr * dt);
    float sn, cs; sincosf(li * dt, &sn, &cs);
    float ar = mag * cs, ai = mag * sn;
    float den = lr * lr + li * li;
    float nr = ar - 1.f, ni = ai;
    float fr = (nr * lr + ni * li) / den, fi = (ni * lr - nr * li) / den;
    float* sb = p.SB + i * 32;
    const float* bre = p.b_re + i * 16; const float* bim = p.b_im + i * 16;
    for (int h = 0; h < 16; h++) {
      float br = bre[h], bi = bim[h];
      sb[h] = fr * br - fi * bi; sb[16 + h] = fr * bi + fi * br;
    }
    float pr = ar, pi = ai;
    for (int k = 0; k < 7; k++) { float nr2 = pr * pr - pi * pi, ni2 = 2.f * pr * pi; pr = nr2; pi = ni2; }
    p.SA[i * 4 + 0] = ar; p.SA[i * 4 + 1] = ai; p.SA[i * 4 + 2] = pr; p.SA[i * 4 + 3] = pi;
    for (int h = 0; h < 16; h++) {
      size_t ci = ((size_t)(layer * 32 + g) * 16 + h);
      p.CM[ci * 128 + pp] = f2bf(p.c_re[ci * 64 + pp]);
      p.CM[ci * 128 + 64 + pp] = f2bf(-p.c_im[ci * 64 + pp]);
    }
  }
}

__device__ __forceinline__ void phaseA(const Params& p, int layer) {
  const int tidf = otid_full();
  const int wid = __builtin_amdgcn_readfirstlane(tidf >> 6), lane = tidf & 63, wr = wid >> 2, wc = wid & 3, fr = lane & 15, fq = lane >> 4;
  const bf* Wl = p.WinT + (size_t)layer * INW * 2048;
  const int nA = 128 * 23;
  const int total = nA + (layer == 0 ? 8 : 0);
  for (int L = blockIdx.x; L < total; L += gridDim.x) {
    f32x4 acc[2][2][4][2]; ZERO_ACC8(acc);
    if (L < nA) {
      int pm, pn; tile_order(L, 128, 23, pm, pn);
      const int brow = pm * 256, bcol = pn * 256;
      gemm256(p.xb, 2048, Wl, 2048, 2048, brow, bcol, acc);
#pragma unroll
      for (int ai = 0; ai < 2; ai++)
#pragma unroll
        for (int m = 0; m < 4; m++) {
          const int tok = brow + ai * 128 + wr * 64 + m * 16 + fr;
#pragma unroll
          for (int bj = 0; bj < 2; bj++)
#pragma unroll
            for (int n = 0; n < 2; n++) {
              const int cb = bcol + bj * 128 + wc * 32 + n * 16;
              f32x4 v = acc[ai][bj][m][n];
              if (n == 0 && (wc & 1) == 0 && ((cb >= C_ATQ && cb < C_ATV) || (cb >= C_IDQ && cb < C_IDW))) {
                f32x4 cs = *(const f32x4*)(p.CS + (size_t)tok * 16 + 4 * (fq & 1));
                f32x4 sn = *(const f32x4*)(p.CS + (size_t)tok * 16 + 8 + 4 * (fq & 1));
#pragma unroll
                for (int e = 0; e < 4; e++) {
                  float o = __shfl_xor(v[e], 32);
                  v[e] = (fq < 2) ? (v[e] * cs[e] - o * sn[e]) : (v[e] * cs[e] + o * sn[e]);
                }
              }
              const int nn = cb + fq * 4;
              if (nn < 5716) {
                const int dn = nn + (nn >= 2628 ? 12 : 0);
                uint2 pv = make_uint2(pk2(v[0], v[1]), pk2(v[2], v[3]));
                *(uint2*)(p.P + (size_t)tok * PW + dn) = pv;
                if (nn >= C_IDK && nn < C_IDW) {
                  const int d = nn - C_IDK; const int b = tok >> 14, li = tok & 16383;
                  size_t o = ((((size_t)(b * 512 + (li >> 5)) * 4 + (d >> 4)) * 64 + ((d >> 3) & 1) * 32 + (li & 31)) * 8) + (d & 7);
                  *(uint2*)(p.KIF + o) = pv;
                }
                if (nn >= C_ATK && nn < C_ATZ) *(uint2*)(p.KVC + (size_t)tok * 256 + (nn - C_ATK)) = pv;
              }
            }
        }
    } else {
      const int t8 = L - nA; const int ly = t8 >> 2, tm = (t8 >> 1) & 1, tn = t8 & 1;
      gemm256(p.memb, 2048, p.WmemT + (size_t)ly * 512 * 2048, 2048, 2048, tm * 256, tn * 256, acc);
#pragma unroll
      for (int ai = 0; ai < 2; ai++)
#pragma unroll
        for (int m = 0; m < 4; m++) {
          const int row = tm * 256 + ai * 128 + wr * 64 + m * 16 + fr; const int b = row >> 8, mm = row & 255;
#pragma unroll
          for (int bj = 0; bj < 2; bj++)
#pragma unroll
            for (int n = 0; n < 2; n++)
#pragma unroll
              for (int e = 0; e < 4; e++) {
                const int nn = tn * 256 + bj * 128 + wc * 32 + n * 16 + fq * 4 + e; const float v = acc[ai][bj][m][n][e];
                if (nn < 256) { int h = nn >> 6, d = nn & 63; p.MK[((((size_t)ly * 2 + b) * 4 + h) * 256 + mm) * 64 + d] = f2bf(v); }
                else { int h = (nn - 256) >> 6, d = nn & 63; p.MVT[((((size_t)ly * 2 + b) * 4 + h) * 64 + d) * 256 + mm] = f2bf(v); }
              }
        }
    }
  }
}

__device__ __forceinline__ float softplusf_(float x) { return x > 15.f ? x : log1pf(__expf(x)); }

__device__ __forceinline__ void ssd_dt_acs(const Params& p, int layer, size_t tok0, int gg, float* sAcs, float* sDt) {
  const int tid = otid(), lane = tid & 63, w = tid >> 6;
#pragma unroll
  for (int k = 0; k < 2; k++) {
    const int hh = 2 * w + k, hd = gg * 8 + hh;
    const float bias = p.dt_bias[layer * 16 + hd], a = -__expf(p.a_log[layer * 16 + hd]);
    const int l0 = 2 * lane;
    float d0 = softplusf_(bf2f(p.P[(tok0 + l0) * PW + C_SDT + hd]) + bias);
    float d1 = softplusf_(bf2f(p.P[(tok0 + l0 + 1) * PW + C_SDT + hd]) + bias);
    float s0 = d0 * a, s1 = s0 + d1 * a;
    float xs = s1;
#pragma unroll
    for (int off = 1; off < 64; off <<= 1) { float v = __shfl_up(xs, off); if (lane >= off) xs += v; }
    float ex = xs - s1;
    sAcs[l0 * 8 + hh] = ex + s0; sAcs[(l0 + 1) * 8 + hh] = ex + s1;
    sDt[l0 * 8 + hh] = d0; sDt[(l0 + 1) * 8 + hh] = d1;
  }
}

struct Conv2 { float w0[4], w1[4], b0, b1, h0[3], h1[3]; };
__device__ __forceinline__ void conv_init(const Params& p, int layer, size_t tokb, int l, int ch, Conv2& c) {
  const float* cw = p.conv_w + (size_t)layer * 4 * 1536 + ch;
#pragma unroll
  for (int k = 0; k < 4; k++) { c.w0[k] = cw[k * 1536]; c.w1[k] = cw[k * 1536 + 1]; }
  c.b0 = p.conv_b[layer * 1536 + ch]; c.b1 = p.conv_b[layer * 1536 + ch + 1];
#pragma unroll
  for (int k = 0; k < 3; k++) {
    int ll = l - 3 + k; unsigned u = 0;
    if (ll >= 0) u = *(const unsigned*)(p.P + (tokb + ll) * PW + C_XBC + ch);
    c.h0[k] = bflo(u); c.h1[k] = bfhi(u);
  }
}
__device__ __forceinline__ void conv_step(const Params& p, size_t tokb, int l, int ch, Conv2& c, float& o0, float& o1) {
  unsigned u = *(const unsigned*)(p.P + (tokb + l) * PW + C_XBC + ch);
  float x0 = bflo(u), x1 = bfhi(u);
  float a0 = c.b0 + c.w0[0] * c.h0[0] + c.w0[1] * c.h0[1] + c.w0[2] * c.h0[2] + c.w0[3] * x0;
  float a1 = c.b1 + c.w1[0] * c.h1[0] + c.w1[1] * c.h1[1] + c.w1[2] * c.h1[2] + c.w1[3] * x1;
  c.h0[0] = c.h0[1]; c.h0[1] = c.h0[2]; c.h0[2] = x0;
  c.h1[0] = c.h1[1]; c.h1[1] = c.h1[2]; c.h1[2] = x1;
  o0 = siluf_(a0); o1 = siluf_(a1);
}

__device__ __forceinline__ void ssd_pass1(const Params& p, int layer, int task, char* sm) {
  const int tid = otid(), lane = tid & 63, w = tid >> 6, r32 = lane & 31, h5 = lane >> 5;
  const int gg = task & 1, c = (task >> 1) & 127, b = task >> 8;
  const size_t tokb = (size_t)b * LSEQ; const int lc0 = c * 128; const size_t tok0 = tokb + lc0;
  float* sAcs = (float*)sm; float* sDt = (float*)(sm + 4096);
  bf* sBT = (bf*)(sm + 8192); bf* sXT = (bf*)(sm + 43008);
  __syncthreads();
  ssd_dt_acs(p, layer, tok0, gg, sAcs, sDt);
  {
    const int cp = tid & 63, tg = tid >> 6; const int ch = 1024 + gg * 128 + 2 * cp;
    Conv2 cv; conv_init(p, layer, tokb, lc0 + tg * 32, ch, cv);
    for (int l = tg * 32; l < tg * 32 + 32; l += 2) {
      float a0, a1, b0, b1;
      conv_step(p, tokb, lc0 + l, ch, cv, a0, a1);
      conv_step(p, tokb, lc0 + l + 1, ch, cv, b0, b1);
      *(unsigned*)(sBT + (2 * cp) * 136 + l) = pk2(a0, b0);
      *(unsigned*)(sBT + (2 * cp + 1) * 136 + l) = pk2(a1, b1);
    }
  }
  __syncthreads();
  if (tid < 8) p.CD[((size_t)(b * 128 + c)) * 16 + gg * 8 + tid] = __expf(sAcs[127 * 8 + tid]);
  for (int hh = 0; hh < 8; hh++) {
    const int hd = gg * 8 + hh;
    if (hh) __syncthreads();
    {
      const int cp = tid & 31, tg = tid >> 5; const int ch = gg * 512 + hh * 64 + 2 * cp;
      const float aend = sAcs[127 * 8 + hh];
      Conv2 cv; conv_init(p, layer, tokb, lc0 + tg * 16, ch, cv);
      for (int l = tg * 16; l < tg * 16 + 16; l += 2) {
        float a0, a1, b0, b1;
        conv_step(p, tokb, lc0 + l, ch, cv, a0, a1);
        conv_step(p, tokb, lc0 + l + 1, ch, cv, b0, b1);
        float sa = sDt[l * 8 + hh] * __expf(aend - sAcs[l * 8 + hh]);
        float sb = sDt[(l + 1) * 8 + hh] * __expf(aend - sAcs[(l + 1) * 8 + hh]);
        *(unsigned*)(sXT + (2 * cp) * 136 + l) = pk2(a0 * sa, b0 * sb);
        *(unsigned*)(sXT + (2 * cp + 1) * 136 + l) = pk2(a1 * sa, b1 * sb);
      }
    }
    __syncthreads();
    f32x16 acc[2];
#pragma unroll
    for (int r = 0; r < 16; r++) { const float z_ = ozero(); acc[0][r] = z_; acc[1][r] = z_; }
#pragma unroll
    for (int ks = 0; ks < 8; ks++) {
      bf16x8 bfr = *(const bf16x8*)(sBT + (32 * w + r32) * 136 + ks * 16 + 8 * h5);
      bf16x8 x0 = *(const bf16x8*)(sXT + (r32) * 136 + ks * 16 + 8 * h5);
      bf16x8 x1 = *(const bf16x8*)(sXT + (32 + r32) * 136 + ks * 16 + 8 * h5);
      acc[0] = mfma32(x0, bfr, acc[0]);
      acc[1] = mfma32(x1, bfr, acc[1]);
    }
    float* st = p.ST + ((size_t)(b * 128 + c) * 16 + hd) * 64 * 128;
#pragma unroll
    for (int pi = 0; pi < 2; pi++)
#pragma unroll
      for (int r = 0; r < 16; r++) {
        int pp = 32 * pi + 8 * (r >> 2) + 4 * h5 + (r & 3);
        st[pp * 128 + 32 * w + r32] = acc[pi][r];
      }
  }
}

__device__ __forceinline__ void ssd_statepass(const Params& p, int task) {
  const int idx = task * 256 + otid();
  const int b = idx >> 15, e4 = idx & 32767;
  const int hd = e4 >> 11;
  const float zc_ = ozero(); float4 carry = make_float4(zc_, zc_, zc_, zc_);
  float* base = p.ST + (size_t)b * 128 * 131072 + (size_t)e4 * 4;
  const float* cd = p.CD + (size_t)b * 128 * 16 + hd;
  for (int c0 = 0; c0 < 128; c0 += 4) {
    float4 v[4]; float d[4];
#pragma unroll
    for (int k = 0; k < 4; k++) { v[k] = *(const float4*)(base + (size_t)(c0 + k) * 131072); d[k] = cd[(c0 + k) * 16]; }
#pragma unroll
    for (int k = 0; k < 4; k++) {
      *(float4*)(base + (size_t)(c0 + k) * 131072) = carry;
      carry.x = carry.x * d[k] + v[k].x; carry.y = carry.y * d[k] + v[k].y;
      carry.z = carry.z * d[k] + v[k].z; carry.w = carry.w * d[k] + v[k].w;
    }
  }
}

__device__ __forceinline__ void ssd_pass2(const Params& p, int layer, int task, char* sm) {
  const int tid = otid(), lane = tid & 63, w = tid >> 6, r32 = lane & 31, h5 = lane >> 5;
  const int lh = task & 1, gg = (task >> 1) & 1, c = (task >> 2) & 127, b = task >> 9;
  const size_t tokb = (size_t)b * LSEQ; const int lc0 = c * 128; const size_t tok0 = tokb + lc0;
  float* sAcs = (float*)sm; float* sDt = (float*)(sm + 4096);
  bf* sC = (bf*)(sm + 8192); bf* sB = (bf*)(sm + 25600); bf* sM = (bf*)(sm + 25600); bf* sXT = (bf*)(sm + 43008);
  float* sSsq = (float*)(sm + 60416);
  const int wr = w >> 1, wc = w & 1;
  const int nS = 64 * (lh + 1);
  __syncthreads();
  ssd_dt_acs(p, layer, tok0, gg, sAcs, sDt);
  if (tid < 64) sSsq[tid] = 0.f;
  {
    const int cp = tid & 63, tg = tid >> 6;
    {
      const int ch = 1280 + gg * 128 + 2 * cp;
      const int lst = 64 * lh + tg * 16;
      Conv2 cv; conv_init(p, layer, tokb, lc0 + lst, ch, cv);
      for (int l = lst; l < lst + 16; l++) {
        float a0, a1; conv_step(p, tokb, lc0 + l, ch, cv, a0, a1);
        *(unsigned*)(sC + (l - 64 * lh) * 136 + 2 * cp) = pk2(a0, a1);
      }
    }
    {
      const int ch = 1024 + gg * 128 + 2 * cp;
      const int per = nS >> 2; const int lst = tg * per;
      Conv2 cv; conv_init(p, layer, tokb, lc0 + lst, ch, cv);
      for (int l = lst; l < lst + per; l++) {
        float a0, a1; conv_step(p, tokb, lc0 + l, ch, cv, a0, a1);
        *(unsigned*)(sB + l * 136 + 2 * cp) = pk2(a0, a1);
      }
    }
  }
  __syncthreads();
  f32x16 cb[2];
#pragma unroll
  for (int r = 0; r < 16; r++) { const float z_ = ozero(); cb[0][r] = z_; cb[1][r] = z_; }
  if (64 * wc < nS) {
#pragma unroll
    for (int ks = 0; ks < 8; ks++) {
      bf16x8 af = *(const bf16x8*)(sC + (32 * wr + r32) * 136 + ks * 16 + 8 * h5);
      bf16x8 b0 = *(const bf16x8*)(sB + (64 * wc + r32) * 136 + ks * 16 + 8 * h5);
      bf16x8 b1 = *(const bf16x8*)(sB + (64 * wc + 32 + r32) * 136 + ks * 16 + 8 * h5);
      cb[0] = mfma32(af, b0, cb[0]);
      cb[1] = mfma32(af, b1, cb[1]);
    }
  }
  __syncthreads();
  const int wc2 = w & 1;
  for (int hh = 0; hh < 8; hh++) {
    const int hd = gg * 8 + hh;
    if (hh) __syncthreads();
    {
      const float dsk = p.ssd_d[layer * 16 + hd];
#pragma unroll
      for (int j = 0; j < 2; j++) {
        const int s = 64 * wc + 32 * j + r32;
        if (s < nS) {
          const float as = sAcs[s * 8 + hh];
#pragma unroll
          for (int r = 0; r < 16; r++) {
            const int lp = 32 * wr + 8 * (r >> 2) + 4 * h5 + (r & 3); const int l = 64 * lh + lp;
            float v = 0.f;
            if (s <= l) v = cb[j][r] * __expf(sAcs[l * 8 + hh] - as);
            if (s == l) v += dsk / sDt[l * 8 + hh];
            sM[lp * 136 + s] = f2bf(v);
          }
        }
      }
    }
    {
      const int cp = tid & 31, tg = tid >> 5; const int ch = gg * 512 + hh * 64 + 2 * cp;
      const int per = nS >> 3; const int lst = tg * per;
      Conv2 cv; conv_init(p, layer, tokb, lc0 + lst, ch, cv);
      for (int l = lst; l < lst + per; l += 2) {
        float a0, a1, b0, b1;
        conv_step(p, tokb, lc0 + l, ch, cv, a0, a1);
        conv_step(p, tokb, lc0 + l + 1, ch, cv, b0, b1);
        float sa = sDt[l * 8 + hh], sb = sDt[(l + 1) * 8 + hh];
        *(unsigned*)(sXT + (2 * cp) * 136 + l) = pk2(a0 * sa, b0 * sb);
        *(unsigned*)(sXT + (2 * cp + 1) * 136 + l) = pk2(a1 * sa, b1 * sb);
      }
    }
    __syncthreads();
    f32x16 yd, yo;
#pragma unroll
    for (int r = 0; r < 16; r++) { const float z_ = ozero(); yd[r] = z_; yo[r] = z_; }
    const int nks = nS >> 4;
    for (int ks = 0; ks < nks; ks++) {
      bf16x8 xf = *(const bf16x8*)(sXT + (32 * wc2 + r32) * 136 + ks * 16 + 8 * h5);
      bf16x8 mf = *(const bf16x8*)(sM + (32 * wr + r32) * 136 + ks * 16 + 8 * h5);
      yd = mfma32(xf, mf, yd);
    }
    {
      const float* pv = p.ST + (((size_t)(b * 128 + c) * 16 + hd) * 64 + 32 * wc2 + r32) * 128 + 8 * h5;
#pragma unroll
      for (int ks = 0; ks < 8; ks++) {
        float4 u0 = *(const float4*)(pv + ks * 16), u1 = *(const float4*)(pv + ks * 16 + 4);
        bf16x8 pf;
        unsigned q0 = pk2(u0.x, u0.y), q1 = pk2(u0.z, u0.w), q2 = pk2(u1.x, u1.y), q3 = pk2(u1.z, u1.w);
        pf[0] = (short)(q0 & 0xFFFF); pf[1] = (short)(q0 >> 16); pf[2] = (short)(q1 & 0xFFFF); pf[3] = (short)(q1 >> 16);
        pf[4] = (short)(q2 & 0xFFFF); pf[5] = (short)(q2 >> 16); pf[6] = (short)(q3 & 0xFFFF); pf[7] = (short)(q3 >> 16);
        bf16x8 cf = *(const bf16x8*)(sC + (32 * wr + r32) * 136 + ks * 16 + 8 * h5);
        yo = mfma32(pf, cf, yo);
      }
    }
    {
      const int lp = 32 * wr + r32; const int l = 64 * lh + lp; const size_t tok = tok0 + l;
      const float eo = __expf(sAcs[l * 8 + hh]);
      float ss = 0.f;
#pragma unroll
      for (int q = 0; q < 4; q++) {
        const int pp = 32 * wc2 + 8 * q + 4 * h5;
        uint2 zz = *(const uint2*)(p.P + tok * PW + C_SSZ + hd * 64 + pp);
        float v0 = (yd[4 * q] + eo * yo[4 * q]) * siluf_(bflo(zz.x));
        float v1 = (yd[4 * q + 1] + eo * yo[4 * q + 1]) * siluf_(bfhi(zz.x));
        float v2 = (yd[4 * q + 2] + eo * yo[4 * q + 2]) * siluf_(bflo(zz.y));
        float v3 = (yd[4 * q + 3] + eo * yo[4 * q + 3]) * siluf_(bfhi(zz.y));
        ss += v0 * v0 + v1 * v1 + v2 * v2 + v3 * v3;
        *(uint2*)(p.Y + tok * YW + Y_SSD + hd * 64 + pp) = make_uint2(pk2(v0, v1), pk2(v2, v3));
      }
      atomicAdd(&sSsq[lp], ss);
    }
  }
  __syncthreads();
  {
    const int lp = tid >> 2, part = tid & 3; const size_t tok = tok0 + 64 * lh + lp;
    const float rs = rsqrtf(sSsq[lp] * (1.f / 512.f) + 1e-5f);
    bf* yp = p.Y + tok * YW + Y_SSD + gg * 512 + part * 128;
    const float* ng = p.norm_g + layer * 1024 + gg * 512 + part * 128;
#pragma unroll 4
    for (int i = 0; i < 16; i++) {
      uint4 u = *(const uint4*)(yp + i * 8);
      float4 g0 = *(const float4*)(ng + i * 8), g1 = *(const float4*)(ng + i * 8 + 4);
      u.x = pk2(bflo(u.x) * rs * g0.x, bfhi(u.x) * rs * g0.y);
      u.y = pk2(bflo(u.y) * rs * g0.z, bfhi(u.y) * rs * g0.w);
      u.z = pk2(bflo(u.z) * rs * g1.x, bfhi(u.z) * rs * g1.y);
      u.w = pk2(bflo(u.w) * rs * g1.z, bfhi(u.w) * rs * g1.w);
      *(uint4*)(yp + i * 8) = u;
    }
  }
}

__device__ __forceinline__ void s5_load_u(const Params& p, size_t tok, int g, float* dst) {
  const uint4* src = (const uint4*)(p.P + tok * PW + C_S5U + g * 16);
  uint4 a = src[0], b = src[1];
  *(float4*)(dst + 0) = make_float4(bflo(a.x), bfhi(a.x), bflo(a.y), bfhi(a.y));
  *(float4*)(dst + 4) = make_float4(bflo(a.z), bfhi(a.z), bflo(a.w), bfhi(a.w));
  *(float4*)(dst + 8) = make_float4(bflo(b.x), bfhi(b.x), bflo(b.y), bfhi(b.y));
  *(float4*)(dst + 12) = make_float4(bflo(b.z), bfhi(b.z), bflo(b.w), bfhi(b.w));
}
#define S5_STEP(uu)                                                                     \
  {                                                                                     \
    float4 u0 = *(const float4*)((uu)), u1 = *(const float4*)((uu) + 4), u2 = *(const float4*)((uu) + 8), u3 = *(const float4*)((uu) + 12); \
    float br = Br[0] * u0.x, bi = Bi[0] * u0.x;                                         \
    br += Br[1] * u0.y; bi += Bi[1] * u0.y; br += Br[2] * u0.z; bi += Bi[2] * u0.z; br += Br[3] * u0.w; bi += Bi[3] * u0.w; \
    br += Br[4] * u1.x; bi += Bi[4] * u1.x; br += Br[5] * u1.y; bi += Bi[5] * u1.y; br += Br[6] * u1.z; bi += Bi[6] * u1.z; br += Br[7] * u1.w; bi += Bi[7] * u1.w; \
    br += Br[8] * u2.x; bi += Bi[8] * u2.x; br += Br[9] * u2.y; bi += Bi[9] * u2.y; br += Br[10] * u2.z; bi += Bi[10] * u2.z; br += Br[11] * u2.w; bi += Bi[11] * u2.w; \
    br += Br[12] * u3.x; bi += Bi[12] * u3.x; br += Br[13] * u3.y; bi += Bi[13] * u3.y; br += Br[14] * u3.z; bi += Bi[14] * u3.z; br += Br[15] * u3.w; bi += Bi[15] * u3.w; \
    float nr_ = ar * sr - ai * si + br; float ni_ = ar * si + ai * sr + bi; sr = nr_; si = ni_; \
  }

__device__ __forceinline__ void s5_pass1(const Params& p, int layer, int task, char* sm) {
  const int tid = otid(), lane = tid & 63, w = tid >> 6;
  const int gq = task & 7, c = (task >> 3) & 127, b = task >> 10;
  const int g = gq * 4 + w;
  const size_t tok0 = (size_t)b * LSEQ + c * 128;
  float* sU = (float*)(sm + w * 8192);
  __syncthreads();
  s5_load_u(p, tok0 + lane, g, sU + lane * 16);
  s5_load_u(p, tok0 + 64 + lane, g, sU + (64 + lane) * 16);
  const size_t pi = ((size_t)(layer * 32 + g)) * 64 + lane;
  float Br[16], Bi[16];
#pragma unroll
  for (int h = 0; h < 16; h++) { Br[h] = p.SB[pi * 32 + h]; Bi[h] = p.SB[pi * 32 + 16 + h]; }
  const float ar = p.SA[pi * 4], ai = p.SA[pi * 4 + 1];
  float sr = 0.f, si = 0.f;
  __builtin_amdgcn_wave_barrier();
  for (int l = 0; l < 128; l++) S5_STEP(sU + l * 16)
  *(float2*)(p.END + (((size_t)(b * 128 + c) * 32 + g) * 64 + lane) * 2) = make_float2(sr, si);
}

__device__ __forceinline__ void s5_carry(const Params& p, int layer, int task) {
  const int idx = task * 256 + otid();
  const int b = idx >> 11, gp = idx & 2047;
  const size_t pi = (size_t)layer * 2048 + gp;
  const float a128r = p.SA[pi * 4 + 2], a128i = p.SA[pi * 4 + 3];
  float sr = ozero(), si = ozero();
  float2* e = (float2*)p.END + (size_t)b * 128 * 2048 + gp;
  for (int c0 = 0; c0 < 128; c0 += 4) {
    float2 v[4];
#pragma unroll
    for (int k = 0; k < 4; k++) v[k] = e[(size_t)(c0 + k) * 2048];
#pragma unroll
    for (int k = 0; k < 4; k++) {
      e[(size_t)(c0 + k) * 2048] = make_float2(sr, si);
      float nr = a128r * sr - a128i * si + v[k].x, ni = a128r * si + a128i * sr + v[k].y; sr = nr; si = ni;
    }
  }
}

__device__ __forceinline__ void s5_pass2(const Params& p, int layer, int task, char* sm) {
  const int tid = otid(), lane = tid & 63, w = tid >> 6;
  const int c = task & 127, b = task >> 7;
  const size_t tok0 = (size_t)b * LSEQ + c * 128;
  float* sU = (float*)(sm + w * 10752); bf* sS = (bf*)(sm + w * 10752 + 2048);
  __syncthreads();
  for (int gi = 0; gi < 8; gi++) {
    const int g = w * 8 + gi;
    const size_t pi = ((size_t)(layer * 32 + g)) * 64 + lane;
    float Br[16], Bi[16];
#pragma unroll
    for (int h = 0; h < 16; h++) { Br[h] = p.SB[pi * 32 + h]; Bi[h] = p.SB[pi * 32 + 16 + h]; }
    const float ar = p.SA[pi * 4], ai = p.SA[pi * 4 + 1];
    float2 s0 = *(const float2*)(p.END + (((size_t)(b * 128 + c) * 32 + g) * 64 + lane) * 2);
    float sr = s0.x, si = s0.y;
    bf16x8 cf[4];
    {
      const bf* cm = p.CM + (((size_t)(layer * 32 + g)) * 16 + (lane & 15)) * 128 + 8 * (lane >> 4);
#pragma unroll
      for (int ks = 0; ks < 4; ks++) cf[ks] = *(const bf16x8*)(cm + ks * 32);
    }
    const float dsk = p.s5_d[(layer * 32 + g) * 16 + (lane & 15)];
    for (int sub = 0; sub < 4; sub++) {
      __builtin_amdgcn_wave_barrier();
      if (lane < 32) s5_load_u(p, tok0 + sub * 32 + lane, g, sU + lane * 16);
      __builtin_amdgcn_wave_barrier();
      for (int l = 0; l < 32; l++) {
        S5_STEP(sU + l * 16)
        sS[l * 136 + lane] = f2bf(sr); sS[l * 136 + 64 + lane] = f2bf(si);
      }
      __builtin_amdgcn_wave_barrier();
#pragma unroll
      for (int mb = 0; mb < 2; mb++) {
        const float z_ = ozero(); f32x4 acc = {z_, z_, z_, z_};
#pragma unroll
        for (int ks = 0; ks < 4; ks++) {
          bf16x8 af = *(const bf16x8*)(sS + (16 * mb + (lane & 15)) * 136 + ks * 32 + 8 * (lane >> 4));
          acc = mfma16(af, cf[ks], acc);
        }
#pragma unroll
        for (int r = 0; r < 4; r++) {
          const int l = 16 * mb + 4 * (lane >> 4) + r;
          float y = acc[r] + dsk * sU[l * 16 + (lane & 15)];
          p.YG[(tok0 + sub * 32 + l) * 512 + g * 16 + (lane & 15)] = f2bf(geluf_(y));
        }
      }
    }
  }
  __syncthreads();
  const int wr = w >> 1, wc = w & 1, r32 = lane & 31, h5 = lane >> 5;
  for (int tn = 0; tn < 4; tn++) {
    f32x16 acc[2][2]; ZERO_ACC(acc);
    gemm_acc<4>(p.YG + tok0 * 512, 512, p.WgluT + ((size_t)layer * 512 + tn * 128) * 512, 512, 512, acc, sm);
#pragma unroll
    for (int i = 0; i < 2; i++) {
      const size_t tok = tok0 + wr * 64 + i * 32 + r32;
#pragma unroll
      for (int j = 0; j < 2; j++)
#pragma unroll
        for (int q = 0; q < 4; q++) {
          const int n = tn * 128 + wc * 64 + j * 32 + q * 8 + h5 * 4;
          float4 bg = *(const float4*)(p.b_glu + layer * 512 + n);
          uint2 yy = *(const uint2*)(p.YG + tok * 512 + n);
          uint2 zz = *(const uint2*)(p.P + tok * PW + C_S5Z + n);
          float o0 = bflo(yy.x) * sigmoidf_(acc[i][j][4 * q] + bg.x) * siluf_(bflo(zz.x));
          float o1 = bfhi(yy.x) * sigmoidf_(acc[i][j][4 * q + 1] + bg.y) * siluf_(bfhi(zz.x));
          float o2 = bflo(yy.y) * sigmoidf_(acc[i][j][4 * q + 2] + bg.z) * siluf_(bflo(zz.y));
          float o3 = bfhi(yy.y) * sigmoidf_(acc[i][j][4 * q + 3] + bg.w) * siluf_(bfhi(zz.y));
          *(uint2*)(p.Y + tok * YW + Y_S5 + n) = make_uint2(pk2(o0, o1), pk2(o2, o3));
        }
    }
  }
}

__device__ __forceinline__ void mem_attn(const Params& p, int layer, int task) {
  const int tid = otid(), lane = tid & 63, h = tid >> 6;
  const int n16 = lane & 15, kq = lane >> 4;
  const size_t tok0 = (size_t)task * 16; const int b = (int)(tok0 >> 14);
  const bf* mk = p.MK + (((size_t)layer * 2 + b) * 4 + h) * 256 * 64;
  const bf* mvt = p.MVT + (((size_t)layer * 2 + b) * 4 + h) * 64 * 256;
  bf16x8 qf[2];
  {
    const bf* qp = p.P + (tok0 + n16) * PW + C_MEQ + h * 64 + 8 * kq;
    qf[0] = *(const bf16x8*)qp; qf[1] = *(const bf16x8*)(qp + 32);
  }
  f32x4 st[16];
#pragma unroll
  for (int kb = 0; kb < 16; kb++) {
    const bf* kp = mk + (size_t)(16 * kb + n16) * 64 + 8 * kq;
    bf16x8 a0 = *(const bf16x8*)kp, a1 = *(const bf16x8*)(kp + 32);
    const float z_ = ozero(); f32x4 acc = {z_, z_, z_, z_};
    acc = mfma16(a0, qf[0], acc); acc = mfma16(a1, qf[1], acc);
    st[kb] = acc * 0.125f;
  }
  float mx = -3.0e38f;
#pragma unroll
  for (int kb = 0; kb < 16; kb++)
#pragma unroll
    for (int r = 0; r < 4; r++) mx = fmaxf(mx, st[kb][r]);
  mx = fmaxf(mx, __shfl_xor(mx, 16)); mx = fmaxf(mx, __shfl_xor(mx, 32));
  float sum = 0.f;
#pragma unroll
  for (int kb = 0; kb < 16; kb++)
#pragma unroll
    for (int r = 0; r < 4; r++) { float e = __expf(st[kb][r] - mx); st[kb][r] = e; sum += e; }
  sum += __shfl_xor(sum, 16); sum += __shfl_xor(sum, 32);
  const float rinv = 1.f / sum;
  f32x4 o[4];
#pragma unroll
  for (int mb = 0; mb < 4; mb++) { const float z_ = ozero(); o[mb] = (f32x4){z_, z_, z_, z_}; }
#pragma unroll
  for (int k2 = 0; k2 < 8; k2++) {
    bf16x8 pf;
    unsigned q0 = pk2(st[2 * k2][0], st[2 * k2][1]), q1 = pk2(st[2 * k2][2], st[2 * k2][3]);
    unsigned q2 = pk2(st[2 * k2 + 1][0], st[2 * k2 + 1][1]), q3 = pk2(st[2 * k2 + 1][2], st[2 * k2 + 1][3]);
    pf[0] = (short)(q0 & 0xFFFF); pf[1] = (short)(q0 >> 16); pf[2] = (short)(q1 & 0xFFFF); pf[3] = (short)(q1 >> 16);
    pf[4] = (short)(q2 & 0xFFFF); pf[5] = (short)(q2 >> 16); pf[6] = (short)(q3 & 0xFFFF); pf[7] = (short)(q3 >> 16);
#pragma unroll
    for (int mb = 0; mb < 4; mb++) {
      const bf* vp = mvt + (size_t)(16 * mb + n16) * 256 + 32 * k2 + 4 * kq;
      uint2 v0 = *(const uint2*)vp, v1 = *(const uint2*)(vp + 16);
      bf16x8 af;
      af[0] = (short)(v0.x & 0xFFFF); af[1] = (short)(v0.x >> 16); af[2] = (short)(v0.y & 0xFFFF); af[3] = (short)(v0.y >> 16);
      af[4] = (short)(v1.x & 0xFFFF); af[5] = (short)(v1.x >> 16); af[6] = (short)(v1.y & 0xFFFF); af[7] = (short)(v1.y >> 16);
      o[mb] = mfma16(af, pf, o[mb]);
    }
  }
  const size_t tok = tok0 + n16;
#pragma unroll
  for (int mb = 0; mb < 4; mb++) {
    const int d = 16 * mb + 4 * kq;
    uint2 zz = *(const uint2*)(p.P + tok * PW + C_MEZ + h * 64 + d);
    float v0 = o[mb][0] * rinv * siluf_(bflo(zz.x)), v1 = o[mb][1] * rinv * siluf_(bfhi(zz.x));
    float v2 = o[mb][2] * rinv * siluf_(bflo(zz.y)), v3 = o[mb][3] * rinv * siluf_(bfhi(zz.y));
    *(uint2*)(p.Y + tok * YW + Y_MEM + h * 64 + d) = make_uint2(pk2(v0, v1), pk2(v2, v3));
  }
}

__device__ __forceinline__ void dsa_wave(const Params& p, int rank, char* sm) {
  const int tid = otid(), lane = tid & 63, w = tid >> 6, r32 = lane & 31, h5 = lane >> 5;
  const int b = rank & 1, qg = 2047 - (rank >> 1), l0 = qg * 8;
  const size_t tokb = (size_t)b * LSEQ;
  unsigned* cand = (unsigned*)(sm + w * (8 * CAP * 4));
  bf* Pb = (bf*)(sm + 65536 + w * 2048);
  bf16x8 aq[4];
  {
    const bf* qp = p.P + (tokb + l0 + (r32 >> 2)) * PW + C_IDQ + (r32 & 3) * 64 + 8 * h5;
#pragma unroll
    for (int ks = 0; ks < 4; ks++) aq[ks] = *(const bf16x8*)(qp + ks * 16);
  }
  float wv[4][4]; int ql[4];
#pragma unroll
  for (int g = 0; g < 4; g++) {
    ql[g] = l0 + 2 * g + h5;
    uint2 u = *(const uint2*)(p.P + (tokb + ql[g]) * PW + C_IDW);
    wv[g][0] = bflo(u.x) * 0.0625f; wv[g][1] = bfhi(u.x) * 0.0625f; wv[g][2] = bflo(u.y) * 0.0625f; wv[g][3] = bfhi(u.y) * 0.0625f;
  }
  unsigned Tg[4] = {0u, 0u, 0u, 0u}; float Tf[4];
  unsigned Tq = 0u; int cntv = 0;
  int nrep_ = (PROBE_MASK & 32) ? 2 : 1; asm volatile("" : "+s"(nrep_));
#pragma unroll 1
  for (int rep_ = 0; rep_ < nrep_; rep_++) {
  Tg[0] = Tg[1] = Tg[2] = Tg[3] = 0u; Tq = 0u; cntv = 0;
  Tf[0] = Tf[1] = Tf[2] = Tf[3] = -__builtin_inff();
  const int ntile = (l0 + 7) / 32 + 1;
  const bf* kif = p.KIF + (size_t)b * 512 * 2048 + lane * 8;
  bf16x8 bq[4][4];
#pragma unroll
  for (int s = 0; s < 4; s++)
    if (s < ntile) {
#pragma unroll
      for (int ks = 0; ks < 4; ks++) bq[s][ks] = *(const bf16x8*)(kif + (size_t)s * 2048 + ks * 512);
    }
  const unsigned ltmask = (1u << r32) - 1u;
  for (int tile0 = 0; tile0 < ntile; tile0 += 4) {
#pragma unroll
    for (int u = 0; u < 4; u++) {
      if ((u & 1) == 0) {
        unsigned long long over = __ballot(lane < 8 && cntv > CAP - 64);
        if (over) {
          while (over) {
            const int q = __builtin_ctzll(over); over &= over - 1;
            const int n = __builtin_amdgcn_readlane(cntv, q);
            unsigned* cb_ = cand + q * CAP;
            unsigned e[8];
#pragma unroll
            for (int i = 0; i < 8; i++) e[i] = (i * 64 + lane < n) ? cb_[i * 64 + lane] : 0u;
            unsigned T = 0u; int cT = n;
            for (int bit = 31; bit >= 14; bit--) {
              const unsigned cnd = T | (1u << bit); int cc = 0;
#pragma unroll
              for (int i = 0; i < 8; i++) cc += __popcll(__ballot(e[i] >= cnd));
              if (cc >= 256) { T = cnd; cT = cc; }
            }
            if (cT > 320) {
              for (int bit = 13; bit >= 0; bit--) {
                const unsigned cnd = T | (1u << bit); int cc = 0;
#pragma unroll
                for (int i = 0; i < 8; i++) cc += __popcll(__ballot(e[i] >= cnd));
                if (cc >= 256) T = cnd;
              }
            }
            int pos = 0;
#pragma unroll
            for (int i = 0; i < 8; i++) {
              const bool keep = e[i] >= T; const unsigned long long m = __ballot(keep);
              if (keep) cb_[pos + __popcll(m & ((1ull << lane) - 1ull))] = e[i];
              pos += __popcll(m);
            }
            if (lane == q) { cntv = pos; Tq = T; }
          }
#pragma unroll
          for (int g = 0; g < 4; g++) {
            unsigned tlo = __builtin_amdgcn_readlane(Tq, 2 * g), thi = __builtin_amdgcn_readlane(Tq, 2 * g + 1);
            Tg[g] = h5 ? thi : tlo;
            const unsigned sh = Tg[g] & 0xFFFFC000u;
            const unsigned fb = (sh & 0x80000000u) ? (sh ^ 0x80000000u) : ~sh;
            Tf[g] = Tg[g] ? __uint_as_float(fb) : -__builtin_inff();
          }
        }
      }
      const int tile = tile0 + u;
      if (tile >= ntile) break;
      f32x16 acc = {0.f, 0.f, 0.f, 0.f, 0.f, 0.f, 0.f, 0.f, 0.f, 0.f, 0.f, 0.f, 0.f, 0.f, 0.f, 0.f};
#pragma unroll
      for (int ks = 0; ks < 4; ks++) acc = mfma32(aq[ks], bq[u][ks], acc);
      if (tile + 4 < ntile) {
#pragma unroll
        for (int ks = 0; ks < 4; ks++) bq[u][ks] = *(const bf16x8*)(kif + (size_t)(tile + 4) * 2048 + ks * 512);
      }
      const int kidx = tile * 32 + r32;
      const bool diag = (tile * 32 + 31 > l0);
#pragma unroll
      for (int g = 0; g < 4; g++) {
        const float r0 = __int_as_float(max(__float_as_int(acc[4 * g]), 0)), r1 = __int_as_float(max(__float_as_int(acc[4 * g + 1]), 0));
        const float r2 = __int_as_float(max(__float_as_int(acc[4 * g + 2]), 0)), r3 = __int_as_float(max(__float_as_int(acc[4 * g + 3]), 0));
        float sc = r0 * wv[g][0]; sc = fmaf(r1, wv[g][1], sc); sc = fmaf(r2, wv[g][2], sc); sc = fmaf(r3, wv[g][3], sc);
        bool c = sc >= Tf[g];
        if (diag) c = c && (kidx <= ql[g]);
        if (__ballot(c)) {
          const float s2 = sc + 0.f;
          unsigned uu = __float_as_uint(s2); uu ^= ((unsigned)((int)uu >> 31) | 0x80000000u);
          const unsigned pk = (uu & 0xFFFFC000u) | (unsigned)(16383 - kidx);
          const bool pass = c && (pk >= Tg[g]);
          const unsigned long long m = __ballot(pass);
          if (m) {
            const unsigned lo = (unsigned)m, hi = (unsigned)(m >> 32);
            const int cA = __builtin_amdgcn_readlane(cntv, 2 * g), cB = __builtin_amdgcn_readlane(cntv, 2 * g + 1);
            if (pass) {
              const int base = h5 ? cB : cA; const unsigned mm = h5 ? hi : lo;
              cand[(2 * g + h5) * CAP + base + __popc(mm & ltmask)] = pk;
            }
            if (lane == 2 * g) cntv += __popc(lo);
            if (lane == 2 * g + 1) cntv += __popc(hi);
          }
        }
      }
    }
  }
  {
    unsigned long long over = __ballot(lane < 8 && cntv > 256);
    while (over) {
      const int q = __builtin_ctzll(over); over &= over - 1;
      const int n = __builtin_amdgcn_readlane(cntv, q);
      unsigned* cb_ = cand + q * CAP;
      unsigned e[8];
#pragma unroll
      for (int i = 0; i < 8; i++) e[i] = (i * 64 + lane < n) ? cb_[i * 64 + lane] : 0u;
      unsigned T = 0u;
      for (int bit = 31; bit >= 0; bit--) {
        const unsigned cnd = T | (1u << bit); int cc = 0;
#pragma unroll
        for (int i = 0; i < 8; i++) cc += __popcll(__ballot(e[i] >= cnd));
        if (cc >= 256) T = cnd;
      }
      int pos = 0;
#pragma unroll
      for (int i = 0; i < 8; i++) {
        const bool keep = e[i] >= T; const unsigned long long m = __ballot(keep);
        if (keep) cb_[pos + __popcll(m & ((1ull << lane) - 1ull))] = e[i];
        pos += __popcll(m);
      }
      if (lane == q) { cntv = pos; Tq = T; }
    }
  }
  }
  __builtin_amdgcn_wave_barrier();
  const int n16 = lane & 15, kq = lane >> 4;
  for (int q = 0; q < 8; q++) {
    const int n = __builtin_amdgcn_readlane(cntv, q);
    const unsigned* sel = cand + q * CAP;
    const size_t tq = tokb + l0 + q;
    for (int grp = 0; grp < 2; grp++) {
      bf16x8 qa0, qa1;
#pragma unroll
      for (int k = 0; k < 8; k++) { int zi_ = 0; asm volatile("" : "+v"(zi_)); qa0[k] = (short)zi_; qa1[k] = (short)zi_; }
      if (n16 < 4) {
        const bf* qp = p.P + tq * PW + C_ATQ + (grp * 4 + n16) * 64 + 8 * kq;
        qa0 = *(const bf16x8*)qp; qa1 = *(const bf16x8*)(qp + 32);
      }
      f32x4 lg[16];
#pragma unroll
      for (int t = 0; t < 16; t++) {
        const int slot = t * 16 + n16; const bool valid = slot < n;
        const int key = valid ? (16383 - (int)(sel[slot] & 0x3FFFu)) : 0;
        const bf* kp = p.KVC + (tokb + key) * 256 + grp * 64 + 8 * kq;
        bf16x8 b0 = *(const bf16x8*)kp, b1 = *(const bf16x8*)(kp + 32);
        const float zc_ = ozero(); f32x4 cc = {zc_, zc_, zc_, zc_};
        cc = mfma16(qa0, b0, cc); cc = mfma16(qa1, b1, cc);
        const bool ok = valid && (kq == 0);
#pragma unroll
        for (int r = 0; r < 4; r++) lg[t][r] = ok ? cc[r] * 0.125f : -3.0e38f;
      }
      float mx[4], sm4[4];
#pragma unroll
      for (int r = 0; r < 4; r++) {
        float m = lg[0][r];
#pragma unroll
        for (int t = 1; t < 16; t++) m = fmaxf(m, lg[t][r]);
#pragma unroll
        for (int off = 1; off < 64; off <<= 1) m = fmaxf(m, __shfl_xor(m, off));
        mx[r] = m;
      }
#pragma unroll
      for (int r = 0; r < 4; r++) {
        float s = 0.f;
#pragma unroll
        for (int t = 0; t < 16; t++) { float e = (lg[t][r] > -1.0e38f) ? __expf(lg[t][r] - mx[r]) : 0.f; lg[t][r] = e; s += e; }
#pragma unroll
        for (int off = 1; off < 64; off <<= 1) s += __shfl_xor(s, off);
        sm4[r] = s;
      }
      __builtin_amdgcn_wave_barrier();
      if (kq == 0) {
#pragma unroll
        for (int t = 0; t < 16; t++)
          *(uint2*)(Pb + (t * 16 + n16) * 4) = make_uint2(pk2(lg[t][0], lg[t][1]), pk2(lg[t][2], lg[t][3]));
      }
      __builtin_amdgcn_wave_barrier();
      float o[32];
#pragma unroll
      for (int i = 0; i < 32; i++) o[i] = ozero();
      const int ksg = lane >> 3, dc = lane & 7;
#pragma unroll 8
      for (int stp = 0; stp < 32; stp++) {
        const int slot = stp * 8 + ksg;
        const int key = (slot < n) ? (16383 - (int)(sel[slot] & 0x3FFFu)) : 0;
        uint2 pp = *(const uint2*)(Pb + slot * 4);
        uint4 vv = *(const uint4*)(p.KVC + (tokb + key) * 256 + 128 + grp * 64 + dc * 8);
        float ph[4] = {bflo(pp.x), bfhi(pp.x), bflo(pp.y), bfhi(pp.y)};
        float vf[8] = {bflo(vv.x), bfhi(vv.x), bflo(vv.y), bfhi(vv.y), bflo(vv.z), bfhi(vv.z), bflo(vv.w), bfhi(vv.w)};
#pragma unroll
        for (int hh = 0; hh < 4; hh++)
#pragma unroll
          for (int d = 0; d < 8; d++) o[hh * 8 + d] += ph[hh] * vf[d];
      }
      const bool b5 = (lane >> 5) & 1, b4 = (lane >> 4) & 1, b3 = (lane >> 3) & 1;
      float o16[16], o8[8], o4[4];
#pragma unroll
      for (int i = 0; i < 16; i++) { float lo = o[i], hi = o[16 + i]; float snd = b5 ? lo : hi; float kp = b5 ? hi : lo; o16[i] = kp + __shfl_xor(snd, 32); }
#pragma unroll
      for (int i = 0; i < 8; i++) { float lo = o16[i], hi = o16[8 + i]; float snd = b4 ? lo : hi; float kp = b4 ? hi : lo; o8[i] = kp + __shfl_xor(snd, 16); }
#pragma unroll
      for (int i = 0; i < 4; i++) { float lo = o8[i], hi = o8[4 + i]; float snd = b3 ? lo : hi; float kp = b3 ? hi : lo; o4[i] = kp + __shfl_xor(snd, 8); }
      const int hsel = (b5 ? 2 : 0) + (b4 ? 1 : 0);
      const float ssum = b5 ? (b4 ? sm4[3] : sm4[2]) : (b4 ? sm4[1] : sm4[0]);
      const float rinv = 1.f / ssum;
      const int col = (grp * 4 + hsel) * 64 + dc * 8 + (b3 ? 4 : 0);
      uint2 zz = *(const uint2*)(p.P + tq * PW + C_ATZ + col);
      float v0 = o4[0] * rinv * siluf_(bflo(zz.x)), v1 = o4[1] * rinv * siluf_(bfhi(zz.x));
      float v2 = o4[2] * rinv * siluf_(bflo(zz.y)), v3 = o4[3] * rinv * siluf_(bfhi(zz.y));
      *(uint2*)(p.Y + tq * YW + Y_ATT + col) = make_uint2(pk2(v0, v1), pk2(v2, v3));
    }
  }
}

__device__ __forceinline__ void phaseB(const Params& p, int layer, char* sm0) {
  const int total = 512 + 2048 + 2048;
  char* sm = sm0 + HB * HALF_LDS;
  for (int t = VB; t < total; t += G2) {
    if (t < 512) ssd_pass1(p, layer, t, sm);
    else if (t < 2560) s5_pass1(p, layer, t - 512, sm);
    else mem_attn(p, layer, t - 2560);
  }
}
__device__ __forceinline__ void phaseC(const Params& p, int layer, char* sm0, bool dsa_only) {
  const int G = G2;
  const int total = dsa_only ? 1024 : 1024 + 256 + 16;
  char* sm = sm0 + HB * HALF_LDS;
  int rr = 0;
  for (int i = VB; i < total; i += G, rr++) {
    if (i < 1024) {
      int pos = i - rr * G; int idx = i;
      if ((rr & 1) && (rr * G + G <= 1024)) idx = rr * G + (G - 1 - pos);
      __syncthreads();
      dsa_wave(p, idx * 4 + (otid() >> 6), sm);
    } else if (i < 1280) ssd_statepass(p, i - 1024);
    else s5_carry(p, layer, i - 1280);
  }
}
__device__ __forceinline__ void phaseD(const Params& p, int layer, char* sm0) {
  const int total = 256 + 1024;
  char* sm = sm0 + HB * HALF_LDS;
  for (int t = VB; t < total; t += G2) {
    if (t < 256) s5_pass2(p, layer, t, sm);
    else ssd_pass2(p, layer, t - 256, sm);
  }
}

__device__ __forceinline__ void phaseE(const Params& p, int layer) {
  const int tidf = otid_full();
  const int wid = __builtin_amdgcn_readfirstlane(tidf >> 6), lane = tidf & 63, wr = wid >> 2, wc = wid & 3, fr = lane & 15, fq = lane >> 4;
  const bf* Wl = p.WinT + (size_t)layer * INW * 2048;
  const bf* Wb = p.WbrT + (size_t)layer * 2048 * YW;
  bf* merged = p.P;
  char* gsb = (char*)p.GS + (size_t)blockIdx.x * 131072;
  const unsigned gs_lane0 = (unsigned)tidf * 16u, lane_c40 = (unsigned)fq * 16u, lane_m0 = (unsigned)(fr * 2048 + fq * 4) * 2u;
  for (int L = blockIdx.x; L < 1024; L += gridDim.x) {
    int pm, pn; tile_order(L, 128, 8, pm, pn);
    const int brow = pm * 256, bcol = pn * 256;
#pragma unroll 1
    for (int s = 0; s < 8; s++) {
      const int br = s >> 1; const bool isBr = (s & 1) != 0;
      const int koff = br == 0 ? 0 : (br == 1 ? 512 : (br == 2 ? 1024 : 2048));
      const int kb = br == 2 ? 1024 : (br == 3 ? 256 : 512);
      const bf* A_ = isBr ? p.Y + koff : p.xb; const int lda_ = isBr ? YW : 2048;
      const bf* B_ = isBr ? Wb + koff : Wl + (size_t)(5716 + br * 2048) * 2048; const int ldb_ = isBr ? YW : 2048;
      const int K_ = isBr ? kb : 2048;
      f32x4 acc[2][2][4][2]; ZERO_ACC8(acc);
      gemm256(A_, lda_, B_, ldb_, K_, brow, bcol, acc);
      unsigned gs_lane = gs_lane0, lane_c4 = lane_c40, lane_m = lane_m0;
      asm volatile("" : "+v"(gs_lane), "+v"(lane_c4), "+v"(lane_m));
      if (!isBr) {
        const char* bgb = (const char*)(p.b_gate + (size_t)layer * 8192 + br * 2048 + bcol + wc * 32);
#pragma unroll
        for (int ai = 0; ai < 2; ai++)
#pragma unroll
          for (int bj = 0; bj < 2; bj++)
#pragma unroll
            for (int m = 0; m < 4; m++) {
              unsigned q[4];
#pragma unroll
              for (int n = 0; n < 2; n++) {
                float4 bg = *(const float4*)(bgb + (bj * 128 + n * 16) * 4 + lane_c4);
                f32x4 v = acc[ai][bj][m][n];
                q[2 * n] = pk2(sigmoidf_(v[0] + bg.x), sigmoidf_(v[1] + bg.y));
                q[2 * n + 1] = pk2(sigmoidf_(v[2] + bg.z), sigmoidf_(v[3] + bg.w));
              }
              *(uint4*)(gsb + ((ai * 2 + bj) * 4 + m) * 8192 + gs_lane) = make_uint4(q[0], q[1], q[2], q[3]);
              __builtin_amdgcn_sched_barrier(0);
            }
      } else {
        char* mb = (char*)merged + ((size_t)(brow + wr * 64) * 2048 + bcol + wc * 32) * 2;
#pragma unroll
        for (int ai = 0; ai < 2; ai++)
#pragma unroll
          for (int bj = 0; bj < 2; bj++)
#pragma unroll
            for (int m = 0; m < 4; m++) {
              uint4 g = *(const uint4*)(gsb + ((ai * 2 + bj) * 4 + m) * 8192 + gs_lane);
              const unsigned gq[4] = {g.x, g.y, g.z, g.w};
#pragma unroll
              for (int n = 0; n < 2; n++) {
                f32x4 v = acc[ai][bj][m][n];
                float o0 = bflo(gq[2 * n]) * v[0], o1 = bfhi(gq[2 * n]) * v[1], o2 = bflo(gq[2 * n + 1]) * v[2], o3 = bfhi(gq[2 * n + 1]) * v[3];
                char* mp = mb + ((size_t)(ai * 128 + m * 16) * 2048 + bj * 128 + n * 16) * 2 + lane_m;
                if (br) { uint2 old = *(const uint2*)mp; o0 += bflo(old.x); o1 += bfhi(old.x); o2 += bflo(old.y); o3 += bfhi(old.y); }
                *(uint2*)mp = make_uint2(pk2(o0, o1), pk2(o2, o3));
              }
              __builtin_amdgcn_sched_barrier(0);
            }
      }
    }
  }
}

__device__ __forceinline__ void phaseF(const Params& p, int layer) {
  const int tidf = otid_full();
  const int wid = __builtin_amdgcn_readfirstlane(tidf >> 6), lane = tidf & 63, wr = wid >> 2, wc = wid & 3, fr = lane & 15, fq = lane >> 4;
  const bf* merged = p.P;
  const float* xres = layer == 0 ? p.x : p.out;
  for (int L = blockIdx.x; L < 1024; L += gridDim.x) {
    int pm, pn; tile_order(L, 128, 8, pm, pn);
    const int brow = pm * 256, bcol = pn * 256;
    f32x4 acc[2][2][4][2]; ZERO_ACC8(acc);
    gemm256(merged, 2048, p.WoutT + (size_t)layer * 2048 * 2048, 2048, 2048, brow, bcol, acc);
#pragma unroll
    for (int ai = 0; ai < 2; ai++)
#pragma unroll
      for (int m = 0; m < 4; m++) {
        const size_t tok = brow + ai * 128 + wr * 64 + m * 16 + fr;
#pragma unroll
        for (int bj = 0; bj < 2; bj++)
#pragma unroll
          for (int n = 0; n < 2; n++) {
            const int col = bcol + bj * 128 + wc * 32 + n * 16 + fq * 4;
            float4 xr = *(const float4*)(xres + tok * 2048 + col);
            f32x4 v = acc[ai][bj][m][n];
            float4 o;
            o.x = 1.41421356237f * xr.x + v[0]; o.y = 1.41421356237f * xr.y + v[1];
            o.z = 1.41421356237f * xr.z + v[2]; o.w = 1.41421356237f * xr.w + v[3];
            *(float4*)(p.out + tok * 2048 + col) = o;
          }
      }
  }
}

__device__ __forceinline__ void phaseG(const Params& p, int layer) {
  const int lane = otid() & 63, w = otid() >> 6;
  const float* g = p.ln_g + layer * 2048; const float* bb = p.ln_b + layer * 2048;
  for (int t = VB; t < TT / 4; t += G2) {
    const size_t row = (size_t)t * 4 + w;
    float* xp = p.out + row * 2048;
    float4 v[8]; float s = 0.f;
#pragma unroll
    for (int i = 0; i < 8; i++) { v[i] = *(const float4*)(xp + (i * 64 + lane) * 4); s += v[i].x + v[i].y + v[i].z + v[i].w; }
#pragma unroll
    for (int off = 1; off < 64; off <<= 1) s += __shfl_xor(s, off);
    const float mu = s * (1.f / 2048.f);
    float q = 0.f;
#pragma unroll
    for (int i = 0; i < 8; i++) {
      float a = v[i].x - mu, b = v[i].y - mu, c = v[i].z - mu, d = v[i].w - mu; q += a * a + b * b + c * c + d * d;
    }
#pragma unroll
    for (int off = 1; off < 64; off <<= 1) q += __shfl_xor(q, off);
    const float rs = rsqrtf(q * (1.f / 2048.f) + 1e-5f);
#pragma unroll
    for (int i = 0; i < 8; i++) {
      const int col = (i * 64 + lane) * 4;
      float4 gg = *(const float4*)(g + col), bv = *(const float4*)(bb + col);
      float4 o;
      o.x = (v[i].x - mu) * rs * gg.x + bv.x; o.y = (v[i].y - mu) * rs * gg.y + bv.y;
      o.z = (v[i].z - mu) * rs * gg.z + bv.z; o.w = (v[i].w - mu) * rs * gg.w + bv.w;
      *(float4*)(xp + col) = o;
      if (layer == 0) *(uint2*)(p.xb + row * 2048 + col) = make_uint2(pk2(o.x, o.y), pk2(o.z, o.w));
    }
  }
}

__global__ void __launch_bounds__(512, 2) mega_kernel(Params p) {
  char* sm = dynsm;
  cg::grid_group grid = cg::this_grid();
  phase0(p, sm); grid.sync();
#pragma unroll 1
  for (int layer = 0; layer < 2; layer++) {
    int nA = (PROBE_MASK & 1) ? 2 : 1, nB = (PROBE_MASK & 2) ? 2 : 1, nC = (PROBE_MASK & 4) ? 2 : 1, nD = (PROBE_MASK & 8) ? 2 : 1, nE = (PROBE_MASK & 16) ? 2 : 1;
    asm volatile("" : "+s"(nA), "+s"(nB), "+s"(nC), "+s"(nD), "+s"(nE));
#pragma unroll 1
    for (int r = 0; r < nA; r++) phaseA(p, layer);
    grid.sync();
#pragma unroll 1
    for (int r = 0; r < nB; r++) phaseB(p, layer, sm);
    grid.sync();
#pragma unroll 1
    for (int r = 0; r < nC; r++) phaseC(p, layer, sm, r + 1 < nC);
    grid.sync();
#pragma unroll 1
    for (int r = 0; r < nD; r++) phaseD(p, layer, sm);
    grid.sync();
#pragma unroll 1
    for (int r = 0; r < nE; r++) phaseE(p, layer);
    grid.sync();
    phaseF(p, layer); grid.sync();
    phaseG(p, layer);
    if (layer == 0) grid.sync();
  }
}

extern "C" void kernel_launch(void* const* d_in, const int* in_sizes, int n_in, void* d_out, int out_size, void* d_ws,
                              size_t ws_size, hipStream_t stream) {
  Params p{};
  p.x = (const float*)d_in[0]; p.mem = (const float*)d_in[1]; p.pos = (const int*)d_in[2];
  p.w_in = (const float*)d_in[3]; p.b_gate = (const float*)d_in[4]; p.lam_re = (const float*)d_in[5];
  p.lam_im = (const float*)d_in[6]; p.log_dt = (const float*)d_in[7]; p.b_re = (const float*)d_in[8];
  p.b_im = (const float*)d_in[9]; p.c_re = (const float*)d_in[10]; p.c_im = (const float*)d_in[11];
  p.s5_d = (const float*)d_in[12]; p.w_glu = (const float*)d_in[13]; p.b_glu = (const float*)d_in[14];
  p.conv_w = (const float*)d_in[15]; p.conv_b = (const float*)d_in[16]; p.dt_bias = (const float*)d_in[17];
  p.a_log = (const float*)d_in[18]; p.ssd_d = (const float*)d_in[19]; p.norm_g = (const float*)d_in[20];
  p.mem_w_kv = (const float*)d_in[21]; p.w_br_s5 = (const float*)d_in[22]; p.w_br_attn = (const float*)d_in[23];
  p.w_br_ssd = (const float*)d_in[24]; p.w_br_mem = (const float*)d_in[25]; p.w_out = (const float*)d_in[26];
  p.ln_g = (const float*)d_in[27]; p.ln_b = (const float*)d_in[28];
  p.out = (float*)d_out;
  char* ws = (char*)d_ws; size_t off = 0;
  auto carve = [&](size_t bytes) { char* r = ws + off; off += (bytes + 255) & ~(size_t)255; return r; };
  p.WinT = (bf*)carve((size_t)2 * INW * 2048 * 2);
  p.WbrT = (bf*)carve((size_t)2 * 2048 * YW * 2);
  p.WoutT = (bf*)carve((size_t)2 * 2048 * 2048 * 2);
  p.WgluT = (bf*)carve((size_t)2 * 512 * 512 * 2);
  p.WmemT = (bf*)carve((size_t)2 * 512 * 2048 * 2);
  p.memb = (bf*)carve((size_t)512 * 2048 * 2);
  p.xb = (bf*)carve((size_t)TT * 2048 * 2);
  p.P = (bf*)carve((size_t)TT * PW * 2);
  p.Y = (bf*)carve((size_t)TT * YW * 2);
  p.YG = (bf*)carve((size_t)TT * 512 * 2);
  p.KIF = (bf*)carve((size_t)TT * 64 * 2);
  p.MK = (bf*)carve((size_t)2 * 2 * 4 * 256 * 64 * 2);
  p.MVT = (bf*)carve((size_t)2 * 2 * 4 * 256 * 64 * 2);
  p.CM = (bf*)carve((size_t)2 * 32 * 16 * 128 * 2);
  p.ST = (float*)carve((size_t)2 * 128 * 131072 * 4);
  p.CS = (float*)carve((size_t)TT * 16 * 4);
  p.END = (float*)carve((size_t)2 * 128 * 32 * 64 * 2 * 4);
  p.CD = (float*)carve((size_t)2 * 128 * 16 * 4);
  p.SB = (float*)carve((size_t)2 * 32 * 64 * 32 * 4);
  p.SA = (float*)carve((size_t)2 * 32 * 64 * 4 * 4);
  p.KVC = (bf*)carve((size_t)TT * 256 * 2);
  p.GS = (bf*)carve((size_t)256 * 16 * 512 * 16);
  if (off > ws_size) { fprintf(stderr, "workspace too small: need %zu have %zu\n", off, ws_size); return; }
  for (int j = 0; j < 8; j++) p.inv[j] = (float)pow(500000.0, -(double)j / 8.0);
  const size_t kDynLds = 2 * HALF_LDS;
  static int grid_blocks = 0;
  if (!grid_blocks) {
    int dev = 0, cus = 0, per_cu = 0;
    (void)hipGetDevice(&dev);
    (void)hipDeviceGetAttribute(&cus, hipDeviceAttributeMultiprocessorCount, dev);
    (void)hipFuncSetAttribute((const void*)mega_kernel, hipFuncAttributeMaxDynamicSharedMemorySize, (int)kDynLds);
    (void)hipOccupancyMaxActiveBlocksPerMultiprocessor(&per_cu, mega_kernel, 512, kDynLds);
    if (per_cu > 1) per_cu = 1;
    grid_blocks = cus * per_cu;
    if (grid_blocks > 256) grid_blocks = 256;
    grid_blocks -= grid_blocks % 8;
  }
  void* args[] = {&p};
  hipError_t e = hipLaunchCooperativeKernel((void*)mega_kernel, dim3(grid_blocks), dim3(512), args, kDynLds, stream);
  if (e != hipSuccess) fprintf(stderr, "cooperative launch failed: %s (grid %d)\n", hipGetErrorString(e), grid_blocks);
}
```

```cpp
#include <hip/hip_runtime.h>
#include <hip/hip_cooperative_groups.h>
#include <cstdio>
#include <cmath>
namespace cg = cooperative_groups;

#ifndef MK_COOP
#define MK_COOP 1
#endif
#ifndef PROBE_MASK
#define PROBE_MASK 0
#endif

typedef unsigned short bf;
typedef short bf16x8 __attribute__((ext_vector_type(8)));
typedef float f32x16 __attribute__((ext_vector_type(16)));
typedef float f32x4 __attribute__((ext_vector_type(4)));

#define TT 32768
#define LSEQ 16384
#define DM 2048
#define INW 13908
#define PW 5760
#define C_S5U 0
#define C_S5Z 512
#define C_ATQ 1024
#define C_ATK 1536
#define C_ATV 1664
#define C_ATZ 1792
#define C_IDQ 2304
#define C_IDK 2560
#define C_IDW 2624
#define C_SSZ 2640
#define C_XBC 3664
#define C_SDT 5200
#define C_MEQ 5216
#define C_MEZ 5472
#define YW 2304
#define Y_S5 0
#define Y_ATT 512
#define Y_SSD 1024
#define Y_MEM 2048
#define CAP 480
#define HALF_LDS 77824

struct Params {
  const float *x, *mem; const int* pos;
  const float *w_in, *b_gate, *lam_re, *lam_im, *log_dt, *b_re, *b_im, *c_re, *c_im, *s5_d, *w_glu, *b_glu,
      *conv_w, *conv_b, *dt_bias, *a_log, *ssd_d, *norm_g, *mem_w_kv, *w_br_s5, *w_br_attn, *w_br_ssd, *w_br_mem,
      *w_out, *ln_g, *ln_b;
  float* out;
  bf *WinT, *WbrT, *WoutT, *WgluT, *WmemT, *memb, *xb, *P, *Y, *YG, *KIF, *MK, *MVT, *CM, *KVC, *GS;
  float *ST, *CS, *END, *CD, *SB, *SA;
  float inv[8];
};

__device__ __forceinline__ float ozero() { float z = 0.f; asm volatile("" : "+v"(z)); return z; }
__device__ __forceinline__ int otid_full() { int t = threadIdx.x; asm volatile("" : "+v"(t)); return t; }
__device__ __forceinline__ int otid() { return otid_full() & 255; }
#define HB (__builtin_amdgcn_readfirstlane(otid_full() >> 8))
#define VB ((int)blockIdx.x * 2 + HB)
#define G2 ((int)gridDim.x * 2)
__device__ __forceinline__ float bf2f(bf v) { return __uint_as_float(((unsigned)v) << 16); }
__device__ __forceinline__ float bflo(unsigned u) { return __uint_as_float(u << 16); }
__device__ __forceinline__ float bfhi(unsigned u) { return __uint_as_float(u & 0xFFFF0000u); }
__device__ __forceinline__ unsigned pk2(float lo, float hi) {
  unsigned r; asm("v_cvt_pk_bf16_f32 %0, %1, %2" : "=v"(r) : "v"(lo), "v"(hi)); return r;
}
__device__ __forceinline__ bf f2bf(float f) { return (bf)(pk2(f, 0.f) & 0xFFFFu); }
__device__ __forceinline__ float sigmoidf_(float x) { return 1.f / (1.f + __expf(-x)); }
__device__ __forceinline__ float siluf_(float x) { return x / (1.f + __expf(-x)); }
__device__ __forceinline__ float geluf_(float x) {
  float u = 0.7978845608028654f * (x + 0.044715f * x * x * x);
  float t = 1.f - 2.f / (1.f + __expf(2.f * u));
  return 0.5f * x * (1.f + t);
}
__device__ __forceinline__ f32x16 mfma32(bf16x8 a, bf16x8 b, f32x16 c) { return __builtin_amdgcn_mfma_f32_32x32x16_bf16(a, b, c, 0, 0, 0); }
__device__ __forceinline__ f32x4 mfma16(bf16x8 a, bf16x8 b, f32x4 c) { return __builtin_amdgcn_mfma_f32_16x16x32_bf16(a, b, c, 0, 0, 0); }

__device__ __forceinline__ bool tile_map(int L, int nMt, int nNt, int SM, int SN, int& tm, int& tn) {
  int per = SM * SN; int x = L & 7; int jj = L >> 3; int sl = jj / per; int j = jj - sl * per; int S = sl * 8 + x;
  int nSn = nNt / SN; int NS = (nMt / SM) * nSn;
  if (S >= NS) return false;
  int mg = S / nSn, ng = S - mg * nSn;
  tm = mg * SM + j / SN; tn = ng * SN + j % SN; return true;
}

typedef unsigned u32x4 __attribute__((ext_vector_type(4)));
struct GStage { u32x4 a0, a1, b0, b1; };
#define G_LOAD(S, ko) { S.a0 = *(const u32x4*)(ga + (ko)); S.a1 = *(const u32x4*)(ga + a64 + (ko)); S.b0 = *(const u32x4*)(gb + (ko)); S.b1 = *(const u32x4*)(gb + b64 + (ko)); }
#define G_WRITE(S, base) { *(u32x4*)(sA + (base) + woff) = S.a0; *(u32x4*)(sA + (base) + woff + 5120) = S.a1; *(u32x4*)(sB + (base) + woff) = S.b0; *(u32x4*)(sB + (base) + woff + 5120) = S.b1; }
#define G_ITER(kt, cur, S)                                                          \
  {                                                                                 \
    _Pragma("unroll") for (int ks = 0; ks < 2; ks++) {                              \
      bf16x8 a0 = *(const bf16x8*)(sA + (cur) + aoff + ks * 32);                    \
      bf16x8 a1 = *(const bf16x8*)(sA + (cur) + aoff + 2560 + ks * 32);             \
      bf16x8 b0 = *(const bf16x8*)(sB + (cur) + boff + ks * 32);                    \
      bf16x8 b1 = *(const bf16x8*)(sB + (cur) + boff + 2560 + ks * 32);             \
      acc[0][0] = mfma32(b0, a0, acc[0][0]);                                        \
      acc[0][1] = mfma32(b1, a0, acc[0][1]);                                        \
      acc[1][0] = mfma32(b0, a1, acc[1][0]);                                        \
      acc[1][1] = mfma32(b1, a1, acc[1][1]);                                        \
    }                                                                               \
    if ((kt) + 1 < nk) {                                                            \
      G_WRITE(S, 10240 - (cur))                                                     \
      if ((kt) + 1 + D < nk) G_LOAD(S, ((kt) + 1 + D) * 32)                         \
    }                                                                               \
    __syncthreads();                                                                \
  }
template <int D>
__device__ __forceinline__ void gemm_acc(const bf* __restrict__ A, int lda, const bf* __restrict__ Bt, int ldb, int K,
                                         f32x16 (&acc)[2][2], char* sm) {
  const int tid = otid(), lane = tid & 63, w = tid >> 6, wr = w >> 1, wc = w & 1, r32 = lane & 31, h5 = lane >> 5;
  const int lrow = tid >> 2, lch = tid & 3;
  const bf* ga = A + (size_t)lrow * lda + lch * 8;
  const bf* gb = Bt + (size_t)lrow * ldb + lch * 8;
  const size_t a64 = (size_t)64 * lda, b64 = (size_t)64 * ldb;
  const int nk = K >> 5;
  char* sA = sm; char* sB = sm + 20480;
  const int woff = lrow * 80 + lch * 16;
  const int aoff = (wr * 64 + r32) * 80 + h5 * 16, boff = (wc * 64 + r32) * 80 + h5 * 16;
  GStage S0, S1, S2, S3;
  G_LOAD(S0, 0) G_LOAD(S1, 32)
  if (D == 4) { G_LOAD(S2, 64) G_LOAD(S3, 96) }
  G_WRITE(S0, 0)
  if (D < nk) G_LOAD(S0, D * 32)
  __syncthreads();
  for (int kt0 = 0; kt0 < nk; kt0 += D) {
    if (D == 4) {
      G_ITER(kt0, 0, S1) G_ITER(kt0 + 1, 10240, S2) G_ITER(kt0 + 2, 0, S3) G_ITER(kt0 + 3, 10240, S0)
    } else {
      G_ITER(kt0, 0, S1) G_ITER(kt0 + 1, 10240, S0)
    }
  }
}
#define ZERO_ACC(a) { const float z_ = ozero(); for (int i_ = 0; i_ < 2; i_++) for (int j_ = 0; j_ < 2; j_++) for (int r_ = 0; r_ < 16; r_++) a[i_][j_][r_] = z_; }


extern __shared__ __attribute__((aligned(16))) char dynsm[];
#define G8_HT (128 * 64)
#define G8_SA(b, h) ((bf*)dynsm + ((b) * 2 + (h)) * G8_HT)
#define G8_SB(b, h) ((bf*)dynsm + (4 + (b) * 2 + (h)) * G8_HT)
__device__ __forceinline__ int g8_lds_byte(int r, int c) {
  int st = (r >> 4) * 2 + (c >> 5), rr = r & 15, cc = c & 31, ob = rr * 64 + cc * 2;
  return st * 1024 + (ob ^ (((ob >> 9) & 1) << 5));
}
__device__ __forceinline__ void g8_stage_rc(int b, int& R, int& C) {
  int st = b / 1024, sb = b % 1024, swz = sb ^ (((sb >> 9) & 1) << 5);
  R = (st >> 1) * 16 + swz / 64; C = (st & 1) * 32 + (swz % 64) / 2;
}
#define G8_LAS __attribute__((address_space(3)))
#define G8_HTB (128 * 64 * 2)
#define G8_OSA(b, h) (((b) * 2 + (h)) * G8_HTB)
#define G8_OSB(b, h) ((4 + (b) * 2 + (h)) * G8_HTB)
#define G8_STAGE(bufoff, gbase, voff) do { _Pragma("unroll") for (int _i = 0; _i < 2; ++_i) \
    __builtin_amdgcn_global_load_lds((const unsigned*)((const char*)(gbase) + (voff)[_i]), (G8_LAS unsigned*)(lds + (bufoff) + ldsw + _i * 8192), 16, 0, 0); } while (0)
#define G8_LDA(dst, b, h) do { _Pragma("unroll") for (int m = 0; m < 4; ++m) _Pragma("unroll") for (int k = 0; k < 2; ++k) dst[m][k] = *(const G8_LAS bf16x8*)(lds + G8_OSA(b, h) + aoff + m * 2048 + k * 1024); } while (0)
#define G8_LDB(dst, b, h) do { _Pragma("unroll") for (int n = 0; n < 2; ++n) _Pragma("unroll") for (int k = 0; k < 2; ++k) dst[n][k] = *(const G8_LAS bf16x8*)(lds + G8_OSB(b, h) + boff + n * 2048 + k * 1024); } while (0)
#define G8_MMA(ai, bj, At_, Bt_) do { __builtin_amdgcn_s_setprio(1);                                                 \
    _Pragma("unroll") for (int m = 0; m < 4; ++m) _Pragma("unroll") for (int n = 0; n < 2; ++n) _Pragma("unroll") for (int k = 0; k < 2; ++k) \
      acc[ai][bj][m][n] = __builtin_amdgcn_mfma_f32_16x16x32_bf16(Bt_[n][k], At_[m][k], acc[ai][bj][m][n], 0, 0, 0); \
    __builtin_amdgcn_s_setprio(0); } while (0)
#define G8_WAIT_V(n) asm volatile("s_waitcnt vmcnt(" #n ")" ::: "memory")
#define G8_WAIT_L(n) asm volatile("s_waitcnt lgkmcnt(" #n ")" ::: "memory")
#define G8_BAR __builtin_amdgcn_s_barrier()
#define G8_SCHED __builtin_amdgcn_sched_barrier(0)

__device__ __forceinline__ void gemm256(const bf* __restrict__ A, int lda, const bf* __restrict__ Bt, int ldb, int K,
                                        int brow, int bcol, f32x4 (&acc)[2][2][4][2]) {
  G8_LAS unsigned char* lds = (G8_LAS unsigned char*)dynsm;
  const int tid = otid_full(), wid = __builtin_amdgcn_readfirstlane(tid >> 6), lane = tid & 63, wr = wid >> 2, wc = wid & 3, fr = lane & 15, fq = lane >> 4;
  unsigned voffA[2], voffB[2];
#pragma unroll
  for (int i = 0; i < 2; ++i) { int R, C; g8_stage_rc(tid * 16 + i * 8192, R, C); voffA[i] = (unsigned)(R * lda + C) * 2u; voffB[i] = (unsigned)(R * ldb + C) * 2u; }
  const size_t kstep = 128;
  const size_t hstepA = (size_t)128 * lda * 2, hstepB = (size_t)128 * ldb * 2;
  const unsigned ldsw = (unsigned)wid * 1024u;
  const int aoff = g8_lds_byte(wr * 64 + fr, fq * 8), boff = g8_lds_byte(wc * 32 + fr, fq * 8);
  const char* cA = (const char*)A + (size_t)brow * lda * 2; const char* cB = (const char*)Bt + (size_t)bcol * ldb * 2;
  bf16x8 At[4][2], B0[2][2], B1[2][2];
  const int nt = K / 64;
  __syncthreads();
  G8_STAGE(G8_OSB(0, 0), cB, voffB); G8_STAGE(G8_OSA(0, 0), cA, voffA); G8_STAGE(G8_OSB(0, 1), cB + hstepB, voffB); G8_STAGE(G8_OSA(0, 1), cA + hstepA, voffA);
  if (wr == 1) G8_BAR;
  G8_WAIT_V(4); G8_BAR;
  G8_STAGE(G8_OSB(1, 0), cB + kstep, voffB); G8_STAGE(G8_OSA(1, 0), cA + kstep, voffA); G8_STAGE(G8_OSB(1, 1), cB + hstepB + kstep, voffB);
  G8_WAIT_V(6); G8_BAR;
  for (int t = 0; t < nt - 2; t += 2) {
    const char* a1 = cA + (size_t)(t + 1) * kstep;
    const char* a2 = cA + (size_t)(t + 2) * kstep; const char* b2 = cB + (size_t)(t + 2) * kstep;
    const char* a3 = a2 + kstep; const char* b3 = b2 + kstep;
    G8_LDB(B0, 0, 0); G8_SCHED; G8_LDA(At, 0, 0); G8_STAGE(G8_OSA(1, 1), a1 + hstepA, voffA);
    G8_WAIT_L(8); G8_BAR; G8_WAIT_L(0); G8_MMA(0, 0, At, B0); G8_BAR; G8_SCHED;
    G8_LDB(B1, 0, 1); G8_STAGE(G8_OSB(0, 0), b2, voffB);
    G8_BAR; G8_WAIT_L(0); G8_MMA(0, 1, At, B1); G8_BAR;
    G8_LDA(At, 0, 1); G8_STAGE(G8_OSA(0, 0), a2, voffA);
    G8_BAR; G8_WAIT_L(0); G8_MMA(1, 0, At, B0); G8_BAR; G8_SCHED;
    G8_STAGE(G8_OSB(0, 1), b2 + hstepB, voffB);
    G8_WAIT_V(6); G8_BAR; G8_MMA(1, 1, At, B1); G8_BAR;
    G8_LDB(B0, 1, 0); G8_SCHED; G8_LDA(At, 1, 0); G8_STAGE(G8_OSA(0, 1), a2 + hstepA, voffA);
    G8_WAIT_L(8); G8_BAR; G8_WAIT_L(0); G8_MMA(0, 0, At, B0); G8_BAR; G8_SCHED;
    G8_LDB(B1, 1, 1); G8_STAGE(G8_OSB(1, 0), b3, voffB);
    G8_BAR; G8_WAIT_L(0); G8_MMA(0, 1, At, B1); G8_BAR;
    G8_LDA(At, 1, 1); G8_STAGE(G8_OSA(1, 0), a3, voffA);
    G8_BAR; G8_WAIT_L(0); G8_MMA(1, 0, At, B0); G8_BAR; G8_SCHED;
    G8_STAGE(G8_OSB(1, 1), b3 + hstepB, voffB);
    G8_WAIT_V(6); G8_BAR; G8_MMA(1, 1, At, B1); G8_BAR;
  }
  { const char* a1 = cA + (size_t)(nt - 1) * kstep;
    G8_LDB(B0, 0, 0); G8_LDA(At, 0, 0); G8_STAGE(G8_OSA(1, 1), a1 + hstepA, voffA);
    G8_BAR; G8_WAIT_L(0); G8_MMA(0, 0, At, B0); G8_BAR;
    G8_LDB(B1, 0, 1); G8_BAR; G8_WAIT_L(0); G8_MMA(0, 1, At, B1); G8_BAR;
    G8_LDA(At, 0, 1); G8_WAIT_V(4); G8_BAR; G8_WAIT_L(0); G8_MMA(1, 0, At, B0); G8_MMA(1, 1, At, B1); G8_BAR; }
  { G8_LDB(B0, 1, 0); G8_LDA(At, 1, 0); G8_WAIT_V(2); G8_BAR; G8_WAIT_L(0); G8_MMA(0, 0, At, B0); G8_BAR;
    G8_LDB(B1, 1, 1); G8_WAIT_V(0); G8_BAR; G8_WAIT_L(0); G8_MMA(0, 1, At, B1); G8_BAR;
    G8_LDA(At, 1, 1); G8_BAR; G8_WAIT_L(0); G8_MMA(1, 0, At, B0); G8_MMA(1, 1, At, B1); G8_BAR; }
  if (wr == 0) G8_BAR;
}
#define ZERO_ACC8(a) { float z_ = 0.f; asm volatile("" : "+v"(z_)); _Pragma("unroll") for (int i_ = 0; i_ < 2; i_++) _Pragma("unroll") for (int j_ = 0; j_ < 2; j_++) _Pragma("unroll") for (int m_ = 0; m_ < 4; m_++) _Pragma("unroll") for (int n_ = 0; n_ < 2; n_++) a[i_][j_][m_][n_] = (f32x4){z_, z_, z_, z_}; }
__device__ __forceinline__ bool tile_order(int L, int nM, int nN, int& pm, int& pn) {
  const int nwg = nM * nN; if (L >= nwg) return false;
  int wgid = L; { const int q = nwg / 8, r = nwg % 8, xcd = wgid % 8, off = wgid / 8; wgid = (xcd < r ? xcd * (q + 1) : r * (q + 1) + (xcd - r) * q) + off; }
  const int nig = 8 * nN, gid = wgid / nig, fm = gid * 8, gsz = (nM - fm) < 8 ? (nM - fm) : 8;
  pm = fm + ((wgid % nig) % gsz); pn = (wgid % nig) / gsz; return true;
}

__device__ __forceinline__ void transpose_tile(const float* __restrict__ src, int R, int C, bf* __restrict__ dst, int ldd, int off, int tile, bf* sm) {
  const int tilesC = (C + 63) >> 6;
  const int tr = tile / tilesC, tc = tile - tr * tilesC;
  const int r0 = tr * 64, c0 = tc * 64;
  const int tid = otid();
#pragma unroll
  for (int i = 0; i < 4; i++) {
    int r = (tid >> 4) + 16 * i; int c = (tid & 15) * 4;
    const float zt_ = ozero(); float4 v = make_float4(zt_, zt_, zt_, zt_);
    if (c0 + c < C) v = *(const float4*)(src + (size_t)(r0 + r) * C + c0 + c);
    sm[(c + 0) * 66 + r] = f2bf(v.x); sm[(c + 1) * 66 + r] = f2bf(v.y);
    sm[(c + 2) * 66 + r] = f2bf(v.z); sm[(c + 3) * 66 + r] = f2bf(v.w);
  }
  __syncthreads();
  {
    int c = tid >> 2, ch = (tid & 3) * 16;
    if (c0 + c < C) {
      unsigned wv[8];
#pragma unroll
      for (int k = 0; k < 8; k++) wv[k] = *(const unsigned*)(sm + c * 66 + ch + 2 * k);
      bf* d = dst + (size_t)(c0 + c) * ldd + off + r0 + ch;
      *(uint4*)d = make_uint4(wv[0], wv[1], wv[2], wv[3]);
      *(uint4*)(d + 8) = make_uint4(wv[4], wv[5], wv[6], wv[7]);
    }
  }
  __syncthreads();
}

__device__ __forceinline__ bool try_tr(int& t, const float* src, int R, int C, bf* dst, int ldd, int off, bf* sm) {
  int nt = (R >> 6) * ((C + 63) >> 6);
  if (t < nt) { transpose_tile(src, R, C, dst, ldd, off, t, sm); return true; }
  t -= nt; return false;
}

__device__ __forceinline__ void phase0(const Params& p, char* smc) {
  bf* sm = (bf*)(smc + HB * HALF_LDS);
  const int perLayer = 32 * 218 + 256 + 256 + 512 + 128 + 1024 + 64 + 256;
  for (int task = VB; task < 2 * perLayer; task += G2) {
    int layer = task / perLayer; int t = task - layer * perLayer;
    bf* WbrL = p.WbrT + (size_t)layer * 2048 * YW;
    if (try_tr(t, p.w_in + (size_t)layer * DM * INW, 2048, INW, p.WinT + (size_t)layer * INW * 2048, 2048, 0, sm)) continue;
    if (try_tr(t, p.w_br_s5 + (size_t)layer * 512 * 2048, 512, 2048, WbrL, YW, 0, sm)) continue;
    if (try_tr(t, p.w_br_attn + (size_t)layer * 512 * 2048, 512, 2048, WbrL, YW, 512, sm)) continue;
    if (try_tr(t, p.w_br_ssd + (size_t)layer * 1024 * 2048, 1024, 2048, WbrL, YW, 1024, sm)) continue;
    if (try_tr(t, p.w_br_mem + (size_t)layer * 256 * 2048, 256, 2048, WbrL, YW, 2048, sm)) continue;
    if (try_tr(t, p.w_out + (size_t)layer * 2048 * 2048, 2048, 2048, p.WoutT + (size_t)layer * 2048 * 2048, 2048, 0, sm)) continue;
    if (try_tr(t, p.w_glu + (size_t)layer * 512 * 512, 512, 512, p.WgluT + (size_t)layer * 512 * 512, 512, 0, sm)) continue;
    if (try_tr(t, p.mem_w_kv + (size_t)layer * 2048 * 512, 2048, 512, p.WmemT + (size_t)layer * 512 * 2048, 2048, 0, sm)) continue;
  }
  const size_t gtid = (size_t)blockIdx.x * 512 + otid_full(), gstr = (size_t)gridDim.x * 512;
  for (size_t i = gtid; i < (size_t)TT * DM / 8; i += gstr) {
    float4 a = *(const float4*)(p.x + i * 8), b = *(const float4*)(p.x + i * 8 + 4);
    *(uint4*)(p.xb + i * 8) = make_uint4(pk2(a.x, a.y), pk2(a.z, a.w), pk2(b.x, b.y), pk2(b.z, b.w));
  }
  for (size_t i = gtid; i < (size_t)512 * DM / 8; i += gstr) {
    float4 a = *(const float4*)(p.mem + i * 8), b = *(const float4*)(p.mem + i * 8 + 4);
    *(uint4*)(p.memb + i * 8) = make_uint4(pk2(a.x, a.y), pk2(a.z, a.w), pk2(b.x, b.y), pk2(b.z, b.w));
  }
  for (size_t i = gtid; i < (size_t)TT; i += gstr) {
    const float ps = (float)p.pos[i];
#pragma unroll
    for (int j = 0; j < 8; j++) {
      float ang = ps * p.inv[j];
      float s, c; sincosf(ang, &s, &c);
      p.CS[i * 16 + j] = c; p.CS[i * 16 + 8 + j] = s;
    }
  }
  for (size_t i = gtid; i < 2 * 32 * 64; i += gstr) {
    int pp = (int)(i & 63), g = (int)((i >> 6) & 31), layer = (int)(i >> 11);
    float dt = expf(p.log_dt[layer * 32 + g]);
    float lr = p.lam_re[i], li = p.lam_im[i];
    float mag = expf(lr * dt);
    float sn, cs; sincosf(li * dt, &sn, &cs);
    float ar = mag * cs, ai = mag * sn;
    float den = lr * lr + li * li;
    float nr = ar - 1.f, ni = ai;
    float fr = (nr * lr + ni * li) / den, fi = (ni * lr - nr * li) / den;
    float* sb = p.SB + i * 32;
    const float* bre = p.b_re + i * 16; const float* bim = p.b_im + i * 16;
    for (int h = 0; h < 16; h++) {
      float br = bre[h], bi = bim[h];
      sb[h] = fr * br - fi * bi; sb[16 + h] = fr * bi + fi * br;
    }
    float pr = ar, pi = ai;
    for (int k = 0; k < 7; k++) { float nr2 = pr * pr - pi * pi, ni2 = 2.f * pr * pi; pr = nr2; pi = ni2; }
    p.SA[i * 4 + 0] = ar; p.SA[i * 4 + 1] = ai; p.SA[i * 4 + 2] = pr; p.SA[i * 4 + 3] = pi;
    for (int h = 0; h < 16; h++) {
      size_t ci = ((size_t)(layer * 32 + g) * 16 + h);
      p.CM[ci * 128 + pp] = f2bf(p.c_re[ci * 64 + pp]);
      p.CM[ci * 128 + 64 + pp] = f2bf(-p.c_im[ci * 64 + pp]);
    }
  }
}

__device__ __forceinline__ void phaseA(const Params& p, int layer) {
  const int tidf = otid_full();
  const int wid = __builtin_amdgcn_readfirstlane(tidf >> 6), lane = tidf & 63, wr = wid >> 2, wc = wid & 3, fr = lane & 15, fq = lane >> 4;
  const bf* Wl = p.WinT + (size_t)layer * INW * 2048;
  const int nA = 128 * 23;
  const int total = nA + (layer == 0 ? 8 : 0);
  for (int L = blockIdx.x; L < total; L += gridDim.x) {
    f32x4 acc[2][2][4][2]; ZERO_ACC8(acc);
    if (L < nA) {
      int pm, pn; tile_order(L, 128, 23, pm, pn);
      const int brow = pm * 256, bcol = pn * 256;
      gemm256(p.xb, 2048, Wl, 2048, 2048, brow, bcol, acc);
#pragma unroll
      for (int ai = 0; ai < 2; ai++)
#pragma unroll
        for (int m = 0; m < 4; m++) {
          const int tok = brow + ai * 128 + wr * 64 + m * 16 + fr;
#pragma unroll
          for (int bj = 0; bj < 2; bj++)
#pragma unroll
            for (int n = 0; n < 2; n++) {
              const int cb = bcol + bj * 128 + wc * 32 + n * 16;
              f32x4 v = acc[ai][bj][m][n];
              if (n == 0 && (wc & 1) == 0 && ((cb >= C_ATQ && cb < C_ATV) || (cb >= C_IDQ && cb < C_IDW))) {
                f32x4 cs = *(const f32x4*)(p.CS + (size_t)tok * 16 + 4 * (fq & 1));
                f32x4 sn = *(const f32x4*)(p.CS + (size_t)tok * 16 + 8 + 4 * (fq & 1));
#pragma unroll
                for (int e = 0; e < 4; e++) {
                  float o = __shfl_xor(v[e], 32);
                  v[e] = (fq < 2) ? (v[e] * cs[e] - o * sn[e]) : (v[e] * cs[e] + o * sn[e]);
                }
              }
              const int nn = cb + fq * 4;
              if (nn < 5716) {
                const int dn = nn + (nn >= 2628 ? 12 : 0);
                uint2 pv = make_uint2(pk2(v[0], v[1]), pk2(v[2], v[3]));
                *(uint2*)(p.P + (size_t)tok * PW + dn) = pv;
                if (nn >= C_IDK && nn < C_IDW) {
                  const int d = nn - C_IDK; const int b = tok >> 14, li = tok & 16383;
                  size_t o = ((((size_t)(b * 512 + (li >> 5)) * 4 + (d >> 4)) * 64 + ((d >> 3) & 1) * 32 + (li & 31)) * 8) + (d & 7);
                  *(uint2*)(p.KIF + o) = pv;
                }
                if (nn >= C_ATK && nn < C_ATZ) *(uint2*)(p.KVC + (size_t)tok * 256 + (nn - C_ATK)) = pv;
              }
            }
        }
    } else {
      const int t8 = L - nA; const int ly = t8 >> 2, tm = (t8 >> 1) & 1, tn = t8 & 1;
      gemm256(p.memb, 2048, p.WmemT + (size_t)ly * 512 * 2048, 2048, 2048, tm * 256, tn * 256, acc);
#pragma unroll
      for (int ai = 0; ai < 2; ai++)
#pragma unroll
        for (int m = 0; m < 4; m++) {
          const int row = tm * 256 + ai * 128 + wr * 64 + m * 16 + fr; const int b = row >> 8, mm = row & 255;
#pragma unroll
          for (int bj = 0; bj < 2; bj++)
#pragma unroll
            for (int n = 0; n < 2; n++)
#pragma unroll
              for (int e = 0; e < 4; e++) {
                const int nn = tn * 256 + bj * 128 + wc * 32 + n * 16 + fq * 4 + e; const float v = acc[ai][bj][m][n][e];
                if (nn < 256) { int h = nn >> 6, d = nn & 63; p.MK[((((size_t)ly * 2 + b) * 4 + h) * 256 + mm) * 64 + d] = f2bf(v); }
                else { int h = (nn - 256) >> 6, d = nn & 63; p.MVT[((((size_t)ly * 2 + b) * 4 + h) * 64 + d) * 256 + mm] = f2bf(v); }
              }
        }
    }
  }
}

__device__ __forceinline__ float softplusf_(float x) { return x > 15.f ? x : log1pf(__expf(x)); }

__device__ __forceinline__ void ssd_dt_acs(const Params& p, int layer, size_t tok0, int gg, float* sAcs, float* sDt) {
  const int tid = otid(), lane = tid & 63, w = tid >> 6;
#pragma unroll
  for (int k = 0; k < 2; k++) {
    const int hh = 2 * w + k, hd = gg * 8 + hh;
    const float bias = p.dt_bias[layer * 16 + hd], a = -__expf(p.a_log[layer * 16 + hd]);
    const int l0 = 2 * lane;
    float d0 = softplusf_(bf2f(p.P[(tok0 + l0) * PW + C_SDT + hd]) + bias);
    float d1 = softplusf_(bf2f(p.P[(tok0 + l0 + 1) * PW + C_SDT + hd]) + bias);
    float s0 = d0 * a, s1 = s0 + d1 * a;
    float xs = s1;
#pragma unroll
    for (int off = 1; off < 64; off <<= 1) { float v = __shfl_up(xs, off); if (lane >= off) xs += v; }
    float ex = xs - s1;
    sAcs[l0 * 8 + hh] = ex + s0; sAcs[(l0 + 1) * 8 + hh] = ex + s1;
    sDt[l0 * 8 + hh] = d0; sDt[(l0 + 1) * 8 + hh] = d1;
  }
}

struct Conv2 { float w0[4], w1[4], b0, b1, h0[3], h1[3]; };
__device__ __forceinline__ void conv_init(const Params& p, int layer, size_t tokb, int l, int ch, Conv2& c) {
  const float* cw = p.conv_w + (size_t)layer * 4 * 1536 + ch;
#pragma unroll
  for (int k = 0; k < 4; k++) { c.w0[k] = cw[k * 1536]; c.w1[k] = cw[k * 1536 + 1]; }
  c.b0 = p.conv_b[layer * 1536 + ch]; c.b1 = p.conv_b[layer * 1536 + ch + 1];
#pragma unroll
  for (int k = 0; k < 3; k++) {
    int ll = l - 3 + k; unsigned u = 0;
    if (ll >= 0) u = *(const unsigned*)(p.P + (tokb + ll) * PW + C_XBC + ch);
    c.h0[k] = bflo(u); c.h1[k] = bfhi(u);
  }
}
__device__ __forceinline__ void conv_step(const Params& p, size_t tokb, int l, int ch, Conv2& c, float& o0, float& o1) {
  unsigned u = *(const unsigned*)(p.P + (tokb + l) * PW + C_XBC + ch);
  float x0 = bflo(u), x1 = bfhi(u);
  float a0 = c.b0 + c.w0[0] * c.h0[0] + c.w0[1] * c.h0[1] + c.w0[2] * c.h0[2] + c.w0[3] * x0;
  float a1 = c.b1 + c.w1[0] * c.h1[0] + c.w1[1] * c.h1[1] + c.w1[2] * c.h1[2] + c.w1[3] * x1;
  c.h0[0] = c.h0[1]; c.h0[1] = c.h0[2]; c.h0[2] = x0;
  c.h1[0] = c.h1[1]; c.h1[1] = c.h1[2]; c.h1[2] = x1;
  o0 = siluf_(a0); o1 = siluf_(a1);
}

__device__ __forceinline__ void conv_val(unsigned u, Conv2& c, float& o0, float& o1) {
  float x0 = bflo(u), x1 = bfhi(u);
  float a0 = c.b0 + c.w0[0] * c.h0[0] + c.w0[1] * c.h0[1] + c.w0[2] * c.h0[2] + c.w0[3] * x0;
  float a1 = c.b1 + c.w1[0] * c.h1[0] + c.w1[1] * c.h1[1] + c.w1[2] * c.h1[2] + c.w1[3] * x1;
  c.h0[0] = c.h0[1]; c.h0[1] = c.h0[2]; c.h0[2] = x0;
  c.h1[0] = c.h1[1]; c.h1[1] = c.h1[2]; c.h1[2] = x1;
  o0 = siluf_(a0); o1 = siluf_(a1);
}
#define CONV_PRELOAD(raw, N, lfirst, nrows, ch)                                                           \
  unsigned raw[N];                                                                                        \
  _Pragma("unroll") for (int k_ = 0; k_ < N; k_++)                                                        \
    raw[k_] = (k_ < (nrows)) ? *(const unsigned*)(p.P + (tokb + (lfirst) + k_) * PW + C_XBC + (ch)) : 0u;

__device__ __forceinline__ void ssd_pass1(const Params& p, int layer, int task, char* sm) {
  const int tid = otid(), lane = tid & 63, w = tid >> 6, r32 = lane & 31, h5 = lane >> 5;
  const int gg = task & 1, c = (task >> 1) & 127, b = task >> 8;
  const size_t tokb = (size_t)b * LSEQ; const int lc0 = c * 128; const size_t tok0 = tokb + lc0;
  float* sAcs = (float*)sm; float* sDt = (float*)(sm + 4096);
  bf* sBT = (bf*)(sm + 8192); bf* sXT = (bf*)(sm + 43008);
  __syncthreads();
  ssd_dt_acs(p, layer, tok0, gg, sAcs, sDt);
  {
    const int cp = tid & 63, tg = tid >> 6; const int ch = 1024 + gg * 128 + 2 * cp;
    Conv2 cv; conv_init(p, layer, tokb, lc0 + tg * 32, ch, cv);
    CONV_PRELOAD(raw, 32, lc0 + tg * 32, 32, ch)
#pragma unroll
    for (int k = 0; k < 32; k += 2) {
      const int l = tg * 32 + k;
      float a0, a1, b0, b1;
      conv_val(raw[k], cv, a0, a1);
      conv_val(raw[k + 1], cv, b0, b1);
      *(unsigned*)(sBT + (2 * cp) * 136 + l) = pk2(a0, b0);
      *(unsigned*)(sBT + (2 * cp + 1) * 136 + l) = pk2(a1, b1);
    }
  }
  __syncthreads();
  if (tid < 8) p.CD[((size_t)(b * 128 + c)) * 16 + gg * 8 + tid] = __expf(sAcs[127 * 8 + tid]);
  for (int hh = 0; hh < 8; hh++) {
    const int hd = gg * 8 + hh;
    if (hh) __syncthreads();
    {
      const int cp = tid & 31, tg = tid >> 5; const int ch = gg * 512 + hh * 64 + 2 * cp;
      const float aend = sAcs[127 * 8 + hh];
      Conv2 cv; conv_init(p, layer, tokb, lc0 + tg * 16, ch, cv);
      CONV_PRELOAD(raw, 16, lc0 + tg * 16, 16, ch)
#pragma unroll
      for (int k = 0; k < 16; k += 2) {
        const int l = tg * 16 + k;
        float a0, a1, b0, b1;
        conv_val(raw[k], cv, a0, a1);
        conv_val(raw[k + 1], cv, b0, b1);
        float sa = sDt[l * 8 + hh] * __expf(aend - sAcs[l * 8 + hh]);
        float sb = sDt[(l + 1) * 8 + hh] * __expf(aend - sAcs[(l + 1) * 8 + hh]);
        *(unsigned*)(sXT + (2 * cp) * 136 + l) = pk2(a0 * sa, b0 * sb);
        *(unsigned*)(sXT + (2 * cp + 1) * 136 + l) = pk2(a1 * sa, b1 * sb);
      }
    }
    __syncthreads();
    f32x16 acc[2];
#pragma unroll
    for (int r = 0; r < 16; r++) { const float z_ = ozero(); acc[0][r] = z_; acc[1][r] = z_; }
#pragma unroll
    for (int ks = 0; ks < 8; ks++) {
      bf16x8 bfr = *(const bf16x8*)(sBT + (32 * w + r32) * 136 + ks * 16 + 8 * h5);
      bf16x8 x0 = *(const bf16x8*)(sXT + (r32) * 136 + ks * 16 + 8 * h5);
      bf16x8 x1 = *(const bf16x8*)(sXT + (32 + r32) * 136 + ks * 16 + 8 * h5);
      acc[0] = mfma32(x0, bfr, acc[0]);
      acc[1] = mfma32(x1, bfr, acc[1]);
    }
    float* st = p.ST + ((size_t)(b * 128 + c) * 16 + hd) * 64 * 128;
#pragma unroll
    for (int pi = 0; pi < 2; pi++)
#pragma unroll
      for (int r = 0; r < 16; r++) {
        int pp = 32 * pi + 8 * (r >> 2) + 4 * h5 + (r & 3);
        st[pp * 128 + 32 * w + r32] = acc[pi][r];
      }
  }
}

__device__ __forceinline__ void ssd_statepass(const Params& p, int task) {
  const int idx = task * 256 + otid();
  const int b = idx >> 15, e4 = idx & 32767;
  const int hd = e4 >> 11;
  const float zc_ = ozero(); float4 carry = make_float4(zc_, zc_, zc_, zc_);
  float* base = p.ST + (size_t)b * 128 * 131072 + (size_t)e4 * 4;
  const float* cd = p.CD + (size_t)b * 128 * 16 + hd;
  for (int c0 = 0; c0 < 128; c0 += 4) {
    float4 v[4]; float d[4];
#pragma unroll
    for (int k = 0; k < 4; k++) { v[k] = *(const float4*)(base + (size_t)(c0 + k) * 131072); d[k] = cd[(c0 + k) * 16]; }
#pragma unroll
    for (int k = 0; k < 4; k++) {
      *(float4*)(base + (size_t)(c0 + k) * 131072) = carry;
      carry.x = carry.x * d[k] + v[k].x; carry.y = carry.y * d[k] + v[k].y;
      carry.z = carry.z * d[k] + v[k].z; carry.w = carry.w * d[k] + v[k].w;
    }
  }
}

__device__ __forceinline__ void ssd_pass2(const Params& p, int layer, int task, char* sm) {
  const int tid = otid(), lane = tid & 63, w = tid >> 6, r32 = lane & 31, h5 = lane >> 5;
  const int lh = task & 1, gg = (task >> 1) & 1, c = (task >> 2) & 127, b = task >> 9;
  const size_t tokb = (size_t)b * LSEQ; const int lc0 = c * 128; const size_t tok0 = tokb + lc0;
  float* sAcs = (float*)sm; float* sDt = (float*)(sm + 4096);
  bf* sC = (bf*)(sm + 8192); bf* sB = (bf*)(sm + 25600); bf* sM = (bf*)(sm + 25600); bf* sXT = (bf*)(sm + 43008);
  float* sSsq = (float*)(sm + 60416);
  const int wr = w >> 1, wc = w & 1;
  const int nS = 64 * (lh + 1);
  __syncthreads();
  ssd_dt_acs(p, layer, tok0, gg, sAcs, sDt);
  if (tid < 64) sSsq[tid] = 0.f;
  {
    const int cp = tid & 63, tg = tid >> 6;
    {
      const int ch = 1280 + gg * 128 + 2 * cp;
      const int lst = 64 * lh + tg * 16;
      Conv2 cv; conv_init(p, layer, tokb, lc0 + lst, ch, cv);
      CONV_PRELOAD(raw, 16, lc0 + lst, 16, ch)
#pragma unroll
      for (int k = 0; k < 16; k++) {
        const int l = lst + k;
        float a0, a1; conv_val(raw[k], cv, a0, a1);
        *(unsigned*)(sC + (l - 64 * lh) * 136 + 2 * cp) = pk2(a0, a1);
      }
    }
    {
      const int ch = 1024 + gg * 128 + 2 * cp;
      const int per = nS >> 2; const int lst = tg * per;
      Conv2 cv; conv_init(p, layer, tokb, lc0 + lst, ch, cv);
      CONV_PRELOAD(raw, 32, lc0 + lst, per, ch)
#pragma unroll
      for (int k = 0; k < 32; k++) {
        if (k < per) {
          const int l = lst + k;
          float a0, a1; conv_val(raw[k], cv, a0, a1);
          *(unsigned*)(sB + l * 136 + 2 * cp) = pk2(a0, a1);
        }
      }
    }
  }
  __syncthreads();
  f32x16 cb[2];
#pragma unroll
  for (int r = 0; r < 16; r++) { const float z_ = ozero(); cb[0][r] = z_; cb[1][r] = z_; }
  if (64 * wc < nS) {
#pragma unroll
    for (int ks = 0; ks < 8; ks++) {
      bf16x8 af = *(const bf16x8*)(sC + (32 * wr + r32) * 136 + ks * 16 + 8 * h5);
      bf16x8 b0 = *(const bf16x8*)(sB + (64 * wc + r32) * 136 + ks * 16 + 8 * h5);
      bf16x8 b1 = *(const bf16x8*)(sB + (64 * wc + 32 + r32) * 136 + ks * 16 + 8 * h5);
      cb[0] = mfma32(af, b0, cb[0]);
      cb[1] = mfma32(af, b1, cb[1]);
    }
  }
  __syncthreads();
  const int wc2 = w & 1;
  for (int hh = 0; hh < 8; hh++) {
    const int hd = gg * 8 + hh;
    if (hh) __syncthreads();
    bf16x8 pfr[8];
    {
      const float* pv = p.ST + (((size_t)(b * 128 + c) * 16 + hd) * 64 + 32 * wc2 + r32) * 128 + 8 * h5;
#pragma unroll
      for (int ks = 0; ks < 8; ks++) {
        float4 u0 = *(const float4*)(pv + ks * 16), u1 = *(const float4*)(pv + ks * 16 + 4);
        unsigned q0 = pk2(u0.x, u0.y), q1 = pk2(u0.z, u0.w), q2 = pk2(u1.x, u1.y), q3 = pk2(u1.z, u1.w);
        pfr[ks][0] = (short)(q0 & 0xFFFF); pfr[ks][1] = (short)(q0 >> 16); pfr[ks][2] = (short)(q1 & 0xFFFF); pfr[ks][3] = (short)(q1 >> 16);
        pfr[ks][4] = (short)(q2 & 0xFFFF); pfr[ks][5] = (short)(q2 >> 16); pfr[ks][6] = (short)(q3 & 0xFFFF); pfr[ks][7] = (short)(q3 >> 16);
      }
    }
    {
      const float dsk = p.ssd_d[layer * 16 + hd];
#pragma unroll
      for (int j = 0; j < 2; j++) {
        const int s = 64 * wc + 32 * j + r32;
        if (s < nS) {
          const float as = sAcs[s * 8 + hh];
#pragma unroll
          for (int r = 0; r < 16; r++) {
            const int lp = 32 * wr + 8 * (r >> 2) + 4 * h5 + (r & 3); const int l = 64 * lh + lp;
            float v = 0.f;
            if (s <= l) v = cb[j][r] * __expf(sAcs[l * 8 + hh] - as);
            if (s == l) v += dsk / sDt[l * 8 + hh];
            sM[lp * 136 + s] = f2bf(v);
          }
        }
      }
    }
    {
      const int cp = tid & 31, tg = tid >> 5; const int ch = gg * 512 + hh * 64 + 2 * cp;
      const int per = nS >> 3; const int lst = tg * per;
      Conv2 cv; conv_init(p, layer, tokb, lc0 + lst, ch, cv);
      CONV_PRELOAD(raw, 16, lc0 + lst, per, ch)
#pragma unroll
      for (int k = 0; k < 16; k += 2) {
        if (k >= per) break;
        const int l = lst + k;
        float a0, a1, b0, b1;
        conv_val(raw[k], cv, a0, a1);
        conv_val(raw[k + 1], cv, b0, b1);
        float sa = sDt[l * 8 + hh], sb = sDt[(l + 1) * 8 + hh];
        *(unsigned*)(sXT + (2 * cp) * 136 + l) = pk2(a0 * sa, b0 * sb);
        *(unsigned*)(sXT + (2 * cp + 1) * 136 + l) = pk2(a1 * sa, b1 * sb);
      }
    }
    __syncthreads();
    f32x16 yd, yo;
#pragma unroll
    for (int r = 0; r < 16; r++) { const float z_ = ozero(); yd[r] = z_; yo[r] = z_; }
    const int nks = nS >> 4;
    for (int ks = 0; ks < nks; ks++) {
      bf16x8 xf = *(const bf16x8*)(sXT + (32 * wc2 + r32) * 136 + ks * 16 + 8 * h5);
      bf16x8 mf = *(const bf16x8*)(sM + (32 * wr + r32) * 136 + ks * 16 + 8 * h5);
      yd = mfma32(xf, mf, yd);
    }
    {
#pragma unroll
      for (int ks = 0; ks < 8; ks++) {
        bf16x8 cf = *(const bf16x8*)(sC + (32 * wr + r32) * 136 + ks * 16 + 8 * h5);
        yo = mfma32(pfr[ks], cf, yo);
      }
    }
    {
      const int lp = 32 * wr + r32; const int l = 64 * lh + lp; const size_t tok = tok0 + l;
      const float eo = __expf(sAcs[l * 8 + hh]);
      float ss = 0.f;
#pragma unroll
      for (int q = 0; q < 4; q++) {
        const int pp = 32 * wc2 + 8 * q + 4 * h5;
        uint2 zz = *(const uint2*)(p.P + tok * PW + C_SSZ + hd * 64 + pp);
        float v0 = (yd[4 * q] + eo * yo[4 * q]) * siluf_(bflo(zz.x));
        float v1 = (yd[4 * q + 1] + eo * yo[4 * q + 1]) * siluf_(bfhi(zz.x));
        float v2 = (yd[4 * q + 2] + eo * yo[4 * q + 2]) * siluf_(bflo(zz.y));
        float v3 = (yd[4 * q + 3] + eo * yo[4 * q + 3]) * siluf_(bfhi(zz.y));
        ss += v0 * v0 + v1 * v1 + v2 * v2 + v3 * v3;
        *(uint2*)(p.Y + tok * YW + Y_SSD + hd * 64 + pp) = make_uint2(pk2(v0, v1), pk2(v2, v3));
      }
      atomicAdd(&sSsq[lp], ss);
    }
  }
  __syncthreads();
  {
    const int lp = tid >> 2, part = tid & 3; const size_t tok = tok0 + 64 * lh + lp;
    const float rs = rsqrtf(sSsq[lp] * (1.f / 512.f) + 1e-5f);
    bf* yp = p.Y + tok * YW + Y_SSD + gg * 512 + part * 128;
    const float* ng = p.norm_g + layer * 1024 + gg * 512 + part * 128;
#pragma unroll 4
    for (int i = 0; i < 16; i++) {
      uint4 u = *(const uint4*)(yp + i * 8);
      float4 g0 = *(const float4*)(ng + i * 8), g1 = *(const float4*)(ng + i * 8 + 4);
      u.x = pk2(bflo(u.x) * rs * g0.x, bfhi(u.x) * rs * g0.y);
      u.y = pk2(bflo(u.y) * rs * g0.z, bfhi(u.y) * rs * g0.w);
      u.z = pk2(bflo(u.z) * rs * g1.x, bfhi(u.z) * rs * g1.y);
      u.w = pk2(bflo(u.w) * rs * g1.z, bfhi(u.w) * rs * g1.w);
      *(uint4*)(yp + i * 8) = u;
    }
  }
}

__device__ __forceinline__ void s5_load_u(const Params& p, size_t tok, int g, float* dst) {
  const uint4* src = (const uint4*)(p.P + tok * PW + C_S5U + g * 16);
  uint4 a = src[0], b = src[1];
  *(float4*)(dst + 0) = make_float4(bflo(a.x), bfhi(a.x), bflo(a.y), bfhi(a.y));
  *(float4*)(dst + 4) = make_float4(bflo(a.z), bfhi(a.z), bflo(a.w), bfhi(a.w));
  *(float4*)(dst + 8) = make_float4(bflo(b.x), bfhi(b.x), bflo(b.y), bfhi(b.y));
  *(float4*)(dst + 12) = make_float4(bflo(b.z), bfhi(b.z), bflo(b.w), bfhi(b.w));
}
typedef float f32x2 __attribute__((ext_vector_type(2)));
#define S5_STEP(uu)                                                                     \
  {                                                                                     \
    float4 u0 = *(const float4*)((uu)), u1 = *(const float4*)((uu) + 4), u2 = *(const float4*)((uu) + 8), u3 = *(const float4*)((uu) + 12); \
    f32x2 bb = B2[0] * (f32x2){u0.x, u0.x};                                             \
    bb = B2[1] * (f32x2){u0.y, u0.y} + bb; bb = B2[2] * (f32x2){u0.z, u0.z} + bb; bb = B2[3] * (f32x2){u0.w, u0.w} + bb;     \
    bb = B2[4] * (f32x2){u1.x, u1.x} + bb; bb = B2[5] * (f32x2){u1.y, u1.y} + bb; bb = B2[6] * (f32x2){u1.z, u1.z} + bb; bb = B2[7] * (f32x2){u1.w, u1.w} + bb; \
    bb = B2[8] * (f32x2){u2.x, u2.x} + bb; bb = B2[9] * (f32x2){u2.y, u2.y} + bb; bb = B2[10] * (f32x2){u2.z, u2.z} + bb; bb = B2[11] * (f32x2){u2.w, u2.w} + bb; \
    bb = B2[12] * (f32x2){u3.x, u3.x} + bb; bb = B2[13] * (f32x2){u3.y, u3.y} + bb; bb = B2[14] * (f32x2){u3.z, u3.z} + bb; bb = B2[15] * (f32x2){u3.w, u3.w} + bb; \
    float nr_ = ar * sr - ai * si + bb.x; float ni_ = ar * si + ai * sr + bb.y; sr = nr_; si = ni_; \
  }

__device__ __forceinline__ void s5_pass1(const Params& p, int layer, int task, char* sm) {
  const int tid = otid(), lane = tid & 63, w = tid >> 6;
  const int gq = task & 7, c = (task >> 3) & 127, b = task >> 10;
  const int g = gq * 4 + w;
  const size_t tok0 = (size_t)b * LSEQ + c * 128;
  float* sU = (float*)(sm + w * 8192);
  __syncthreads();
  s5_load_u(p, tok0 + lane, g, sU + lane * 16);
  s5_load_u(p, tok0 + 64 + lane, g, sU + (64 + lane) * 16);
  const size_t pi = ((size_t)(layer * 32 + g)) * 64 + lane;
  f32x2 B2[16];
#pragma unroll
  for (int h = 0; h < 16; h++) { B2[h].x = p.SB[pi * 32 + h]; B2[h].y = p.SB[pi * 32 + 16 + h]; }
  const float ar = p.SA[pi * 4], ai = p.SA[pi * 4 + 1];
  float sr = 0.f, si = 0.f;
  __builtin_amdgcn_wave_barrier();
  for (int l = 0; l < 128; l++) S5_STEP(sU + l * 16)
  *(float2*)(p.END + (((size_t)(b * 128 + c) * 32 + g) * 64 + lane) * 2) = make_float2(sr, si);
}

__device__ __forceinline__ void s5_carry(const Params& p, int layer, int task) {
  const int idx = task * 256 + otid();
  const int b = idx >> 11, gp = idx & 2047;
  const size_t pi = (size_t)layer * 2048 + gp;
  const float a128r = p.SA[pi * 4 + 2], a128i = p.SA[pi * 4 + 3];
  float sr = ozero(), si = ozero();
  float2* e = (float2*)p.END + (size_t)b * 128 * 2048 + gp;
  for (int c0 = 0; c0 < 128; c0 += 4) {
    float2 v[4];
#pragma unroll
    for (int k = 0; k < 4; k++) v[k] = e[(size_t)(c0 + k) * 2048];
#pragma unroll
    for (int k = 0; k < 4; k++) {
      e[(size_t)(c0 + k) * 2048] = make_float2(sr, si);
      float nr = a128r * sr - a128i * si + v[k].x, ni = a128r * si + a128i * sr + v[k].y; sr = nr; si = ni;
    }
  }
}

__device__ __forceinline__ void s5_pass2(const Params& p, int layer, int task, char* sm) {
  const int tid = otid(), lane = tid & 63, w = tid >> 6;
  const int c = task & 127, b = task >> 7;
  const size_t tok0 = (size_t)b * LSEQ + c * 128;
  float* sU = (float*)(sm + w * 10752); bf* sS = (bf*)(sm + w * 10752 + 2048);
  __syncthreads();
  for (int gi = 0; gi < 8; gi++) {
    const int g = w * 8 + gi;
    const size_t pi = ((size_t)(layer * 32 + g)) * 64 + lane;
    f32x2 B2[16];
#pragma unroll
    for (int h = 0; h < 16; h++) { B2[h].x = p.SB[pi * 32 + h]; B2[h].y = p.SB[pi * 32 + 16 + h]; }
    const float ar = p.SA[pi * 4], ai = p.SA[pi * 4 + 1];
    float2 s0 = *(const float2*)(p.END + (((size_t)(b * 128 + c) * 32 + g) * 64 + lane) * 2);
    float sr = s0.x, si = s0.y;
    bf16x8 cf[4];
    {
      const bf* cm = p.CM + (((size_t)(layer * 32 + g)) * 16 + (lane & 15)) * 128 + 8 * (lane >> 4);
#pragma unroll
      for (int ks = 0; ks < 4; ks++) cf[ks] = *(const bf16x8*)(cm + ks * 32);
    }
    const float dsk = p.s5_d[(layer * 32 + g) * 16 + (lane & 15)];
    for (int sub = 0; sub < 4; sub++) {
      __builtin_amdgcn_wave_barrier();
      if (lane < 32) s5_load_u(p, tok0 + sub * 32 + lane, g, sU + lane * 16);
      __builtin_amdgcn_wave_barrier();
      for (int l = 0; l < 32; l++) {
        S5_STEP(sU + l * 16)
        sS[l * 136 + lane] = f2bf(sr); sS[l * 136 + 64 + lane] = f2bf(si);
      }
      __builtin_amdgcn_wave_barrier();
#pragma unroll
      for (int mb = 0; mb < 2; mb++) {
        const float z_ = ozero(); f32x4 acc = {z_, z_, z_, z_};
#pragma unroll
        for (int ks = 0; ks < 4; ks++) {
          bf16x8 af = *(const bf16x8*)(sS + (16 * mb + (lane & 15)) * 136 + ks * 32 + 8 * (lane >> 4));
          acc = mfma16(af, cf[ks], acc);
        }
#pragma unroll
        for (int r = 0; r < 4; r++) {
          const int l = 16 * mb + 4 * (lane >> 4) + r;
          float y = acc[r] + dsk * sU[l * 16 + (lane & 15)];
          p.YG[(tok0 + sub * 32 + l) * 512 + g * 16 + (lane & 15)] = f2bf(geluf_(y));
        }
      }
    }
  }
  __syncthreads();
  const int wr = w >> 1, wc = w & 1, r32 = lane & 31, h5 = lane >> 5;
  for (int tn = 0; tn < 4; tn++) {
    f32x16 acc[2][2]; ZERO_ACC(acc);
    gemm_acc<4>(p.YG + tok0 * 512, 512, p.WgluT + ((size_t)layer * 512 + tn * 128) * 512, 512, 512, acc, sm);
#pragma unroll
    for (int i = 0; i < 2; i++) {
      const size_t tok = tok0 + wr * 64 + i * 32 + r32;
#pragma unroll
      for (int j = 0; j < 2; j++)
#pragma unroll
        for (int q = 0; q < 4; q++) {
          const int n = tn * 128 + wc * 64 + j * 32 + q * 8 + h5 * 4;
          float4 bg = *(const float4*)(p.b_glu + layer * 512 + n);
          uint2 yy = *(const uint2*)(p.YG + tok * 512 + n);
          uint2 zz = *(const uint2*)(p.P + tok * PW + C_S5Z + n);
          float o0 = bflo(yy.x) * sigmoidf_(acc[i][j][4 * q] + bg.x) * siluf_(bflo(zz.x));
          float o1 = bfhi(yy.x) * sigmoidf_(acc[i][j][4 * q + 1] + bg.y) * siluf_(bfhi(zz.x));
          float o2 = bflo(yy.y) * sigmoidf_(acc[i][j][4 * q + 2] + bg.z) * siluf_(bflo(zz.y));
          float o3 = bfhi(yy.y) * sigmoidf_(acc[i][j][4 * q + 3] + bg.w) * siluf_(bfhi(zz.y));
          *(uint2*)(p.Y + tok * YW + Y_S5 + n) = make_uint2(pk2(o0, o1), pk2(o2, o3));
        }
    }
  }
}

__device__ __forceinline__ void mem_attn(const Params& p, int layer, int task) {
  const int tid = otid(), lane = tid & 63, h = tid >> 6;
  const int n16 = lane & 15, kq = lane >> 4;
  const size_t tok0 = (size_t)task * 16; const int b = (int)(tok0 >> 14);
  const bf* mk = p.MK + (((size_t)layer * 2 + b) * 4 + h) * 256 * 64;
  const bf* mvt = p.MVT + (((size_t)layer * 2 + b) * 4 + h) * 64 * 256;
  bf16x8 qf[2];
  {
    const bf* qp = p.P + (tok0 + n16) * PW + C_MEQ + h * 64 + 8 * kq;
    qf[0] = *(const bf16x8*)qp; qf[1] = *(const bf16x8*)(qp + 32);
  }
  f32x4 st[16];
#pragma unroll
  for (int kb = 0; kb < 16; kb++) {
    const bf* kp = mk + (size_t)(16 * kb + n16) * 64 + 8 * kq;
    bf16x8 a0 = *(const bf16x8*)kp, a1 = *(const bf16x8*)(kp + 32);
    const float z_ = ozero(); f32x4 acc = {z_, z_, z_, z_};
    acc = mfma16(a0, qf[0], acc); acc = mfma16(a1, qf[1], acc);
    st[kb] = acc * 0.125f;
  }
  float mx = -3.0e38f;
#pragma unroll
  for (int kb = 0; kb < 16; kb++)
#pragma unroll
    for (int r = 0; r < 4; r++) mx = fmaxf(mx, st[kb][r]);
  mx = fmaxf(mx, __shfl_xor(mx, 16)); mx = fmaxf(mx, __shfl_xor(mx, 32));
  float sum = 0.f;
#pragma unroll
  for (int kb = 0; kb < 16; kb++)
#pragma unroll
    for (int r = 0; r < 4; r++) { float e = __expf(st[kb][r] - mx); st[kb][r] = e; sum += e; }
  sum += __shfl_xor(sum, 16); sum += __shfl_xor(sum, 32);
  const float rinv = 1.f / sum;
  f32x4 o[4];
#pragma unroll
  for (int mb = 0; mb < 4; mb++) { const float z_ = ozero(); o[mb] = (f32x4){z_, z_, z_, z_}; }
#pragma unroll
  for (int k2 = 0; k2 < 8; k2++) {
    bf16x8 pf;
    unsigned q0 = pk2(st[2 * k2][0], st[2 * k2][1]), q1 = pk2(st[2 * k2][2], st[2 * k2][3]);
    unsigned q2 = pk2(st[2 * k2 + 1][0], st[2 * k2 + 1][1]), q3 = pk2(st[2 * k2 + 1][2], st[2 * k2 + 1][3]);
    pf[0] = (short)(q0 & 0xFFFF); pf[1] = (short)(q0 >> 16); pf[2] = (short)(q1 & 0xFFFF); pf[3] = (short)(q1 >> 16);
    pf[4] = (short)(q2 & 0xFFFF); pf[5] = (short)(q2 >> 16); pf[6] = (short)(q3 & 0xFFFF); pf[7] = (short)(q3 >> 16);
#pragma unroll
    for (int mb = 0; mb < 4; mb++) {
      const bf* vp = mvt + (size_t)(16 * mb + n16) * 256 + 32 * k2 + 4 * kq;
      uint2 v0 = *(const uint2*)vp, v1 = *(const uint2*)(vp + 16);
      bf16x8 af;
      af[0] = (short)(v0.x & 0xFFFF); af[1] = (short)(v0.x >> 16); af[2] = (short)(v0.y & 0xFFFF); af[3] = (short)(v0.y >> 16);
      af[4] = (short)(v1.x & 0xFFFF); af[5] = (short)(v1.x >> 16); af[6] = (short)(v1.y & 0xFFFF); af[7] = (short)(v1.y >> 16);
      o[mb] = mfma16(af, pf, o[mb]);
    }
  }
  const size_t tok = tok0 + n16;
#pragma unroll
  for (int mb = 0; mb < 4; mb++) {
    const int d = 16 * mb + 4 * kq;
    uint2 zz = *(const uint2*)(p.P + tok * PW + C_MEZ + h * 64 + d);
    float v0 = o[mb][0] * rinv * siluf_(bflo(zz.x)), v1 = o[mb][1] * rinv * siluf_(bfhi(zz.x));
    float v2 = o[mb][2] * rinv * siluf_(bflo(zz.y)), v3 = o[mb][3] * rinv * siluf_(bfhi(zz.y));
    *(uint2*)(p.Y + tok * YW + Y_MEM + h * 64 + d) = make_uint2(pk2(v0, v1), pk2(v2, v3));
  }
}

__device__ __forceinline__ void dsa_wave(const Params& p, int rank, char* sm) {
  const int tid = otid(), lane = tid & 63, w = tid >> 6, r32 = lane & 31, h5 = lane >> 5;
  const int b = rank & 1, qg = 2047 - (rank >> 1), l0 = qg * 8;
  const size_t tokb = (size_t)b * LSEQ;
  unsigned* cand = (unsigned*)(sm + w * (8 * CAP * 4));
  bf* Pb = (bf*)(sm + 61440 + w * 4096);
  bf16x8 aq[4];
  {
    const bf* qp = p.P + (tokb + l0 + (r32 >> 2)) * PW + C_IDQ + (r32 & 3) * 64 + 8 * h5;
#pragma unroll
    for (int ks = 0; ks < 4; ks++) aq[ks] = *(const bf16x8*)(qp + ks * 16);
  }
  float wv[4][4]; int ql[4];
#pragma unroll
  for (int g = 0; g < 4; g++) {
    ql[g] = l0 + 2 * g + h5;
    uint2 u = *(const uint2*)(p.P + (tokb + ql[g]) * PW + C_IDW);
    wv[g][0] = bflo(u.x) * 0.0625f; wv[g][1] = bfhi(u.x) * 0.0625f; wv[g][2] = bflo(u.y) * 0.0625f; wv[g][3] = bfhi(u.y) * 0.0625f;
  }
  unsigned Tg[4] = {0u, 0u, 0u, 0u}; float Tf[4];
  unsigned Tq = 0u; int cntv = 0;
  int nrep_ = (PROBE_MASK & 32) ? 2 : 1; asm volatile("" : "+s"(nrep_));
#pragma unroll 1
  for (int rep_ = 0; rep_ < nrep_; rep_++) {
  Tg[0] = Tg[1] = Tg[2] = Tg[3] = 0u; Tq = 0u; cntv = 0;
  Tf[0] = Tf[1] = Tf[2] = Tf[3] = -__builtin_inff();
  const int ntile = (l0 + 7) / 32 + 1;
  const bf* kif = p.KIF + (size_t)b * 512 * 2048 + lane * 8;
  bf16x8 bqA[4][4], bqB[4][4];
#pragma unroll
  for (int s = 0; s < 4; s++) {
    const int ts = s < ntile ? s : ntile - 1;
#pragma unroll
    for (int ks = 0; ks < 4; ks++) bqA[s][ks] = *(const bf16x8*)(kif + (size_t)ts * 2048 + ks * 512);
  }
  const unsigned ltmask = (1u << r32) - 1u;
#define DSA_COMPACT_CHECK()                                                                                              \
  {                                                                                                                     \
    unsigned long long over = __ballot(lane < 8 && cntv > CAP - 64);                                                    \
    if (over) {                                                                                                         \
      while (over) {                                                                                                    \
        const int q = __builtin_ctzll(over); over &= over - 1;                                                          \
        const int n = __builtin_amdgcn_readlane(cntv, q);                                                               \
        unsigned* cb_ = cand + q * CAP;                                                                                 \
        unsigned e[8];                                                                                                  \
        _Pragma("unroll") for (int i = 0; i < 8; i++) e[i] = (i * 64 + lane < n) ? cb_[i * 64 + lane] : 0u;             \
        unsigned T = 0u; int cT = n;                                                                                    \
        int nsr_ = (PROBE_MASK & 64) ? 2 : 1; asm volatile("" : "+s"(nsr_));                                            \
        _Pragma("unroll 1") for (int sr_ = 0; sr_ < nsr_; sr_++) { T = 0u; cT = n;                                      \
        const unsigned Told_ = (unsigned)__builtin_amdgcn_readlane((int)Tq, q);                                         \
        for (int bit = 31; bit >= 14; bit--) {                                                                          \
          const unsigned cnd = T | (1u << bit); int cc = 0;                                                             \
          if (cnd <= Told_) { T = cnd; continue; }                       \
          _Pragma("unroll") for (int i = 0; i < 8; i++) cc += __popcll(__ballot(e[i] >= cnd));                          \
          if (cc >= 256) { T = cnd; cT = cc; }                                                                          \
        } }                                                                                                             \
        if (cT > 320) {                                                                                                 \
          for (int bit = 13; bit >= 0; bit--) {                                                                         \
            const unsigned cnd = T | (1u << bit); int cc = 0;                                                           \
            _Pragma("unroll") for (int i = 0; i < 8; i++) cc += __popcll(__ballot(e[i] >= cnd));                        \
            if (cc >= 256) T = cnd;                                                                                     \
          }                                                                                                             \
        }                                                                                                               \
        int pos = 0;                                                                                                    \
        _Pragma("unroll") for (int i = 0; i < 8; i++) {                                                                 \
          const bool keep = e[i] >= T; const unsigned long long m = __ballot(keep);                                     \
          if (keep) cb_[pos + __popcll(m & ((1ull << lane) - 1ull))] = e[i];                                            \
          pos += __popcll(m);                                                                                           \
        }                                                                                                               \
        if (lane == q) { cntv = pos; Tq = T; }                                                                          \
      }                                                                                                                 \
      _Pragma("unroll") for (int g = 0; g < 4; g++) {                                                                   \
        unsigned tlo = __builtin_amdgcn_readlane(Tq, 2 * g), thi = __builtin_amdgcn_readlane(Tq, 2 * g + 1);            \
        Tg[g] = h5 ? thi : tlo;                                                                                         \
        const unsigned sh = Tg[g] & 0xFFFFC000u;                                                                        \
        const unsigned fb = (sh & 0x80000000u) ? (sh ^ 0x80000000u) : ~sh;                                              \
        Tf[g] = Tg[g] ? __uint_as_float(fb) : -__builtin_inff();                                                        \
      }                                                                                                                 \
    }                                                                                                                   \
  }
#define DSA_G(g, DIAG)                                                                                                  \
      {                                                                                                                 \
        const float r0 = __int_as_float(max(__float_as_int(acc[4 * g]), 0)), r1 = __int_as_float(max(__float_as_int(acc[4 * g + 1]), 0)); \
        const float r2 = __int_as_float(max(__float_as_int(acc[4 * g + 2]), 0)), r3 = __int_as_float(max(__float_as_int(acc[4 * g + 3]), 0)); \
        float sc = r0 * wv[g][0]; sc = fmaf(r1, wv[g][1], sc); sc = fmaf(r2, wv[g][2], sc); sc = fmaf(r3, wv[g][3], sc); \
        unsigned long long m0 = __builtin_amdgcn_fcmpf(sc, Tf[g], 3  );                                            \
        if (DIAG) m0 &= __builtin_amdgcn_sicmp(kidx, ql[g], 41  );                                                 \
        if (m0) {                                                                                                       \
          const float s2 = sc + 0.f;                                                                                    \
          unsigned uu = __float_as_uint(s2); uu ^= ((unsigned)((int)uu >> 31) | 0x80000000u);                           \
          const unsigned pk = (uu & 0xFFFFC000u) | (unsigned)(16383 - kidx);                                            \
          const unsigned long long m = m0 & __builtin_amdgcn_uicmp(pk, Tg[g], 35  );                              \
          if (m) {                                                                                                      \
            const unsigned lo = (unsigned)m, hi = (unsigned)(m >> 32);                                                  \
            const int cA = __builtin_amdgcn_readlane(cntv, 2 * g), cB = __builtin_amdgcn_readlane(cntv, 2 * g + 1);     \
            const unsigned mm = h5 ? hi : lo;                                                                           \
            if ((mm >> r32) & 1u) {                                                                                     \
              const int base = h5 ? cB : cA;                                                                            \
              cand[(2 * g + h5) * CAP + base + __popc(mm & ltmask)] = pk;                                               \
            }                                                                                                           \
            if (lane == 2 * g) cntv += __popc(lo);                                                                      \
            if (lane == 2 * g + 1) cntv += __popc(hi);                                                                  \
          }                                                                                                             \
        }                                                                                                               \
      }
#define DSA_GROUP(BC, BN, TB)                                                                                           \
  _Pragma("unroll") for (int u = 0; u < 4; u++) {                                                                       \
    if ((u & 1) == 0) DSA_COMPACT_CHECK()                                                                               \
    const int tile = (TB) + u;                                                                                          \
    f32x16 acc = {0.f, 0.f, 0.f, 0.f, 0.f, 0.f, 0.f, 0.f, 0.f, 0.f, 0.f, 0.f, 0.f, 0.f, 0.f, 0.f};                    \
    _Pragma("unroll") for (int ks = 0; ks < 4; ks++) acc = mfma32(aq[ks], BC[u][ks], acc);                              \
    if (u == 0) {                                                                                                       \
      _Pragma("unroll") for (int s = 0; s < 4; s++) {                                                                   \
        const int tn_ = ((TB) + 4 + s < ntile) ? (TB) + 4 + s : ntile - 1;                                              \
        _Pragma("unroll") for (int ks = 0; ks < 4; ks++) BN[s][ks] = *(const bf16x8*)(kif + (size_t)tn_ * 2048 + ks * 512); \
      }                                                                                                                 \
    }                                                                                                                   \
    const int kidx = tile * 32 + r32;                                                                                   \
    const bool diag = (tile * 32 + 31 > l0);                                                                            \
    if (!diag) { DSA_G(0, false) DSA_G(1, false) DSA_G(2, false) DSA_G(3, false) }                                      \
    else { DSA_G(0, true) DSA_G(1, true) DSA_G(2, true) DSA_G(3, true) }                                                \
  }
  for (int tile0 = 0; tile0 < ntile; tile0 += 8) {
    DSA_GROUP(bqA, bqB, tile0)
    DSA_GROUP(bqB, bqA, tile0 + 4)
  }
  {
    unsigned long long over = __ballot(lane < 8 && cntv > 256);
    while (over) {
      const int q = __builtin_ctzll(over); over &= over - 1;
      const int n = __builtin_amdgcn_readlane(cntv, q);
      unsigned* cb_ = cand + q * CAP;
      unsigned e[8];
#pragma unroll
      for (int i = 0; i < 8; i++) e[i] = (i * 64 + lane < n) ? cb_[i * 64 + lane] : 0u;
      unsigned T = 0u;
      for (int bit = 31; bit >= 0; bit--) {
        const unsigned cnd = T | (1u << bit); int cc = 0;
#pragma unroll
        for (int i = 0; i < 8; i++) cc += __popcll(__ballot(e[i] >= cnd));
        if (cc >= 256) T = cnd;
      }
      int pos = 0;
#pragma unroll
      for (int i = 0; i < 8; i++) {
        const bool keep = e[i] >= T; const unsigned long long m = __ballot(keep);
        if (keep) cb_[pos + __popcll(m & ((1ull << lane) - 1ull))] = e[i];
        pos += __popcll(m);
      }
      if (lane == q) { cntv = pos; Tq = T; }
    }
  }
  }
  __builtin_amdgcn_wave_barrier();
  const int n16 = lane & 15, kq = lane >> 4;
#define DPP_ROR(v, n) __int_as_float(__builtin_amdgcn_update_dpp(0, __float_as_int(v), 0x120 + (n), 0xf, 0xf, false))
  for (int q = 0; q < 8; q++) {
    const int n = __builtin_amdgcn_readlane(cntv, q);
    const unsigned* sel = cand + q * CAP;
    const size_t tq = tokb + l0 + q;
    float ssum[2][4];
#pragma unroll
    for (int grp = 0; grp < 2; grp++) {
      bf16x8 qa0, qa1;
#pragma unroll
      for (int k = 0; k < 8; k++) { int zi_ = 0; asm volatile("" : "+v"(zi_)); qa0[k] = (short)zi_; qa1[k] = (short)zi_; }
      if (n16 < 4) {
        const bf* qp = p.P + tq * PW + C_ATQ + (grp * 4 + n16) * 64 + 8 * kq;
        qa0 = *(const bf16x8*)qp; qa1 = *(const bf16x8*)(qp + 32);
      }
      f32x4 lg[16];
#pragma unroll
      for (int t = 0; t < 16; t++) {
        const int slot = t * 16 + n16; const bool valid = slot < n;
        const int key = valid ? (16383 - (int)(sel[slot] & 0x3FFFu)) : 0;
        const bf* kp = p.KVC + (tokb + key) * 256 + grp * 64 + 8 * kq;
        bf16x8 b0 = *(const bf16x8*)kp, b1 = *(const bf16x8*)(kp + 32);
        const float zc_ = ozero(); f32x4 cc = {zc_, zc_, zc_, zc_};
        cc = mfma16(qa0, b0, cc); cc = mfma16(qa1, b1, cc);
        const bool ok = valid && (kq == 0);
#pragma unroll
        for (int r = 0; r < 4; r++) lg[t][r] = ok ? cc[r] * 0.125f : -3.0e38f;
      }
      float mx[4];
#pragma unroll
      for (int r = 0; r < 4; r++) {
        float m = lg[0][r];
#pragma unroll
        for (int t = 1; t < 16; t++) m = fmaxf(m, lg[t][r]);
        m = fmaxf(m, DPP_ROR(m, 8)); m = fmaxf(m, DPP_ROR(m, 4)); m = fmaxf(m, DPP_ROR(m, 2)); m = fmaxf(m, DPP_ROR(m, 1));
        mx[r] = __int_as_float(__builtin_amdgcn_readfirstlane(__float_as_int(m)));
      }
#pragma unroll
      for (int r = 0; r < 4; r++) {
        float s = 0.f;
#pragma unroll
        for (int t = 0; t < 16; t++) { float e = (lg[t][r] > -1.0e38f) ? __expf(lg[t][r] - mx[r]) : 0.f; lg[t][r] = e; s += e; }
        s += DPP_ROR(s, 8); s += DPP_ROR(s, 4); s += DPP_ROR(s, 2); s += DPP_ROR(s, 1);
        ssum[grp][r] = __int_as_float(__builtin_amdgcn_readfirstlane(__float_as_int(s)));
      }
      if (grp == 0) __builtin_amdgcn_wave_barrier();
      if (kq == 0) {
#pragma unroll
        for (int t = 0; t < 16; t++)
          *(uint2*)(Pb + (t * 16 + n16) * 8 + grp * 4) = make_uint2(pk2(lg[t][0], lg[t][1]), pk2(lg[t][2], lg[t][3]));
      }
    }
    __builtin_amdgcn_wave_barrier();
    float o[64];
#pragma unroll
    for (int i = 0; i < 64; i++) o[i] = ozero();
    const int ksg = lane >> 3, dc = lane & 7;
#pragma unroll 8
    for (int stp = 0; stp < 32; stp++) {
      const int slot = stp * 8 + ksg;
      const int key = (slot < n) ? (16383 - (int)(sel[slot] & 0x3FFFu)) : 0;
      uint4 pp = *(const uint4*)(Pb + slot * 8);
      const bf* vp = p.KVC + (tokb + key) * 256 + 128 + dc * 8;
      uint4 va = *(const uint4*)vp, vb = *(const uint4*)(vp + 64);
      float ph[8] = {bflo(pp.x), bfhi(pp.x), bflo(pp.y), bfhi(pp.y), bflo(pp.z), bfhi(pp.z), bflo(pp.w), bfhi(pp.w)};
      float v0[8] = {bflo(va.x), bfhi(va.x), bflo(va.y), bfhi(va.y), bflo(va.z), bfhi(va.z), bflo(va.w), bfhi(va.w)};
      float v1[8] = {bflo(vb.x), bfhi(vb.x), bflo(vb.y), bfhi(vb.y), bflo(vb.z), bfhi(vb.z), bflo(vb.w), bfhi(vb.w)};
#pragma unroll
      for (int hh = 0; hh < 4; hh++)
#pragma unroll
        for (int d = 0; d < 8; d++) { o[hh * 8 + d] += ph[hh] * v0[d]; o[(4 + hh) * 8 + d] += ph[4 + hh] * v1[d]; }
    }
    __builtin_amdgcn_wave_barrier();
    const bool b5 = (lane >> 5) & 1, b4 = (lane >> 4) & 1, b3 = (lane >> 3) & 1;
    float o32[32], o16[16], o8[8];
#pragma unroll
    for (int i = 0; i < 32; i++) { float lo = o[i], hi = o[32 + i]; float snd = b5 ? lo : hi; float kp = b5 ? hi : lo; o32[i] = kp + __shfl_xor(snd, 32); }
#pragma unroll
    for (int i = 0; i < 16; i++) { float lo = o32[i], hi = o32[16 + i]; float snd = b4 ? lo : hi; float kp = b4 ? hi : lo; o16[i] = kp + __shfl_xor(snd, 16); }
#pragma unroll
    for (int i = 0; i < 8; i++) { float lo = o16[i], hi = o16[8 + i]; float snd = b3 ? lo : hi; float kp = b3 ? hi : lo; o8[i] = kp + __shfl_xor(snd, 8); }
    const float s_g0 = b4 ? (b3 ? ssum[0][3] : ssum[0][2]) : (b3 ? ssum[0][1] : ssum[0][0]);
    const float s_g1 = b4 ? (b3 ? ssum[1][3] : ssum[1][2]) : (b3 ? ssum[1][1] : ssum[1][0]);
    const float rinv = 1.f / (b5 ? s_g1 : s_g0);
    const int hsel = (b5 ? 4 : 0) + (b4 ? 2 : 0) + (b3 ? 1 : 0);
    const int col = hsel * 64 + dc * 8;
    uint4 zz = *(const uint4*)(p.P + tq * PW + C_ATZ + col);
    uint4 ov;
    ov.x = pk2(o8[0] * rinv * siluf_(bflo(zz.x)), o8[1] * rinv * siluf_(bfhi(zz.x)));
    ov.y = pk2(o8[2] * rinv * siluf_(bflo(zz.y)), o8[3] * rinv * siluf_(bfhi(zz.y)));
    ov.z = pk2(o8[4] * rinv * siluf_(bflo(zz.z)), o8[5] * rinv * siluf_(bfhi(zz.z)));
    ov.w = pk2(o8[6] * rinv * siluf_(bflo(zz.w)), o8[7] * rinv * siluf_(bfhi(zz.w)));
    *(uint4*)(p.Y + tq * YW + Y_ATT + col) = ov;
  }
}

__device__ __forceinline__ void phaseB(const Params& p, int layer, char* sm0) {
  const int total = 512 + 2048 + 2048;
  char* sm = sm0 + HB * HALF_LDS;
  for (int t = VB; t < total; t += G2) {
    if (t < 512) ssd_pass1(p, layer, t, sm);
    else if (t < 2560) s5_pass1(p, layer, t - 512, sm);
    else mem_attn(p, layer, t - 2560);
  }
}
__device__ __forceinline__ void phaseC(const Params& p, int layer, char* sm0, bool dsa_only) {
  const int G = G2;
  const int total = dsa_only ? 1024 : 1024 + 256 + 16;
  char* sm = sm0 + HB * HALF_LDS;
  int rr = 0;
  for (int i = VB; i < total; i += G, rr++) {
    if (i < 1024) {
      int pos = i - rr * G; int idx = i;
      if ((rr & 1) && (rr * G + G <= 1024)) idx = rr * G + (G - 1 - pos);
      __syncthreads();
      dsa_wave(p, idx * 4 + (otid() >> 6), sm);
    } else if (i < 1280) ssd_statepass(p, i - 1024);
    else s5_carry(p, layer, i - 1280);
  }
}
__device__ __forceinline__ void phaseD(const Params& p, int layer, char* sm0) {
  const int total = 256 + 1024;
  char* sm = sm0 + HB * HALF_LDS;
  const int vb = VB;
  if (G2 == 512) {
    if (vb < 256) { s5_pass2(p, layer, vb, sm); ssd_pass2(p, layer, vb, sm); }
    else {
#pragma unroll 1
      for (int k = 0; k < 3; k++) ssd_pass2(p, layer, 256 + (vb - 256) * 3 + k, sm);
    }
  } else {
    for (int t = vb; t < total; t += G2) {
      if (t < 256) s5_pass2(p, layer, t, sm);
      else ssd_pass2(p, layer, t - 256, sm);
    }
  }
}

__device__ __forceinline__ void phaseE(const Params& p, int layer) {
  const int tidf = otid_full();
  const int wid = __builtin_amdgcn_readfirstlane(tidf >> 6), lane = tidf & 63, wr = wid >> 2, wc = wid & 3, fr = lane & 15, fq = lane >> 4;
  const bf* Wl = p.WinT + (size_t)layer * INW * 2048;
  const bf* Wb = p.WbrT + (size_t)layer * 2048 * YW;
  bf* merged = p.P;
  char* gsb = (char*)p.GS + (size_t)blockIdx.x * 131072;
  const unsigned gs_lane0 = (unsigned)tidf * 16u, lane_c40 = (unsigned)fq * 16u, lane_m0 = (unsigned)(fr * 2048 + fq * 4) * 2u;
  for (int L = blockIdx.x; L < 1024; L += gridDim.x) {
    int pm, pn; tile_order(L, 128, 8, pm, pn);
    const int brow = pm * 256, bcol = pn * 256;
#pragma unroll 1
    for (int s = 0; s < 8; s++) {
      const int br = s >> 1; const bool isBr = (s & 1) != 0;
      const int koff = br == 0 ? 0 : (br == 1 ? 512 : (br == 2 ? 1024 : 2048));
      const int kb = br == 2 ? 1024 : (br == 3 ? 256 : 512);
      const bf* A_ = isBr ? p.Y + koff : p.xb; const int lda_ = isBr ? YW : 2048;
      const bf* B_ = isBr ? Wb + koff : Wl + (size_t)(5716 + br * 2048) * 2048; const int ldb_ = isBr ? YW : 2048;
      const int K_ = isBr ? kb : 2048;
      f32x4 acc[2][2][4][2]; ZERO_ACC8(acc);
      gemm256(A_, lda_, B_, ldb_, K_, brow, bcol, acc);
      unsigned gs_lane = gs_lane0, lane_c4 = lane_c40, lane_m = lane_m0;
      asm volatile("" : "+v"(gs_lane), "+v"(lane_c4), "+v"(lane_m));
      if (!isBr) {
        const char* bgb = (const char*)(p.b_gate + (size_t)layer * 8192 + br * 2048 + bcol + wc * 32);
#pragma unroll
        for (int ai = 0; ai < 2; ai++)
#pragma unroll
          for (int bj = 0; bj < 2; bj++)
#pragma unroll
            for (int m = 0; m < 4; m++) {
              unsigned q[4];
#pragma unroll
              for (int n = 0; n < 2; n++) {
                float4 bg = *(const float4*)(bgb + (bj * 128 + n * 16) * 4 + lane_c4);
                f32x4 v = acc[ai][bj][m][n];
                q[2 * n] = pk2(sigmoidf_(v[0] + bg.x), sigmoidf_(v[1] + bg.y));
                q[2 * n + 1] = pk2(sigmoidf_(v[2] + bg.z), sigmoidf_(v[3] + bg.w));
              }
              *(uint4*)(gsb + ((ai * 2 + bj) * 4 + m) * 8192 + gs_lane) = make_uint4(q[0], q[1], q[2], q[3]);
              __builtin_amdgcn_sched_barrier(0);
            }
      } else {
        char* mb = (char*)merged + ((size_t)(brow + wr * 64) * 2048 + bcol + wc * 32) * 2;
#pragma unroll
        for (int ai = 0; ai < 2; ai++)
#pragma unroll
          for (int bj = 0; bj < 2; bj++)
#pragma unroll
            for (int m = 0; m < 4; m++) {
              uint4 g = *(const uint4*)(gsb + ((ai * 2 + bj) * 4 + m) * 8192 + gs_lane);
              const unsigned gq[4] = {g.x, g.y, g.z, g.w};
#pragma unroll
              for (int n = 0; n < 2; n++) {
                f32x4 v = acc[ai][bj][m][n];
                float o0 = bflo(gq[2 * n]) * v[0], o1 = bfhi(gq[2 * n]) * v[1], o2 = bflo(gq[2 * n + 1]) * v[2], o3 = bfhi(gq[2 * n + 1]) * v[3];
                char* mp = mb + ((size_t)(ai * 128 + m * 16) * 2048 + bj * 128 + n * 16) * 2 + lane_m;
                if (br) { uint2 old = *(const uint2*)mp; o0 += bflo(old.x); o1 += bfhi(old.x); o2 += bflo(old.y); o3 += bfhi(old.y); }
                *(uint2*)mp = make_uint2(pk2(o0, o1), pk2(o2, o3));
              }
              __builtin_amdgcn_sched_barrier(0);
            }
      }
    }
  }
}

__device__ __forceinline__ void phaseF(const Params& p, int layer) {
  const int tidf = otid_full();
  const int wid = __builtin_amdgcn_readfirstlane(tidf >> 6), lane = tidf & 63, wr = wid >> 2, wc = wid & 3, fr = lane & 15, fq = lane >> 4;
  const bf* merged = p.P;
  const float* xres = layer == 0 ? p.x : p.out;
  for (int L = blockIdx.x; L < 1024; L += gridDim.x) {
    int pm, pn; tile_order(L, 128, 8, pm, pn);
    const int brow = pm * 256, bcol = pn * 256;
    f32x4 acc[2][2][4][2]; ZERO_ACC8(acc);
    gemm256(merged, 2048, p.WoutT + (size_t)layer * 2048 * 2048, 2048, 2048, brow, bcol, acc);
#pragma unroll
    for (int ai = 0; ai < 2; ai++)
#pragma unroll
      for (int m = 0; m < 4; m++) {
        const size_t tok = brow + ai * 128 + wr * 64 + m * 16 + fr;
#pragma unroll
        for (int bj = 0; bj < 2; bj++)
#pragma unroll
          for (int n = 0; n < 2; n++) {
            const int col = bcol + bj * 128 + wc * 32 + n * 16 + fq * 4;
            float4 xr = *(const float4*)(xres + tok * 2048 + col);
            f32x4 v = acc[ai][bj][m][n];
            float4 o;
            o.x = 1.41421356237f * xr.x + v[0]; o.y = 1.41421356237f * xr.y + v[1];
            o.z = 1.41421356237f * xr.z + v[2]; o.w = 1.41421356237f * xr.w + v[3];
            *(float4*)(p.out + tok * 2048 + col) = o;
          }
      }
  }
}

__device__ __forceinline__ void phaseG(const Params& p, int layer) {
  const int lane = otid() & 63, w = otid() >> 6;
  const float* g = p.ln_g + layer * 2048; const float* bb = p.ln_b + layer * 2048;
  for (int t = VB; t < TT / 4; t += G2) {
    const size_t row = (size_t)t * 4 + w;
    float* xp = p.out + row * 2048;
    float4 v[8]; float s = 0.f;
#pragma unroll
    for (int i = 0; i < 8; i++) { v[i] = *(const float4*)(xp + (i * 64 + lane) * 4); s += v[i].x + v[i].y + v[i].z + v[i].w; }
#pragma unroll
    for (int off = 1; off < 64; off <<= 1) s += __shfl_xor(s, off);
    const float mu = s * (1.f / 2048.f);
    float q = 0.f;
#pragma unroll
    for (int i = 0; i < 8; i++) {
      float a = v[i].x - mu, b = v[i].y - mu, c = v[i].z - mu, d = v[i].w - mu; q += a * a + b * b + c * c + d * d;
    }
#pragma unroll
    for (int off = 1; off < 64; off <<= 1) q += __shfl_xor(q, off);
    const float rs = rsqrtf(q * (1.f / 2048.f) + 1e-5f);
#pragma unroll
    for (int i = 0; i < 8; i++) {
      const int col = (i * 64 + lane) * 4;
      float4 gg = *(const float4*)(g + col), bv = *(const float4*)(bb + col);
      float4 o;
      o.x = (v[i].x - mu) * rs * gg.x + bv.x; o.y = (v[i].y - mu) * rs * gg.y + bv.y;
      o.z = (v[i].z - mu) * rs * gg.z + bv.z; o.w = (v[i].w - mu) * rs * gg.w + bv.w;
      *(float4*)(xp + col) = o;
      if (layer == 0) *(uint2*)(p.xb + row * 2048 + col) = make_uint2(pk2(o.x, o.y), pk2(o.z, o.w));
    }
  }
}

__global__ void __launch_bounds__(512, 2) mega_kernel(Params p) {
  char* sm = dynsm;
  cg::grid_group grid = cg::this_grid();
  phase0(p, sm); grid.sync();
#pragma unroll 1
  for (int layer = 0; layer < 2; layer++) {
    int nA = (PROBE_MASK & 1) ? 2 : 1, nB = (PROBE_MASK & 2) ? 2 : 1, nC = (PROBE_MASK & 4) ? 2 : 1, nD = (PROBE_MASK & 8) ? 2 : 1, nE = (PROBE_MASK & 16) ? 2 : 1;
    asm volatile("" : "+s"(nA), "+s"(nB), "+s"(nC), "+s"(nD), "+s"(nE));
#pragma unroll 1
    for (int r = 0; r < nA; r++) phaseA(p, layer);
    grid.sync();
#pragma unroll 1
    for (int r = 0; r < nB; r++) phaseB(p, layer, sm);
    grid.sync();
#pragma unroll 1
    for (int r = 0; r < nC; r++) phaseC(p, layer, sm, r + 1 < nC);
    grid.sync();
#pragma unroll 1
    for (int r = 0; r < nD; r++) phaseD(p, layer, sm);
    grid.sync();
#pragma unroll 1
    for (int r = 0; r < nE; r++) phaseE(p, layer);
    grid.sync();
    phaseF(p, layer); grid.sync();
    phaseG(p, layer);
    if (layer == 0) grid.sync();
  }
}

extern "C" void kernel_launch(void* const* d_in, const int* in_sizes, int n_in, void* d_out, int out_size, void* d_ws,
                              size_t ws_size, hipStream_t stream) {
  Params p{};
  p.x = (const float*)d_in[0]; p.mem = (const float*)d_in[1]; p.pos = (const int*)d_in[2];
  p.w_in = (const float*)d_in[3]; p.b_gate = (const float*)d_in[4]; p.lam_re = (const float*)d_in[5];
  p.lam_im = (const float*)d_in[6]; p.log_dt = (const float*)d_in[7]; p.b_re = (const float*)d_in[8];
  p.b_im = (const float*)d_in[9]; p.c_re = (const float*)d_in[10]; p.c_im = (const float*)d_in[11];
  p.s5_d = (const float*)d_in[12]; p.w_glu = (const float*)d_in[13]; p.b_glu = (const float*)d_in[14];
  p.conv_w = (const float*)d_in[15]; p.conv_b = (const float*)d_in[16]; p.dt_bias = (const float*)d_in[17];
  p.a_log = (const float*)d_in[18]; p.ssd_d = (const float*)d_in[19]; p.norm_g = (const float*)d_in[20];
  p.mem_w_kv = (const float*)d_in[21]; p.w_br_s5 = (const float*)d_in[22]; p.w_br_attn = (const float*)d_in[23];
  p.w_br_ssd = (const float*)d_in[24]; p.w_br_mem = (const float*)d_in[25]; p.w_out = (const float*)d_in[26];
  p.ln_g = (const float*)d_in[27]; p.ln_b = (const float*)d_in[28];
  p.out = (float*)d_out;
  char* ws = (char*)d_ws; size_t off = 0;
  auto carve = [&](size_t bytes) { char* r = ws + off; off += (bytes + 255) & ~(size_t)255; return r; };
  p.WinT = (bf*)carve((size_t)2 * INW * 2048 * 2);
  p.WbrT = (bf*)carve((size_t)2 * 2048 * YW * 2);
  p.WoutT = (bf*)carve((size_t)2 * 2048 * 2048 * 2);
  p.WgluT = (bf*)carve((size_t)2 * 512 * 512 * 2);
  p.WmemT = (bf*)carve((size_t)2 * 512 * 2048 * 2);
  p.memb = (bf*)carve((size_t)512 * 2048 * 2);
  p.xb = (bf*)carve((size_t)TT * 2048 * 2);
  p.P = (bf*)carve((size_t)TT * PW * 2);
  p.Y = (bf*)carve((size_t)TT * YW * 2);
  p.YG = (bf*)carve((size_t)TT * 512 * 2);
  p.KIF = (bf*)carve((size_t)TT * 64 * 2);
  p.MK = (bf*)carve((size_t)2 * 2 * 4 * 256 * 64 * 2);
  p.MVT = (bf*)carve((size_t)2 * 2 * 4 * 256 * 64 * 2);
  p.CM = (bf*)carve((size_t)2 * 32 * 16 * 128 * 2);
  p.ST = (float*)carve((size_t)2 * 128 * 131072 * 4);
  p.CS = (float*)carve((size_t)TT * 16 * 4);
  p.END = (float*)carve((size_t)2 * 128 * 32 * 64 * 2 * 4);
  p.CD = (float*)carve((size_t)2 * 128 * 16 * 4);
  p.SB = (float*)carve((size_t)2 * 32 * 64 * 32 * 4);
  p.SA = (float*)carve((size_t)2 * 32 * 64 * 4 * 4);
  p.KVC = (bf*)carve((size_t)TT * 256 * 2);
  p.GS = (bf*)carve((size_t)256 * 16 * 512 * 16);
  if (off > ws_size) { fprintf(stderr, "workspace too small: need %zu have %zu\n", off, ws_size); return; }
  for (int j = 0; j < 8; j++) p.inv[j] = (float)pow(500000.0, -(double)j / 8.0);
  const size_t kDynLds = 2 * HALF_LDS;
  static int grid_blocks = 0;
  if (!grid_blocks) {
    int dev = 0, cus = 0, per_cu = 0;
    (void)hipGetDevice(&dev);
    (void)hipDeviceGetAttribute(&cus, hipDeviceAttributeMultiprocessorCount, dev);
    (void)hipFuncSetAttribute((const void*)mega_kernel, hipFuncAttributeMaxDynamicSharedMemorySize, (int)kDynLds);
    (void)hipOccupancyMaxActiveBlocksPerMultiprocessor(&per_cu, mega_kernel, 512, kDynLds);
    if (per_cu > 1) per_cu = 1;
    grid_blocks = cus * per_cu;
    if (grid_blocks > 256) grid_blocks = 256;
    grid_blocks -= grid_blocks % 8;
  }
  void* args[] = {&p};
  hipError_t e = hipLaunchCooperativeKernel((void*)mega_kernel, dim3(grid_blocks), dim3(512), args, kDynLds, stream);
  if (e != hipSuccess) fprintf(stderr, "cooperative launch failed: %s (grid %d)\n", hipGetErrorString(e), grid_blocks);
}
```

```cpp
#include <hip/hip_runtime.h>
#include <hip/hip_cooperative_groups.h>
#include <cstdio>
#include <cmath>
namespace cg = cooperative_groups;

#ifndef MK_COOP
#define MK_COOP 1
#endif
#ifndef PROBE_MASK
#define PROBE_MASK 0
#endif

typedef unsigned short bf;
typedef short bf16x8 __attribute__((ext_vector_type(8)));
typedef float f32x16 __attribute__((ext_vector_type(16)));
typedef float f32x4 __attribute__((ext_vector_type(4)));

#define TT 32768
#define LSEQ 16384
#define DM 2048
#define INW 13908
#define PW 5760
#define C_S5U 0
#define C_S5Z 512
#define C_ATQ 1024
#define C_ATK 1536
#define C_ATV 1664
#define C_ATZ 1792
#define C_IDQ 2304
#define C_IDK 2560
#define C_IDW 2624
#define C_SSZ 2640
#define C_XBC 3664
#define C_SDT 5200
#define C_MEQ 5216
#define C_MEZ 5472
#define YW 2304
#define Y_S5 0
#define Y_ATT 512
#define Y_SSD 1024
#define Y_MEM 2048
#define CAP 480
#define HALF_LDS 77824

struct Params {
  const float *x, *mem; const int* pos;
  const float *w_in, *b_gate, *lam_re, *lam_im, *log_dt, *b_re, *b_im, *c_re, *c_im, *s5_d, *w_glu, *b_glu,
      *conv_w, *conv_b, *dt_bias, *a_log, *ssd_d, *norm_g, *mem_w_kv, *w_br_s5, *w_br_attn, *w_br_ssd, *w_br_mem,
      *w_out, *ln_g, *ln_b;
  float* out;
  bf *WinT, *WbrT, *WoutT, *WgluT, *WmemT, *memb, *xb, *P, *Y, *YG, *KIF, *MK, *MVT, *CM, *KVC, *GS;
  float *ST, *CS, *END, *CD, *SB, *SA;
  float inv[8];
};

__device__ __forceinline__ float ozero() { float z = 0.f; asm volatile("" : "+v"(z)); return z; }
__device__ __forceinline__ int otid_full() { int t = threadIdx.x; asm volatile("" : "+v"(t)); return t; }
__device__ __forceinline__ int otid() { return otid_full() & 255; }
#define HB (__builtin_amdgcn_readfirstlane(otid_full() >> 8))
#define VB ((int)blockIdx.x * 2 + HB)
#define G2 ((int)gridDim.x * 2)
__device__ __forceinline__ float bf2f(bf v) { return __uint_as_float(((unsigned)v) << 16); }
__device__ __forceinline__ float bflo(unsigned u) { return __uint_as_float(u << 16); }
__device__ __forceinline__ float bfhi(unsigned u) { return __uint_as_float(u & 0xFFFF0000u); }
typedef float f32x2p_t __attribute__((ext_vector_type(2)));
typedef __bf16 bf16x2p_t __attribute__((ext_vector_type(2)));
__device__ __forceinline__ unsigned pk2(float lo, float hi) {
  f32x2p_t v = {lo, hi};
  return __builtin_bit_cast(unsigned, __builtin_convertvector(v, bf16x2p_t));
}
__device__ __forceinline__ bf f2bf(float f) { return (bf)(pk2(f, 0.f) & 0xFFFFu); }
__device__ __forceinline__ float sigmoidf_(float x) { return __builtin_amdgcn_rcpf(1.f + __expf(-x)); }
__device__ __forceinline__ float siluf_(float x) { return x * __builtin_amdgcn_rcpf(1.f + __expf(-x)); }
__device__ __forceinline__ float geluf_(float x) {
  float u = 0.7978845608028654f * (x + 0.044715f * x * x * x);
  float t = 1.f - 2.f * __builtin_amdgcn_rcpf(1.f + __expf(2.f * u));
  return 0.5f * x * (1.f + t);
}
__device__ __forceinline__ f32x16 mfma32(bf16x8 a, bf16x8 b, f32x16 c) { return __builtin_amdgcn_mfma_f32_32x32x16_bf16(a, b, c, 0, 0, 0); }
__device__ __forceinline__ f32x4 mfma16(bf16x8 a, bf16x8 b, f32x4 c) { return __builtin_amdgcn_mfma_f32_16x16x32_bf16(a, b, c, 0, 0, 0); }

__device__ __forceinline__ bool tile_map(int L, int nMt, int nNt, int SM, int SN, int& tm, int& tn) {
  int per = SM * SN; int x = L & 7; int jj = L >> 3; int sl = jj / per; int j = jj - sl * per; int S = sl * 8 + x;
  int nSn = nNt / SN; int NS = (nMt / SM) * nSn;
  if (S >= NS) return false;
  int mg = S / nSn, ng = S - mg * nSn;
  tm = mg * SM + j / SN; tn = ng * SN + j % SN; return true;
}

typedef unsigned u32x4 __attribute__((ext_vector_type(4)));
struct GStage { u32x4 a0, a1, b0, b1; };
#define G_LOAD(S, ko) { S.a0 = *(const u32x4*)(ga + (ko)); S.a1 = *(const u32x4*)(ga + a64 + (ko)); S.b0 = *(const u32x4*)(gb + (ko)); S.b1 = *(const u32x4*)(gb + b64 + (ko)); }
#define G_WRITE(S, base) { *(u32x4*)(sA + (base) + woff) = S.a0; *(u32x4*)(sA + (base) + woff + 5120) = S.a1; *(u32x4*)(sB + (base) + woff) = S.b0; *(u32x4*)(sB + (base) + woff + 5120) = S.b1; }
#define G_ITER(kt, cur, S)                                                          \
  {                                                                                 \
    _Pragma("unroll") for (int ks = 0; ks < 2; ks++) {                              \
      bf16x8 a0 = *(const bf16x8*)(sA + (cur) + aoff + ks * 32);                    \
      bf16x8 a1 = *(const bf16x8*)(sA + (cur) + aoff + 2560 + ks * 32);             \
      bf16x8 b0 = *(const bf16x8*)(sB + (cur) + boff + ks * 32);                    \
      bf16x8 b1 = *(const bf16x8*)(sB + (cur) + boff + 2560 + ks * 32);             \
      acc[0][0] = mfma32(b0, a0, acc[0][0]);                                        \
      acc[0][1] = mfma32(b1, a0, acc[0][1]);                                        \
      acc[1][0] = mfma32(b0, a1, acc[1][0]);                                        \
      acc[1][1] = mfma32(b1, a1, acc[1][1]);                                        \
    }                                                                               \
    if ((kt) + 1 < nk) {                                                            \
      G_WRITE(S, 10240 - (cur))                                                     \
      if ((kt) + 1 + D < nk) G_LOAD(S, ((kt) + 1 + D) * 32)                         \
    }                                                                               \
    __syncthreads();                                                                \
  }
template <int D>
__device__ __forceinline__ void gemm_acc(const bf* __restrict__ A, int lda, const bf* __restrict__ Bt, int ldb, int K,
                                         f32x16 (&acc)[2][2], char* sm) {
  const int tid = otid(), lane = tid & 63, w = tid >> 6, wr = w >> 1, wc = w & 1, r32 = lane & 31, h5 = lane >> 5;
  const int lrow = tid >> 2, lch = tid & 3;
  const bf* ga = A + (size_t)lrow * lda + lch * 8;
  const bf* gb = Bt + (size_t)lrow * ldb + lch * 8;
  const size_t a64 = (size_t)64 * lda, b64 = (size_t)64 * ldb;
  const int nk = K >> 5;
  char* sA = sm; char* sB = sm + 20480;
  const int woff = lrow * 80 + lch * 16;
  const int aoff = (wr * 64 + r32) * 80 + h5 * 16, boff = (wc * 64 + r32) * 80 + h5 * 16;
  GStage S0, S1, S2, S3;
  G_LOAD(S0, 0) G_LOAD(S1, 32)
  if (D == 4) { G_LOAD(S2, 64) G_LOAD(S3, 96) }
  G_WRITE(S0, 0)
  if (D < nk) G_LOAD(S0, D * 32)
  __syncthreads();
  for (int kt0 = 0; kt0 < nk; kt0 += D) {
    if (D == 4) {
      G_ITER(kt0, 0, S1) G_ITER(kt0 + 1, 10240, S2) G_ITER(kt0 + 2, 0, S3) G_ITER(kt0 + 3, 10240, S0)
    } else {
      G_ITER(kt0, 0, S1) G_ITER(kt0 + 1, 10240, S0)
    }
  }
}
#define ZERO_ACC(a) { const float z_ = ozero(); for (int i_ = 0; i_ < 2; i_++) for (int j_ = 0; j_ < 2; j_++) for (int r_ = 0; r_ < 16; r_++) a[i_][j_][r_] = z_; }


extern __shared__ __attribute__((aligned(16))) char dynsm[];
#define G8_HT (128 * 64)
#define G8_SA(b, h) ((bf*)dynsm + ((b) * 2 + (h)) * G8_HT)
#define G8_SB(b, h) ((bf*)dynsm + (4 + (b) * 2 + (h)) * G8_HT)
__device__ __forceinline__ int g8_lds_byte(int r, int c) {
  int st = (r >> 4) * 2 + (c >> 5), rr = r & 15, cc = c & 31, ob = rr * 64 + cc * 2;
  return st * 1024 + (ob ^ (((ob >> 9) & 1) << 5));
}
__device__ __forceinline__ void g8_stage_rc(int b, int& R, int& C) {
  int st = b / 1024, sb = b % 1024, swz = sb ^ (((sb >> 9) & 1) << 5);
  R = (st >> 1) * 16 + swz / 64; C = (st & 1) * 32 + (swz % 64) / 2;
}
#define G8_LAS __attribute__((address_space(3)))
#define G8_HTB (128 * 64 * 2)
#define G8_OSA(b, h) (((b) * 2 + (h)) * G8_HTB)
#define G8_OSB(b, h) ((4 + (b) * 2 + (h)) * G8_HTB)
#define G8_STAGE(bufoff, gbase, voff) do { _Pragma("unroll") for (int _i = 0; _i < 2; ++_i) \
    __builtin_amdgcn_global_load_lds((const unsigned*)((const char*)(gbase) + (voff)[_i]), (G8_LAS unsigned*)(lds + (bufoff) + ldsw + _i * 8192), 16, 0, 0); } while (0)
#define G8_LDA(dst, b, h) do { _Pragma("unroll") for (int m = 0; m < 4; ++m) _Pragma("unroll") for (int k = 0; k < 2; ++k) dst[m][k] = *(const G8_LAS bf16x8*)(lds + G8_OSA(b, h) + aoff + m * 2048 + k * 1024); } while (0)
#define G8_LDB(dst, b, h) do { _Pragma("unroll") for (int n = 0; n < 2; ++n) _Pragma("unroll") for (int k = 0; k < 2; ++k) dst[n][k] = *(const G8_LAS bf16x8*)(lds + G8_OSB(b, h) + boff + n * 2048 + k * 1024); } while (0)
#define G8_MMA(ai, bj, At_, Bt_) do { __builtin_amdgcn_s_setprio(1);                                                 \
    _Pragma("unroll") for (int m = 0; m < 4; ++m) _Pragma("unroll") for (int n = 0; n < 2; ++n) _Pragma("unroll") for (int k = 0; k < 2; ++k) \
      acc[ai][bj][m][n] = __builtin_amdgcn_mfma_f32_16x16x32_bf16(Bt_[n][k], At_[m][k], acc[ai][bj][m][n], 0, 0, 0); \
    __builtin_amdgcn_s_setprio(0); } while (0)
#define G8_WAIT_V(n) asm volatile("s_waitcnt vmcnt(" #n ")" ::: "memory")
#define G8_WAIT_L(n) asm volatile("s_waitcnt lgkmcnt(" #n ")" ::: "memory")
#define G8_BAR __builtin_amdgcn_s_barrier()
#define G8_SCHED __builtin_amdgcn_sched_barrier(0)

__device__ __forceinline__ void gemm256(const bf* __restrict__ A, int lda, const bf* __restrict__ Bt, int ldb, int K,
                                        int brow, int bcol, f32x4 (&acc)[2][2][4][2]) {
  G8_LAS unsigned char* lds = (G8_LAS unsigned char*)dynsm;
  const int tid = otid_full(), wid = __builtin_amdgcn_readfirstlane(tid >> 6), lane = tid & 63, wr = wid >> 2, wc = wid & 3, fr = lane & 15, fq = lane >> 4;
  unsigned voffA[2], voffB[2];
#pragma unroll
  for (int i = 0; i < 2; ++i) { int R, C; g8_stage_rc(tid * 16 + i * 8192, R, C); voffA[i] = (unsigned)(R * lda + C) * 2u; voffB[i] = (unsigned)(R * ldb + C) * 2u; }
  const size_t kstep = 128;
  const size_t hstepA = (size_t)128 * lda * 2, hstepB = (size_t)128 * ldb * 2;
  const unsigned ldsw = (unsigned)wid * 1024u;
  const int aoff = g8_lds_byte(wr * 64 + fr, fq * 8), boff = g8_lds_byte(wc * 32 + fr, fq * 8);
  const char* cA = (const char*)A + (size_t)brow * lda * 2; const char* cB = (const char*)Bt + (size_t)bcol * ldb * 2;
  bf16x8 At[4][2], B0[2][2], B1[2][2];
  const int nt = K / 64;
  __syncthreads();
  G8_STAGE(G8_OSB(0, 0), cB, voffB); G8_STAGE(G8_OSA(0, 0), cA, voffA); G8_STAGE(G8_OSB(0, 1), cB + hstepB, voffB); G8_STAGE(G8_OSA(0, 1), cA + hstepA, voffA);
  if (wr == 1) G8_BAR;
  G8_WAIT_V(4); G8_BAR;
  G8_STAGE(G8_OSB(1, 0), cB + kstep, voffB); G8_STAGE(G8_OSA(1, 0), cA + kstep, voffA); G8_STAGE(G8_OSB(1, 1), cB + hstepB + kstep, voffB);
  G8_WAIT_V(6); G8_BAR;
  for (int t = 0; t < nt - 2; t += 2) {
    const char* a1 = cA + (size_t)(t + 1) * kstep;
    const char* a2 = cA + (size_t)(t + 2) * kstep; const char* b2 = cB + (size_t)(t + 2) * kstep;
    const char* a3 = a2 + kstep; const char* b3 = b2 + kstep;
    G8_LDB(B0, 0, 0); G8_SCHED; G8_LDA(At, 0, 0); G8_STAGE(G8_OSA(1, 1), a1 + hstepA, voffA);
    G8_WAIT_L(8); G8_BAR; G8_WAIT_L(0); G8_MMA(0, 0, At, B0); G8_BAR; G8_SCHED;
    G8_LDB(B1, 0, 1); G8_STAGE(G8_OSB(0, 0), b2, voffB);
    G8_BAR; G8_WAIT_L(0); G8_MMA(0, 1, At, B1); G8_BAR;
    G8_LDA(At, 0, 1); G8_STAGE(G8_OSA(0, 0), a2, voffA);
    G8_BAR; G8_WAIT_L(0); G8_MMA(1, 0, At, B0); G8_BAR; G8_SCHED;
    G8_STAGE(G8_OSB(0, 1), b2 + hstepB, voffB);
    G8_WAIT_V(6); G8_BAR; G8_MMA(1, 1, At, B1); G8_BAR;
    G8_LDB(B0, 1, 0); G8_SCHED; G8_LDA(At, 1, 0); G8_STAGE(G8_OSA(0, 1), a2 + hstepA, voffA);
    G8_WAIT_L(8); G8_BAR; G8_WAIT_L(0); G8_MMA(0, 0, At, B0); G8_BAR; G8_SCHED;
    G8_LDB(B1, 1, 1); G8_STAGE(G8_OSB(1, 0), b3, voffB);
    G8_BAR; G8_WAIT_L(0); G8_MMA(0, 1, At, B1); G8_BAR;
    G8_LDA(At, 1, 1); G8_STAGE(G8_OSA(1, 0), a3, voffA);
    G8_BAR; G8_WAIT_L(0); G8_MMA(1, 0, At, B0); G8_BAR; G8_SCHED;
    G8_STAGE(G8_OSB(1, 1), b3 + hstepB, voffB);
    G8_WAIT_V(6); G8_BAR; G8_MMA(1, 1, At, B1); G8_BAR;
  }
  { const char* a1 = cA + (size_t)(nt - 1) * kstep;
    G8_LDB(B0, 0, 0); G8_LDA(At, 0, 0); G8_STAGE(G8_OSA(1, 1), a1 + hstepA, voffA);
    G8_BAR; G8_WAIT_L(0); G8_MMA(0, 0, At, B0); G8_BAR;
    G8_LDB(B1, 0, 1); G8_BAR; G8_WAIT_L(0); G8_MMA(0, 1, At, B1); G8_BAR;
    G8_LDA(At, 0, 1); G8_WAIT_V(4); G8_BAR; G8_WAIT_L(0); G8_MMA(1, 0, At, B0); G8_MMA(1, 1, At, B1); G8_BAR; }
  { G8_LDB(B0, 1, 0); G8_LDA(At, 1, 0); G8_WAIT_V(2); G8_BAR; G8_WAIT_L(0); G8_MMA(0, 0, At, B0); G8_BAR;
    G8_LDB(B1, 1, 1); G8_WAIT_V(0); G8_BAR; G8_WAIT_L(0); G8_MMA(0, 1, At, B1); G8_BAR;
    G8_LDA(At, 1, 1); G8_BAR; G8_WAIT_L(0); G8_MMA(1, 0, At, B0); G8_MMA(1, 1, At, B1); G8_BAR; }
  if (wr == 0) G8_BAR;
}
#define ZERO_ACC8(a) { float z_ = 0.f; asm volatile("" : "+v"(z_)); _Pragma("unroll") for (int i_ = 0; i_ < 2; i_++) _Pragma("unroll") for (int j_ = 0; j_ < 2; j_++) _Pragma("unroll") for (int m_ = 0; m_ < 4; m_++) _Pragma("unroll") for (int n_ = 0; n_ < 2; n_++) a[i_][j_][m_][n_] = (f32x4){z_, z_, z_, z_}; }
__device__ __forceinline__ bool tile_order(int L, int nM, int nN, int& pm, int& pn) {
  const int nwg = nM * nN; if (L >= nwg) return false;
  int wgid = L; { const int q = nwg / 8, r = nwg % 8, xcd = wgid % 8, off = wgid / 8; wgid = (xcd < r ? xcd * (q + 1) : r * (q + 1) + (xcd - r) * q) + off; }
  const int nig = 8 * nN, gid = wgid / nig, fm = gid * 8, gsz = (nM - fm) < 8 ? (nM - fm) : 8;
  pm = fm + ((wgid % nig) % gsz); pn = (wgid % nig) / gsz; return true;
}

__device__ __forceinline__ void transpose_tile(const float* __restrict__ src, int R, int C, bf* __restrict__ dst, int ldd, int off, int tile, bf* sm) {
  const int tilesC = (C + 63) >> 6;
  const int tr = tile / tilesC, tc = tile - tr * tilesC;
  const int r0 = tr * 64, c0 = tc * 64;
  const int tid = otid();
#pragma unroll
  for (int i = 0; i < 4; i++) {
    int r = (tid >> 4) + 16 * i; int c = (tid & 15) * 4;
    const float zt_ = ozero(); float4 v = make_float4(zt_, zt_, zt_, zt_);
    if (c0 + c < C) v = *(const float4*)(src + (size_t)(r0 + r) * C + c0 + c);
    sm[(c + 0) * 66 + r] = f2bf(v.x); sm[(c + 1) * 66 + r] = f2bf(v.y);
    sm[(c + 2) * 66 + r] = f2bf(v.z); sm[(c + 3) * 66 + r] = f2bf(v.w);
  }
  __syncthreads();
  {
    int c = tid >> 2, ch = (tid & 3) * 16;
    if (c0 + c < C) {
      unsigned wv[8];
#pragma unroll
      for (int k = 0; k < 8; k++) wv[k] = *(const unsigned*)(sm + c * 66 + ch + 2 * k);
      bf* d = dst + (size_t)(c0 + c) * ldd + off + r0 + ch;
      *(uint4*)d = make_uint4(wv[0], wv[1], wv[2], wv[3]);
      *(uint4*)(d + 8) = make_uint4(wv[4], wv[5], wv[6], wv[7]);
    }
  }
  __syncthreads();
}

__device__ __forceinline__ bool try_tr(int& t, const float* src, int R, int C, bf* dst, int ldd, int off, bf* sm) {
  int nt = (R >> 6) * ((C + 63) >> 6);
  if (t < nt) { transpose_tile(src, R, C, dst, ldd, off, t, sm); return true; }
  t -= nt; return false;
}

__device__ __forceinline__ void phase0(const Params& p, char* smc) {
  bf* sm = (bf*)(smc + HB * HALF_LDS);
  const int perLayer = 32 * 218 + 256 + 256 + 512 + 128 + 1024 + 64 + 256;
  for (int task = VB; task < 2 * perLayer; task += G2) {
    int layer = task / perLayer; int t = task - layer * perLayer;
    bf* WbrL = p.WbrT + (size_t)layer * 2048 * YW;
    if (try_tr(t, p.w_in + (size_t)layer * DM * INW, 2048, INW, p.WinT + (size_t)layer * INW * 2048, 2048, 0, sm)) continue;
    if (try_tr(t, p.w_br_s5 + (size_t)layer * 512 * 2048, 512, 2048, WbrL, YW, 0, sm)) continue;
    if (try_tr(t, p.w_br_attn + (size_t)layer * 512 * 2048, 512, 2048, WbrL, YW, 512, sm)) continue;
    if (try_tr(t, p.w_br_ssd + (size_t)layer * 1024 * 2048, 1024, 2048, WbrL, YW, 1024, sm)) continue;
    if (try_tr(t, p.w_br_mem + (size_t)layer * 256 * 2048, 256, 2048, WbrL, YW, 2048, sm)) continue;
    if (try_tr(t, p.w_out + (size_t)layer * 2048 * 2048, 2048, 2048, p.WoutT + (size_t)layer * 2048 * 2048, 2048, 0, sm)) continue;
    if (try_tr(t, p.w_glu + (size_t)layer * 512 * 512, 512, 512, p.WgluT + (size_t)layer * 512 * 512, 512, 0, sm)) continue;
    if (try_tr(t, p.mem_w_kv + (size_t)layer * 2048 * 512, 2048, 512, p.WmemT + (size_t)layer * 512 * 2048, 2048, 0, sm)) continue;
  }
  const size_t gtid = (size_t)blockIdx.x * 512 + otid_full(), gstr = (size_t)gridDim.x * 512;
  for (size_t i0 = gtid; i0 < (size_t)TT * DM / 8; i0 += 4 * gstr) {
    float4 a[4], b[4];
#pragma unroll
    for (int k = 0; k < 4; k++) {
      const size_t i = i0 + k * gstr;
      if (i < (size_t)TT * DM / 8) { a[k] = *(const float4*)(p.x + i * 8); b[k] = *(const float4*)(p.x + i * 8 + 4); }
    }
#pragma unroll
    for (int k = 0; k < 4; k++) {
      const size_t i = i0 + k * gstr;
      if (i < (size_t)TT * DM / 8)
        *(uint4*)(p.xb + i * 8) = make_uint4(pk2(a[k].x, a[k].y), pk2(a[k].z, a[k].w), pk2(b[k].x, b[k].y), pk2(b[k].z, b[k].w));
    }
  }
  for (size_t i = gtid; i < (size_t)512 * DM / 8; i += gstr) {
    float4 a = *(const float4*)(p.mem + i * 8), b = *(const float4*)(p.mem + i * 8 + 4);
    *(uint4*)(p.memb + i * 8) = make_uint4(pk2(a.x, a.y), pk2(a.z, a.w), pk2(b.x, b.y), pk2(b.z, b.w));
  }
  for (size_t i = gtid; i < (size_t)TT; i += gstr) {
    const float ps = (float)p.pos[i];
#pragma unroll
    for (int j = 0; j < 8; j++) {
      float ang = ps * p.inv[j];
      float s, c; sincosf(ang, &s, &c);
      p.CS[i * 16 + j] = c; p.CS[i * 16 + 8 + j] = s;
    }
  }
  for (size_t i = gtid; i < 2 * 32 * 64; i += gstr) {
    int pp = (int)(i & 63), g = (int)((i >> 6) & 31), layer = (int)(i >> 11);
    float dt = expf(p.log_dt[layer * 32 + g]);
    float lr = p.lam_re[i], li = p.lam_im[i];
    float mag = expf(lr * dt);
    float sn, cs; sincosf(li * dt, &sn, &cs);
    float ar = mag * cs, ai = mag * sn;
    float den = lr * lr + li * li;
    float nr = ar - 1.f, ni = ai;
    float fr = (nr * lr + ni * li) / den, fi = (ni * lr - nr * li) / den;
    float* sb = p.SB + i * 32;
    const float* bre = p.b_re + i * 16; const float* bim = p.b_im + i * 16;
    for (int h = 0; h < 16; h++) {
      float br = bre[h], bi = bim[h];
      sb[h] = fr * br - fi * bi; sb[16 + h] = fr * bi + fi * br;
    }
    float pr = ar, pi = ai;
    for (int k = 0; k < 7; k++) { float nr2 = pr * pr - pi * pi, ni2 = 2.f * pr * pi; pr = nr2; pi = ni2; }
    p.SA[i * 4 + 0] = ar; p.SA[i * 4 + 1] = ai; p.SA[i * 4 + 2] = pr; p.SA[i * 4 + 3] = pi;
    for (int h = 0; h < 16; h++) {
      size_t ci = ((size_t)(layer * 32 + g) * 16 + h);
      p.CM[ci * 128 + pp] = f2bf(p.c_re[ci * 64 + pp]);
      p.CM[ci * 128 + 64 + pp] = f2bf(-p.c_im[ci * 64 + pp]);
    }
  }
}

__device__ __forceinline__ void phaseA(const Params& p, int layer) {
  const int tidf = otid_full();
  const int wid = __builtin_amdgcn_readfirstlane(tidf >> 6), lane = tidf & 63, wr = wid >> 2, wc = wid & 3, fr = lane & 15, fq = lane >> 4;
  const bf* Wl = p.WinT + (size_t)layer * INW * 2048;
  const int nA = 128 * 23;
  const int total = nA + (layer == 0 ? 8 : 0);
  for (int L = blockIdx.x; L < total; L += gridDim.x) {
    f32x4 acc[2][2][4][2]; ZERO_ACC8(acc);
    if (L < nA) {
      int pm, pn; tile_order(L, 128, 23, pm, pn);
      const int brow = pm * 256, bcol = pn * 256;
      gemm256(p.xb, 2048, Wl, 2048, 2048, brow, bcol, acc);
      int fr_o = fr; asm volatile("" : "+v"(fr_o));
#pragma unroll
      for (int ai = 0; ai < 2; ai++)
#pragma unroll
        for (int m = 0; m < 4; m++) {
          __builtin_amdgcn_sched_barrier(0);
          const int tok = brow + ai * 128 + wr * 64 + m * 16 + fr_o;
#pragma unroll
          for (int bj = 0; bj < 2; bj++)
#pragma unroll
            for (int n = 0; n < 2; n++) {
              const int cb = bcol + bj * 128 + wc * 32 + n * 16;
              f32x4 v = acc[ai][bj][m][n];
              if (n == 0 && (wc & 1) == 0 && ((cb >= C_ATQ && cb < C_ATV) || (cb >= C_IDQ && cb < C_IDW))) {
                f32x4 cs = *(const f32x4*)(p.CS + (size_t)tok * 16 + 4 * (fq & 1));
                f32x4 sn = *(const f32x4*)(p.CS + (size_t)tok * 16 + 8 + 4 * (fq & 1));
#pragma unroll
                for (int e = 0; e < 4; e++) {
                  float o = __shfl_xor(v[e], 32);
                  v[e] = (fq < 2) ? (v[e] * cs[e] - o * sn[e]) : (v[e] * cs[e] + o * sn[e]);
                }
              }
              const int nn = cb + fq * 4;
              if (nn < 5716) {
                const int dn = nn + (nn >= 2628 ? 12 : 0);
                uint2 pv = make_uint2(pk2(v[0], v[1]), pk2(v[2], v[3]));
                *(uint2*)(p.P + (size_t)tok * PW + dn) = pv;
                if (nn >= C_IDK && nn < C_IDW) {
                  const int d = nn - C_IDK; const int b = tok >> 14, li = tok & 16383;
                  size_t o = ((((size_t)(b * 512 + (li >> 5)) * 4 + (d >> 4)) * 64 + ((d >> 3) & 1) * 32 + (li & 31)) * 8) + (d & 7);
                  *(uint2*)(p.KIF + o) = pv;
                }
                if (nn >= C_ATK && nn < C_ATZ) *(uint2*)(p.KVC + (size_t)tok * 256 + (nn - C_ATK)) = pv;
              }
            }
        }
    } else {
      const int t8 = L - nA; const int ly = t8 >> 2, tm = (t8 >> 1) & 1, tn = t8 & 1;
      gemm256(p.memb, 2048, p.WmemT + (size_t)ly * 512 * 2048, 2048, 2048, tm * 256, tn * 256, acc);
#pragma unroll
      for (int ai = 0; ai < 2; ai++)
#pragma unroll
        for (int m = 0; m < 4; m++) {
          const int row = tm * 256 + ai * 128 + wr * 64 + m * 16 + fr; const int b = row >> 8, mm = row & 255;
#pragma unroll
          for (int bj = 0; bj < 2; bj++)
#pragma unroll
            for (int n = 0; n < 2; n++)
#pragma unroll
              for (int e = 0; e < 4; e++) {
                const int nn = tn * 256 + bj * 128 + wc * 32 + n * 16 + fq * 4 + e; const float v = acc[ai][bj][m][n][e];
                if (nn < 256) { int h = nn >> 6, d = nn & 63; p.MK[((((size_t)ly * 2 + b) * 4 + h) * 256 + mm) * 64 + d] = f2bf(v); }
                else { int h = (nn - 256) >> 6, d = nn & 63; p.MVT[((((size_t)ly * 2 + b) * 4 + h) * 64 + d) * 256 + mm] = f2bf(v); }
              }
        }
    }
  }
}

__device__ __forceinline__ float softplusf_(float x) {
  const float e = __expf(x);
  const float sp = (e < 0.01f) ? e * (1.f - 0.5f * e) : __logf(1.f + e);
  return x > 15.f ? x : sp;
}

__device__ __forceinline__ void ssd_dt_acs(const Params& p, int layer, size_t tok0, int gg, float* sAcs, float* sDt) {
  const int tid = otid(), lane = tid & 63, w = tid >> 6;
#pragma unroll
  for (int k = 0; k < 2; k++) {
    const int hh = 2 * w + k, hd = gg * 8 + hh;
    const float bias = p.dt_bias[layer * 16 + hd], a = -__expf(p.a_log[layer * 16 + hd]);
    const int l0 = 2 * lane;
    float d0 = softplusf_(bf2f(p.P[(tok0 + l0) * PW + C_SDT + hd]) + bias);
    float d1 = softplusf_(bf2f(p.P[(tok0 + l0 + 1) * PW + C_SDT + hd]) + bias);
    float s0 = d0 * a, s1 = s0 + d1 * a;
    float xs = s1;
#pragma unroll
    for (int off = 1; off < 64; off <<= 1) { float v = __shfl_up(xs, off); if (lane >= off) xs += v; }
    float ex = xs - s1;
    sAcs[l0 * 8 + hh] = ex + s0; sAcs[(l0 + 1) * 8 + hh] = ex + s1;
    sDt[l0 * 8 + hh] = d0; sDt[(l0 + 1) * 8 + hh] = d1;
  }
}

struct Conv2 { float w0[4], w1[4], b0, b1, h0[3], h1[3]; };
__device__ __forceinline__ void conv_init(const Params& p, int layer, size_t tokb, int l, int ch, Conv2& c) {
  const float* cw = p.conv_w + (size_t)layer * 4 * 1536 + ch;
#pragma unroll
  for (int k = 0; k < 4; k++) { c.w0[k] = cw[k * 1536]; c.w1[k] = cw[k * 1536 + 1]; }
  c.b0 = p.conv_b[layer * 1536 + ch]; c.b1 = p.conv_b[layer * 1536 + ch + 1];
#pragma unroll
  for (int k = 0; k < 3; k++) {
    int ll = l - 3 + k; unsigned u = 0;
    if (ll >= 0) u = *(const unsigned*)(p.P + (tokb + ll) * PW + C_XBC + ch);
    c.h0[k] = bflo(u); c.h1[k] = bfhi(u);
  }
}
__device__ __forceinline__ void conv_step(const Params& p, size_t tokb, int l, int ch, Conv2& c, float& o0, float& o1) {
  unsigned u = *(const unsigned*)(p.P + (tokb + l) * PW + C_XBC + ch);
  float x0 = bflo(u), x1 = bfhi(u);
  float a0 = c.b0 + c.w0[0] * c.h0[0] + c.w0[1] * c.h0[1] + c.w0[2] * c.h0[2] + c.w0[3] * x0;
  float a1 = c.b1 + c.w1[0] * c.h1[0] + c.w1[1] * c.h1[1] + c.w1[2] * c.h1[2] + c.w1[3] * x1;
  c.h0[0] = c.h0[1]; c.h0[1] = c.h0[2]; c.h0[2] = x0;
  c.h1[0] = c.h1[1]; c.h1[1] = c.h1[2]; c.h1[2] = x1;
  o0 = siluf_(a0); o1 = siluf_(a1);
}

__device__ __forceinline__ void conv_val(unsigned u, Conv2& c, float& o0, float& o1) {
  float x0 = bflo(u), x1 = bfhi(u);
  float a0 = c.b0 + c.w0[0] * c.h0[0] + c.w0[1] * c.h0[1] + c.w0[2] * c.h0[2] + c.w0[3] * x0;
  float a1 = c.b1 + c.w1[0] * c.h1[0] + c.w1[1] * c.h1[1] + c.w1[2] * c.h1[2] + c.w1[3] * x1;
  c.h0[0] = c.h0[1]; c.h0[1] = c.h0[2]; c.h0[2] = x0;
  c.h1[0] = c.h1[1]; c.h1[1] = c.h1[2]; c.h1[2] = x1;
  o0 = siluf_(a0); o1 = siluf_(a1);
}
#define CONV_PRELOAD(raw, N, lfirst, nrows, ch)                                                           \
  unsigned raw[N];                                                                                        \
  _Pragma("unroll") for (int k_ = 0; k_ < N; k_++)                                                        \
    raw[k_] = (k_ < (nrows)) ? *(const unsigned*)(p.P + (tokb + (lfirst) + k_) * PW + C_XBC + (ch)) : 0u;

__device__ __forceinline__ void ssd_pass1(const Params& p, int layer, int task, char* sm) {
  const int tid = otid(), lane = tid & 63, w = tid >> 6, r32 = lane & 31, h5 = lane >> 5;
  const int gg = task & 1, c = (task >> 1) & 127, b = task >> 8;
  const size_t tokb = (size_t)b * LSEQ; const int lc0 = c * 128; const size_t tok0 = tokb + lc0;
  float* sAcs = (float*)sm; float* sDt = (float*)(sm + 4096);
  bf* sBT = (bf*)(sm + 8192); bf* sXT = (bf*)(sm + 43008);
  __syncthreads();
  ssd_dt_acs(p, layer, tok0, gg, sAcs, sDt);
  {
    const int cp = tid & 63, tg = tid >> 6; const int ch = 1024 + gg * 128 + 2 * cp;
    Conv2 cv; conv_init(p, layer, tokb, lc0 + tg * 32, ch, cv);
    CONV_PRELOAD(raw, 32, lc0 + tg * 32, 32, ch)
#pragma unroll
    for (int k = 0; k < 32; k += 2) {
      const int l = tg * 32 + k;
      float a0, a1, b0, b1;
      conv_val(raw[k], cv, a0, a1);
      conv_val(raw[k + 1], cv, b0, b1);
      *(unsigned*)(sBT + (2 * cp) * 136 + l) = pk2(a0, b0);
      *(unsigned*)(sBT + (2 * cp + 1) * 136 + l) = pk2(a1, b1);
    }
  }
  __syncthreads();
  if (tid < 8) p.CD[((size_t)(b * 128 + c)) * 16 + gg * 8 + tid] = __expf(sAcs[127 * 8 + tid]);
  for (int hh = 0; hh < 8; hh++) {
    const int hd = gg * 8 + hh;
    if (hh) __syncthreads();
    {
      const int cp = tid & 31, tg = tid >> 5; const int ch = gg * 512 + hh * 64 + 2 * cp;
      const float aend = sAcs[127 * 8 + hh];
      Conv2 cv; conv_init(p, layer, tokb, lc0 + tg * 16, ch, cv);
      CONV_PRELOAD(raw, 16, lc0 + tg * 16, 16, ch)
#pragma unroll
      for (int k = 0; k < 16; k += 2) {
        const int l = tg * 16 + k;
        float a0, a1, b0, b1;
        conv_val(raw[k], cv, a0, a1);
        conv_val(raw[k + 1], cv, b0, b1);
        float sa = sDt[l * 8 + hh] * __expf(aend - sAcs[l * 8 + hh]);
        float sb = sDt[(l + 1) * 8 + hh] * __expf(aend - sAcs[(l + 1) * 8 + hh]);
        *(unsigned*)(sXT + (2 * cp) * 136 + l) = pk2(a0 * sa, b0 * sb);
        *(unsigned*)(sXT + (2 * cp + 1) * 136 + l) = pk2(a1 * sa, b1 * sb);
      }
    }
    __syncthreads();
    f32x16 acc[2];
#pragma unroll
    for (int r = 0; r < 16; r++) { const float z_ = ozero(); acc[0][r] = z_; acc[1][r] = z_; }
#pragma unroll
    for (int ks = 0; ks < 8; ks++) {
      bf16x8 bfr = *(const bf16x8*)(sBT + (32 * w + r32) * 136 + ks * 16 + 8 * h5);
      bf16x8 x0 = *(const bf16x8*)(sXT + (r32) * 136 + ks * 16 + 8 * h5);
      bf16x8 x1 = *(const bf16x8*)(sXT + (32 + r32) * 136 + ks * 16 + 8 * h5);
      acc[0] = mfma32(x0, bfr, acc[0]);
      acc[1] = mfma32(x1, bfr, acc[1]);
    }
    float* st = p.ST + ((size_t)(b * 128 + c) * 16 + hd) * 64 * 128;
#pragma unroll
    for (int pi = 0; pi < 2; pi++)
#pragma unroll
      for (int r = 0; r < 16; r++) {
        int pp = 32 * pi + 8 * (r >> 2) + 4 * h5 + (r & 3);
        st[pp * 128 + 32 * w + r32] = acc[pi][r];
      }
  }
}

__device__ __forceinline__ void ssd_statepass(const Params& p, int task) {
  const int idx = task * 256 + otid();
  const int b = idx >> 15, e4 = idx & 32767;
  const int hd = e4 >> 11;
  const float zc_ = ozero(); float4 carry = make_float4(zc_, zc_, zc_, zc_);
  float* base = p.ST + (size_t)b * 128 * 131072 + (size_t)e4 * 4;
  const float* cd = p.CD + (size_t)b * 128 * 16 + hd;
  for (int c0 = 0; c0 < 128; c0 += 4) {
    float4 v[4]; float d[4];
#pragma unroll
    for (int k = 0; k < 4; k++) { v[k] = *(const float4*)(base + (size_t)(c0 + k) * 131072); d[k] = cd[(c0 + k) * 16]; }
#pragma unroll
    for (int k = 0; k < 4; k++) {
      *(float4*)(base + (size_t)(c0 + k) * 131072) = carry;
      carry.x = carry.x * d[k] + v[k].x; carry.y = carry.y * d[k] + v[k].y;
      carry.z = carry.z * d[k] + v[k].z; carry.w = carry.w * d[k] + v[k].w;
    }
  }
}

__device__ __forceinline__ void ssd_pass2(const Params& p, int layer, int task, char* sm) {
  const int tid = otid(), lane = tid & 63, w = tid >> 6, r32 = lane & 31, h5 = lane >> 5;
  const int lh = task & 1, gg = (task >> 1) & 1, c = (task >> 2) & 127, b = task >> 9;
  const size_t tokb = (size_t)b * LSEQ; const int lc0 = c * 128; const size_t tok0 = tokb + lc0;
  float* sAcs = (float*)sm; float* sDt = (float*)(sm + 4096);
  bf* sC = (bf*)(sm + 8192); bf* sB = (bf*)(sm + 25600); bf* sM = (bf*)(sm + 25600); bf* sXT = (bf*)(sm + 43008);
  float* sSsq = (float*)(sm + 60416);
  const int wr = w >> 1, wc = w & 1;
  const int nS = 64 * (lh + 1);
  __syncthreads();
  ssd_dt_acs(p, layer, tok0, gg, sAcs, sDt);
  {
    const int cp = tid & 63, tg = tid >> 6;
    {
      const int ch = 1280 + gg * 128 + 2 * cp;
      const int lst = 64 * lh + tg * 16;
      Conv2 cv; conv_init(p, layer, tokb, lc0 + lst, ch, cv);
      CONV_PRELOAD(raw, 16, lc0 + lst, 16, ch)
#pragma unroll
      for (int k = 0; k < 16; k++) {
        const int l = lst + k;
        float a0, a1; conv_val(raw[k], cv, a0, a1);
        *(unsigned*)(sC + (l - 64 * lh) * 136 + 2 * cp) = pk2(a0, a1);
      }
    }
    {
      const int ch = 1024 + gg * 128 + 2 * cp;
      const int per = nS >> 2; const int lst = tg * per;
      Conv2 cv; conv_init(p, layer, tokb, lc0 + lst, ch, cv);
      CONV_PRELOAD(raw, 32, lc0 + lst, per, ch)
#pragma unroll
      for (int k = 0; k < 32; k++) {
        if (k < per) {
          const int l = lst + k;
          float a0, a1; conv_val(raw[k], cv, a0, a1);
          *(unsigned*)(sB + l * 136 + 2 * cp) = pk2(a0, a1);
        }
      }
    }
  }
  __syncthreads();
  f32x16 cb[2];
#pragma unroll
  for (int r = 0; r < 16; r++) { const float z_ = ozero(); cb[0][r] = z_; cb[1][r] = z_; }
  if (64 * wc < nS) {
#pragma unroll
    for (int ks = 0; ks < 8; ks++) {
      bf16x8 af = *(const bf16x8*)(sC + (32 * wr + r32) * 136 + ks * 16 + 8 * h5);
      bf16x8 b0 = *(const bf16x8*)(sB + (64 * wc + r32) * 136 + ks * 16 + 8 * h5);
      bf16x8 b1 = *(const bf16x8*)(sB + (64 * wc + 32 + r32) * 136 + ks * 16 + 8 * h5);
      cb[0] = mfma32(af, b0, cb[0]);
      cb[1] = mfma32(af, b1, cb[1]);
    }
  }
  __syncthreads();
  const int wc2 = w & 1;
  for (int hh = 0; hh < 8; hh++) {
    const int hd = gg * 8 + hh;
    if (hh) __syncthreads();
    bf16x8 pfr[8];
    {
      const float* pv = p.ST + (((size_t)(b * 128 + c) * 16 + hd) * 64 + 32 * wc2 + r32) * 128 + 8 * h5;
#pragma unroll
      for (int ks = 0; ks < 8; ks++) {
        float4 u0 = *(const float4*)(pv + ks * 16), u1 = *(const float4*)(pv + ks * 16 + 4);
        unsigned q0 = pk2(u0.x, u0.y), q1 = pk2(u0.z, u0.w), q2 = pk2(u1.x, u1.y), q3 = pk2(u1.z, u1.w);
        pfr[ks][0] = (short)(q0 & 0xFFFF); pfr[ks][1] = (short)(q0 >> 16); pfr[ks][2] = (short)(q1 & 0xFFFF); pfr[ks][3] = (short)(q1 >> 16);
        pfr[ks][4] = (short)(q2 & 0xFFFF); pfr[ks][5] = (short)(q2 >> 16); pfr[ks][6] = (short)(q3 & 0xFFFF); pfr[ks][7] = (short)(q3 >> 16);
      }
    }
    {
      const float dsk = p.ssd_d[layer * 16 + hd];
#pragma unroll
      for (int j = 0; j < 2; j++) {
        const int s = 64 * wc + 32 * j + r32;
        if (s < nS) {
          const float as = sAcs[s * 8 + hh];
#pragma unroll
          for (int r = 0; r < 16; r++) {
            const int lp = 32 * wr + 8 * (r >> 2) + 4 * h5 + (r & 3); const int l = 64 * lh + lp;
            float v = 0.f;
            if (s <= l) v = cb[j][r] * __expf(sAcs[l * 8 + hh] - as);
            if (s == l) v += dsk * __builtin_amdgcn_rcpf(sDt[l * 8 + hh]);
            sM[lp * 136 + s] = f2bf(v);
          }
        }
      }
    }
    {
      const int cp = tid & 31, tg = tid >> 5; const int ch = gg * 512 + hh * 64 + 2 * cp;
      const int per = nS >> 3; const int lst = tg * per;
      Conv2 cv; conv_init(p, layer, tokb, lc0 + lst, ch, cv);
      CONV_PRELOAD(raw, 16, lc0 + lst, per, ch)
#pragma unroll
      for (int k = 0; k < 16; k += 2) {
        if (k >= per) break;
        const int l = lst + k;
        float a0, a1, b0, b1;
        conv_val(raw[k], cv, a0, a1);
        conv_val(raw[k + 1], cv, b0, b1);
        float sa = sDt[l * 8 + hh], sb = sDt[(l + 1) * 8 + hh];
        *(unsigned*)(sXT + (2 * cp) * 136 + l) = pk2(a0 * sa, b0 * sb);
        *(unsigned*)(sXT + (2 * cp + 1) * 136 + l) = pk2(a1 * sa, b1 * sb);
      }
    }
    __syncthreads();
    f32x16 yd, yo;
#pragma unroll
    for (int r = 0; r < 16; r++) { const float z_ = ozero(); yd[r] = z_; yo[r] = z_; }
    const int nks = nS >> 4;
    for (int ks = 0; ks < nks; ks++) {
      bf16x8 xf = *(const bf16x8*)(sXT + (32 * wc2 + r32) * 136 + ks * 16 + 8 * h5);
      bf16x8 mf = *(const bf16x8*)(sM + (32 * wr + r32) * 136 + ks * 16 + 8 * h5);
      yd = mfma32(xf, mf, yd);
    }
    {
#pragma unroll
      for (int ks = 0; ks < 8; ks++) {
        bf16x8 cf = *(const bf16x8*)(sC + (32 * wr + r32) * 136 + ks * 16 + 8 * h5);
        yo = mfma32(pfr[ks], cf, yo);
      }
    }
    {
      const int lp = 32 * wr + r32; const int l = 64 * lh + lp; const size_t tok = tok0 + l;
      const float eo = __expf(sAcs[l * 8 + hh]);
      float ss = 0.f;
#pragma unroll
      for (int q = 0; q < 4; q++) {
        const int pp = 32 * wc2 + 8 * q + 4 * h5;
        uint2 zz = *(const uint2*)(p.P + tok * PW + C_SSZ + hd * 64 + pp);
        float v0 = (yd[4 * q] + eo * yo[4 * q]) * siluf_(bflo(zz.x));
        float v1 = (yd[4 * q + 1] + eo * yo[4 * q + 1]) * siluf_(bfhi(zz.x));
        float v2 = (yd[4 * q + 2] + eo * yo[4 * q + 2]) * siluf_(bflo(zz.y));
        float v3 = (yd[4 * q + 3] + eo * yo[4 * q + 3]) * siluf_(bfhi(zz.y));
        ss += v0 * v0 + v1 * v1 + v2 * v2 + v3 * v3;
        *(uint2*)(p.Y + tok * YW + Y_SSD + hd * 64 + pp) = make_uint2(pk2(v0, v1), pk2(v2, v3));
      }
      sSsq[lp * 32 + hh * 4 + wc2 * 2 + h5] = ss;
    }
  }
  __syncthreads();
  {
    const int lp = tid >> 2, part = tid & 3; const size_t tok = tok0 + 64 * lh + lp;
    float tot = 0.f;
#pragma unroll
    for (int k = 0; k < 32; k += 4) { float4 v4 = *(const float4*)(sSsq + lp * 32 + k); tot += (v4.x + v4.y) + (v4.z + v4.w); }
    const float rs = rsqrtf(tot * (1.f / 512.f) + 1e-5f);
    bf* yp = p.Y + tok * YW + Y_SSD + gg * 512 + part * 128;
    const float* ng = p.norm_g + layer * 1024 + gg * 512 + part * 128;
#pragma unroll 4
    for (int i = 0; i < 16; i++) {
      uint4 u = *(const uint4*)(yp + i * 8);
      float4 g0 = *(const float4*)(ng + i * 8), g1 = *(const float4*)(ng + i * 8 + 4);
      u.x = pk2(bflo(u.x) * rs * g0.x, bfhi(u.x) * rs * g0.y);
      u.y = pk2(bflo(u.y) * rs * g0.z, bfhi(u.y) * rs * g0.w);
      u.z = pk2(bflo(u.z) * rs * g1.x, bfhi(u.z) * rs * g1.y);
      u.w = pk2(bflo(u.w) * rs * g1.z, bfhi(u.w) * rs * g1.w);
      *(uint4*)(yp + i * 8) = u;
    }
  }
}

__device__ __forceinline__ void s5_ld_u(const Params& p, size_t tok, int g, uint4& a, uint4& b) {
  const uint4* src = (const uint4*)(p.P + tok * PW + C_S5U + g * 16);
  a = src[0]; b = src[1];
}
__device__ __forceinline__ void s5_st_u(float* dst, const uint4 a, const uint4 b) {
  *(float4*)(dst + 0) = make_float4(bflo(a.x), bfhi(a.x), bflo(a.y), bfhi(a.y));
  *(float4*)(dst + 4) = make_float4(bflo(a.z), bfhi(a.z), bflo(a.w), bfhi(a.w));
  *(float4*)(dst + 8) = make_float4(bflo(b.x), bfhi(b.x), bflo(b.y), bfhi(b.y));
  *(float4*)(dst + 12) = make_float4(bflo(b.z), bfhi(b.z), bflo(b.w), bfhi(b.w));
}
__device__ __forceinline__ void s5_load_u(const Params& p, size_t tok, int g, float* dst) {
  const uint4* src = (const uint4*)(p.P + tok * PW + C_S5U + g * 16);
  uint4 a = src[0], b = src[1];
  *(float4*)(dst + 0) = make_float4(bflo(a.x), bfhi(a.x), bflo(a.y), bfhi(a.y));
  *(float4*)(dst + 4) = make_float4(bflo(a.z), bfhi(a.z), bflo(a.w), bfhi(a.w));
  *(float4*)(dst + 8) = make_float4(bflo(b.x), bfhi(b.x), bflo(b.y), bfhi(b.y));
  *(float4*)(dst + 12) = make_float4(bflo(b.z), bfhi(b.z), bflo(b.w), bfhi(b.w));
}
typedef float f32x2 __attribute__((ext_vector_type(2)));
#define S5_STEP(uu)                                                                     \
  {                                                                                     \
    float4 u0 = *(const float4*)((uu)), u1 = *(const float4*)((uu) + 4), u2 = *(const float4*)((uu) + 8), u3 = *(const float4*)((uu) + 12); \
    f32x2 bb = B2[0] * (f32x2){u0.x, u0.x};                                             \
    bb = B2[1] * (f32x2){u0.y, u0.y} + bb; bb = B2[2] * (f32x2){u0.z, u0.z} + bb; bb = B2[3] * (f32x2){u0.w, u0.w} + bb;     \
    bb = B2[4] * (f32x2){u1.x, u1.x} + bb; bb = B2[5] * (f32x2){u1.y, u1.y} + bb; bb = B2[6] * (f32x2){u1.z, u1.z} + bb; bb = B2[7] * (f32x2){u1.w, u1.w} + bb; \
    bb = B2[8] * (f32x2){u2.x, u2.x} + bb; bb = B2[9] * (f32x2){u2.y, u2.y} + bb; bb = B2[10] * (f32x2){u2.z, u2.z} + bb; bb = B2[11] * (f32x2){u2.w, u2.w} + bb; \
    bb = B2[12] * (f32x2){u3.x, u3.x} + bb; bb = B2[13] * (f32x2){u3.y, u3.y} + bb; bb = B2[14] * (f32x2){u3.z, u3.z} + bb; bb = B2[15] * (f32x2){u3.w, u3.w} + bb; \
    float nr_ = ar * sr - ai * si + bb.x; float ni_ = ar * si + ai * sr + bb.y; sr = nr_; si = ni_; \
  }

__device__ __forceinline__ void s5_pass1(const Params& p, int layer, int task, char* sm) {
  const int tid = otid(), lane = tid & 63, w = tid >> 6;
  const int gq = task & 7, c = (task >> 3) & 127, b = task >> 10;
  const int g = gq * 4 + w;
  const size_t tok0 = (size_t)b * LSEQ + c * 128;
  float* sU = (float*)(sm + w * 8192);
  __syncthreads();
  s5_load_u(p, tok0 + lane, g, sU + lane * 16);
  s5_load_u(p, tok0 + 64 + lane, g, sU + (64 + lane) * 16);
  const size_t pi = ((size_t)(layer * 32 + g)) * 64 + lane;
  f32x2 B2[16];
#pragma unroll
  for (int h = 0; h < 16; h++) { B2[h].x = p.SB[pi * 32 + h]; B2[h].y = p.SB[pi * 32 + 16 + h]; }
  const float ar = p.SA[pi * 4], ai = p.SA[pi * 4 + 1];
  float sr = 0.f, si = 0.f;
  __builtin_amdgcn_wave_barrier();
  for (int l = 0; l < 128; l++) S5_STEP(sU + l * 16)
  *(float2*)(p.END + (((size_t)(b * 128 + c) * 32 + g) * 64 + lane) * 2) = make_float2(sr, si);
}

__device__ __forceinline__ void s5_carry(const Params& p, int layer, int task) {
  const int idx = task * 256 + otid();
  const int b = idx >> 11, gp = idx & 2047;
  const size_t pi = (size_t)layer * 2048 + gp;
  const float a128r = p.SA[pi * 4 + 2], a128i = p.SA[pi * 4 + 3];
  float sr = ozero(), si = ozero();
  float2* e = (float2*)p.END + (size_t)b * 128 * 2048 + gp;
  for (int c0 = 0; c0 < 128; c0 += 4) {
    float2 v[4];
#pragma unroll
    for (int k = 0; k < 4; k++) v[k] = e[(size_t)(c0 + k) * 2048];
#pragma unroll
    for (int k = 0; k < 4; k++) {
      e[(size_t)(c0 + k) * 2048] = make_float2(sr, si);
      float nr = a128r * sr - a128i * si + v[k].x, ni = a128r * si + a128i * sr + v[k].y; sr = nr; si = ni;
    }
  }
}

__device__ __forceinline__ void s5_pass2(const Params& p, int layer, int task, char* sm) {
  const int tid = otid(), lane = tid & 63, w = tid >> 6;
  const int c = task & 127, b = task >> 7;
  const size_t tok0 = (size_t)b * LSEQ + c * 128;
  float* sU = (float*)(sm + w * 10752); bf* sS = (bf*)(sm + w * 10752 + 2048);
  __syncthreads();
  uint4 ua, ub;
  s5_ld_u(p, tok0 + (lane & 31), w * 8, ua, ub);
  for (int gi = 0; gi < 8; gi++) {
    const int g = w * 8 + gi;
    const size_t pi = ((size_t)(layer * 32 + g)) * 64 + lane;
    f32x2 B2[16];
#pragma unroll
    for (int h = 0; h < 16; h++) { B2[h].x = p.SB[pi * 32 + h]; B2[h].y = p.SB[pi * 32 + 16 + h]; }
    const float ar = p.SA[pi * 4], ai = p.SA[pi * 4 + 1];
    float2 s0 = *(const float2*)(p.END + (((size_t)(b * 128 + c) * 32 + g) * 64 + lane) * 2);
    float sr = s0.x, si = s0.y;
    bf16x8 cf[4];
    {
      const bf* cm = p.CM + (((size_t)(layer * 32 + g)) * 16 + (lane & 15)) * 128 + 8 * (lane >> 4);
#pragma unroll
      for (int ks = 0; ks < 4; ks++) cf[ks] = *(const bf16x8*)(cm + ks * 32);
    }
    const float dsk = p.s5_d[(layer * 32 + g) * 16 + (lane & 15)];
    for (int sub = 0; sub < 4; sub++) {
      __builtin_amdgcn_wave_barrier();
      if (lane < 32) s5_st_u(sU + lane * 16, ua, ub);
      {
        const int nsub = (sub + 1) & 3; const int ng = g + (sub == 3 ? 1 : 0);
        if (sub < 3 || gi < 7) s5_ld_u(p, tok0 + nsub * 32 + (lane & 31), ng, ua, ub);
      }
      __builtin_amdgcn_wave_barrier();
      for (int l = 0; l < 32; l++) {
        S5_STEP(sU + l * 16)
        sS[l * 136 + lane] = f2bf(sr); sS[l * 136 + 64 + lane] = f2bf(si);
      }
      __builtin_amdgcn_wave_barrier();
#pragma unroll
      for (int mb = 0; mb < 2; mb++) {
        const float z_ = ozero(); f32x4 acc = {z_, z_, z_, z_};
#pragma unroll
        for (int ks = 0; ks < 4; ks++) {
          bf16x8 af = *(const bf16x8*)(sS + (16 * mb + (lane & 15)) * 136 + ks * 32 + 8 * (lane >> 4));
          acc = mfma16(af, cf[ks], acc);
        }
#pragma unroll
        for (int r = 0; r < 4; r++) {
          const int l = 16 * mb + 4 * (lane >> 4) + r;
          float y = acc[r] + dsk * sU[l * 16 + (lane & 15)];
          p.YG[(tok0 + sub * 32 + l) * 512 + g * 16 + (lane & 15)] = f2bf(geluf_(y));
        }
      }
    }
  }
  __syncthreads();
  const int wr = w >> 1, wc = w & 1, r32 = lane & 31, h5 = lane >> 5;
  for (int tn = 0; tn < 4; tn++) {
    f32x16 acc[2][2]; ZERO_ACC(acc);
    gemm_acc<4>(p.YG + tok0 * 512, 512, p.WgluT + ((size_t)layer * 512 + tn * 128) * 512, 512, 512, acc, sm);
#pragma unroll
    for (int i = 0; i < 2; i++) {
      const size_t tok = tok0 + wr * 64 + i * 32 + r32;
#pragma unroll
      for (int j = 0; j < 2; j++)
#pragma unroll
        for (int q = 0; q < 4; q++) {
          const int n = tn * 128 + wc * 64 + j * 32 + q * 8 + h5 * 4;
          float4 bg = *(const float4*)(p.b_glu + layer * 512 + n);
          uint2 yy = *(const uint2*)(p.YG + tok * 512 + n);
          uint2 zz = *(const uint2*)(p.P + tok * PW + C_S5Z + n);
          float o0 = bflo(yy.x) * sigmoidf_(acc[i][j][4 * q] + bg.x) * siluf_(bflo(zz.x));
          float o1 = bfhi(yy.x) * sigmoidf_(acc[i][j][4 * q + 1] + bg.y) * siluf_(bfhi(zz.x));
          float o2 = bflo(yy.y) * sigmoidf_(acc[i][j][4 * q + 2] + bg.z) * siluf_(bflo(zz.y));
          float o3 = bfhi(yy.y) * sigmoidf_(acc[i][j][4 * q + 3] + bg.w) * siluf_(bfhi(zz.y));
          *(uint2*)(p.Y + tok * YW + Y_S5 + n) = make_uint2(pk2(o0, o1), pk2(o2, o3));
        }
    }
  }
}

__device__ __forceinline__ void mem_attn(const Params& p, int layer, int task) {
  const int tid = otid(), lane = tid & 63, h = tid >> 6;
  const int n16 = lane & 15, kq = lane >> 4;
  const size_t tok0 = (size_t)task * 16; const int b = (int)(tok0 >> 14);
  const bf* mk = p.MK + (((size_t)layer * 2 + b) * 4 + h) * 256 * 64;
  const bf* mvt = p.MVT + (((size_t)layer * 2 + b) * 4 + h) * 64 * 256;
  bf16x8 qf[2];
  {
    const bf* qp = p.P + (tok0 + n16) * PW + C_MEQ + h * 64 + 8 * kq;
    qf[0] = *(const bf16x8*)qp; qf[1] = *(const bf16x8*)(qp + 32);
  }
  f32x4 st[16];
#pragma unroll
  for (int kb = 0; kb < 16; kb++) {
    const bf* kp = mk + (size_t)(16 * kb + n16) * 64 + 8 * kq;
    bf16x8 a0 = *(const bf16x8*)kp, a1 = *(const bf16x8*)(kp + 32);
    const float z_ = ozero(); f32x4 acc = {z_, z_, z_, z_};
    acc = mfma16(a0, qf[0], acc); acc = mfma16(a1, qf[1], acc);
    st[kb] = acc * 0.125f;
  }
  float mx = -3.0e38f;
#pragma unroll
  for (int kb = 0; kb < 16; kb++)
#pragma unroll
    for (int r = 0; r < 4; r++) mx = fmaxf(mx, st[kb][r]);
  mx = fmaxf(mx, __shfl_xor(mx, 16)); mx = fmaxf(mx, __shfl_xor(mx, 32));
  float sum = 0.f;
#pragma unroll
  for (int kb = 0; kb < 16; kb++)
#pragma unroll
    for (int r = 0; r < 4; r++) { float e = __expf(st[kb][r] - mx); st[kb][r] = e; sum += e; }
  sum += __shfl_xor(sum, 16); sum += __shfl_xor(sum, 32);
  const float rinv = 1.f / sum;
  f32x4 o[4];
#pragma unroll
  for (int mb = 0; mb < 4; mb++) { const float z_ = ozero(); o[mb] = (f32x4){z_, z_, z_, z_}; }
#pragma unroll
  for (int k2 = 0; k2 < 8; k2++) {
    bf16x8 pf;
    unsigned q0 = pk2(st[2 * k2][0], st[2 * k2][1]), q1 = pk2(st[2 * k2][2], st[2 * k2][3]);
    unsigned q2 = pk2(st[2 * k2 + 1][0], st[2 * k2 + 1][1]), q3 = pk2(st[2 * k2 + 1][2], st[2 * k2 + 1][3]);
    pf[0] = (short)(q0 & 0xFFFF); pf[1] = (short)(q0 >> 16); pf[2] = (short)(q1 & 0xFFFF); pf[3] = (short)(q1 >> 16);
    pf[4] = (short)(q2 & 0xFFFF); pf[5] = (short)(q2 >> 16); pf[6] = (short)(q3 & 0xFFFF); pf[7] = (short)(q3 >> 16);
#pragma unroll
    for (int mb = 0; mb < 4; mb++) {
      const bf* vp = mvt + (size_t)(16 * mb + n16) * 256 + 32 * k2 + 4 * kq;
      uint2 v0 = *(const uint2*)vp, v1 = *(const uint2*)(vp + 16);
      bf16x8 af;
      af[0] = (short)(v0.x & 0xFFFF); af[1] = (short)(v0.x >> 16); af[2] = (short)(v0.y & 0xFFFF); af[3] = (short)(v0.y >> 16);
      af[4] = (short)(v1.x & 0xFFFF); af[5] = (short)(v1.x >> 16); af[6] = (short)(v1.y & 0xFFFF); af[7] = (short)(v1.y >> 16);
      o[mb] = mfma16(af, pf, o[mb]);
    }
  }
  const size_t tok = tok0 + n16;
#pragma unroll
  for (int mb = 0; mb < 4; mb++) {
    const int d = 16 * mb + 4 * kq;
    uint2 zz = *(const uint2*)(p.P + tok * PW + C_MEZ + h * 64 + d);
    float v0 = o[mb][0] * rinv * siluf_(bflo(zz.x)), v1 = o[mb][1] * rinv * siluf_(bfhi(zz.x));
    float v2 = o[mb][2] * rinv * siluf_(bflo(zz.y)), v3 = o[mb][3] * rinv * siluf_(bfhi(zz.y));
    *(uint2*)(p.Y + tok * YW + Y_MEM + h * 64 + d) = make_uint2(pk2(v0, v1), pk2(v2, v3));
  }
}

__device__ __forceinline__ void dsa_wave(const Params& p, int rank, char* sm) {
  const int tid = otid(), lane = tid & 63, w = tid >> 6, r32 = lane & 31, h5 = lane >> 5;
  const int b = rank & 1, qg = 2047 - (rank >> 1), l0 = qg * 8;
  const size_t tokb = (size_t)b * LSEQ;
  unsigned* cand = (unsigned*)(sm + w * (8 * CAP * 4));
  bf* Pb = (bf*)(sm + 61440 + w * 4096);
  bf16x8 aq[4];
  {
    const bf* qp = p.P + (tokb + l0 + (r32 >> 2)) * PW + C_IDQ + (r32 & 3) * 64 + 8 * h5;
#pragma unroll
    for (int ks = 0; ks < 4; ks++) aq[ks] = *(const bf16x8*)(qp + ks * 16);
  }
  float wv[4][4]; int ql[4];
#pragma unroll
  for (int g = 0; g < 4; g++) {
    ql[g] = l0 + 2 * g + h5;
    uint2 u = *(const uint2*)(p.P + (tokb + ql[g]) * PW + C_IDW);
    wv[g][0] = bflo(u.x) * 0.0625f; wv[g][1] = bfhi(u.x) * 0.0625f; wv[g][2] = bflo(u.y) * 0.0625f; wv[g][3] = bfhi(u.y) * 0.0625f;
  }
  unsigned Tg[4] = {0u, 0u, 0u, 0u}; float Tf[4];
  unsigned Tq = 0u; int cntv = 0;
  int nrep_ = (PROBE_MASK & 32) ? 2 : 1; asm volatile("" : "+s"(nrep_));
#pragma unroll 1
  for (int rep_ = 0; rep_ < nrep_; rep_++) {
  Tg[0] = Tg[1] = Tg[2] = Tg[3] = 0u; Tq = 0u; cntv = 0;
  Tf[0] = Tf[1] = Tf[2] = Tf[3] = -__builtin_inff();
  const int ntile = (l0 + 7) / 32 + 1;
  const bf* kif = p.KIF + (size_t)b * 512 * 2048 + lane * 8;
  bf16x8 bqA[4][4], bqB[4][4];
#pragma unroll
  for (int s = 0; s < 4; s++) {
    const int ts = s < ntile ? s : ntile - 1;
#pragma unroll
    for (int ks = 0; ks < 4; ks++) bqA[s][ks] = *(const bf16x8*)(kif + (size_t)ts * 2048 + ks * 512);
  }
  const unsigned ltmask = (1u << r32) - 1u;
#define DSA_COMPACT_CHECK()                                                                                              \
  {                                                                                                                     \
    unsigned long long over = __ballot(lane < 8 && cntv > CAP - 64);                                                    \
    if (over) {                                                                                                         \
      while (over) {                                                                                                    \
        const int q = __builtin_ctzll(over); over &= over - 1;                                                          \
        const int n = __builtin_amdgcn_readlane(cntv, q);                                                               \
        unsigned* cb_ = cand + q * CAP;                                                                                 \
        unsigned e[8];                                                                                                  \
        _Pragma("unroll") for (int i = 0; i < 8; i++) e[i] = (i * 64 + lane < n) ? cb_[i * 64 + lane] : 0u;             \
        unsigned T = 0u; int cT = n;                                                                                    \
        int nsr_ = (PROBE_MASK & 64) ? 2 : 1; asm volatile("" : "+s"(nsr_));                                            \
        _Pragma("unroll 1") for (int sr_ = 0; sr_ < nsr_; sr_++) { T = 0u; cT = n;                                      \
        const unsigned Told_ = (unsigned)__builtin_amdgcn_readlane((int)Tq, q);                                         \
        for (int bit = 31; bit >= 14; bit--) {                                                                          \
          const unsigned cnd = T | (1u << bit); int cc = 0;                                                             \
          if (cnd <= Told_) { T = cnd; continue; }                       \
          _Pragma("unroll") for (int i = 0; i < 8; i++) cc += __popcll(__ballot(e[i] >= cnd));                          \
          if (cc >= 256) { T = cnd; cT = cc; }                                                                          \
        } }                                                                                                             \
        if (cT > 320) {                                                                                                 \
          for (int bit = 13; bit >= 0; bit--) {                                                                         \
            const unsigned cnd = T | (1u << bit); int cc = 0;                                                           \
            _Pragma("unroll") for (int i = 0; i < 8; i++) cc += __popcll(__ballot(e[i] >= cnd));                        \
            if (cc >= 256) T = cnd;                                                                                     \
          }                                                                                                             \
        }                                                                                                               \
        int pos = 0;                                                                                                    \
        _Pragma("unroll") for (int i = 0; i < 8; i++) {                                                                 \
          const bool keep = e[i] >= T; const unsigned long long m = __ballot(keep);                                     \
          if (keep) cb_[pos + __popcll(m & ((1ull << lane) - 1ull))] = e[i];                                            \
          pos += __popcll(m);                                                                                           \
        }                                                                                                               \
        if (lane == q) { cntv = pos; Tq = T; }                                                                          \
      }                                                                                                                 \
      _Pragma("unroll") for (int g = 0; g < 4; g++) {                                                                   \
        unsigned tlo = __builtin_amdgcn_readlane(Tq, 2 * g), thi = __builtin_amdgcn_readlane(Tq, 2 * g + 1);            \
        Tg[g] = h5 ? thi : tlo;                                                                                         \
        const unsigned sh = Tg[g] & 0xFFFFC000u;                                                                        \
        const unsigned fb = (sh & 0x80000000u) ? (sh ^ 0x80000000u) : ~sh;                                              \
        Tf[g] = Tg[g] ? __uint_as_float(fb) : -__builtin_inff();                                                        \
      }                                                                                                                 \
    }                                                                                                                   \
  }
#define DSA_G(g, DIAG)                                                                                                  \
      {                                                                                                                 \
        const float r0 = __int_as_float(max(__float_as_int(acc[4 * g]), 0)), r1 = __int_as_float(max(__float_as_int(acc[4 * g + 1]), 0)); \
        const float r2 = __int_as_float(max(__float_as_int(acc[4 * g + 2]), 0)), r3 = __int_as_float(max(__float_as_int(acc[4 * g + 3]), 0)); \
        float sc = r0 * wv[g][0]; sc = fmaf(r1, wv[g][1], sc); sc = fmaf(r2, wv[g][2], sc); sc = fmaf(r3, wv[g][3], sc); \
        unsigned long long m0 = __builtin_amdgcn_fcmpf(sc, Tf[g], 3  );                                            \
        if (DIAG) m0 &= __builtin_amdgcn_sicmp(kidx, ql[g], 41  );                                                 \
        if (m0) {                                                                                                       \
          const float s2 = sc + 0.f;                                                                                    \
          unsigned uu = __float_as_uint(s2); uu ^= ((unsigned)((int)uu >> 31) | 0x80000000u);                           \
          const unsigned pk = (uu & 0xFFFFC000u) | (unsigned)(16383 - kidx);                                            \
          const unsigned long long m = m0 & __builtin_amdgcn_uicmp(pk, Tg[g], 35  );                              \
          if (m) {                                                                                                      \
            const unsigned lo = (unsigned)m, hi = (unsigned)(m >> 32);                                                  \
            const int cA = __builtin_amdgcn_readlane(cntv, 2 * g), cB = __builtin_amdgcn_readlane(cntv, 2 * g + 1);     \
            const unsigned mm = h5 ? hi : lo;                                                                           \
            if ((mm >> r32) & 1u) {                                                                                     \
              const int base = h5 ? cB : cA;                                                                            \
              cand[(2 * g + h5) * CAP + base + __popc(mm & ltmask)] = pk;                                               \
            }                                                                                                           \
            if (lane == 2 * g) cntv += __popc(lo);                                                                      \
            if (lane == 2 * g + 1) cntv += __popc(hi);                                                                  \
          }                                                                                                             \
        }                                                                                                               \
      }
#define DSA_GROUP(BC, BN, TB)                                                                                           \
  _Pragma("unroll") for (int u = 0; u < 4; u++) {                                                                       \
    if ((u & 1) == 0) DSA_COMPACT_CHECK()                                                                               \
    const int tile = (TB) + u;                                                                                          \
    f32x16 acc = {0.f, 0.f, 0.f, 0.f, 0.f, 0.f, 0.f, 0.f, 0.f, 0.f, 0.f, 0.f, 0.f, 0.f, 0.f, 0.f};                    \
    _Pragma("unroll") for (int ks = 0; ks < 4; ks++) acc = mfma32(aq[ks], BC[u][ks], acc);                              \
    if (u == 0) {                                                                                                       \
      _Pragma("unroll") for (int s = 0; s < 4; s++) {                                                                   \
        const int tn_ = ((TB) + 4 + s < ntile) ? (TB) + 4 + s : ntile - 1;                                              \
        _Pragma("unroll") for (int ks = 0; ks < 4; ks++) BN[s][ks] = *(const bf16x8*)(kif + (size_t)tn_ * 2048 + ks * 512); \
      }                                                                                                                 \
    }                                                                                                                   \
    const int kidx = tile * 32 + r32;                                                                                   \
    const bool diag = (tile * 32 + 31 > l0);                                                                            \
    if (!diag) { DSA_G(0, false) DSA_G(1, false) DSA_G(2, false) DSA_G(3, false) }                                      \
    else { DSA_G(0, true) DSA_G(1, true) DSA_G(2, true) DSA_G(3, true) }                                                \
  }
  for (int tile0 = 0; tile0 < ntile; tile0 += 8) {
    DSA_GROUP(bqA, bqB, tile0)
    DSA_GROUP(bqB, bqA, tile0 + 4)
  }
  {
    unsigned long long over = __ballot(lane < 8 && cntv > 256);
    while (over) {
      const int q = __builtin_ctzll(over); over &= over - 1;
      const int n = __builtin_amdgcn_readlane(cntv, q);
      unsigned* cb_ = cand + q * CAP;
      unsigned e[8];
#pragma unroll
      for (int i = 0; i < 8; i++) e[i] = (i * 64 + lane < n) ? cb_[i * 64 + lane] : 0u;
      unsigned T = 0u;
      for (int bit = 31; bit >= 0; bit--) {
        const unsigned cnd = T | (1u << bit); int cc = 0;
#pragma unroll
        for (int i = 0; i < 8; i++) cc += __popcll(__ballot(e[i] >= cnd));
        if (cc >= 256) T = cnd;
      }
      int pos = 0;
#pragma unroll
      for (int i = 0; i < 8; i++) {
        const bool keep = e[i] >= T; const unsigned long long m = __ballot(keep);
        if (keep) cb_[pos + __popcll(m & ((1ull << lane) - 1ull))] = e[i];
        pos += __popcll(m);
      }
      if (lane == q) { cntv = pos; Tq = T; }
    }
  }
  }
  __builtin_amdgcn_wave_barrier();
  const int n16 = lane & 15, kq = lane >> 4;
#define DPP_ROR(v, n) __int_as_float(__builtin_amdgcn_update_dpp(0, __float_as_int(v), 0x120 + (n), 0xf, 0xf, false))
  for (int q = 0; q < 8; q++) {
    const int n = __builtin_amdgcn_readlane(cntv, q);
    const unsigned* sel = cand + q * CAP;
    const size_t tq = tokb + l0 + q;
    float ssum[2][4];
#pragma unroll
    for (int grp = 0; grp < 2; grp++) {
      bf16x8 qa0, qa1;
#pragma unroll
      for (int k = 0; k < 8; k++) { int zi_ = 0; asm volatile("" : "+v"(zi_)); qa0[k] = (short)zi_; qa1[k] = (short)zi_; }
      if (n16 < 4) {
        const bf* qp = p.P + tq * PW + C_ATQ + (grp * 4 + n16) * 64 + 8 * kq;
        qa0 = *(const bf16x8*)qp; qa1 = *(const bf16x8*)(qp + 32);
      }
      f32x4 lg[16];
#pragma unroll
      for (int t = 0; t < 16; t++) {
        const int slot = t * 16 + n16; const bool valid = slot < n;
        const int key = valid ? (16383 - (int)(sel[slot] & 0x3FFFu)) : 0;
        const bf* kp = p.KVC + (tokb + key) * 256 + grp * 64 + 8 * kq;
        bf16x8 b0 = *(const bf16x8*)kp, b1 = *(const bf16x8*)(kp + 32);
        const float zc_ = ozero(); f32x4 cc = {zc_, zc_, zc_, zc_};
        cc = mfma16(qa0, b0, cc); cc = mfma16(qa1, b1, cc);
        const bool ok = valid && (kq == 0);
#pragma unroll
        for (int r = 0; r < 4; r++) lg[t][r] = ok ? cc[r] * 0.125f : -3.0e38f;
      }
      float mx[4];
#pragma unroll
      for (int r = 0; r < 4; r++) {
        float m = lg[0][r];
#pragma unroll
        for (int t = 1; t < 16; t++) m = fmaxf(m, lg[t][r]);
        m = fmaxf(m, DPP_ROR(m, 8)); m = fmaxf(m, DPP_ROR(m, 4)); m = fmaxf(m, DPP_ROR(m, 2)); m = fmaxf(m, DPP_ROR(m, 1));
        mx[r] = __int_as_float(__builtin_amdgcn_readfirstlane(__float_as_int(m)));
      }
#pragma unroll
      for (int r = 0; r < 4; r++) {
        float s = 0.f;
#pragma unroll
        for (int t = 0; t < 16; t++) { float e = (lg[t][r] > -1.0e38f) ? __expf(lg[t][r] - mx[r]) : 0.f; lg[t][r] = e; s += e; }
        s += DPP_ROR(s, 8); s += DPP_ROR(s, 4); s += DPP_ROR(s, 2); s += DPP_ROR(s, 1);
        ssum[grp][r] = __int_as_float(__builtin_amdgcn_readfirstlane(__float_as_int(s)));
      }
      if (grp == 0) __builtin_amdgcn_wave_barrier();
      if (kq == 0) {
#pragma unroll
        for (int t = 0; t < 16; t++)
          *(uint2*)(Pb + (t * 16 + n16) * 8 + grp * 4) = make_uint2(pk2(lg[t][0], lg[t][1]), pk2(lg[t][2], lg[t][3]));
      }
    }
    __builtin_amdgcn_wave_barrier();
    float o[64];
#pragma unroll
    for (int i = 0; i < 64; i++) o[i] = ozero();
    const int ksg = lane >> 3, dc = lane & 7;
#pragma unroll 8
    for (int stp = 0; stp < 32; stp++) {
      const int slot = stp * 8 + ksg;
      const int key = (slot < n) ? (16383 - (int)(sel[slot] & 0x3FFFu)) : 0;
      uint4 pp = *(const uint4*)(Pb + slot * 8);
      const bf* vp = p.KVC + (tokb + key) * 256 + 128 + dc * 8;
      uint4 va = *(const uint4*)vp, vb = *(const uint4*)(vp + 64);
      float ph[8] = {bflo(pp.x), bfhi(pp.x), bflo(pp.y), bfhi(pp.y), bflo(pp.z), bfhi(pp.z), bflo(pp.w), bfhi(pp.w)};
      float v0[8] = {bflo(va.x), bfhi(va.x), bflo(va.y), bfhi(va.y), bflo(va.z), bfhi(va.z), bflo(va.w), bfhi(va.w)};
      float v1[8] = {bflo(vb.x), bfhi(vb.x), bflo(vb.y), bfhi(vb.y), bflo(vb.z), bfhi(vb.z), bflo(vb.w), bfhi(vb.w)};
#pragma unroll
      for (int hh = 0; hh < 4; hh++)
#pragma unroll
        for (int d = 0; d < 8; d++) { o[hh * 8 + d] += ph[hh] * v0[d]; o[(4 + hh) * 8 + d] += ph[4 + hh] * v1[d]; }
    }
    __builtin_amdgcn_wave_barrier();
    const bool b5 = (lane >> 5) & 1, b4 = (lane >> 4) & 1, b3 = (lane >> 3) & 1;
    float o32[32], o16[16], o8[8];
#pragma unroll
    for (int i = 0; i < 32; i++) { float lo = o[i], hi = o[32 + i]; float snd = b5 ? lo : hi; float kp = b5 ? hi : lo; o32[i] = kp + __shfl_xor(snd, 32); }
#pragma unroll
    for (int i = 0; i < 16; i++) { float lo = o32[i], hi = o32[16 + i]; float snd = b4 ? lo : hi; float kp = b4 ? hi : lo; o16[i] = kp + __shfl_xor(snd, 16); }
#pragma unroll
    for (int i = 0; i < 8; i++) { float lo = o16[i], hi = o16[8 + i]; float snd = b3 ? lo : hi; float kp = b3 ? hi : lo; o8[i] = kp + __shfl_xor(snd, 8); }
    const float s_g0 = b4 ? (b3 ? ssum[0][3] : ssum[0][2]) : (b3 ? ssum[0][1] : ssum[0][0]);
    const float s_g1 = b4 ? (b3 ? ssum[1][3] : ssum[1][2]) : (b3 ? ssum[1][1] : ssum[1][0]);
    const float rinv = 1.f / (b5 ? s_g1 : s_g0);
    const int hsel = (b5 ? 4 : 0) + (b4 ? 2 : 0) + (b3 ? 1 : 0);
    const int col = hsel * 64 + dc * 8;
    uint4 zz = *(const uint4*)(p.P + tq * PW + C_ATZ + col);
    uint4 ov;
    ov.x = pk2(o8[0] * rinv * siluf_(bflo(zz.x)), o8[1] * rinv * siluf_(bfhi(zz.x)));
    ov.y = pk2(o8[2] * rinv * siluf_(bflo(zz.y)), o8[3] * rinv * siluf_(bfhi(zz.y)));
    ov.z = pk2(o8[4] * rinv * siluf_(bflo(zz.z)), o8[5] * rinv * siluf_(bfhi(zz.z)));
    ov.w = pk2(o8[6] * rinv * siluf_(bflo(zz.w)), o8[7] * rinv * siluf_(bfhi(zz.w)));
    *(uint4*)(p.Y + tq * YW + Y_ATT + col) = ov;
  }
}

__device__ __forceinline__ void phaseB(const Params& p, int layer, char* sm0) {
  const int total = 512 + 2048 + 2048;
  char* sm = sm0 + HB * HALF_LDS;
  for (int t = VB; t < total; t += G2) {
    if (t < 512) ssd_pass1(p, layer, t, sm);
    else if (t < 2560) s5_pass1(p, layer, t - 512, sm);
    else mem_attn(p, layer, t - 2560);
  }
}
__device__ __forceinline__ void phaseC(const Params& p, int layer, char* sm0, bool dsa_only) {
  const int G = G2;
  const int total = dsa_only ? 1024 : 1024 + 256 + 16;
  char* sm = sm0 + HB * HALF_LDS;
  int rr = 0;
  for (int i = VB; i < total; i += G, rr++) {
    if (i < 1024) {
      int pos = i - rr * G; int idx = i;
      if ((rr & 1) && (rr * G + G <= 1024)) idx = rr * G + (G - 1 - pos);
      __syncthreads();
      dsa_wave(p, idx * 4 + (otid() >> 6), sm);
    } else if (i < 1280) ssd_statepass(p, i - 1024);
    else s5_carry(p, layer, i - 1280);
  }
}
__device__ __forceinline__ void phaseD(const Params& p, int layer, char* sm0) {
  const int total = 256 + 1024;
  char* sm = sm0 + HB * HALF_LDS;
  const int vb = VB;
  if (G2 == 512) {
    if (vb < 256) { s5_pass2(p, layer, vb, sm); ssd_pass2(p, layer, vb, sm); }
    else {
#pragma unroll 1
      for (int k = 0; k < 3; k++) ssd_pass2(p, layer, 256 + (vb - 256) * 3 + k, sm);
    }
  } else {
    for (int t = vb; t < total; t += G2) {
      if (t < 256) s5_pass2(p, layer, t, sm);
      else ssd_pass2(p, layer, t - 256, sm);
    }
  }
}

__device__ __forceinline__ void phaseE(const Params& p, int layer) {
  const int tidf = otid_full();
  const int wid = __builtin_amdgcn_readfirstlane(tidf >> 6), lane = tidf & 63, wr = wid >> 2, wc = wid & 3, fr = lane & 15, fq = lane >> 4;
  const bf* Wl = p.WinT + (size_t)layer * INW * 2048;
  const bf* Wb = p.WbrT + (size_t)layer * 2048 * YW;
  bf* merged = p.P;
  char* gsb = (char*)p.GS + (size_t)blockIdx.x * 131072;
  const unsigned gs_lane0 = (unsigned)tidf * 16u, lane_c40 = (unsigned)fq * 16u, lane_m0 = (unsigned)(fr * 2048 + fq * 4) * 2u;
  for (int L = blockIdx.x; L < 1024; L += gridDim.x) {
    int pm, pn; tile_order(L, 128, 8, pm, pn);
    const int brow = pm * 256, bcol = pn * 256;
#pragma unroll 1
    for (int s = 0; s < 8; s++) {
      const int br = s >> 1; const bool isBr = (s & 1) != 0;
      const int koff = br == 0 ? 0 : (br == 1 ? 512 : (br == 2 ? 1024 : 2048));
      const int kb = br == 2 ? 1024 : (br == 3 ? 256 : 512);
      const bf* A_ = isBr ? p.Y + koff : p.xb; const int lda_ = isBr ? YW : 2048;
      const bf* B_ = isBr ? Wb + koff : Wl + (size_t)(5716 + br * 2048) * 2048; const int ldb_ = isBr ? YW : 2048;
      const int K_ = isBr ? kb : 2048;
      f32x4 acc[2][2][4][2]; ZERO_ACC8(acc);
      gemm256(A_, lda_, B_, ldb_, K_, brow, bcol, acc);
      unsigned gs_lane = gs_lane0, lane_c4 = lane_c40, lane_m = lane_m0;
      asm volatile("" : "+v"(gs_lane), "+v"(lane_c4), "+v"(lane_m));
      if (!isBr) {
        const char* bgb = (const char*)(p.b_gate + (size_t)layer * 8192 + br * 2048 + bcol + wc * 32);
#pragma unroll
        for (int ai = 0; ai < 2; ai++)
#pragma unroll
          for (int bj = 0; bj < 2; bj++)
#pragma unroll
            for (int m = 0; m < 4; m++) {
              unsigned q[4];
#pragma unroll
              for (int n = 0; n < 2; n++) {
                float4 bg = *(const float4*)(bgb + (bj * 128 + n * 16) * 4 + lane_c4);
                f32x4 v = acc[ai][bj][m][n];
                q[2 * n] = pk2(sigmoidf_(v[0] + bg.x), sigmoidf_(v[1] + bg.y));
                q[2 * n + 1] = pk2(sigmoidf_(v[2] + bg.z), sigmoidf_(v[3] + bg.w));
              }
              *(uint4*)(gsb + ((ai * 2 + bj) * 4 + m) * 8192 + gs_lane) = make_uint4(q[0], q[1], q[2], q[3]);
              __builtin_amdgcn_sched_barrier(0);
            }
      } else {
        char* mb = (char*)merged + ((size_t)(brow + wr * 64) * 2048 + bcol + wc * 32) * 2;
#pragma unroll
        for (int ai = 0; ai < 2; ai++)
#pragma unroll
          for (int bj = 0; bj < 2; bj++)
#pragma unroll
            for (int m = 0; m < 4; m++) {
              uint4 g = *(const uint4*)(gsb + ((ai * 2 + bj) * 4 + m) * 8192 + gs_lane);
              const unsigned gq[4] = {g.x, g.y, g.z, g.w};
#pragma unroll
              for (int n = 0; n < 2; n++) {
                f32x4 v = acc[ai][bj][m][n];
                float o0 = bflo(gq[2 * n]) * v[0], o1 = bfhi(gq[2 * n]) * v[1], o2 = bflo(gq[2 * n + 1]) * v[2], o3 = bfhi(gq[2 * n + 1]) * v[3];
                char* mp = mb + ((size_t)(ai * 128 + m * 16) * 2048 + bj * 128 + n * 16) * 2 + lane_m;
                if (br) { uint2 old = *(const uint2*)mp; o0 += bflo(old.x); o1 += bfhi(old.x); o2 += bflo(old.y); o3 += bfhi(old.y); }
                *(uint2*)mp = make_uint2(pk2(o0, o1), pk2(o2, o3));
              }
              __builtin_amdgcn_sched_barrier(0);
            }
      }
    }
  }
}

__device__ __forceinline__ void phaseF(const Params& p, int layer) {
  const int tidf = otid_full();
  const int wid = __builtin_amdgcn_readfirstlane(tidf >> 6), lane = tidf & 63, wr = wid >> 2, wc = wid & 3, fr = lane & 15, fq = lane >> 4;
  const bf* merged = p.P;
  const float* xres = layer == 0 ? p.x : p.out;
  for (int L = blockIdx.x; L < 1024; L += gridDim.x) {
    int pm, pn; tile_order(L, 128, 8, pm, pn);
    const int brow = pm * 256, bcol = pn * 256;
    f32x4 acc[2][2][4][2]; ZERO_ACC8(acc);
    gemm256(merged, 2048, p.WoutT + (size_t)layer * 2048 * 2048, 2048, 2048, brow, bcol, acc);
#pragma unroll
    for (int ai = 0; ai < 2; ai++)
#pragma unroll
      for (int m = 0; m < 4; m++) {
        const size_t tok = brow + ai * 128 + wr * 64 + m * 16 + fr;
#pragma unroll
        for (int bj = 0; bj < 2; bj++)
#pragma unroll
          for (int n = 0; n < 2; n++) {
            const int col = bcol + bj * 128 + wc * 32 + n * 16 + fq * 4;
            float4 xr = *(const float4*)(xres + tok * 2048 + col);
            f32x4 v = acc[ai][bj][m][n];
            float4 o;
            o.x = 1.41421356237f * xr.x + v[0]; o.y = 1.41421356237f * xr.y + v[1];
            o.z = 1.41421356237f * xr.z + v[2]; o.w = 1.41421356237f * xr.w + v[3];
            *(float4*)(p.out + tok * 2048 + col) = o;
          }
      }
  }
}

__device__ __forceinline__ void phaseG(const Params& p, int layer) {
  const int lane = otid() & 63, w = otid() >> 6;
  const float* g = p.ln_g + layer * 2048; const float* bb = p.ln_b + layer * 2048;
  for (int t = VB; t < TT / 4; t += G2) {
    const size_t row = (size_t)t * 4 + w;
    float* xp = p.out + row * 2048;
    float4 v[8]; float s = 0.f;
#pragma unroll
    for (int i = 0; i < 8; i++) { v[i] = *(const float4*)(xp + (i * 64 + lane) * 4); s += v[i].x + v[i].y + v[i].z + v[i].w; }
#pragma unroll
    for (int off = 1; off < 64; off <<= 1) s += __shfl_xor(s, off);
    const float mu = s * (1.f / 2048.f);
    float q = 0.f;
#pragma unroll
    for (int i = 0; i < 8; i++) {
      float a = v[i].x - mu, b = v[i].y - mu, c = v[i].z - mu, d = v[i].w - mu; q += a * a + b * b + c * c + d * d;
    }
#pragma unroll
    for (int off = 1; off < 64; off <<= 1) q += __shfl_xor(q, off);
    const float rs = rsqrtf(q * (1.f / 2048.f) + 1e-5f);
#pragma unroll
    for (int i = 0; i < 8; i++) {
      const int col = (i * 64 + lane) * 4;
      float4 gg = *(const float4*)(g + col), bv = *(const float4*)(bb + col);
      float4 o;
      o.x = (v[i].x - mu) * rs * gg.x + bv.x; o.y = (v[i].y - mu) * rs * gg.y + bv.y;
      o.z = (v[i].z - mu) * rs * gg.z + bv.z; o.w = (v[i].w - mu) * rs * gg.w + bv.w;
      *(float4*)(xp + col) = o;
      if (layer == 0) *(uint2*)(p.xb + row * 2048 + col) = make_uint2(pk2(o.x, o.y), pk2(o.z, o.w));
    }
  }
}

__global__ void __launch_bounds__(512, 2) mega_kernel(Params p) {
  char* sm = dynsm;
  cg::grid_group grid = cg::this_grid();
  phase0(p, sm); grid.sync();
#pragma unroll 1
  for (int layer = 0; layer < 2; layer++) {
    int nA = (PROBE_MASK & 1) ? 2 : 1, nB = (PROBE_MASK & 2) ? 2 : 1, nC = (PROBE_MASK & 4) ? 2 : 1, nD = (PROBE_MASK & 8) ? 2 : 1, nE = (PROBE_MASK & 16) ? 2 : 1;
    asm volatile("" : "+s"(nA), "+s"(nB), "+s"(nC), "+s"(nD), "+s"(nE));
#pragma unroll 1
    for (int r = 0; r < nA; r++) phaseA(p, layer);
    grid.sync();
#pragma unroll 1
    for (int r = 0; r < nB; r++) phaseB(p, layer, sm);
    grid.sync();
#pragma unroll 1
    for (int r = 0; r < nC; r++) phaseC(p, layer, sm, r + 1 < nC);
    grid.sync();
#pragma unroll 1
    for (int r = 0; r < nD; r++) phaseD(p, layer, sm);
    grid.sync();
#pragma unroll 1
    for (int r = 0; r < nE; r++) phaseE(p, layer);
    grid.sync();
    phaseF(p, layer); grid.sync();
    phaseG(p, layer);
    if (layer == 0) grid.sync();
  }
}

extern "C" void kernel_launch(void* const* d_in, const int* in_sizes, int n_in, void* d_out, int out_size, void* d_ws,
                              size_t ws_size, hipStream_t stream) {
  Params p{};
  p.x = (const float*)d_in[0]; p.mem = (const float*)d_in[1]; p.pos = (const int*)d_in[2];
  p.w_in = (const float*)d_in[3]; p.b_gate = (const float*)d_in[4]; p.lam_re = (const float*)d_in[5];
  p.lam_im = (const float*)d_in[6]; p.log_dt = (const float*)d_in[7]; p.b_re = (const float*)d_in[8];
  p.b_im = (const float*)d_in[9]; p.c_re = (const float*)d_in[10]; p.c_im = (const float*)d_in[11];
  p.s5_d = (const float*)d_in[12]; p.w_glu = (const float*)d_in[13]; p.b_glu = (const float*)d_in[14];
  p.conv_w = (const float*)d_in[15]; p.conv_b = (const float*)d_in[16]; p.dt_bias = (const float*)d_in[17];
  p.a_log = (const float*)d_in[18]; p.ssd_d = (const float*)d_in[19]; p.norm_g = (const float*)d_in[20];
  p.mem_w_kv = (const float*)d_in[21]; p.w_br_s5 = (const float*)d_in[22]; p.w_br_attn = (const float*)d_in[23];
  p.w_br_ssd = (const float*)d_in[24]; p.w_br_mem = (const float*)d_in[25]; p.w_out = (const float*)d_in[26];
  p.ln_g = (const float*)d_in[27]; p.ln_b = (const float*)d_in[28];
  p.out = (float*)d_out;
  char* ws = (char*)d_ws; size_t off = 0;
  auto carve = [&](size_t bytes) { char* r = ws + off; off += (bytes + 255) & ~(size_t)255; return r; };
  p.WinT = (bf*)carve((size_t)2 * INW * 2048 * 2);
  p.WbrT = (bf*)carve((size_t)2 * 2048 * YW * 2);
  p.WoutT = (bf*)carve((size_t)2 * 2048 * 2048 * 2);
  p.WgluT = (bf*)carve((size_t)2 * 512 * 512 * 2);
  p.WmemT = (bf*)carve((size_t)2 * 512 * 2048 * 2);
  p.memb = (bf*)carve((size_t)512 * 2048 * 2);
  p.xb = (bf*)carve((size_t)TT * 2048 * 2);
  p.P = (bf*)carve((size_t)TT * PW * 2);
  p.Y = (bf*)carve((size_t)TT * YW * 2);
  p.YG = (bf*)carve((size_t)TT * 512 * 2);
  p.KIF = (bf*)carve((size_t)TT * 64 * 2);
  p.MK = (bf*)carve((size_t)2 * 2 * 4 * 256 * 64 * 2);
  p.MVT = (bf*)carve((size_t)2 * 2 * 4 * 256 * 64 * 2);
  p.CM = (bf*)carve((size_t)2 * 32 * 16 * 128 * 2);
  p.ST = (float*)carve((size_t)2 * 128 * 131072 * 4);
  p.CS = (float*)carve((size_t)TT * 16 * 4);
  p.END = (float*)carve((size_t)2 * 128 * 32 * 64 * 2 * 4);
  p.CD = (float*)carve((size_t)2 * 128 * 16 * 4);
  p.SB = (float*)carve((size_t)2 * 32 * 64 * 32 * 4);
  p.SA = (float*)carve((size_t)2 * 32 * 64 * 4 * 4);
  p.KVC = (bf*)carve((size_t)TT * 256 * 2);
  p.GS = (bf*)carve((size_t)256 * 16 * 512 * 16);
  if (off > ws_size) { fprintf(stderr, "workspace too small: need %zu have %zu\n", off, ws_size); return; }
  for (int j = 0; j < 8; j++) p.inv[j] = (float)pow(500000.0, -(double)j / 8.0);
  const size_t kDynLds = 2 * HALF_LDS;
  static int grid_blocks = 0;
  if (!grid_blocks) {
    int dev = 0, cus = 0, per_cu = 0;
    (void)hipGetDevice(&dev);
    (void)hipDeviceGetAttribute(&cus, hipDeviceAttributeMultiprocessorCount, dev);
    (void)hipFuncSetAttribute((const void*)mega_kernel, hipFuncAttributeMaxDynamicSharedMemorySize, (int)kDynLds);
    (void)hipOccupancyMaxActiveBlocksPerMultiprocessor(&per_cu, mega_kernel, 512, kDynLds);
    if (per_cu > 1) per_cu = 1;
    grid_blocks = cus * per_cu;
    if (grid_blocks > 256) grid_blocks = 256;
    grid_blocks -= grid_blocks % 8;
  }
  void* args[] = {&p};
  hipError_t e = hipLaunchCooperativeKernel((void*)mega_kernel, dim3(grid_blocks), dim3(512), args, kDynLds, stream);
  if (e != hipSuccess) fprintf(stderr, "cooperative launch failed: %s (grid %d)\n", hipGetErrorString(e), grid_blocks);
}
```

```cpp
#include <hip/hip_runtime.h>
#include <hip/hip_cooperative_groups.h>
#include <cstdio>
#include <cmath>
namespace cg = cooperative_groups;

#ifndef MK_COOP
#define MK_COOP 1
#endif
#ifndef PROBE_MASK
#define PROBE_MASK 0
#endif

typedef unsigned short bf;
typedef short bf16x8 __attribute__((ext_vector_type(8)));
typedef float f32x16 __attribute__((ext_vector_type(16)));
typedef float f32x4 __attribute__((ext_vector_type(4)));

#define TT 32768
#define LSEQ 16384
#define DM 2048
#define INW 13908
#define PW 5760
#define C_S5U 0
#define C_S5Z 512
#define C_ATQ 1024
#define C_ATK 1536
#define C_ATV 1664
#define C_ATZ 1792
#define C_IDQ 2304
#define C_IDK 2560
#define C_IDW 2624
#define C_SSZ 2640
#define C_XBC 3664
#define C_SDT 5200
#define C_MEQ 5216
#define C_MEZ 5472
#define YW 2304
#define Y_S5 0
#define Y_ATT 512
#define Y_SSD 1024
#define Y_MEM 2048
#define CAP 480
#define HALF_LDS 77824

struct Params {
  const float *x, *mem; const int* pos;
  const float *w_in, *b_gate, *lam_re, *lam_im, *log_dt, *b_re, *b_im, *c_re, *c_im, *s5_d, *w_glu, *b_glu,
      *conv_w, *conv_b, *dt_bias, *a_log, *ssd_d, *norm_g, *mem_w_kv, *w_br_s5, *w_br_attn, *w_br_ssd, *w_br_mem,
      *w_out, *ln_g, *ln_b;
  float* out;
  bf *WinT, *WbrT, *WoutT, *WgluT, *WmemT, *memb, *xb, *P, *Y, *YG, *KIF, *MK, *MVT, *CM, *KVC, *GS;
  float *ST, *CS, *END, *CD, *SB, *SA;
  float inv[8];
};

__device__ __forceinline__ float ozero() { float z = 0.f; asm volatile("" : "+v"(z)); return z; }
__device__ __forceinline__ int otid_full() { int t = threadIdx.x; asm volatile("" : "+v"(t)); return t; }
__device__ __forceinline__ int otid() { return otid_full() & 255; }
#define HB (__builtin_amdgcn_readfirstlane(otid_full() >> 8))
#define VB ((int)blockIdx.x * 2 + HB)
#define G2 ((int)gridDim.x * 2)
__device__ __forceinline__ float bf2f(bf v) { return __uint_as_float(((unsigned)v) << 16); }
__device__ __forceinline__ float bflo(unsigned u) { return __uint_as_float(u << 16); }
__device__ __forceinline__ float bfhi(unsigned u) { return __uint_as_float(u & 0xFFFF0000u); }
typedef float f32x2p_t __attribute__((ext_vector_type(2)));
typedef __bf16 bf16x2p_t __attribute__((ext_vector_type(2)));
__device__ __forceinline__ unsigned pk2(float lo, float hi) {
  f32x2p_t v = {lo, hi};
  return __builtin_bit_cast(unsigned, __builtin_convertvector(v, bf16x2p_t));
}
__device__ __forceinline__ bf f2bf(float f) { return (bf)(pk2(f, 0.f) & 0xFFFFu); }
__device__ __forceinline__ float sigmoidf_(float x) { return __builtin_amdgcn_rcpf(1.f + __expf(-x)); }
__device__ __forceinline__ float siluf_(float x) { return x * __builtin_amdgcn_rcpf(1.f + __expf(-x)); }
__device__ __forceinline__ float geluf_(float x) {
  float u = 0.7978845608028654f * (x + 0.044715f * x * x * x);
  float t = 1.f - 2.f * __builtin_amdgcn_rcpf(1.f + __expf(2.f * u));
  return 0.5f * x * (1.f + t);
}
__device__ __forceinline__ f32x16 mfma32(bf16x8 a, bf16x8 b, f32x16 c) { return __builtin_amdgcn_mfma_f32_32x32x16_bf16(a, b, c, 0, 0, 0); }
__device__ __forceinline__ f32x4 mfma16(bf16x8 a, bf16x8 b, f32x4 c) { return __builtin_amdgcn_mfma_f32_16x16x32_bf16(a, b, c, 0, 0, 0); }

__device__ __forceinline__ bool tile_map(int L, int nMt, int nNt, int SM, int SN, int& tm, int& tn) {
  int per = SM * SN; int x = L & 7; int jj = L >> 3; int sl = jj / per; int j = jj - sl * per; int S = sl * 8 + x;
  int nSn = nNt / SN; int NS = (nMt / SM) * nSn;
  if (S >= NS) return false;
  int mg = S / nSn, ng = S - mg * nSn;
  tm = mg * SM + j / SN; tn = ng * SN + j % SN; return true;
}

typedef unsigned u32x4 __attribute__((ext_vector_type(4)));
struct GStage { u32x4 a0, a1, b0, b1; };
#define G_LOAD(S, ko) { S.a0 = *(const u32x4*)(ga + (ko)); S.a1 = *(const u32x4*)(ga + a64 + (ko)); S.b0 = *(const u32x4*)(gb + (ko)); S.b1 = *(const u32x4*)(gb + b64 + (ko)); }
#define G_WRITE(S, base) { *(u32x4*)(sA + (base) + woff) = S.a0; *(u32x4*)(sA + (base) + woff + 5120) = S.a1; *(u32x4*)(sB + (base) + woff) = S.b0; *(u32x4*)(sB + (base) + woff + 5120) = S.b1; }
#define G_ITER(kt, cur, S)                                                          \
  {                                                                                 \
    _Pragma("unroll") for (int ks = 0; ks < 2; ks++) {                              \
      bf16x8 a0 = *(const bf16x8*)(sA + (cur) + aoff + ks * 32);                    \
      bf16x8 a1 = *(const bf16x8*)(sA + (cur) + aoff + 2560 + ks * 32);             \
      bf16x8 b0 = *(const bf16x8*)(sB + (cur) + boff + ks * 32);                    \
      bf16x8 b1 = *(const bf16x8*)(sB + (cur) + boff + 2560 + ks * 32);             \
      acc[0][0] = mfma32(b0, a0, acc[0][0]);                                        \
      acc[0][1] = mfma32(b1, a0, acc[0][1]);                                        \
      acc[1][0] = mfma32(b0, a1, acc[1][0]);                                        \
      acc[1][1] = mfma32(b1, a1, acc[1][1]);                                        \
    }                                                                               \
    if ((kt) + 1 < nk) {                                                            \
      G_WRITE(S, 10240 - (cur))                                                     \
      if ((kt) + 1 + D < nk) G_LOAD(S, ((kt) + 1 + D) * 32)                         \
    }                                                                               \
    __syncthreads();                                                                \
  }
template <int D>
__device__ __forceinline__ void gemm_acc(const bf* __restrict__ A, int lda, const bf* __restrict__ Bt, int ldb, int K,
                                         f32x16 (&acc)[2][2], char* sm) {
  const int tid = otid(), lane = tid & 63, w = tid >> 6, wr = w >> 1, wc = w & 1, r32 = lane & 31, h5 = lane >> 5;
  const int lrow = tid >> 2, lch = tid & 3;
  const bf* ga = A + (size_t)lrow * lda + lch * 8;
  const bf* gb = Bt + (size_t)lrow * ldb + lch * 8;
  const size_t a64 = (size_t)64 * lda, b64 = (size_t)64 * ldb;
  const int nk = K >> 5;
  char* sA = sm; char* sB = sm + 20480;
  const int woff = lrow * 80 + lch * 16;
  const int aoff = (wr * 64 + r32) * 80 + h5 * 16, boff = (wc * 64 + r32) * 80 + h5 * 16;
  GStage S0, S1, S2, S3;
  G_LOAD(S0, 0) G_LOAD(S1, 32)
  if (D == 4) { G_LOAD(S2, 64) G_LOAD(S3, 96) }
  G_WRITE(S0, 0)
  if (D < nk) G_LOAD(S0, D * 32)
  __syncthreads();
  for (int kt0 = 0; kt0 < nk; kt0 += D) {
    if (D == 4) {
      G_ITER(kt0, 0, S1) G_ITER(kt0 + 1, 10240, S2) G_ITER(kt0 + 2, 0, S3) G_ITER(kt0 + 3, 10240, S0)
    } else {
      G_ITER(kt0, 0, S1) G_ITER(kt0 + 1, 10240, S0)
    }
  }
}
#define ZERO_ACC(a) { const float z_ = ozero(); for (int i_ = 0; i_ < 2; i_++) for (int j_ = 0; j_ < 2; j_++) for (int r_ = 0; r_ < 16; r_++) a[i_][j_][r_] = z_; }


extern __shared__ __attribute__((aligned(16))) char dynsm[];
#define G8_HT (128 * 64)
#define G8_SA(b, h) ((bf*)dynsm + ((b) * 2 + (h)) * G8_HT)
#define G8_SB(b, h) ((bf*)dynsm + (4 + (b) * 2 + (h)) * G8_HT)
__device__ __forceinline__ int g8_lds_byte(int r, int c) {
  int st = (r >> 4) * 2 + (c >> 5), rr = r & 15, cc = c & 31, ob = rr * 64 + cc * 2;
  return st * 1024 + (ob ^ (((ob >> 9) & 1) << 5));
}
__device__ __forceinline__ void g8_stage_rc(int b, int& R, int& C) {
  int st = b / 1024, sb = b % 1024, swz = sb ^ (((sb >> 9) & 1) << 5);
  R = (st >> 1) * 16 + swz / 64; C = (st & 1) * 32 + (swz % 64) / 2;
}
#define G8_LAS __attribute__((address_space(3)))
#define G8_HTB (128 * 64 * 2)
#define G8_OSA(b, h) (((b) * 2 + (h)) * G8_HTB)
#define G8_OSB(b, h) ((4 + (b) * 2 + (h)) * G8_HTB)
#define G8_STAGE(bufoff, gbase, voff) do { _Pragma("unroll") for (int _i = 0; _i < 2; ++_i) \
    __builtin_amdgcn_global_load_lds((const unsigned*)((const char*)(gbase) + (voff)[_i]), (G8_LAS unsigned*)(lds + (bufoff) + ldsw + _i * 8192), 16, 0, 0); } while (0)
#define G8_LDA(dst, b, h) do { _Pragma("unroll") for (int m = 0; m < 4; ++m) _Pragma("unroll") for (int k = 0; k < 2; ++k) dst[m][k] = *(const G8_LAS bf16x8*)(lds + G8_OSA(b, h) + aoff + m * 2048 + k * 1024); } while (0)
#define G8_LDB(dst, b, h) do { _Pragma("unroll") for (int n = 0; n < 2; ++n) _Pragma("unroll") for (int k = 0; k < 2; ++k) dst[n][k] = *(const G8_LAS bf16x8*)(lds + G8_OSB(b, h) + boff + n * 2048 + k * 1024); } while (0)
#define G8_MMA(ai, bj, At_, Bt_) do { __builtin_amdgcn_s_setprio(1);                                                 \
    _Pragma("unroll") for (int m = 0; m < 4; ++m) _Pragma("unroll") for (int n = 0; n < 2; ++n) _Pragma("unroll") for (int k = 0; k < 2; ++k) \
      acc[ai][bj][m][n] = __builtin_amdgcn_mfma_f32_16x16x32_bf16(Bt_[n][k], At_[m][k], acc[ai][bj][m][n], 0, 0, 0); \
    __builtin_amdgcn_s_setprio(0); } while (0)
#define G8_WAIT_V(n) asm volatile("s_waitcnt vmcnt(" #n ")" ::: "memory")
#define G8_WAIT_L(n) asm volatile("s_waitcnt lgkmcnt(" #n ")" ::: "memory")
#define G8_BAR __builtin_amdgcn_s_barrier()
#define G8_SCHED __builtin_amdgcn_sched_barrier(0)

__device__ __forceinline__ void gemm256(const bf* __restrict__ A, int lda, const bf* __restrict__ Bt, int ldb, int K,
                                        int brow, int bcol, f32x4 (&acc)[2][2][4][2]) {
  G8_LAS unsigned char* lds = (G8_LAS unsigned char*)dynsm;
  const int tid = otid_full(), wid = __builtin_amdgcn_readfirstlane(tid >> 6), lane = tid & 63, wr = wid >> 2, wc = wid & 3, fr = lane & 15, fq = lane >> 4;
  unsigned voffA[2], voffB[2];
#pragma unroll
  for (int i = 0; i < 2; ++i) { int R, C; g8_stage_rc(tid * 16 + i * 8192, R, C); voffA[i] = (unsigned)(R * lda + C) * 2u; voffB[i] = (unsigned)(R * ldb + C) * 2u; }
  const size_t kstep = 128;
  const size_t hstepA = (size_t)128 * lda * 2, hstepB = (size_t)128 * ldb * 2;
  const unsigned ldsw = (unsigned)wid * 1024u;
  const int aoff = g8_lds_byte(wr * 64 + fr, fq * 8), boff = g8_lds_byte(wc * 32 + fr, fq * 8);
  const char* cA = (const char*)A + (size_t)brow * lda * 2; const char* cB = (const char*)Bt + (size_t)bcol * ldb * 2;
  bf16x8 At[4][2], B0[2][2], B1[2][2];
  const int nt = K / 64;
  __syncthreads();
  G8_STAGE(G8_OSB(0, 0), cB, voffB); G8_STAGE(G8_OSA(0, 0), cA, voffA); G8_STAGE(G8_OSB(0, 1), cB + hstepB, voffB); G8_STAGE(G8_OSA(0, 1), cA + hstepA, voffA);
  if (wr == 1) G8_BAR;
  G8_WAIT_V(4); G8_BAR;
  G8_STAGE(G8_OSB(1, 0), cB + kstep, voffB); G8_STAGE(G8_OSA(1, 0), cA + kstep, voffA); G8_STAGE(G8_OSB(1, 1), cB + hstepB + kstep, voffB);
  G8_WAIT_V(6); G8_BAR;
  for (int t = 0; t < nt - 2; t += 2) {
    const char* a1 = cA + (size_t)(t + 1) * kstep;
    const char* a2 = cA + (size_t)(t + 2) * kstep; const char* b2 = cB + (size_t)(t + 2) * kstep;
    const char* a3 = a2 + kstep; const char* b3 = b2 + kstep;
    G8_LDB(B0, 0, 0); G8_SCHED; G8_LDA(At, 0, 0); G8_STAGE(G8_OSA(1, 1), a1 + hstepA, voffA);
    G8_WAIT_L(8); G8_BAR; G8_WAIT_L(0); G8_MMA(0, 0, At, B0); G8_BAR; G8_SCHED;
    G8_LDB(B1, 0, 1); G8_STAGE(G8_OSB(0, 0), b2, voffB);
    G8_BAR; G8_WAIT_L(0); G8_MMA(0, 1, At, B1); G8_BAR;
    G8_LDA(At, 0, 1); G8_STAGE(G8_OSA(0, 0), a2, voffA);
    G8_BAR; G8_WAIT_L(0); G8_MMA(1, 0, At, B0); G8_BAR; G8_SCHED;
    G8_STAGE(G8_OSB(0, 1), b2 + hstepB, voffB);
    G8_WAIT_V(6); G8_BAR; G8_MMA(1, 1, At, B1); G8_BAR;
    G8_LDB(B0, 1, 0); G8_SCHED; G8_LDA(At, 1, 0); G8_STAGE(G8_OSA(0, 1), a2 + hstepA, voffA);
    G8_WAIT_L(8); G8_BAR; G8_WAIT_L(0); G8_MMA(0, 0, At, B0); G8_BAR; G8_SCHED;
    G8_LDB(B1, 1, 1); G8_STAGE(G8_OSB(1, 0), b3, voffB);
    G8_BAR; G8_WAIT_L(0); G8_MMA(0, 1, At, B1); G8_BAR;
    G8_LDA(At, 1, 1); G8_STAGE(G8_OSA(1, 0), a3, voffA);
    G8_BAR; G8_WAIT_L(0); G8_MMA(1, 0, At, B0); G8_BAR; G8_SCHED;
    G8_STAGE(G8_OSB(1, 1), b3 + hstepB, voffB);
    G8_WAIT_V(6); G8_BAR; G8_MMA(1, 1, At, B1); G8_BAR;
  }
  { const char* a1 = cA + (size_t)(nt - 1) * kstep;
    G8_LDB(B0, 0, 0); G8_LDA(At, 0, 0); G8_STAGE(G8_OSA(1, 1), a1 + hstepA, voffA);
    G8_BAR; G8_WAIT_L(0); G8_MMA(0, 0, At, B0); G8_BAR;
    G8_LDB(B1, 0, 1); G8_BAR; G8_WAIT_L(0); G8_MMA(0, 1, At, B1); G8_BAR;
    G8_LDA(At, 0, 1); G8_WAIT_V(4); G8_BAR; G8_WAIT_L(0); G8_MMA(1, 0, At, B0); G8_MMA(1, 1, At, B1); G8_BAR; }
  { G8_LDB(B0, 1, 0); G8_LDA(At, 1, 0); G8_WAIT_V(2); G8_BAR; G8_WAIT_L(0); G8_MMA(0, 0, At, B0); G8_BAR;
    G8_LDB(B1, 1, 1); G8_WAIT_V(0); G8_BAR; G8_WAIT_L(0); G8_MMA(0, 1, At, B1); G8_BAR;
    G8_LDA(At, 1, 1); G8_BAR; G8_WAIT_L(0); G8_MMA(1, 0, At, B0); G8_MMA(1, 1, At, B1); G8_BAR; }
  if (wr == 0) G8_BAR;
}
#define ZERO_ACC8(a) { float z_ = 0.f; asm volatile("" : "+v"(z_)); _Pragma("unroll") for (int i_ = 0; i_ < 2; i_++) _Pragma("unroll") for (int j_ = 0; j_ < 2; j_++) _Pragma("unroll") for (int m_ = 0; m_ < 4; m_++) _Pragma("unroll") for (int n_ = 0; n_ < 2; n_++) a[i_][j_][m_][n_] = (f32x4){z_, z_, z_, z_}; }
__device__ __forceinline__ bool tile_order(int L, int nM, int nN, int& pm, int& pn) {
  const int nwg = nM * nN; if (L >= nwg) return false;
  int wgid = L; { const int q = nwg / 8, r = nwg % 8, xcd = wgid % 8, off = wgid / 8; wgid = (xcd < r ? xcd * (q + 1) : r * (q + 1) + (xcd - r) * q) + off; }
  const int nig = 8 * nN, gid = wgid / nig, fm = gid * 8, gsz = (nM - fm) < 8 ? (nM - fm) : 8;
  pm = fm + ((wgid % nig) % gsz); pn = (wgid % nig) / gsz; return true;
}

__device__ __forceinline__ void transpose_tile(const float* __restrict__ src, int R, int C, bf* __restrict__ dst, int ldd, int off, int tile, bf* sm) {
  const int tilesC = (C + 63) >> 6;
  const int tr = tile / tilesC, tc = tile - tr * tilesC;
  const int r0 = tr * 64, c0 = tc * 64;
  const int tid = otid();
#pragma unroll
  for (int i = 0; i < 4; i++) {
    int r = (tid >> 4) + 16 * i; int c = (tid & 15) * 4;
    const float zt_ = ozero(); float4 v = make_float4(zt_, zt_, zt_, zt_);
    if (c0 + c < C) v = *(const float4*)(src + (size_t)(r0 + r) * C + c0 + c);
    sm[(c + 0) * 66 + r] = f2bf(v.x); sm[(c + 1) * 66 + r] = f2bf(v.y);
    sm[(c + 2) * 66 + r] = f2bf(v.z); sm[(c + 3) * 66 + r] = f2bf(v.w);
  }
  __syncthreads();
  {
    int c = tid >> 2, ch = (tid & 3) * 16;
    if (c0 + c < C) {
      unsigned wv[8];
#pragma unroll
      for (int k = 0; k < 8; k++) wv[k] = *(const unsigned*)(sm + c * 66 + ch + 2 * k);
      bf* d = dst + (size_t)(c0 + c) * ldd + off + r0 + ch;
      *(uint4*)d = make_uint4(wv[0], wv[1], wv[2], wv[3]);
      *(uint4*)(d + 8) = make_uint4(wv[4], wv[5], wv[6], wv[7]);
    }
  }
  __syncthreads();
}

__device__ __forceinline__ bool try_tr(int& t, const float* src, int R, int C, bf* dst, int ldd, int off, bf* sm) {
  int nt = (R >> 6) * ((C + 63) >> 6);
  if (t < nt) { transpose_tile(src, R, C, dst, ldd, off, t, sm); return true; }
  t -= nt; return false;
}

__device__ __forceinline__ void phase0(const Params& p, char* smc) {
  bf* sm = (bf*)(smc + HB * HALF_LDS);
  const int perLayer = 32 * 218 + 256 + 256 + 512 + 128 + 1024 + 64 + 256;
  for (int task = VB; task < 2 * perLayer; task += G2) {
    int layer = task / perLayer; int t = task - layer * perLayer;
    bf* WbrL = p.WbrT + (size_t)layer * 2048 * YW;
    if (try_tr(t, p.w_in + (size_t)layer * DM * INW, 2048, INW, p.WinT + (size_t)layer * INW * 2048, 2048, 0, sm)) continue;
    if (try_tr(t, p.w_br_s5 + (size_t)layer * 512 * 2048, 512, 2048, WbrL, YW, 0, sm)) continue;
    if (try_tr(t, p.w_br_attn + (size_t)layer * 512 * 2048, 512, 2048, WbrL, YW, 512, sm)) continue;
    if (try_tr(t, p.w_br_ssd + (size_t)layer * 1024 * 2048, 1024, 2048, WbrL, YW, 1024, sm)) continue;
    if (try_tr(t, p.w_br_mem + (size_t)layer * 256 * 2048, 256, 2048, WbrL, YW, 2048, sm)) continue;
    if (try_tr(t, p.w_out + (size_t)layer * 2048 * 2048, 2048, 2048, p.WoutT + (size_t)layer * 2048 * 2048, 2048, 0, sm)) continue;
    if (try_tr(t, p.w_glu + (size_t)layer * 512 * 512, 512, 512, p.WgluT + (size_t)layer * 512 * 512, 512, 0, sm)) continue;
    if (try_tr(t, p.mem_w_kv + (size_t)layer * 2048 * 512, 2048, 512, p.WmemT + (size_t)layer * 512 * 2048, 2048, 0, sm)) continue;
  }
  const size_t gtid = (size_t)blockIdx.x * 512 + otid_full(), gstr = (size_t)gridDim.x * 512;
  for (size_t i0 = gtid; i0 < (size_t)TT * DM / 8; i0 += 4 * gstr) {
    float4 a[4], b[4];
#pragma unroll
    for (int k = 0; k < 4; k++) {
      const size_t i = i0 + k * gstr;
      if (i < (size_t)TT * DM / 8) { a[k] = *(const float4*)(p.x + i * 8); b[k] = *(const float4*)(p.x + i * 8 + 4); }
    }
#pragma unroll
    for (int k = 0; k < 4; k++) {
      const size_t i = i0 + k * gstr;
      if (i < (size_t)TT * DM / 8)
        *(uint4*)(p.xb + i * 8) = make_uint4(pk2(a[k].x, a[k].y), pk2(a[k].z, a[k].w), pk2(b[k].x, b[k].y), pk2(b[k].z, b[k].w));
    }
  }
  for (size_t i = gtid; i < (size_t)512 * DM / 8; i += gstr) {
    float4 a = *(const float4*)(p.mem + i * 8), b = *(const float4*)(p.mem + i * 8 + 4);
    *(uint4*)(p.memb + i * 8) = make_uint4(pk2(a.x, a.y), pk2(a.z, a.w), pk2(b.x, b.y), pk2(b.z, b.w));
  }
  for (size_t i = gtid; i < (size_t)TT; i += gstr) {
    const float ps = (float)p.pos[i];
#pragma unroll
    for (int j = 0; j < 8; j++) {
      float ang = ps * p.inv[j];
      float s, c; sincosf(ang, &s, &c);
      p.CS[i * 16 + j] = c; p.CS[i * 16 + 8 + j] = s;
    }
  }
  for (size_t i = gtid; i < 2 * 32 * 64; i += gstr) {
    int pp = (int)(i & 63), g = (int)((i >> 6) & 31), layer = (int)(i >> 11);
    float dt = expf(p.log_dt[layer * 32 + g]);
    float lr = p.lam_re[i], li = p.lam_im[i];
    float mag = expf(lr * dt);
    float sn, cs; sincosf(li * dt, &sn, &cs);
    float ar = mag * cs, ai = mag * sn;
    float den = lr * lr + li * li;
    float nr = ar - 1.f, ni = ai;
    float fr = (nr * lr + ni * li) / den, fi = (ni * lr - nr * li) / den;
    float* sb = p.SB + i * 32;
    const float* bre = p.b_re + i * 16; const float* bim = p.b_im + i * 16;
    for (int h = 0; h < 16; h++) {
      float br = bre[h], bi = bim[h];
      sb[h] = fr * br - fi * bi; sb[16 + h] = fr * bi + fi * br;
    }
    float pr = ar, pi = ai;
    for (int k = 0; k < 7; k++) { float nr2 = pr * pr - pi * pi, ni2 = 2.f * pr * pi; pr = nr2; pi = ni2; }
    p.SA[i * 4 + 0] = ar; p.SA[i * 4 + 1] = ai; p.SA[i * 4 + 2] = pr; p.SA[i * 4 + 3] = pi;
    for (int h = 0; h < 16; h++) {
      size_t ci = ((size_t)(layer * 32 + g) * 16 + h);
      p.CM[ci * 128 + pp] = f2bf(p.c_re[ci * 64 + pp]);
      p.CM[ci * 128 + 64 + pp] = f2bf(-p.c_im[ci * 64 + pp]);
    }
  }
}

__device__ __forceinline__ void phaseA(const Params& p, int layer) {
  const int tidf = otid_full();
  const int wid = __builtin_amdgcn_readfirstlane(tidf >> 6), lane = tidf & 63, wr = wid >> 2, wc = wid & 3, fr = lane & 15, fq = lane >> 4;
  const bf* Wl = p.WinT + (size_t)layer * INW * 2048;
  const int nA = 128 * 23;
  const int total = nA + (layer == 0 ? 8 : 0);
  for (int L = blockIdx.x; L < total; L += gridDim.x) {
    f32x4 acc[2][2][4][2]; ZERO_ACC8(acc);
    if (L < nA) {
      int pm, pn; tile_order(L, 128, 23, pm, pn);
      const int brow = pm * 256, bcol = pn * 256;
      gemm256(p.xb, 2048, Wl, 2048, 2048, brow, bcol, acc);
      int fr_o = fr; asm volatile("" : "+v"(fr_o));
#pragma unroll
      for (int ai = 0; ai < 2; ai++)
#pragma unroll
        for (int m = 0; m < 4; m++) {
          __builtin_amdgcn_sched_barrier(0);
          const int tok = brow + ai * 128 + wr * 64 + m * 16 + fr_o;
#pragma unroll
          for (int bj = 0; bj < 2; bj++)
#pragma unroll
            for (int n = 0; n < 2; n++) {
              const int cb = bcol + bj * 128 + wc * 32 + n * 16;
              f32x4 v = acc[ai][bj][m][n];
              if (n == 0 && (wc & 1) == 0 && ((cb >= C_ATQ && cb < C_ATV) || (cb >= C_IDQ && cb < C_IDW))) {
                f32x4 cs = *(const f32x4*)(p.CS + (size_t)tok * 16 + 4 * (fq & 1));
                f32x4 sn = *(const f32x4*)(p.CS + (size_t)tok * 16 + 8 + 4 * (fq & 1));
#pragma unroll
                for (int e = 0; e < 4; e++) {
                  float o = __shfl_xor(v[e], 32);
                  v[e] = (fq < 2) ? (v[e] * cs[e] - o * sn[e]) : (v[e] * cs[e] + o * sn[e]);
                }
              }
              const int nn = cb + fq * 4;
              if (nn < 5716) {
                const int dn = nn + (nn >= 2628 ? 12 : 0);
                uint2 pv = make_uint2(pk2(v[0], v[1]), pk2(v[2], v[3]));
                *(uint2*)(p.P + (size_t)tok * PW + dn) = pv;
                if (nn >= C_IDK && nn < C_IDW) {
                  const int d = nn - C_IDK; const int b = tok >> 14, li = tok & 16383;
                  size_t o = ((((size_t)(b * 512 + (li >> 5)) * 4 + (d >> 4)) * 64 + ((d >> 3) & 1) * 32 + (li & 31)) * 8) + (d & 7);
                  *(uint2*)(p.KIF + o) = pv;
                }
                if (nn >= C_ATK && nn < C_ATZ) *(uint2*)(p.KVC + (size_t)tok * 256 + (nn - C_ATK)) = pv;
              }
            }
        }
    } else {
      const int t8 = L - nA; const int ly = t8 >> 2, tm = (t8 >> 1) & 1, tn = t8 & 1;
      gemm256(p.memb, 2048, p.WmemT + (size_t)ly * 512 * 2048, 2048, 2048, tm * 256, tn * 256, acc);
#pragma unroll
      for (int ai = 0; ai < 2; ai++)
#pragma unroll
        for (int m = 0; m < 4; m++) {
          const int row = tm * 256 + ai * 128 + wr * 64 + m * 16 + fr; const int b = row >> 8, mm = row & 255;
#pragma unroll
          for (int bj = 0; bj < 2; bj++)
#pragma unroll
            for (int n = 0; n < 2; n++)
#pragma unroll
              for (int e = 0; e < 4; e++) {
                const int nn = tn * 256 + bj * 128 + wc * 32 + n * 16 + fq * 4 + e; const float v = acc[ai][bj][m][n][e];
                if (nn < 256) { int h = nn >> 6, d = nn & 63; p.MK[((((size_t)ly * 2 + b) * 4 + h) * 256 + mm) * 64 + d] = f2bf(v); }
                else { int h = (nn - 256) >> 6, d = nn & 63; p.MVT[((((size_t)ly * 2 + b) * 4 + h) * 64 + d) * 256 + mm] = f2bf(v); }
              }
        }
    }
  }
}

__device__ __forceinline__ float softplusf_(float x) {
  const float e = __expf(x);
  const float sp = (e < 0.01f) ? e * (1.f - 0.5f * e) : __logf(1.f + e);
  return x > 15.f ? x : sp;
}

__device__ __forceinline__ void ssd_dt_acs(const Params& p, int layer, size_t tok0, int gg, float* sAcs, float* sDt) {
  const int tid = otid(), lane = tid & 63, w = tid >> 6;
#pragma unroll
  for (int k = 0; k < 2; k++) {
    const int hh = 2 * w + k, hd = gg * 8 + hh;
    const float bias = p.dt_bias[layer * 16 + hd], a = -__expf(p.a_log[layer * 16 + hd]);
    const int l0 = 2 * lane;
    float d0 = softplusf_(bf2f(p.P[(tok0 + l0) * PW + C_SDT + hd]) + bias);
    float d1 = softplusf_(bf2f(p.P[(tok0 + l0 + 1) * PW + C_SDT + hd]) + bias);
    float s0 = d0 * a, s1 = s0 + d1 * a;
    float xs = s1;
#pragma unroll
    for (int off = 1; off < 64; off <<= 1) { float v = __shfl_up(xs, off); if (lane >= off) xs += v; }
    float ex = xs - s1;
    sAcs[l0 * 8 + hh] = ex + s0; sAcs[(l0 + 1) * 8 + hh] = ex + s1;
    sDt[l0 * 8 + hh] = d0; sDt[(l0 + 1) * 8 + hh] = d1;
  }
}

struct Conv2 { float w0[4], w1[4], b0, b1, h0[3], h1[3]; };
__device__ __forceinline__ void conv_init(const Params& p, int layer, size_t tokb, int l, int ch, Conv2& c) {
  const float* cw = p.conv_w + (size_t)layer * 4 * 1536 + ch;
#pragma unroll
  for (int k = 0; k < 4; k++) { c.w0[k] = cw[k * 1536]; c.w1[k] = cw[k * 1536 + 1]; }
  c.b0 = p.conv_b[layer * 1536 + ch]; c.b1 = p.conv_b[layer * 1536 + ch + 1];
#pragma unroll
  for (int k = 0; k < 3; k++) {
    int ll = l - 3 + k; unsigned u = 0;
    if (ll >= 0) u = *(const unsigned*)(p.P + (tokb + ll) * PW + C_XBC + ch);
    c.h0[k] = bflo(u); c.h1[k] = bfhi(u);
  }
}
__device__ __forceinline__ void conv_step(const Params& p, size_t tokb, int l, int ch, Conv2& c, float& o0, float& o1) {
  unsigned u = *(const unsigned*)(p.P + (tokb + l) * PW + C_XBC + ch);
  float x0 = bflo(u), x1 = bfhi(u);
  float a0 = c.b0 + c.w0[0] * c.h0[0] + c.w0[1] * c.h0[1] + c.w0[2] * c.h0[2] + c.w0[3] * x0;
  float a1 = c.b1 + c.w1[0] * c.h1[0] + c.w1[1] * c.h1[1] + c.w1[2] * c.h1[2] + c.w1[3] * x1;
  c.h0[0] = c.h0[1]; c.h0[1] = c.h0[2]; c.h0[2] = x0;
  c.h1[0] = c.h1[1]; c.h1[1] = c.h1[2]; c.h1[2] = x1;
  o0 = siluf_(a0); o1 = siluf_(a1);
}

__device__ __forceinline__ void conv_val(unsigned u, Conv2& c, float& o0, float& o1) {
  float x0 = bflo(u), x1 = bfhi(u);
  float a0 = c.b0 + c.w0[0] * c.h0[0] + c.w0[1] * c.h0[1] + c.w0[2] * c.h0[2] + c.w0[3] * x0;
  float a1 = c.b1 + c.w1[0] * c.h1[0] + c.w1[1] * c.h1[1] + c.w1[2] * c.h1[2] + c.w1[3] * x1;
  c.h0[0] = c.h0[1]; c.h0[1] = c.h0[2]; c.h0[2] = x0;
  c.h1[0] = c.h1[1]; c.h1[1] = c.h1[2]; c.h1[2] = x1;
  o0 = siluf_(a0); o1 = siluf_(a1);
}
#define CONV_PRELOAD(raw, N, lfirst, nrows, ch)                                                           \
  unsigned raw[N];                                                                                        \
  _Pragma("unroll") for (int k_ = 0; k_ < N; k_++)                                                        \
    raw[k_] = (k_ < (nrows)) ? *(const unsigned*)(p.P + (tokb + (lfirst) + k_) * PW + C_XBC + (ch)) : 0u;

__device__ __forceinline__ void ssd_pass1(const Params& p, int layer, int task, char* sm) {
  const int tid = otid(), lane = tid & 63, w = tid >> 6, r32 = lane & 31, h5 = lane >> 5;
  const int gg = task & 1, c = (task >> 1) & 127, b = task >> 8;
  const size_t tokb = (size_t)b * LSEQ; const int lc0 = c * 128; const size_t tok0 = tokb + lc0;
  float* sAcs = (float*)sm; float* sDt = (float*)(sm + 4096);
  bf* sBT = (bf*)(sm + 8192); bf* sXT = (bf*)(sm + 43008);
  __syncthreads();
  ssd_dt_acs(p, layer, tok0, gg, sAcs, sDt);
  {
    const int cp = tid & 63, tg = tid >> 6; const int ch = 1024 + gg * 128 + 2 * cp;
    Conv2 cv; conv_init(p, layer, tokb, lc0 + tg * 32, ch, cv);
    CONV_PRELOAD(raw, 32, lc0 + tg * 32, 32, ch)
#pragma unroll
    for (int k = 0; k < 32; k += 2) {
      const int l = tg * 32 + k;
      float a0, a1, b0, b1;
      conv_val(raw[k], cv, a0, a1);
      conv_val(raw[k + 1], cv, b0, b1);
      *(unsigned*)(sBT + (2 * cp) * 136 + l) = pk2(a0, b0);
      *(unsigned*)(sBT + (2 * cp + 1) * 136 + l) = pk2(a1, b1);
    }
  }
  __syncthreads();
  if (tid < 8) p.CD[((size_t)(b * 128 + c)) * 16 + gg * 8 + tid] = __expf(sAcs[127 * 8 + tid]);
  for (int hh = 0; hh < 8; hh++) {
    const int hd = gg * 8 + hh;
    if (hh) __syncthreads();
    {
      const int cp = tid & 31, tg = tid >> 5; const int ch = gg * 512 + hh * 64 + 2 * cp;
      const float aend = sAcs[127 * 8 + hh];
      Conv2 cv; conv_init(p, layer, tokb, lc0 + tg * 16, ch, cv);
      CONV_PRELOAD(raw, 16, lc0 + tg * 16, 16, ch)
#pragma unroll
      for (int k = 0; k < 16; k += 2) {
        const int l = tg * 16 + k;
        float a0, a1, b0, b1;
        conv_val(raw[k], cv, a0, a1);
        conv_val(raw[k + 1], cv, b0, b1);
        float sa = sDt[l * 8 + hh] * __expf(aend - sAcs[l * 8 + hh]);
        float sb = sDt[(l + 1) * 8 + hh] * __expf(aend - sAcs[(l + 1) * 8 + hh]);
        *(unsigned*)(sXT + (2 * cp) * 136 + l) = pk2(a0 * sa, b0 * sb);
        *(unsigned*)(sXT + (2 * cp + 1) * 136 + l) = pk2(a1 * sa, b1 * sb);
      }
    }
    __syncthreads();
    f32x16 acc[2];
#pragma unroll
    for (int r = 0; r < 16; r++) { const float z_ = ozero(); acc[0][r] = z_; acc[1][r] = z_; }
#pragma unroll
    for (int ks = 0; ks < 8; ks++) {
      bf16x8 bfr = *(const bf16x8*)(sBT + (32 * w + r32) * 136 + ks * 16 + 8 * h5);
      bf16x8 x0 = *(const bf16x8*)(sXT + (r32) * 136 + ks * 16 + 8 * h5);
      bf16x8 x1 = *(const bf16x8*)(sXT + (32 + r32) * 136 + ks * 16 + 8 * h5);
      acc[0] = mfma32(x0, bfr, acc[0]);
      acc[1] = mfma32(x1, bfr, acc[1]);
    }
    float* st = p.ST + ((size_t)(b * 128 + c) * 16 + hd) * 64 * 128;
#pragma unroll
    for (int pi = 0; pi < 2; pi++)
#pragma unroll
      for (int r = 0; r < 16; r++) {
        int pp = 32 * pi + 8 * (r >> 2) + 4 * h5 + (r & 3);
        st[pp * 128 + 32 * w + r32] = acc[pi][r];
      }
  }
}

__device__ __forceinline__ void ssd_statepass(const Params& p, int task) {
  const int idx = task * 256 + otid();
  const int b = idx >> 15, e4 = idx & 32767;
  const int hd = e4 >> 11;
  const float zc_ = ozero(); float4 carry = make_float4(zc_, zc_, zc_, zc_);
  float* base = p.ST + (size_t)b * 128 * 131072 + (size_t)e4 * 4;
  const float* cd = p.CD + (size_t)b * 128 * 16 + hd;
  for (int c0 = 0; c0 < 128; c0 += 4) {
    float4 v[4]; float d[4];
#pragma unroll
    for (int k = 0; k < 4; k++) { v[k] = *(const float4*)(base + (size_t)(c0 + k) * 131072); d[k] = cd[(c0 + k) * 16]; }
#pragma unroll
    for (int k = 0; k < 4; k++) {
      *(float4*)(base + (size_t)(c0 + k) * 131072) = carry;
      carry.x = carry.x * d[k] + v[k].x; carry.y = carry.y * d[k] + v[k].y;
      carry.z = carry.z * d[k] + v[k].z; carry.w = carry.w * d[k] + v[k].w;
    }
  }
}

__device__ __forceinline__ void ssd_pass2(const Params& p, int layer, int task, char* sm) {
  const int tid = otid(), lane = tid & 63, w = tid >> 6, r32 = lane & 31, h5 = lane >> 5;
  const int lh = task & 1, gg = (task >> 1) & 1, c = (task >> 2) & 127, b = task >> 9;
  const size_t tokb = (size_t)b * LSEQ; const int lc0 = c * 128; const size_t tok0 = tokb + lc0;
  float* sAcs = (float*)sm; float* sDt = (float*)(sm + 4096);
  bf* sC = (bf*)(sm + 8192); bf* sB = (bf*)(sm + 25600); bf* sM = (bf*)(sm + 25600); bf* sXT = (bf*)(sm + 43008);
  float* sSsq = (float*)(sm + 60416);
  const int wr = w >> 1, wc = w & 1;
  const int nS = 64 * (lh + 1);
  __syncthreads();
  ssd_dt_acs(p, layer, tok0, gg, sAcs, sDt);
  {
    const int cp = tid & 63, tg = tid >> 6;
    {
      const int ch = 1280 + gg * 128 + 2 * cp;
      const int lst = 64 * lh + tg * 16;
      Conv2 cv; conv_init(p, layer, tokb, lc0 + lst, ch, cv);
      CONV_PRELOAD(raw, 16, lc0 + lst, 16, ch)
#pragma unroll
      for (int k = 0; k < 16; k++) {
        const int l = lst + k;
        float a0, a1; conv_val(raw[k], cv, a0, a1);
        *(unsigned*)(sC + (l - 64 * lh) * 136 + 2 * cp) = pk2(a0, a1);
      }
    }
    {
      const int ch = 1024 + gg * 128 + 2 * cp;
      const int per = nS >> 2; const int lst = tg * per;
      Conv2 cv; conv_init(p, layer, tokb, lc0 + lst, ch, cv);
      CONV_PRELOAD(raw, 32, lc0 + lst, per, ch)
#pragma unroll
      for (int k = 0; k < 32; k++) {
        if (k < per) {
          const int l = lst + k;
          float a0, a1; conv_val(raw[k], cv, a0, a1);
          *(unsigned*)(sB + l * 136 + 2 * cp) = pk2(a0, a1);
        }
      }
    }
  }
  __syncthreads();
  f32x16 cb[2];
#pragma unroll
  for (int r = 0; r < 16; r++) { const float z_ = ozero(); cb[0][r] = z_; cb[1][r] = z_; }
  if (64 * wc < nS) {
#pragma unroll
    for (int ks = 0; ks < 8; ks++) {
      bf16x8 af = *(const bf16x8*)(sC + (32 * wr + r32) * 136 + ks * 16 + 8 * h5);
      bf16x8 b0 = *(const bf16x8*)(sB + (64 * wc + r32) * 136 + ks * 16 + 8 * h5);
      bf16x8 b1 = *(const bf16x8*)(sB + (64 * wc + 32 + r32) * 136 + ks * 16 + 8 * h5);
      cb[0] = mfma32(af, b0, cb[0]);
      cb[1] = mfma32(af, b1, cb[1]);
    }
  }
  __syncthreads();
  const int wc2 = w & 1;
  for (int hh = 0; hh < 8; hh++) {
    const int hd = gg * 8 + hh;
    if (hh) __syncthreads();
    bf16x8 pfr[8];
    {
      const float* pv = p.ST + (((size_t)(b * 128 + c) * 16 + hd) * 64 + 32 * wc2 + r32) * 128 + 8 * h5;
#pragma unroll
      for (int ks = 0; ks < 8; ks++) {
        float4 u0 = *(const float4*)(pv + ks * 16), u1 = *(const float4*)(pv + ks * 16 + 4);
        unsigned q0 = pk2(u0.x, u0.y), q1 = pk2(u0.z, u0.w), q2 = pk2(u1.x, u1.y), q3 = pk2(u1.z, u1.w);
        pfr[ks][0] = (short)(q0 & 0xFFFF); pfr[ks][1] = (short)(q0 >> 16); pfr[ks][2] = (short)(q1 & 0xFFFF); pfr[ks][3] = (short)(q1 >> 16);
        pfr[ks][4] = (short)(q2 & 0xFFFF); pfr[ks][5] = (short)(q2 >> 16); pfr[ks][6] = (short)(q3 & 0xFFFF); pfr[ks][7] = (short)(q3 >> 16);
      }
    }
    {
      const float dsk = p.ssd_d[layer * 16 + hd];
#pragma unroll
      for (int j = 0; j < 2; j++) {
        const int s = 64 * wc + 32 * j + r32;
        if (s < nS) {
          const float as = sAcs[s * 8 + hh];
#pragma unroll
          for (int r = 0; r < 16; r++) {
            const int lp = 32 * wr + 8 * (r >> 2) + 4 * h5 + (r & 3); const int l = 64 * lh + lp;
            float v = 0.f;
            if (s <= l) v = cb[j][r] * __expf(sAcs[l * 8 + hh] - as);
            if (s == l) v += dsk * __builtin_amdgcn_rcpf(sDt[l * 8 + hh]);
            sM[lp * 136 + s] = f2bf(v);
          }
        }
      }
    }
    {
      const int cp = tid & 31, tg = tid >> 5; const int ch = gg * 512 + hh * 64 + 2 * cp;
      const int per = nS >> 3; const int lst = tg * per;
      Conv2 cv; conv_init(p, layer, tokb, lc0 + lst, ch, cv);
      CONV_PRELOAD(raw, 16, lc0 + lst, per, ch)
#pragma unroll
      for (int k = 0; k < 16; k += 2) {
        if (k >= per) break;
        const int l = lst + k;
        float a0, a1, b0, b1;
        conv_val(raw[k], cv, a0, a1);
        conv_val(raw[k + 1], cv, b0, b1);
        float sa = sDt[l * 8 + hh], sb = sDt[(l + 1) * 8 + hh];
        *(unsigned*)(sXT + (2 * cp) * 136 + l) = pk2(a0 * sa, b0 * sb);
        *(unsigned*)(sXT + (2 * cp + 1) * 136 + l) = pk2(a1 * sa, b1 * sb);
      }
    }
    __syncthreads();
    f32x16 yd, yo;
#pragma unroll
    for (int r = 0; r < 16; r++) { const float z_ = ozero(); yd[r] = z_; yo[r] = z_; }
    const int nks = nS >> 4;
    for (int ks = 0; ks < nks; ks++) {
      bf16x8 xf = *(const bf16x8*)(sXT + (32 * wc2 + r32) * 136 + ks * 16 + 8 * h5);
      bf16x8 mf = *(const bf16x8*)(sM + (32 * wr + r32) * 136 + ks * 16 + 8 * h5);
      yd = mfma32(xf, mf, yd);
    }
    {
#pragma unroll
      for (int ks = 0; ks < 8; ks++) {
        bf16x8 cf = *(const bf16x8*)(sC + (32 * wr + r32) * 136 + ks * 16 + 8 * h5);
        yo = mfma32(pfr[ks], cf, yo);
      }
    }
    {
      const int lp = 32 * wr + r32; const int l = 64 * lh + lp; const size_t tok = tok0 + l;
      const float eo = __expf(sAcs[l * 8 + hh]);
      float ss = 0.f;
#pragma unroll
      for (int q = 0; q < 4; q++) {
        const int pp = 32 * wc2 + 8 * q + 4 * h5;
        uint2 zz = *(const uint2*)(p.P + tok * PW + C_SSZ + hd * 64 + pp);
        float v0 = (yd[4 * q] + eo * yo[4 * q]) * siluf_(bflo(zz.x));
        float v1 = (yd[4 * q + 1] + eo * yo[4 * q + 1]) * siluf_(bfhi(zz.x));
        float v2 = (yd[4 * q + 2] + eo * yo[4 * q + 2]) * siluf_(bflo(zz.y));
        float v3 = (yd[4 * q + 3] + eo * yo[4 * q + 3]) * siluf_(bfhi(zz.y));
        ss += v0 * v0 + v1 * v1 + v2 * v2 + v3 * v3;
        *(uint2*)(p.Y + tok * YW + Y_SSD + hd * 64 + pp) = make_uint2(pk2(v0, v1), pk2(v2, v3));
      }
      sSsq[lp * 32 + hh * 4 + wc2 * 2 + h5] = ss;
    }
  }
  __syncthreads();
  {
    const int lp = tid >> 2, part = tid & 3; const size_t tok = tok0 + 64 * lh + lp;
    float tot = 0.f;
#pragma unroll
    for (int k = 0; k < 32; k += 4) { float4 v4 = *(const float4*)(sSsq + lp * 32 + k); tot += (v4.x + v4.y) + (v4.z + v4.w); }
    const float rs = rsqrtf(tot * (1.f / 512.f) + 1e-5f);
    bf* yp = p.Y + tok * YW + Y_SSD + gg * 512 + part * 128;
    const float* ng = p.norm_g + layer * 1024 + gg * 512 + part * 128;
#pragma unroll 4
    for (int i = 0; i < 16; i++) {
      uint4 u = *(const uint4*)(yp + i * 8);
      float4 g0 = *(const float4*)(ng + i * 8), g1 = *(const float4*)(ng + i * 8 + 4);
      u.x = pk2(bflo(u.x) * rs * g0.x, bfhi(u.x) * rs * g0.y);
      u.y = pk2(bflo(u.y) * rs * g0.z, bfhi(u.y) * rs * g0.w);
      u.z = pk2(bflo(u.z) * rs * g1.x, bfhi(u.z) * rs * g1.y);
      u.w = pk2(bflo(u.w) * rs * g1.z, bfhi(u.w) * rs * g1.w);
      *(uint4*)(yp + i * 8) = u;
    }
  }
}

__device__ __forceinline__ void s5_ld_u(const Params& p, size_t tok, int g, uint4& a, uint4& b) {
  const uint4* src = (const uint4*)(p.P + tok * PW + C_S5U + g * 16);
  a = src[0]; b = src[1];
}
__device__ __forceinline__ void s5_st_u(float* dst, const uint4 a, const uint4 b) {
  *(float4*)(dst + 0) = make_float4(bflo(a.x), bfhi(a.x), bflo(a.y), bfhi(a.y));
  *(float4*)(dst + 4) = make_float4(bflo(a.z), bfhi(a.z), bflo(a.w), bfhi(a.w));
  *(float4*)(dst + 8) = make_float4(bflo(b.x), bfhi(b.x), bflo(b.y), bfhi(b.y));
  *(float4*)(dst + 12) = make_float4(bflo(b.z), bfhi(b.z), bflo(b.w), bfhi(b.w));
}
__device__ __forceinline__ void s5_load_u(const Params& p, size_t tok, int g, float* dst) {
  const uint4* src = (const uint4*)(p.P + tok * PW + C_S5U + g * 16);
  uint4 a = src[0], b = src[1];
  *(float4*)(dst + 0) = make_float4(bflo(a.x), bfhi(a.x), bflo(a.y), bfhi(a.y));
  *(float4*)(dst + 4) = make_float4(bflo(a.z), bfhi(a.z), bflo(a.w), bfhi(a.w));
  *(float4*)(dst + 8) = make_float4(bflo(b.x), bfhi(b.x), bflo(b.y), bfhi(b.y));
  *(float4*)(dst + 12) = make_float4(bflo(b.z), bfhi(b.z), bflo(b.w), bfhi(b.w));
}
typedef float f32x2 __attribute__((ext_vector_type(2)));
#define S5_STEP(uu)                                                                     \
  {                                                                                     \
    float4 u0 = *(const float4*)((uu)), u1 = *(const float4*)((uu) + 4), u2 = *(const float4*)((uu) + 8), u3 = *(const float4*)((uu) + 12); \
    f32x2 bb = B2[0] * (f32x2){u0.x, u0.x};                                             \
    bb = B2[1] * (f32x2){u0.y, u0.y} + bb; bb = B2[2] * (f32x2){u0.z, u0.z} + bb; bb = B2[3] * (f32x2){u0.w, u0.w} + bb;     \
    bb = B2[4] * (f32x2){u1.x, u1.x} + bb; bb = B2[5] * (f32x2){u1.y, u1.y} + bb; bb = B2[6] * (f32x2){u1.z, u1.z} + bb; bb = B2[7] * (f32x2){u1.w, u1.w} + bb; \
    bb = B2[8] * (f32x2){u2.x, u2.x} + bb; bb = B2[9] * (f32x2){u2.y, u2.y} + bb; bb = B2[10] * (f32x2){u2.z, u2.z} + bb; bb = B2[11] * (f32x2){u2.w, u2.w} + bb; \
    bb = B2[12] * (f32x2){u3.x, u3.x} + bb; bb = B2[13] * (f32x2){u3.y, u3.y} + bb; bb = B2[14] * (f32x2){u3.z, u3.z} + bb; bb = B2[15] * (f32x2){u3.w, u3.w} + bb; \
    float nr_ = ar * sr - ai * si + bb.x; float ni_ = ar * si + ai * sr + bb.y; sr = nr_; si = ni_; \
  }

__device__ __forceinline__ void s5_pass1(const Params& p, int layer, int task, char* sm) {
  const int tid = otid(), lane = tid & 63, w = tid >> 6;
  const int gq = task & 7, c = (task >> 3) & 127, b = task >> 10;
  const int g = gq * 4 + w;
  const size_t tok0 = (size_t)b * LSEQ + c * 128;
  float* sU = (float*)(sm + w * 8192);
  __syncthreads();
  s5_load_u(p, tok0 + lane, g, sU + lane * 16);
  s5_load_u(p, tok0 + 64 + lane, g, sU + (64 + lane) * 16);
  const size_t pi = ((size_t)(layer * 32 + g)) * 64 + lane;
  f32x2 B2[16];
#pragma unroll
  for (int h = 0; h < 16; h++) { B2[h].x = p.SB[pi * 32 + h]; B2[h].y = p.SB[pi * 32 + 16 + h]; }
  const float ar = p.SA[pi * 4], ai = p.SA[pi * 4 + 1];
  float sr = 0.f, si = 0.f;
  __builtin_amdgcn_wave_barrier();
  for (int l = 0; l < 128; l++) S5_STEP(sU + l * 16)
  *(float2*)(p.END + (((size_t)(b * 128 + c) * 32 + g) * 64 + lane) * 2) = make_float2(sr, si);
}

__device__ __forceinline__ void s5_carry(const Params& p, int layer, int task) {
  const int idx = task * 256 + otid();
  const int b = idx >> 11, gp = idx & 2047;
  const size_t pi = (size_t)layer * 2048 + gp;
  const float a128r = p.SA[pi * 4 + 2], a128i = p.SA[pi * 4 + 3];
  float sr = ozero(), si = ozero();
  float2* e = (float2*)p.END + (size_t)b * 128 * 2048 + gp;
  for (int c0 = 0; c0 < 128; c0 += 4) {
    float2 v[4];
#pragma unroll
    for (int k = 0; k < 4; k++) v[k] = e[(size_t)(c0 + k) * 2048];
#pragma unroll
    for (int k = 0; k < 4; k++) {
      e[(size_t)(c0 + k) * 2048] = make_float2(sr, si);
      float nr = a128r * sr - a128i * si + v[k].x, ni = a128r * si + a128i * sr + v[k].y; sr = nr; si = ni;
    }
  }
}

__device__ __forceinline__ void s5_pass2(const Params& p, int layer, int task, char* sm) {
  const int tid = otid(), lane = tid & 63, w = tid >> 6;
  const int c = task & 127, b = task >> 7;
  const size_t tok0 = (size_t)b * LSEQ + c * 128;
  float* sU = (float*)(sm + w * 10752); bf* sS = (bf*)(sm + w * 10752 + 2048);
  __syncthreads();
  uint4 ua, ub;
  s5_ld_u(p, tok0 + (lane & 31), w * 8, ua, ub);
  for (int gi = 0; gi < 8; gi++) {
    const int g = w * 8 + gi;
    const size_t pi = ((size_t)(layer * 32 + g)) * 64 + lane;
    f32x2 B2[16];
#pragma unroll
    for (int h = 0; h < 16; h++) { B2[h].x = p.SB[pi * 32 + h]; B2[h].y = p.SB[pi * 32 + 16 + h]; }
    const float ar = p.SA[pi * 4], ai = p.SA[pi * 4 + 1];
    float2 s0 = *(const float2*)(p.END + (((size_t)(b * 128 + c) * 32 + g) * 64 + lane) * 2);
    float sr = s0.x, si = s0.y;
    bf16x8 cf[4];
    {
      const bf* cm = p.CM + (((size_t)(layer * 32 + g)) * 16 + (lane & 15)) * 128 + 8 * (lane >> 4);
#pragma unroll
      for (int ks = 0; ks < 4; ks++) cf[ks] = *(const bf16x8*)(cm + ks * 32);
    }
    const float dsk = p.s5_d[(layer * 32 + g) * 16 + (lane & 15)];
    for (int sub = 0; sub < 4; sub++) {
      __builtin_amdgcn_wave_barrier();
      if (lane < 32) s5_st_u(sU + lane * 16, ua, ub);
      {
        const int nsub = (sub + 1) & 3; const int ng = g + (sub == 3 ? 1 : 0);
        if (sub < 3 || gi < 7) s5_ld_u(p, tok0 + nsub * 32 + (lane & 31), ng, ua, ub);
      }
      __builtin_amdgcn_wave_barrier();
      for (int l = 0; l < 32; l++) {
        S5_STEP(sU + l * 16)
        sS[l * 136 + lane] = f2bf(sr); sS[l * 136 + 64 + lane] = f2bf(si);
      }
      __builtin_amdgcn_wave_barrier();
#pragma unroll
      for (int mb = 0; mb < 2; mb++) {
        const float z_ = ozero(); f32x4 acc = {z_, z_, z_, z_};
#pragma unroll
        for (int ks = 0; ks < 4; ks++) {
          bf16x8 af = *(const bf16x8*)(sS + (16 * mb + (lane & 15)) * 136 + ks * 32 + 8 * (lane >> 4));
          acc = mfma16(af, cf[ks], acc);
        }
#pragma unroll
        for (int r = 0; r < 4; r++) {
          const int l = 16 * mb + 4 * (lane >> 4) + r;
          float y = acc[r] + dsk * sU[l * 16 + (lane & 15)];
          p.YG[(tok0 + sub * 32 + l) * 512 + g * 16 + (lane & 15)] = f2bf(geluf_(y));
        }
      }
    }
  }
  __syncthreads();
  const int wr = w >> 1, wc = w & 1, r32 = lane & 31, h5 = lane >> 5;
  for (int tn = 0; tn < 4; tn++) {
    f32x16 acc[2][2]; ZERO_ACC(acc);
    gemm_acc<4>(p.YG + tok0 * 512, 512, p.WgluT + ((size_t)layer * 512 + tn * 128) * 512, 512, 512, acc, sm);
#pragma unroll
    for (int i = 0; i < 2; i++) {
      const size_t tok = tok0 + wr * 64 + i * 32 + r32;
#pragma unroll
      for (int j = 0; j < 2; j++)
#pragma unroll
        for (int q = 0; q < 4; q++) {
          const int n = tn * 128 + wc * 64 + j * 32 + q * 8 + h5 * 4;
          float4 bg = *(const float4*)(p.b_glu + layer * 512 + n);
          uint2 yy = *(const uint2*)(p.YG + tok * 512 + n);
          uint2 zz = *(const uint2*)(p.P + tok * PW + C_S5Z + n);
          float o0 = bflo(yy.x) * sigmoidf_(acc[i][j][4 * q] + bg.x) * siluf_(bflo(zz.x));
          float o1 = bfhi(yy.x) * sigmoidf_(acc[i][j][4 * q + 1] + bg.y) * siluf_(bfhi(zz.x));
          float o2 = bflo(yy.y) * sigmoidf_(acc[i][j][4 * q + 2] + bg.z) * siluf_(bflo(zz.y));
          float o3 = bfhi(yy.y) * sigmoidf_(acc[i][j][4 * q + 3] + bg.w) * siluf_(bfhi(zz.y));
          *(uint2*)(p.Y + tok * YW + Y_S5 + n) = make_uint2(pk2(o0, o1), pk2(o2, o3));
        }
    }
  }
}

__device__ __forceinline__ void mem_attn(const Params& p, int layer, int task) {
  const int tid = otid(), lane = tid & 63, h = tid >> 6;
  const int n16 = lane & 15, kq = lane >> 4;
  const size_t tok0 = (size_t)task * 16; const int b = (int)(tok0 >> 14);
  const bf* mk = p.MK + (((size_t)layer * 2 + b) * 4 + h) * 256 * 64;
  const bf* mvt = p.MVT + (((size_t)layer * 2 + b) * 4 + h) * 64 * 256;
  bf16x8 qf[2];
  {
    const bf* qp = p.P + (tok0 + n16) * PW + C_MEQ + h * 64 + 8 * kq;
    qf[0] = *(const bf16x8*)qp; qf[1] = *(const bf16x8*)(qp + 32);
  }
  f32x4 st[16];
#pragma unroll
  for (int kb = 0; kb < 16; kb++) {
    const bf* kp = mk + (size_t)(16 * kb + n16) * 64 + 8 * kq;
    bf16x8 a0 = *(const bf16x8*)kp, a1 = *(const bf16x8*)(kp + 32);
    const float z_ = ozero(); f32x4 acc = {z_, z_, z_, z_};
    acc = mfma16(a0, qf[0], acc); acc = mfma16(a1, qf[1], acc);
    st[kb] = acc * 0.125f;
  }
  float mx = -3.0e38f;
#pragma unroll
  for (int kb = 0; kb < 16; kb++)
#pragma unroll
    for (int r = 0; r < 4; r++) mx = fmaxf(mx, st[kb][r]);
  mx = fmaxf(mx, __shfl_xor(mx, 16)); mx = fmaxf(mx, __shfl_xor(mx, 32));
  float sum = 0.f;
#pragma unroll
  for (int kb = 0; kb < 16; kb++)
#pragma unroll
    for (int r = 0; r < 4; r++) { float e = __expf(st[kb][r] - mx); st[kb][r] = e; sum += e; }
  sum += __shfl_xor(sum, 16); sum += __shfl_xor(sum, 32);
  const float rinv = 1.f / sum;
  f32x4 o[4];
#pragma unroll
  for (int mb = 0; mb < 4; mb++) { const float z_ = ozero(); o[mb] = (f32x4){z_, z_, z_, z_}; }
#pragma unroll
  for (int k2 = 0; k2 < 8; k2++) {
    bf16x8 pf;
    unsigned q0 = pk2(st[2 * k2][0], st[2 * k2][1]), q1 = pk2(st[2 * k2][2], st[2 * k2][3]);
    unsigned q2 = pk2(st[2 * k2 + 1][0], st[2 * k2 + 1][1]), q3 = pk2(st[2 * k2 + 1][2], st[2 * k2 + 1][3]);
    pf[0] = (short)(q0 & 0xFFFF); pf[1] = (short)(q0 >> 16); pf[2] = (short)(q1 & 0xFFFF); pf[3] = (short)(q1 >> 16);
    pf[4] = (short)(q2 & 0xFFFF); pf[5] = (short)(q2 >> 16); pf[6] = (short)(q3 & 0xFFFF); pf[7] = (short)(q3 >> 16);
#pragma unroll
    for (int mb = 0; mb < 4; mb++) {
      const bf* vp = mvt + (size_t)(16 * mb + n16) * 256 + 32 * k2 + 4 * kq;
      uint2 v0 = *(const uint2*)vp, v1 = *(const uint2*)(vp + 16);
      bf16x8 af;
      af[0] = (short)(v0.x & 0xFFFF); af[1] = (short)(v0.x >> 16); af[2] = (short)(v0.y & 0xFFFF); af[3] = (short)(v0.y >> 16);
      af[4] = (short)(v1.x & 0xFFFF); af[5] = (short)(v1.x >> 16); af[6] = (short)(v1.y & 0xFFFF); af[7] = (short)(v1.y >> 16);
      o[mb] = mfma16(af, pf, o[mb]);
    }
  }
  const size_t tok = tok0 + n16;
#pragma unroll
  for (int mb = 0; mb < 4; mb++) {
    const int d = 16 * mb + 4 * kq;
    uint2 zz = *(const uint2*)(p.P + tok * PW + C_MEZ + h * 64 + d);
    float v0 = o[mb][0] * rinv * siluf_(bflo(zz.x)), v1 = o[mb][1] * rinv * siluf_(bfhi(zz.x));
    float v2 = o[mb][2] * rinv * siluf_(bflo(zz.y)), v3 = o[mb][3] * rinv * siluf_(bfhi(zz.y));
    *(uint2*)(p.Y + tok * YW + Y_MEM + h * 64 + d) = make_uint2(pk2(v0, v1), pk2(v2, v3));
  }
}

__device__ __forceinline__ void dsa_wave(const Params& p, int rank, char* sm) {
  const int tid = otid(), lane = tid & 63, w = tid >> 6, r32 = lane & 31, h5 = lane >> 5;
  const int b = rank & 1, qg = 2047 - (rank >> 1), l0 = qg * 8;
  const size_t tokb = (size_t)b * LSEQ;
  unsigned* cand = (unsigned*)(sm + w * (8 * CAP * 4));
  bf* Pb = (bf*)(sm + 61440 + w * 4096);
  bf16x8 aq[4];
  {
    const bf* qp = p.P + (tokb + l0 + (r32 >> 2)) * PW + C_IDQ + (r32 & 3) * 64 + 8 * h5;
#pragma unroll
    for (int ks = 0; ks < 4; ks++) aq[ks] = *(const bf16x8*)(qp + ks * 16);
  }
  float wv[4][4]; int ql[4];
#pragma unroll
  for (int g = 0; g < 4; g++) {
    ql[g] = l0 + 2 * g + h5;
    uint2 u = *(const uint2*)(p.P + (tokb + ql[g]) * PW + C_IDW);
    wv[g][0] = bflo(u.x) * 0.0625f; wv[g][1] = bfhi(u.x) * 0.0625f; wv[g][2] = bflo(u.y) * 0.0625f; wv[g][3] = bfhi(u.y) * 0.0625f;
  }
  unsigned Tg[4] = {0u, 0u, 0u, 0u}; float Tf[4];
  unsigned Tq = 0u; int cntv = 0;
  int nrep_ = (PROBE_MASK & 32) ? 2 : 1; asm volatile("" : "+s"(nrep_));
#pragma unroll 1
  for (int rep_ = 0; rep_ < nrep_; rep_++) {
  Tg[0] = Tg[1] = Tg[2] = Tg[3] = 0u; Tq = 0u; cntv = 0;
  Tf[0] = Tf[1] = Tf[2] = Tf[3] = -__builtin_inff();
  const int ntile = (l0 + 7) / 32 + 1;
  const bf* kif = p.KIF + (size_t)b * 512 * 2048 + lane * 8;
  bf16x8 bqA[4][4], bqB[4][4];
#pragma unroll
  for (int s = 0; s < 4; s++) {
    const int ts = s < ntile ? s : ntile - 1;
#pragma unroll
    for (int ks = 0; ks < 4; ks++) bqA[s][ks] = *(const bf16x8*)(kif + (size_t)ts * 2048 + ks * 512);
  }
  const unsigned ltmask = (1u << r32) - 1u;
#define DSA_COMPACT_CHECK()                                                                                              \
  {                                                                                                                     \
    unsigned long long over = __ballot(lane < 8 && cntv > CAP - 64);                                                    \
    if (over) {                                                                                                         \
      while (over) {                                                                                                    \
        const int q = __builtin_ctzll(over); over &= over - 1;                                                          \
        const int n = __builtin_amdgcn_readlane(cntv, q);                                                               \
        unsigned* cb_ = cand + q * CAP;                                                                                 \
        unsigned e[8];                                                                                                  \
        _Pragma("unroll") for (int i = 0; i < 8; i++) e[i] = (i * 64 + lane < n) ? cb_[i * 64 + lane] : 0u;             \
        unsigned T = 0u; int cT = n;                                                                                    \
        int nsr_ = (PROBE_MASK & 64) ? 2 : 1; asm volatile("" : "+s"(nsr_));                                            \
        _Pragma("unroll 1") for (int sr_ = 0; sr_ < nsr_; sr_++) { T = 0u; cT = n;                                      \
        const unsigned Told_ = (unsigned)__builtin_amdgcn_readlane((int)Tq, q);                                         \
        for (int bit = 31; bit >= 14; bit--) {                                                                          \
          const unsigned cnd = T | (1u << bit); int cc = 0;                                                             \
          if (cnd <= Told_) { T = cnd; continue; }                       \
          _Pragma("unroll") for (int i = 0; i < 8; i++) cc += __popcll(__ballot(e[i] >= cnd));                          \
          if (cc >= 256) { T = cnd; cT = cc; }                                                                          \
        } }                                                                                                             \
        if (cT > 320) {                                                                                                 \
          for (int bit = 13; bit >= 0; bit--) {                                                                         \
            const unsigned cnd = T | (1u << bit); int cc = 0;                                                           \
            _Pragma("unroll") for (int i = 0; i < 8; i++) cc += __popcll(__ballot(e[i] >= cnd));                        \
            if (cc >= 256) T = cnd;                                                                                     \
          }                                                                                                             \
        }                                                                                                               \
        int pos = 0;                                                                                                    \
        _Pragma("unroll") for (int i = 0; i < 8; i++) {                                                                 \
          const bool keep = e[i] >= T; const unsigned long long m = __ballot(keep);                                     \
          if (keep) cb_[pos + __popcll(m & ((1ull << lane) - 1ull))] = e[i];                                            \
          pos += __popcll(m);                                                                                           \
        }                                                                                                               \
        if (lane == q) { cntv = pos; Tq = T; }                                                                          \
      }                                                                                                                 \
      _Pragma("unroll") for (int g = 0; g < 4; g++) {                                                                   \
        unsigned tlo = __builtin_amdgcn_readlane(Tq, 2 * g), thi = __builtin_amdgcn_readlane(Tq, 2 * g + 1);            \
        Tg[g] = h5 ? thi : tlo;                                                                                         \
        const unsigned sh = Tg[g] & 0xFFFFC000u;                                                                        \
        const unsigned fb = (sh & 0x80000000u) ? (sh ^ 0x80000000u) : ~sh;                                              \
        Tf[g] = Tg[g] ? __uint_as_float(fb) : -__builtin_inff();                                                        \
      }                                                                                                                 \
    }                                                                                                                   \
  }
#define DSA_G(g, DIAG)                                                                                                  \
      {                                                                                                                 \
        const float r0 = __int_as_float(max(__float_as_int(acc[4 * g]), 0)), r1 = __int_as_float(max(__float_as_int(acc[4 * g + 1]), 0)); \
        const float r2 = __int_as_float(max(__float_as_int(acc[4 * g + 2]), 0)), r3 = __int_as_float(max(__float_as_int(acc[4 * g + 3]), 0)); \
        float sc = r0 * wv[g][0]; sc = fmaf(r1, wv[g][1], sc); sc = fmaf(r2, wv[g][2], sc); sc = fmaf(r3, wv[g][3], sc); \
        unsigned long long m0 = __builtin_amdgcn_fcmpf(sc, Tf[g], 3  );                                            \
        if (DIAG) m0 &= __builtin_amdgcn_sicmp(kidx, ql[g], 41  );                                                 \
        if (m0) {                                                                                                       \
          const float s2 = sc + 0.f;                                                                                    \
          unsigned uu = __float_as_uint(s2); uu ^= ((unsigned)((int)uu >> 31) | 0x80000000u);                           \
          const unsigned pk = (uu & 0xFFFFC000u) | (unsigned)(16383 - kidx);                                            \
          const unsigned long long m = m0 & __builtin_amdgcn_uicmp(pk, Tg[g], 35  );                              \
          if (m) {                                                                                                      \
            const unsigned lo = (unsigned)m, hi = (unsigned)(m >> 32);                                                  \
            const int cA = __builtin_amdgcn_readlane(cntv, 2 * g), cB = __builtin_amdgcn_readlane(cntv, 2 * g + 1);     \
            const unsigned mm = h5 ? hi : lo;                                                                           \
            if ((mm >> r32) & 1u) {                                                                                     \
              const int base = h5 ? cB : cA;                                                                            \
              cand[(2 * g + h5) * CAP + base + __popc(mm & ltmask)] = pk;                                               \
            }                                                                                                           \
            if (lane == 2 * g) cntv += __popc(lo);                                                                      \
            if (lane == 2 * g + 1) cntv += __popc(hi);                                                                  \
          }                                                                                                             \
        }                                                                                                               \
      }
#define DSA_GROUP(BC, BN, TB)                                                                                           \
  _Pragma("unroll") for (int u = 0; u < 4; u++) {                                                                       \
    if ((u & 1) == 0) DSA_COMPACT_CHECK()                                                                               \
    const int tile = (TB) + u;                                                                                          \
    f32x16 acc = {0.f, 0.f, 0.f, 0.f, 0.f, 0.f, 0.f, 0.f, 0.f, 0.f, 0.f, 0.f, 0.f, 0.f, 0.f, 0.f};                    \
    _Pragma("unroll") for (int ks = 0; ks < 4; ks++) acc = mfma32(aq[ks], BC[u][ks], acc);                              \
    if (u == 0) {                                                                                                       \
      _Pragma("unroll") for (int s = 0; s < 4; s++) {                                                                   \
        const int tn_ = ((TB) + 4 + s < ntile) ? (TB) + 4 + s : ntile - 1;                                              \
        _Pragma("unroll") for (int ks = 0; ks < 4; ks++) BN[s][ks] = *(const bf16x8*)(kif + (size_t)tn_ * 2048 + ks * 512); \
      }                                                                                                                 \
    }                                                                                                                   \
    const int kidx = tile * 32 + r32;                                                                                   \
    const bool diag = (tile * 32 + 31 > l0);                                                                            \
    if (!diag) { DSA_G(0, false) DSA_G(1, false) DSA_G(2, false) DSA_G(3, false) }                                      \
    else { DSA_G(0, true) DSA_G(1, true) DSA_G(2, true) DSA_G(3, true) }                                                \
  }
  for (int tile0 = 0; tile0 < ntile; tile0 += 8) {
    DSA_GROUP(bqA, bqB, tile0)
    DSA_GROUP(bqB, bqA, tile0 + 4)
  }
  {
    unsigned long long over = __ballot(lane < 8 && cntv > 256);
    while (over) {
      const int q = __builtin_ctzll(over); over &= over - 1;
      const int n = __builtin_amdgcn_readlane(cntv, q);
      unsigned* cb_ = cand + q * CAP;
      unsigned e[8];
#pragma unroll
      for (int i = 0; i < 8; i++) e[i] = (i * 64 + lane < n) ? cb_[i * 64 + lane] : 0u;
      unsigned T = 0u;
      for (int bit = 31; bit >= 0; bit--) {
        const unsigned cnd = T | (1u << bit); int cc = 0;
#pragma unroll
        for (int i = 0; i < 8; i++) cc += __popcll(__ballot(e[i] >= cnd));
        if (cc >= 256) T = cnd;
      }
      int pos = 0;
#pragma unroll
      for (int i = 0; i < 8; i++) {
        const bool keep = e[i] >= T; const unsigned long long m = __ballot(keep);
        if (keep) cb_[pos + __popcll(m & ((1ull << lane) - 1ull))] = e[i];
        pos += __popcll(m);
      }
      if (lane == q) { cntv = pos; Tq = T; }
    }
  }
  }
  __builtin_amdgcn_wave_barrier();
  const int n16 = lane & 15, kq = lane >> 4;
#define DPP_ROR(v, n) __int_as_float(__builtin_amdgcn_update_dpp(0, __float_as_int(v), 0x120 + (n), 0xf, 0xf, false))
  for (int q = 0; q < 8; q++) {
    const int n = __builtin_amdgcn_readlane(cntv, q);
    const unsigned* sel = cand + q * CAP;
    const size_t tq = tokb + l0 + q;
    float ssum[2][4];
#pragma unroll
    for (int grp = 0; grp < 2; grp++) {
      bf16x8 qa0, qa1;
#pragma unroll
      for (int k = 0; k < 8; k++) { int zi_ = 0; asm volatile("" : "+v"(zi_)); qa0[k] = (short)zi_; qa1[k] = (short)zi_; }
      if (n16 < 4) {
        const bf* qp = p.P + tq * PW + C_ATQ + (grp * 4 + n16) * 64 + 8 * kq;
        qa0 = *(const bf16x8*)qp; qa1 = *(const bf16x8*)(qp + 32);
      }
      f32x4 lg[16];
#pragma unroll
      for (int t = 0; t < 16; t++) {
        const int slot = t * 16 + n16; const bool valid = slot < n;
        const int key = valid ? (16383 - (int)(sel[slot] & 0x3FFFu)) : 0;
        const bf* kp = p.KVC + (tokb + key) * 256 + grp * 64 + 8 * kq;
        bf16x8 b0 = *(const bf16x8*)kp, b1 = *(const bf16x8*)(kp + 32);
        const float zc_ = ozero(); f32x4 cc = {zc_, zc_, zc_, zc_};
        cc = mfma16(qa0, b0, cc); cc = mfma16(qa1, b1, cc);
        const bool ok = valid && (kq == 0);
#pragma unroll
        for (int r = 0; r < 4; r++) lg[t][r] = ok ? cc[r] * 0.125f : -3.0e38f;
      }
      float mx[4];
#pragma unroll
      for (int r = 0; r < 4; r++) {
        float m = lg[0][r];
#pragma unroll
        for (int t = 1; t < 16; t++) m = fmaxf(m, lg[t][r]);
        m = fmaxf(m, DPP_ROR(m, 8)); m = fmaxf(m, DPP_ROR(m, 4)); m = fmaxf(m, DPP_ROR(m, 2)); m = fmaxf(m, DPP_ROR(m, 1));
        mx[r] = __int_as_float(__builtin_amdgcn_readfirstlane(__float_as_int(m)));
      }
#pragma unroll
      for (int r = 0; r < 4; r++) {
        float s = 0.f;
#pragma unroll
        for (int t = 0; t < 16; t++) { float e = (lg[t][r] > -1.0e38f) ? __expf(lg[t][r] - mx[r]) : 0.f; lg[t][r] = e; s += e; }
        s += DPP_ROR(s, 8); s += DPP_ROR(s, 4); s += DPP_ROR(s, 2); s += DPP_ROR(s, 1);
        ssum[grp][r] = __int_as_float(__builtin_amdgcn_readfirstlane(__float_as_int(s)));
      }
      if (grp == 0) __builtin_amdgcn_wave_barrier();
      if (kq == 0) {
#pragma unroll
        for (int t = 0; t < 16; t++)
          *(uint2*)(Pb + (t * 16 + n16) * 8 + grp * 4) = make_uint2(pk2(lg[t][0], lg[t][1]), pk2(lg[t][2], lg[t][3]));
      }
    }
    __builtin_amdgcn_wave_barrier();
    float o[64];
#pragma unroll
    for (int i = 0; i < 64; i++) o[i] = ozero();
    const int ksg = lane >> 3, dc = lane & 7;
#pragma unroll 8
    for (int stp = 0; stp < 32; stp++) {
      const int slot = stp * 8 + ksg;
      const int key = (slot < n) ? (16383 - (int)(sel[slot] & 0x3FFFu)) : 0;
      uint4 pp = *(const uint4*)(Pb + slot * 8);
      const bf* vp = p.KVC + (tokb + key) * 256 + 128 + dc * 8;
      uint4 va = *(const uint4*)vp, vb = *(const uint4*)(vp + 64);
      float ph[8] = {bflo(pp.x), bfhi(pp.x), bflo(pp.y), bfhi(pp.y), bflo(pp.z), bfhi(pp.z), bflo(pp.w), bfhi(pp.w)};
      float v0[8] = {bflo(va.x), bfhi(va.x), bflo(va.y), bfhi(va.y), bflo(va.z), bfhi(va.z), bflo(va.w), bfhi(va.w)};
      float v1[8] = {bflo(vb.x), bfhi(vb.x), bflo(vb.y), bfhi(vb.y), bflo(vb.z), bfhi(vb.z), bflo(vb.w), bfhi(vb.w)};
#pragma unroll
      for (int hh = 0; hh < 4; hh++)
#pragma unroll
        for (int d = 0; d < 8; d++) { o[hh * 8 + d] += ph[hh] * v0[d]; o[(4 + hh) * 8 + d] += ph[4 + hh] * v1[d]; }
    }
    __builtin_amdgcn_wave_barrier();
    const bool b5 = (lane >> 5) & 1, b4 = (lane >> 4) & 1, b3 = (lane >> 3) & 1;
    float o32[32], o16[16], o8[8];
#pragma unroll
    for (int i = 0; i < 32; i++) { float lo = o[i], hi = o[32 + i]; float snd = b5 ? lo : hi; float kp = b5 ? hi : lo; o32[i] = kp + __shfl_xor(snd, 32); }
#pragma unroll
    for (int i = 0; i < 16; i++) { float lo = o32[i], hi = o32[16 + i]; float snd = b4 ? lo : hi; float kp = b4 ? hi : lo; o16[i] = kp + __shfl_xor(snd, 16); }
#pragma unroll
    for (int i = 0; i < 8; i++) { float lo = o16[i], hi = o16[8 + i]; float snd = b3 ? lo : hi; float kp = b3 ? hi : lo; o8[i] = kp + __shfl_xor(snd, 8); }
    const float s_g0 = b4 ? (b3 ? ssum[0][3] : ssum[0][2]) : (b3 ? ssum[0][1] : ssum[0][0]);
    const float s_g1 = b4 ? (b3 ? ssum[1][3] : ssum[1][2]) : (b3 ? ssum[1][1] : ssum[1][0]);
    const float rinv = 1.f / (b5 ? s_g1 : s_g0);
    const int hsel = (b5 ? 4 : 0) + (b4 ? 2 : 0) + (b3 ? 1 : 0);
    const int col = hsel * 64 + dc * 8;
    uint4 zz = *(const uint4*)(p.P + tq * PW + C_ATZ + col);
    uint4 ov;
    ov.x = pk2(o8[0] * rinv * siluf_(bflo(zz.x)), o8[1] * rinv * siluf_(bfhi(zz.x)));
    ov.y = pk2(o8[2] * rinv * siluf_(bflo(zz.y)), o8[3] * rinv * siluf_(bfhi(zz.y)));
    ov.z = pk2(o8[4] * rinv * siluf_(bflo(zz.z)), o8[5] * rinv * siluf_(bfhi(zz.z)));
    ov.w = pk2(o8[6] * rinv * siluf_(bflo(zz.w)), o8[7] * rinv * siluf_(bfhi(zz.w)));
    *(uint4*)(p.Y + tq * YW + Y_ATT + col) = ov;
  }
}

__device__ __forceinline__ void phaseB(const Params& p, int layer, char* sm0) {
  const int total = 512 + 2048 + 2048;
  char* sm = sm0 + HB * HALF_LDS;
  for (int t = VB; t < total; t += G2) {
    if (t < 512) ssd_pass1(p, layer, t, sm);
    else if (t < 2560) s5_pass1(p, layer, t - 512, sm);
    else mem_attn(p, layer, t - 2560);
  }
}
__device__ __forceinline__ void phaseC(const Params& p, int layer, char* sm0, bool dsa_only) {
  const int G = G2;
  const int total = dsa_only ? 1024 : 1024 + 256 + 16;
  char* sm = sm0 + HB * HALF_LDS;
  int rr = 0;
  for (int i = VB; i < total; i += G, rr++) {
    if (i < 1024) {
      int pos = i - rr * G; int idx = i;
      if ((rr & 1) && (rr * G + G <= 1024)) idx = rr * G + (G - 1 - pos);
      __syncthreads();
      dsa_wave(p, idx * 4 + (otid() >> 6), sm);
    } else if (i < 1280) ssd_statepass(p, i - 1024);
    else s5_carry(p, layer, i - 1280);
  }
}
__device__ __forceinline__ void phaseD(const Params& p, int layer, char* sm0) {
  const int total = 256 + 1024;
  char* sm = sm0 + HB * HALF_LDS;
  const int vb = VB;
  if (G2 == 512) {
    if (vb < 256) { s5_pass2(p, layer, vb, sm); ssd_pass2(p, layer, vb, sm); }
    else {
#pragma unroll 1
      for (int k = 0; k < 3; k++) ssd_pass2(p, layer, 256 + (vb - 256) * 3 + k, sm);
    }
  } else {
    for (int t = vb; t < total; t += G2) {
      if (t < 256) s5_pass2(p, layer, t, sm);
      else ssd_pass2(p, layer, t - 256, sm);
    }
  }
}

__device__ __forceinline__ void phaseE(const Params& p, int layer) {
  const int tidf = otid_full();
  const int wid = __builtin_amdgcn_readfirstlane(tidf >> 6), lane = tidf & 63, wr = wid >> 2, wc = wid & 3, fr = lane & 15, fq = lane >> 4;
  const bf* Wl = p.WinT + (size_t)layer * INW * 2048;
  const bf* Wb = p.WbrT + (size_t)layer * 2048 * YW;
  bf* merged = p.P;
  char* gsb = (char*)p.GS + (size_t)blockIdx.x * 131072;
  const unsigned gs_lane0 = (unsigned)tidf * 16u, lane_c40 = (unsigned)fq * 16u, lane_m0 = (unsigned)(fr * 2048 + fq * 4) * 2u;
  for (int L = blockIdx.x; L < 1024; L += gridDim.x) {
    int pm, pn; tile_order(L, 128, 8, pm, pn);
    const int brow = pm * 256, bcol = pn * 256;
#pragma unroll 1
    for (int s = 0; s < 8; s++) {
      const int br = s >> 1; const bool isBr = (s & 1) != 0;
      const int koff = br == 0 ? 0 : (br == 1 ? 512 : (br == 2 ? 1024 : 2048));
      const int kb = br == 2 ? 1024 : (br == 3 ? 256 : 512);
      const bf* A_ = isBr ? p.Y + koff : p.xb; const int lda_ = isBr ? YW : 2048;
      const bf* B_ = isBr ? Wb + koff : Wl + (size_t)(5716 + br * 2048) * 2048; const int ldb_ = isBr ? YW : 2048;
      const int K_ = isBr ? kb : 2048;
      f32x4 acc[2][2][4][2]; ZERO_ACC8(acc);
      gemm256(A_, lda_, B_, ldb_, K_, brow, bcol, acc);
      unsigned gs_lane = gs_lane0, lane_c4 = lane_c40, lane_m = lane_m0;
      asm volatile("" : "+v"(gs_lane), "+v"(lane_c4), "+v"(lane_m));
      if (!isBr) {
        const char* bgb = (const char*)(p.b_gate + (size_t)layer * 8192 + br * 2048 + bcol + wc * 32);
#pragma unroll
        for (int ai = 0; ai < 2; ai++)
#pragma unroll
          for (int bj = 0; bj < 2; bj++)
#pragma unroll
            for (int m = 0; m < 4; m++) {
              unsigned q[4];
#pragma unroll
              for (int n = 0; n < 2; n++) {
                float4 bg = *(const float4*)(bgb + (bj * 128 + n * 16) * 4 + lane_c4);
                f32x4 v = acc[ai][bj][m][n];
                q[2 * n] = pk2(sigmoidf_(v[0] + bg.x), sigmoidf_(v[1] + bg.y));
                q[2 * n + 1] = pk2(sigmoidf_(v[2] + bg.z), sigmoidf_(v[3] + bg.w));
              }
              *(uint4*)(gsb + ((ai * 2 + bj) * 4 + m) * 8192 + gs_lane) = make_uint4(q[0], q[1], q[2], q[3]);
              __builtin_amdgcn_sched_barrier(0);
            }
      } else {
        char* mb = (char*)merged + ((size_t)(brow + wr * 64) * 2048 + bcol + wc * 32) * 2;
#pragma unroll
        for (int ai = 0; ai < 2; ai++)
#pragma unroll
          for (int bj = 0; bj < 2; bj++) {
#pragma unroll
            for (int mh = 0; mh < 2; mh++) {
              uint4 g4[2]; uint2 old[2][2];
#pragma unroll
              for (int mm = 0; mm < 2; mm++) {
                const int m = mh * 2 + mm;
                g4[mm] = *(const uint4*)(gsb + ((ai * 2 + bj) * 4 + m) * 8192 + gs_lane);
                if (br) {
#pragma unroll
                  for (int n = 0; n < 2; n++)
                    old[mm][n] = *(const uint2*)(mb + ((size_t)(ai * 128 + m * 16) * 2048 + bj * 128 + n * 16) * 2 + lane_m);
                }
              }
#pragma unroll
              for (int mm = 0; mm < 2; mm++) {
                const int m = mh * 2 + mm;
                const unsigned gq[4] = {g4[mm].x, g4[mm].y, g4[mm].z, g4[mm].w};
#pragma unroll
                for (int n = 0; n < 2; n++) {
                  f32x4 v = acc[ai][bj][m][n];
                  float o0 = bflo(gq[2 * n]) * v[0], o1 = bfhi(gq[2 * n]) * v[1], o2 = bflo(gq[2 * n + 1]) * v[2], o3 = bfhi(gq[2 * n + 1]) * v[3];
                  char* mp = mb + ((size_t)(ai * 128 + m * 16) * 2048 + bj * 128 + n * 16) * 2 + lane_m;
                  if (br) { o0 += bflo(old[mm][n].x); o1 += bfhi(old[mm][n].x); o2 += bflo(old[mm][n].y); o3 += bfhi(old[mm][n].y); }
                  *(uint2*)mp = make_uint2(pk2(o0, o1), pk2(o2, o3));
                }
              }
              __builtin_amdgcn_sched_barrier(0);
            }
          }
      }
    }
  }
}

__device__ __forceinline__ void phaseF(const Params& p, int layer) {
  const int tidf = otid_full();
  const int wid = __builtin_amdgcn_readfirstlane(tidf >> 6), lane = tidf & 63, wr = wid >> 2, wc = wid & 3, fr = lane & 15, fq = lane >> 4;
  const bf* merged = p.P;
  const float* xres = layer == 0 ? p.x : p.out;
  for (int L = blockIdx.x; L < 1024; L += gridDim.x) {
    int pm, pn; tile_order(L, 128, 8, pm, pn);
    const int brow = pm * 256, bcol = pn * 256;
    f32x4 acc[2][2][4][2]; ZERO_ACC8(acc);
    gemm256(merged, 2048, p.WoutT + (size_t)layer * 2048 * 2048, 2048, 2048, brow, bcol, acc);
#pragma unroll
    for (int ai = 0; ai < 2; ai++)
#pragma unroll
      for (int m = 0; m < 4; m++) {
        const size_t tok = brow + ai * 128 + wr * 64 + m * 16 + fr;
#pragma unroll
        for (int bj = 0; bj < 2; bj++)
#pragma unroll
          for (int n = 0; n < 2; n++) {
            const int col = bcol + bj * 128 + wc * 32 + n * 16 + fq * 4;
            float4 xr = *(const float4*)(xres + tok * 2048 + col);
            f32x4 v = acc[ai][bj][m][n];
            float4 o;
            o.x = 1.41421356237f * xr.x + v[0]; o.y = 1.41421356237f * xr.y + v[1];
            o.z = 1.41421356237f * xr.z + v[2]; o.w = 1.41421356237f * xr.w + v[3];
            *(float4*)(p.out + tok * 2048 + col) = o;
          }
      }
  }
}

__device__ __forceinline__ void phaseG(const Params& p, int layer) {
  const int lane = otid() & 63, w = otid() >> 6;
  const float* g = p.ln_g + layer * 2048; const float* bb = p.ln_b + layer * 2048;
  for (int t = VB; t < TT / 4; t += G2) {
    const size_t row = (size_t)t * 4 + w;
    float* xp = p.out + row * 2048;
    float4 v[8]; float s = 0.f;
#pragma unroll
    for (int i = 0; i < 8; i++) { v[i] = *(const float4*)(xp + (i * 64 + lane) * 4); s += v[i].x + v[i].y + v[i].z + v[i].w; }
#pragma unroll
    for (int off = 1; off < 64; off <<= 1) s += __shfl_xor(s, off);
    const float mu = s * (1.f / 2048.f);
    float q = 0.f;
#pragma unroll
    for (int i = 0; i < 8; i++) {
      float a = v[i].x - mu, b = v[i].y - mu, c = v[i].z - mu, d = v[i].w - mu; q += a * a + b * b + c * c + d * d;
    }
#pragma unroll
    for (int off = 1; off < 64; off <<= 1) q += __shfl_xor(q, off);
    const float rs = rsqrtf(q * (1.f / 2048.f) + 1e-5f);
#pragma unroll
    for (int i = 0; i < 8; i++) {
      const int col = (i * 64 + lane) * 4;
      float4 gg = *(const float4*)(g + col), bv = *(const float4*)(bb + col);
      float4 o;
      o.x = (v[i].x - mu) * rs * gg.x + bv.x; o.y = (v[i].y - mu) * rs * gg.y + bv.y;
      o.z = (v[i].z - mu) * rs * gg.z + bv.z; o.w = (v[i].w - mu) * rs * gg.w + bv.w;
      *(float4*)(xp + col) = o;
      if (layer == 0) *(uint2*)(p.xb + row * 2048 + col) = make_uint2(pk2(o.x, o.y), pk2(o.z, o.w));
    }
  }
}

__global__ void __launch_bounds__(512, 2) mega_kernel(Params p) {
  char* sm = dynsm;
  cg::grid_group grid = cg::this_grid();
  phase0(p, sm); grid.sync();
#pragma unroll 1
  for (int layer = 0; layer < 2; layer++) {
    int nA = (PROBE_MASK & 1) ? 2 : 1, nB = (PROBE_MASK & 2) ? 2 : 1, nC = (PROBE_MASK & 4) ? 2 : 1, nD = (PROBE_MASK & 8) ? 2 : 1, nE = (PROBE_MASK & 16) ? 2 : 1;
    asm volatile("" : "+s"(nA), "+s"(nB), "+s"(nC), "+s"(nD), "+s"(nE));
#pragma unroll 1
    for (int r = 0; r < nA; r++) phaseA(p, layer);
    grid.sync();
#pragma unroll 1
    for (int r = 0; r < nB; r++) phaseB(p, layer, sm);
    grid.sync();
#pragma unroll 1
    for (int r = 0; r < nC; r++) phaseC(p, layer, sm, r + 1 < nC);
    grid.sync();
#pragma unroll 1
    for (int r = 0; r < nD; r++) phaseD(p, layer, sm);
    grid.sync();
#pragma unroll 1
    for (int r = 0; r < nE; r++) phaseE(p, layer);
    grid.sync();
    phaseF(p, layer); grid.sync();
    phaseG(p, layer);
    if (layer == 0) grid.sync();
  }
}

extern "C" void kernel_launch(void* const* d_in, const int* in_sizes, int n_in, void* d_out, int out_size, void* d_ws,
                              size_t ws_size, hipStream_t stream) {
  Params p{};
  p.x = (const float*)d_in[0]; p.mem = (const float*)d_in[1]; p.pos = (const int*)d_in[2];
  p.w_in = (const float*)d_in[3]; p.b_gate = (const float*)d_in[4]; p.lam_re = (const float*)d_in[5];
  p.lam_im = (const float*)d_in[6]; p.log_dt = (const float*)d_in[7]; p.b_re = (const float*)d_in[8];
  p.b_im = (const float*)d_in[9]; p.c_re = (const float*)d_in[10]; p.c_im = (const float*)d_in[11];
  p.s5_d = (const float*)d_in[12]; p.w_glu = (const float*)d_in[13]; p.b_glu = (const float*)d_in[14];
  p.conv_w = (const float*)d_in[15]; p.conv_b = (const float*)d_in[16]; p.dt_bias = (const float*)d_in[17];
  p.a_log = (const float*)d_in[18]; p.ssd_d = (const float*)d_in[19]; p.norm_g = (const float*)d_in[20];
  p.mem_w_kv = (const float*)d_in[21]; p.w_br_s5 = (const float*)d_in[22]; p.w_br_attn = (const float*)d_in[23];
  p.w_br_ssd = (const float*)d_in[24]; p.w_br_mem = (const float*)d_in[25]; p.w_out = (const float*)d_in[26];
  p.ln_g = (const float*)d_in[27]; p.ln_b = (const float*)d_in[28];
  p.out = (float*)d_out;
  char* ws = (char*)d_ws; size_t off = 0;
  auto carve = [&](size_t bytes) { char* r = ws + off; off += (bytes + 255) & ~(size_t)255; return r; };
  p.WinT = (bf*)carve((size_t)2 * INW * 2048 * 2);
  p.WbrT = (bf*)carve((size_t)2 * 2048 * YW * 2);
  p.WoutT = (bf*)carve((size_t)2 * 2048 * 2048 * 2);
  p.WgluT = (bf*)carve((size_t)2 * 512 * 512 * 2);
  p.WmemT = (bf*)carve((size_t)2 * 512 * 2048 * 2);
  p.memb = (bf*)carve((size_t)512 * 2048 * 2);
  p.xb = (bf*)carve((size_t)TT * 2048 * 2);
  p.P = (bf*)carve((size_t)TT * PW * 2);
  p.Y = (bf*)carve((size_t)TT * YW * 2);
  p.YG = (bf*)carve((size_t)TT * 512 * 2);
  p.KIF = (bf*)carve((size_t)TT * 64 * 2);
  p.MK = (bf*)carve((size_t)2 * 2 * 4 * 256 * 64 * 2);
  p.MVT = (bf*)carve((size_t)2 * 2 * 4 * 256 * 64 * 2);
  p.CM = (bf*)carve((size_t)2 * 32 * 16 * 128 * 2);
  p.ST = (float*)carve((size_t)2 * 128 * 131072 * 4);
  p.CS = (float*)carve((size_t)TT * 16 * 4);
  p.END = (float*)carve((size_t)2 * 128 * 32 * 64 * 2 * 4);
  p.CD = (float*)carve((size_t)2 * 128 * 16 * 4);
  p.SB = (float*)carve((size_t)2 * 32 * 64 * 32 * 4);
  p.SA = (float*)carve((size_t)2 * 32 * 64 * 4 * 4);
  p.KVC = (bf*)carve((size_t)TT * 256 * 2);
  p.GS = (bf*)carve((size_t)256 * 16 * 512 * 16);
  if (off > ws_size) { fprintf(stderr, "workspace too small: need %zu have %zu\n", off, ws_size); return; }
  for (int j = 0; j < 8; j++) p.inv[j] = (float)pow(500000.0, -(double)j / 8.0);
  const size_t kDynLds = 2 * HALF_LDS;
  static int grid_blocks = 0;
  if (!grid_blocks) {
    int dev = 0, cus = 0, per_cu = 0;
    (void)hipGetDevice(&dev);
    (void)hipDeviceGetAttribute(&cus, hipDeviceAttributeMultiprocessorCount, dev);
    (void)hipFuncSetAttribute((const void*)mega_kernel, hipFuncAttributeMaxDynamicSharedMemorySize, (int)kDynLds);
    (void)hipOccupancyMaxActiveBlocksPerMultiprocessor(&per_cu, mega_kernel, 512, kDynLds);
    if (per_cu > 1) per_cu = 1;
    grid_blocks = cus * per_cu;
    if (grid_blocks > 256) grid_blocks = 256;
    grid_blocks -= grid_blocks % 8;
  }
  void* args[] = {&p};
  hipError_t e = hipLaunchCooperativeKernel((void*)mega_kernel, dim3(grid_blocks), dim3(512), args, kDynLds, stream);
  if (e != hipSuccess) fprintf(stderr, "cooperative launch failed: %s (grid %d)\n", hipGetErrorString(e), grid_blocks);
}
```

```cpp
#include <hip/hip_runtime.h>
#include <hip/hip_cooperative_groups.h>
#include <cstdio>
#include <cmath>
namespace cg = cooperative_groups;

#ifndef MK_COOP
#define MK_COOP 1
#endif
#ifndef PROBE_MASK
#define PROBE_MASK 0
#endif

typedef unsigned short bf;
typedef short bf16x8 __attribute__((ext_vector_type(8)));
typedef float f32x16 __attribute__((ext_vector_type(16)));
typedef float f32x4 __attribute__((ext_vector_type(4)));

#define TT 32768
#define LSEQ 16384
#define DM 2048
#define INW 13908
#define PW 5760
#define C_S5U 0
#define C_S5Z 512
#define C_ATQ 1024
#define C_ATK 1536
#define C_ATV 1664
#define C_ATZ 1792
#define C_IDQ 2304
#define C_IDK 2560
#define C_IDW 2624
#define C_SSZ 2640
#define C_XBC 3664
#define C_SDT 5200
#define C_MEQ 5216
#define C_MEZ 5472
#define YW 2304
#define Y_S5 0
#define Y_ATT 512
#define Y_SSD 1024
#define Y_MEM 2048
#define CAP 480
#define HALF_LDS 77824

struct Params {
  const float *x, *mem; const int* pos;
  const float *w_in, *b_gate, *lam_re, *lam_im, *log_dt, *b_re, *b_im, *c_re, *c_im, *s5_d, *w_glu, *b_glu,
      *conv_w, *conv_b, *dt_bias, *a_log, *ssd_d, *norm_g, *mem_w_kv, *w_br_s5, *w_br_attn, *w_br_ssd, *w_br_mem,
      *w_out, *ln_g, *ln_b;
  float* out;
  bf *WinT, *WbrT, *WoutT, *WgluT, *WmemT, *memb, *xb, *P, *Y, *YG, *KIF, *MK, *MVT, *CM, *KVC, *GS;
  float *ST, *CS, *END, *CD, *SB, *SA;
  float inv[8];
};

__device__ __forceinline__ float ozero() { float z = 0.f; asm volatile("" : "+v"(z)); return z; }
__device__ __forceinline__ int otid_full() { int t = threadIdx.x; asm volatile("" : "+v"(t)); return t; }
__device__ __forceinline__ int otid() { return otid_full() & 255; }
#define HB (__builtin_amdgcn_readfirstlane(otid_full() >> 8))
#define VB ((int)blockIdx.x * 2 + HB)
#define G2 ((int)gridDim.x * 2)
__device__ __forceinline__ float bf2f(bf v) { return __uint_as_float(((unsigned)v) << 16); }
__device__ __forceinline__ float bflo(unsigned u) { return __uint_as_float(u << 16); }
__device__ __forceinline__ float bfhi(unsigned u) { return __uint_as_float(u & 0xFFFF0000u); }
typedef float f32x2p_t __attribute__((ext_vector_type(2)));
typedef __bf16 bf16x2p_t __attribute__((ext_vector_type(2)));
__device__ __forceinline__ unsigned pk2(float lo, float hi) {
  f32x2p_t v = {lo, hi};
  return __builtin_bit_cast(unsigned, __builtin_convertvector(v, bf16x2p_t));
}
__device__ __forceinline__ bf f2bf(float f) { return (bf)(pk2(f, 0.f) & 0xFFFFu); }
__device__ __forceinline__ float sigmoidf_(float x) { return __builtin_amdgcn_rcpf(1.f + __expf(-x)); }
__device__ __forceinline__ float siluf_(float x) { return x * __builtin_amdgcn_rcpf(1.f + __expf(-x)); }
__device__ __forceinline__ float geluf_(float x) {
  float u = 0.7978845608028654f * (x + 0.044715f * x * x * x);
  float t = 1.f - 2.f * __builtin_amdgcn_rcpf(1.f + __expf(2.f * u));
  return 0.5f * x * (1.f + t);
}
__device__ __forceinline__ f32x16 mfma32(bf16x8 a, bf16x8 b, f32x16 c) { return __builtin_amdgcn_mfma_f32_32x32x16_bf16(a, b, c, 0, 0, 0); }
__device__ __forceinline__ f32x4 mfma16(bf16x8 a, bf16x8 b, f32x4 c) { return __builtin_amdgcn_mfma_f32_16x16x32_bf16(a, b, c, 0, 0, 0); }

__device__ __forceinline__ bool tile_map(int L, int nMt, int nNt, int SM, int SN, int& tm, int& tn) {
  int per = SM * SN; int x = L & 7; int jj = L >> 3; int sl = jj / per; int j = jj - sl * per; int S = sl * 8 + x;
  int nSn = nNt / SN; int NS = (nMt / SM) * nSn;
  if (S >= NS) return false;
  int mg = S / nSn, ng = S - mg * nSn;
  tm = mg * SM + j / SN; tn = ng * SN + j % SN; return true;
}

typedef unsigned u32x4 __attribute__((ext_vector_type(4)));
struct GStage { u32x4 a0, a1, b0, b1; };
#define G_LOAD(S, ko) { S.a0 = *(const u32x4*)(ga + (ko)); S.a1 = *(const u32x4*)(ga + a64 + (ko)); S.b0 = *(const u32x4*)(gb + (ko)); S.b1 = *(const u32x4*)(gb + b64 + (ko)); }
#define G_WRITE(S, base) { *(u32x4*)(sA + (base) + woff) = S.a0; *(u32x4*)(sA + (base) + woff + 5120) = S.a1; *(u32x4*)(sB + (base) + woff) = S.b0; *(u32x4*)(sB + (base) + woff + 5120) = S.b1; }
#define G_ITER(kt, cur, S)                                                          \
  {                                                                                 \
    _Pragma("unroll") for (int ks = 0; ks < 2; ks++) {                              \
      bf16x8 a0 = *(const bf16x8*)(sA + (cur) + aoff + ks * 32);                    \
      bf16x8 a1 = *(const bf16x8*)(sA + (cur) + aoff + 2560 + ks * 32);             \
      bf16x8 b0 = *(const bf16x8*)(sB + (cur) + boff + ks * 32);                    \
      bf16x8 b1 = *(const bf16x8*)(sB + (cur) + boff + 2560 + ks * 32);             \
      acc[0][0] = mfma32(b0, a0, acc[0][0]);                                        \
      acc[0][1] = mfma32(b1, a0, acc[0][1]);                                        \
      acc[1][0] = mfma32(b0, a1, acc[1][0]);                                        \
      acc[1][1] = mfma32(b1, a1, acc[1][1]);                                        \
    }                                                                               \
    if ((kt) + 1 < nk) {                                                            \
      G_WRITE(S, 10240 - (cur))                                                     \
      if ((kt) + 1 + D < nk) G_LOAD(S, ((kt) + 1 + D) * 32)                         \
    }                                                                               \
    __syncthreads();                                                                \
  }
template <int D>
__device__ __forceinline__ void gemm_acc(const bf* __restrict__ A, int lda, const bf* __restrict__ Bt, int ldb, int K,
                                         f32x16 (&acc)[2][2], char* sm) {
  const int tid = otid(), lane = tid & 63, w = tid >> 6, wr = w >> 1, wc = w & 1, r32 = lane & 31, h5 = lane >> 5;
  const int lrow = tid >> 2, lch = tid & 3;
  const bf* ga = A + (size_t)lrow * lda + lch * 8;
  const bf* gb = Bt + (size_t)lrow * ldb + lch * 8;
  const size_t a64 = (size_t)64 * lda, b64 = (size_t)64 * ldb;
  const int nk = K >> 5;
  char* sA = sm; char* sB = sm + 20480;
  const int woff = lrow * 80 + lch * 16;
  const int aoff = (wr * 64 + r32) * 80 + h5 * 16, boff = (wc * 64 + r32) * 80 + h5 * 16;
  GStage S0, S1, S2, S3;
  G_LOAD(S0, 0) G_LOAD(S1, 32)
  if (D == 4) { G_LOAD(S2, 64) G_LOAD(S3, 96) }
  G_WRITE(S0, 0)
  if (D < nk) G_LOAD(S0, D * 32)
  __syncthreads();
  for (int kt0 = 0; kt0 < nk; kt0 += D) {
    if (D == 4) {
      G_ITER(kt0, 0, S1) G_ITER(kt0 + 1, 10240, S2) G_ITER(kt0 + 2, 0, S3) G_ITER(kt0 + 3, 10240, S0)
    } else {
      G_ITER(kt0, 0, S1) G_ITER(kt0 + 1, 10240, S0)
    }
  }
}
#define ZERO_ACC(a) { const float z_ = ozero(); for (int i_ = 0; i_ < 2; i_++) for (int j_ = 0; j_ < 2; j_++) for (int r_ = 0; r_ < 16; r_++) a[i_][j_][r_] = z_; }


extern __shared__ __attribute__((aligned(16))) char dynsm[];
#define G8_HT (128 * 64)
#define G8_SA(b, h) ((bf*)dynsm + ((b) * 2 + (h)) * G8_HT)
#define G8_SB(b, h) ((bf*)dynsm + (4 + (b) * 2 + (h)) * G8_HT)
__device__ __forceinline__ int g8_lds_byte(int r, int c) {
  int st = (r >> 4) * 2 + (c >> 5), rr = r & 15, cc = c & 31, ob = rr * 64 + cc * 2;
  return st * 1024 + (ob ^ (((ob >> 9) & 1) << 5));
}
__device__ __forceinline__ void g8_stage_rc(int b, int& R, int& C) {
  int st = b / 1024, sb = b % 1024, swz = sb ^ (((sb >> 9) & 1) << 5);
  R = (st >> 1) * 16 + swz / 64; C = (st & 1) * 32 + (swz % 64) / 2;
}
#define G8_LAS __attribute__((address_space(3)))
#define G8_HTB (128 * 64 * 2)
#define G8_OSA(b, h) (((b) * 2 + (h)) * G8_HTB)
#define G8_OSB(b, h) ((4 + (b) * 2 + (h)) * G8_HTB)
#define G8_STAGE(bufoff, gbase, voff) do { _Pragma("unroll") for (int _i = 0; _i < 2; ++_i) \
    __builtin_amdgcn_global_load_lds((const unsigned*)((const char*)(gbase) + (voff)[_i]), (G8_LAS unsigned*)(lds + (bufoff) + ldsw + _i * 8192), 16, 0, 0); } while (0)
#define G8_LDA(dst, b, h) do { _Pragma("unroll") for (int m = 0; m < 4; ++m) _Pragma("unroll") for (int k = 0; k < 2; ++k) dst[m][k] = *(const G8_LAS bf16x8*)(lds + G8_OSA(b, h) + aoff + m * 2048 + k * 1024); } while (0)
#define G8_LDB(dst, b, h) do { _Pragma("unroll") for (int n = 0; n < 2; ++n) _Pragma("unroll") for (int k = 0; k < 2; ++k) dst[n][k] = *(const G8_LAS bf16x8*)(lds + G8_OSB(b, h) + boff + n * 2048 + k * 1024); } while (0)
#define G8_MMA(ai, bj, At_, Bt_) do { __builtin_amdgcn_s_setprio(1);                                                 \
    _Pragma("unroll") for (int m = 0; m < 4; ++m) _Pragma("unroll") for (int n = 0; n < 2; ++n) _Pragma("unroll") for (int k = 0; k < 2; ++k) \
      acc[ai][bj][m][n] = __builtin_amdgcn_mfma_f32_16x16x32_bf16(Bt_[n][k], At_[m][k], acc[ai][bj][m][n], 0, 0, 0); \
    __builtin_amdgcn_s_setprio(0); } while (0)
#define G8_WAIT_V(n) asm volatile("s_waitcnt vmcnt(" #n ")" ::: "memory")
#define G8_WAIT_L(n) asm volatile("s_waitcnt lgkmcnt(" #n ")" ::: "memory")
#define G8_BAR __builtin_amdgcn_s_barrier()
#define G8_SCHED __builtin_amdgcn_sched_barrier(0)

__device__ __forceinline__ void gemm256(const bf* __restrict__ A, int lda, const bf* __restrict__ Bt, int ldb, int K,
                                        int brow, int bcol, f32x4 (&acc)[2][2][4][2]) {
  G8_LAS unsigned char* lds = (G8_LAS unsigned char*)dynsm;
  const int tid = otid_full(), wid = __builtin_amdgcn_readfirstlane(tid >> 6), lane = tid & 63, wr = wid >> 2, wc = wid & 3, fr = lane & 15, fq = lane >> 4;
  unsigned voffA[2], voffB[2];
#pragma unroll
  for (int i = 0; i < 2; ++i) { int R, C; g8_stage_rc(tid * 16 + i * 8192, R, C); voffA[i] = (unsigned)(R * lda + C) * 2u; voffB[i] = (unsigned)(R * ldb + C) * 2u; }
  const size_t kstep = 128;
  const size_t hstepA = (size_t)128 * lda * 2, hstepB = (size_t)128 * ldb * 2;
  const unsigned ldsw = (unsigned)wid * 1024u;
  const int aoff = g8_lds_byte(wr * 64 + fr, fq * 8), boff = g8_lds_byte(wc * 32 + fr, fq * 8);
  const char* cA = (const char*)A + (size_t)brow * lda * 2; const char* cB = (const char*)Bt + (size_t)bcol * ldb * 2;
  bf16x8 At[4][2], B0[2][2], B1[2][2];
  const int nt = K / 64;
  __syncthreads();
  G8_STAGE(G8_OSB(0, 0), cB, voffB); G8_STAGE(G8_OSA(0, 0), cA, voffA); G8_STAGE(G8_OSB(0, 1), cB + hstepB, voffB); G8_STAGE(G8_OSA(0, 1), cA + hstepA, voffA);
  if (wr == 1) G8_BAR;
  G8_WAIT_V(4); G8_BAR;
  G8_STAGE(G8_OSB(1, 0), cB + kstep, voffB); G8_STAGE(G8_OSA(1, 0), cA + kstep, voffA); G8_STAGE(G8_OSB(1, 1), cB + hstepB + kstep, voffB);
  G8_WAIT_V(6); G8_BAR;
  for (int t = 0; t < nt - 2; t += 2) {
    const char* a1 = cA + (size_t)(t + 1) * kstep;
    const char* a2 = cA + (size_t)(t + 2) * kstep; const char* b2 = cB + (size_t)(t + 2) * kstep;
    const char* a3 = a2 + kstep; const char* b3 = b2 + kstep;
    G8_LDB(B0, 0, 0); G8_SCHED; G8_LDA(At, 0, 0); G8_STAGE(G8_OSA(1, 1), a1 + hstepA, voffA);
    G8_WAIT_L(8); G8_BAR; G8_WAIT_L(0); G8_MMA(0, 0, At, B0); G8_BAR; G8_SCHED;
    G8_LDB(B1, 0, 1); G8_STAGE(G8_OSB(0, 0), b2, voffB);
    G8_BAR; G8_WAIT_L(0); G8_MMA(0, 1, At, B1); G8_BAR;
    G8_LDA(At, 0, 1); G8_STAGE(G8_OSA(0, 0), a2, voffA);
    G8_BAR; G8_WAIT_L(0); G8_MMA(1, 0, At, B0); G8_BAR; G8_SCHED;
    G8_STAGE(G8_OSB(0, 1), b2 + hstepB, voffB);
    G8_WAIT_V(6); G8_BAR; G8_MMA(1, 1, At, B1); G8_BAR;
    G8_LDB(B0, 1, 0); G8_SCHED; G8_LDA(At, 1, 0); G8_STAGE(G8_OSA(0, 1), a2 + hstepA, voffA);
    G8_WAIT_L(8); G8_BAR; G8_WAIT_L(0); G8_MMA(0, 0, At, B0); G8_BAR; G8_SCHED;
    G8_LDB(B1, 1, 1); G8_STAGE(G8_OSB(1, 0), b3, voffB);
    G8_BAR; G8_WAIT_L(0); G8_MMA(0, 1, At, B1); G8_BAR;
    G8_LDA(At, 1, 1); G8_STAGE(G8_OSA(1, 0), a3, voffA);
    G8_BAR; G8_WAIT_L(0); G8_MMA(1, 0, At, B0); G8_BAR; G8_SCHED;
    G8_STAGE(G8_OSB(1, 1), b3 + hstepB, voffB);
    G8_WAIT_V(6); G8_BAR; G8_MMA(1, 1, At, B1); G8_BAR;
  }
  { const char* a1 = cA + (size_t)(nt - 1) * kstep;
    G8_LDB(B0, 0, 0); G8_LDA(At, 0, 0); G8_STAGE(G8_OSA(1, 1), a1 + hstepA, voffA);
    G8_BAR; G8_WAIT_L(0); G8_MMA(0, 0, At, B0); G8_BAR;
    G8_LDB(B1, 0, 1); G8_BAR; G8_WAIT_L(0); G8_MMA(0, 1, At, B1); G8_BAR;
    G8_LDA(At, 0, 1); G8_WAIT_V(4); G8_BAR; G8_WAIT_L(0); G8_MMA(1, 0, At, B0); G8_MMA(1, 1, At, B1); G8_BAR; }
  { G8_LDB(B0, 1, 0); G8_LDA(At, 1, 0); G8_WAIT_V(2); G8_BAR; G8_WAIT_L(0); G8_MMA(0, 0, At, B0); G8_BAR;
    G8_LDB(B1, 1, 1); G8_WAIT_V(0); G8_BAR; G8_WAIT_L(0); G8_MMA(0, 1, At, B1); G8_BAR;
    G8_LDA(At, 1, 1); G8_BAR; G8_WAIT_L(0); G8_MMA(1, 0, At, B0); G8_MMA(1, 1, At, B1); G8_BAR; }
  if (wr == 0) G8_BAR;
}
#define ZERO_ACC8(a) { float z_ = 0.f; asm volatile("" : "+v"(z_)); _Pragma("unroll") for (int i_ = 0; i_ < 2; i_++) _Pragma("unroll") for (int j_ = 0; j_ < 2; j_++) _Pragma("unroll") for (int m_ = 0; m_ < 4; m_++) _Pragma("unroll") for (int n_ = 0; n_ < 2; n_++) a[i_][j_][m_][n_] = (f32x4){z_, z_, z_, z_}; }
__device__ __forceinline__ bool tile_order(int L, int nM, int nN, int& pm, int& pn) {
  const int nwg = nM * nN; if (L >= nwg) return false;
  int wgid = L; { const int q = nwg / 8, r = nwg % 8, xcd = wgid % 8, off = wgid / 8; wgid = (xcd < r ? xcd * (q + 1) : r * (q + 1) + (xcd - r) * q) + off; }
  const int nig = 8 * nN, gid = wgid / nig, fm = gid * 8, gsz = (nM - fm) < 8 ? (nM - fm) : 8;
  pm = fm + ((wgid % nig) % gsz); pn = (wgid % nig) / gsz; return true;
}

__device__ __forceinline__ void transpose_tile(const float* __restrict__ src, int R, int C, bf* __restrict__ dst, int ldd, int off, int tile, bf* sm) {
  const int tilesC = (C + 63) >> 6;
  const int tr = tile / tilesC, tc = tile - tr * tilesC;
  const int r0 = tr * 64, c0 = tc * 64;
  const int tid = otid();
#pragma unroll
  for (int i = 0; i < 4; i++) {
    int r = (tid >> 4) + 16 * i; int c = (tid & 15) * 4;
    const float zt_ = ozero(); float4 v = make_float4(zt_, zt_, zt_, zt_);
    if (c0 + c < C) v = *(const float4*)(src + (size_t)(r0 + r) * C + c0 + c);
    sm[(c + 0) * 66 + r] = f2bf(v.x); sm[(c + 1) * 66 + r] = f2bf(v.y);
    sm[(c + 2) * 66 + r] = f2bf(v.z); sm[(c + 3) * 66 + r] = f2bf(v.w);
  }
  __syncthreads();
  {
    int c = tid >> 2, ch = (tid & 3) * 16;
    if (c0 + c < C) {
      unsigned wv[8];
#pragma unroll
      for (int k = 0; k < 8; k++) wv[k] = *(const unsigned*)(sm + c * 66 + ch + 2 * k);
      bf* d = dst + (size_t)(c0 + c) * ldd + off + r0 + ch;
      *(uint4*)d = make_uint4(wv[0], wv[1], wv[2], wv[3]);
      *(uint4*)(d + 8) = make_uint4(wv[4], wv[5], wv[6], wv[7]);
    }
  }
  __syncthreads();
}

__device__ __forceinline__ bool try_tr(int& t, const float* src, int R, int C, bf* dst, int ldd, int off, bf* sm) {
  int nt = (R >> 6) * ((C + 63) >> 6);
  if (t < nt) { transpose_tile(src, R, C, dst, ldd, off, t, sm); return true; }
  t -= nt; return false;
}

__device__ __forceinline__ void phase0(const Params& p, char* smc) {
  bf* sm = (bf*)(smc + HB * HALF_LDS);
  const int perLayer = 32 * 218 + 256 + 256 + 512 + 128 + 1024 + 64 + 256;
  for (int task = VB; task < 2 * perLayer; task += G2) {
    int layer = task / perLayer; int t = task - layer * perLayer;
    bf* WbrL = p.WbrT + (size_t)layer * 2048 * YW;
    if (try_tr(t, p.w_in + (size_t)layer * DM * INW, 2048, INW, p.WinT + (size_t)layer * INW * 2048, 2048, 0, sm)) continue;
    if (try_tr(t, p.w_br_s5 + (size_t)layer * 512 * 2048, 512, 2048, WbrL, YW, 0, sm)) continue;
    if (try_tr(t, p.w_br_attn + (size_t)layer * 512 * 2048, 512, 2048, WbrL, YW, 512, sm)) continue;
    if (try_tr(t, p.w_br_ssd + (size_t)layer * 1024 * 2048, 1024, 2048, WbrL, YW, 1024, sm)) continue;
    if (try_tr(t, p.w_br_mem + (size_t)layer * 256 * 2048, 256, 2048, WbrL, YW, 2048, sm)) continue;
    if (try_tr(t, p.w_out + (size_t)layer * 2048 * 2048, 2048, 2048, p.WoutT + (size_t)layer * 2048 * 2048, 2048, 0, sm)) continue;
    if (try_tr(t, p.w_glu + (size_t)layer * 512 * 512, 512, 512, p.WgluT + (size_t)layer * 512 * 512, 512, 0, sm)) continue;
    if (try_tr(t, p.mem_w_kv + (size_t)layer * 2048 * 512, 2048, 512, p.WmemT + (size_t)layer * 512 * 2048, 2048, 0, sm)) continue;
  }
  const size_t gtid = (size_t)blockIdx.x * 512 + otid_full(), gstr = (size_t)gridDim.x * 512;
  for (size_t i0 = gtid; i0 < (size_t)TT * DM / 8; i0 += 4 * gstr) {
    float4 a[4], b[4];
#pragma unroll
    for (int k = 0; k < 4; k++) {
      const size_t i = i0 + k * gstr;
      if (i < (size_t)TT * DM / 8) { a[k] = *(const float4*)(p.x + i * 8); b[k] = *(const float4*)(p.x + i * 8 + 4); }
    }
#pragma unroll
    for (int k = 0; k < 4; k++) {
      const size_t i = i0 + k * gstr;
      if (i < (size_t)TT * DM / 8)
        *(uint4*)(p.xb + i * 8) = make_uint4(pk2(a[k].x, a[k].y), pk2(a[k].z, a[k].w), pk2(b[k].x, b[k].y), pk2(b[k].z, b[k].w));
    }
  }
  for (size_t i = gtid; i < (size_t)512 * DM / 8; i += gstr) {
    float4 a = *(const float4*)(p.mem + i * 8), b = *(const float4*)(p.mem + i * 8 + 4);
    *(uint4*)(p.memb + i * 8) = make_uint4(pk2(a.x, a.y), pk2(a.z, a.w), pk2(b.x, b.y), pk2(b.z, b.w));
  }
  for (size_t i = gtid; i < (size_t)TT; i += gstr) {
    const float ps = (float)p.pos[i];
#pragma unroll
    for (int j = 0; j < 8; j++) {
      float ang = ps * p.inv[j];
      float s, c; sincosf(ang, &s, &c);
      p.CS[i * 16 + j] = c; p.CS[i * 16 + 8 + j] = s;
    }
  }
  for (size_t i = gtid; i < 2 * 32 * 64; i += gstr) {
    int pp = (int)(i & 63), g = (int)((i >> 6) & 31), layer = (int)(i >> 11);
    float dt = expf(p.log_dt[layer * 32 + g]);
    float lr = p.lam_re[i], li = p.lam_im[i];
    float mag = expf(lr * dt);
    float sn, cs; sincosf(li * dt, &sn, &cs);
    float ar = mag * cs, ai = mag * sn;
    float den = lr * lr + li * li;
    float nr = ar - 1.f, ni = ai;
    float fr = (nr * lr + ni * li) / den, fi = (ni * lr - nr * li) / den;
    float* sb = p.SB + i * 32;
    const float* bre = p.b_re + i * 16; const float* bim = p.b_im + i * 16;
    for (int h = 0; h < 16; h++) {
      float br = bre[h], bi = bim[h];
      sb[h] = fr * br - fi * bi; sb[16 + h] = fr * bi + fi * br;
    }
    float pr = ar, pi = ai;
    for (int k = 0; k < 7; k++) { float nr2 = pr * pr - pi * pi, ni2 = 2.f * pr * pi; pr = nr2; pi = ni2; }
    p.SA[i * 4 + 0] = ar; p.SA[i * 4 + 1] = ai; p.SA[i * 4 + 2] = pr; p.SA[i * 4 + 3] = pi;
    for (int h = 0; h < 16; h++) {
      size_t ci = ((size_t)(layer * 32 + g) * 16 + h);
      p.CM[ci * 128 + pp] = f2bf(p.c_re[ci * 64 + pp]);
      p.CM[ci * 128 + 64 + pp] = f2bf(-p.c_im[ci * 64 + pp]);
    }
  }
}

__device__ __forceinline__ void phaseA(const Params& p, int layer) {
  const int tidf = otid_full();
  const int wid = __builtin_amdgcn_readfirstlane(tidf >> 6), lane = tidf & 63, wr = wid >> 2, wc = wid & 3, fr = lane & 15, fq = lane >> 4;
  const bf* Wl = p.WinT + (size_t)layer * INW * 2048;
  const int nA = 128 * 23;
  const int total = nA + (layer == 0 ? 8 : 0);
  for (int L = blockIdx.x; L < total; L += gridDim.x) {
    f32x4 acc[2][2][4][2]; ZERO_ACC8(acc);
    if (L < nA) {
      int pm, pn; tile_order(L, 128, 23, pm, pn);
      const int brow = pm * 256, bcol = pn * 256;
      gemm256(p.xb, 2048, Wl, 2048, 2048, brow, bcol, acc);
      int fr_o = fr; asm volatile("" : "+v"(fr_o));
#pragma unroll
      for (int ai = 0; ai < 2; ai++)
#pragma unroll
        for (int m = 0; m < 4; m++) {
          __builtin_amdgcn_sched_barrier(0);
          const int tok = brow + ai * 128 + wr * 64 + m * 16 + fr_o;
#pragma unroll
          for (int bj = 0; bj < 2; bj++)
#pragma unroll
            for (int n = 0; n < 2; n++) {
              const int cb = bcol + bj * 128 + wc * 32 + n * 16;
              f32x4 v = acc[ai][bj][m][n];
              if (n == 0 && (wc & 1) == 0 && ((cb >= C_ATQ && cb < C_ATV) || (cb >= C_IDQ && cb < C_IDW))) {
                f32x4 cs = *(const f32x4*)(p.CS + (size_t)tok * 16 + 4 * (fq & 1));
                f32x4 sn = *(const f32x4*)(p.CS + (size_t)tok * 16 + 8 + 4 * (fq & 1));
#pragma unroll
                for (int e = 0; e < 4; e++) {
                  float o = __shfl_xor(v[e], 32);
                  v[e] = (fq < 2) ? (v[e] * cs[e] - o * sn[e]) : (v[e] * cs[e] + o * sn[e]);
                }
              }
              const int nn = cb + fq * 4;
              if (nn < 5716) {
                const int dn = nn + (nn >= 2628 ? 12 : 0);
                uint2 pv = make_uint2(pk2(v[0], v[1]), pk2(v[2], v[3]));
                *(uint2*)(p.P + (size_t)tok * PW + dn) = pv;
                if (nn >= C_IDK && nn < C_IDW) {
                  const int d = nn - C_IDK; const int b = tok >> 14, li = tok & 16383;
                  size_t o = ((((size_t)(b * 512 + (li >> 5)) * 4 + (d >> 4)) * 64 + ((d >> 3) & 1) * 32 + (li & 31)) * 8) + (d & 7);
                  *(uint2*)(p.KIF + o) = pv;
                }
                if (nn >= C_ATK && nn < C_ATZ) *(uint2*)(p.KVC + (size_t)tok * 256 + (nn - C_ATK)) = pv;
              }
            }
        }
    } else {
      const int t8 = L - nA; const int ly = t8 >> 2, tm = (t8 >> 1) & 1, tn = t8 & 1;
      gemm256(p.memb, 2048, p.WmemT + (size_t)ly * 512 * 2048, 2048, 2048, tm * 256, tn * 256, acc);
#pragma unroll
      for (int ai = 0; ai < 2; ai++)
#pragma unroll
        for (int m = 0; m < 4; m++) {
          const int row = tm * 256 + ai * 128 + wr * 64 + m * 16 + fr; const int b = row >> 8, mm = row & 255;
#pragma unroll
          for (int bj = 0; bj < 2; bj++)
#pragma unroll
            for (int n = 0; n < 2; n++)
#pragma unroll
              for (int e = 0; e < 4; e++) {
                const int nn = tn * 256 + bj * 128 + wc * 32 + n * 16 + fq * 4 + e; const float v = acc[ai][bj][m][n][e];
                if (nn < 256) { int h = nn >> 6, d = nn & 63; p.MK[((((size_t)ly * 2 + b) * 4 + h) * 256 + mm) * 64 + d] = f2bf(v); }
                else { int h = (nn - 256) >> 6, d = nn & 63; p.MVT[((((size_t)ly * 2 + b) * 4 + h) * 64 + d) * 256 + mm] = f2bf(v); }
              }
        }
    }
  }
}

__device__ __forceinline__ float softplusf_(float x) {
  const float e = __expf(x);
  const float sp = (e < 0.01f) ? e * (1.f - 0.5f * e) : __logf(1.f + e);
  return x > 15.f ? x : sp;
}

__device__ __forceinline__ void ssd_dt_acs(const Params& p, int layer, size_t tok0, int gg, float* sAcs, float* sDt) {
  const int tid = otid(), lane = tid & 63, w = tid >> 6;
#pragma unroll
  for (int k = 0; k < 2; k++) {
    const int hh = 2 * w + k, hd = gg * 8 + hh;
    const float bias = p.dt_bias[layer * 16 + hd], a = -__expf(p.a_log[layer * 16 + hd]);
    const int l0 = 2 * lane;
    float d0 = softplusf_(bf2f(p.P[(tok0 + l0) * PW + C_SDT + hd]) + bias);
    float d1 = softplusf_(bf2f(p.P[(tok0 + l0 + 1) * PW + C_SDT + hd]) + bias);
    float s0 = d0 * a, s1 = s0 + d1 * a;
    float xs = s1;
#pragma unroll
    for (int off = 1; off < 64; off <<= 1) { float v = __shfl_up(xs, off); if (lane >= off) xs += v; }
    float ex = xs - s1;
    sAcs[l0 * 8 + hh] = ex + s0; sAcs[(l0 + 1) * 8 + hh] = ex + s1;
    sDt[l0 * 8 + hh] = d0; sDt[(l0 + 1) * 8 + hh] = d1;
  }
}

struct Conv2 { float w0[4], w1[4], b0, b1, h0[3], h1[3]; };
__device__ __forceinline__ void conv_init(const Params& p, int layer, size_t tokb, int l, int ch, Conv2& c) {
  const float* cw = p.conv_w + (size_t)layer * 4 * 1536 + ch;
#pragma unroll
  for (int k = 0; k < 4; k++) { c.w0[k] = cw[k * 1536]; c.w1[k] = cw[k * 1536 + 1]; }
  c.b0 = p.conv_b[layer * 1536 + ch]; c.b1 = p.conv_b[layer * 1536 + ch + 1];
#pragma unroll
  for (int k = 0; k < 3; k++) {
    int ll = l - 3 + k; unsigned u = 0;
    if (ll >= 0) u = *(const unsigned*)(p.P + (tokb + ll) * PW + C_XBC + ch);
    c.h0[k] = bflo(u); c.h1[k] = bfhi(u);
  }
}
__device__ __forceinline__ void conv_step(const Params& p, size_t tokb, int l, int ch, Conv2& c, float& o0, float& o1) {
  unsigned u = *(const unsigned*)(p.P + (tokb + l) * PW + C_XBC + ch);
  float x0 = bflo(u), x1 = bfhi(u);
  float a0 = c.b0 + c.w0[0] * c.h0[0] + c.w0[1] * c.h0[1] + c.w0[2] * c.h0[2] + c.w0[3] * x0;
  float a1 = c.b1 + c.w1[0] * c.h1[0] + c.w1[1] * c.h1[1] + c.w1[2] * c.h1[2] + c.w1[3] * x1;
  c.h0[0] = c.h0[1]; c.h0[1] = c.h0[2]; c.h0[2] = x0;
  c.h1[0] = c.h1[1]; c.h1[1] = c.h1[2]; c.h1[2] = x1;
  o0 = siluf_(a0); o1 = siluf_(a1);
}

__device__ __forceinline__ void conv_val(unsigned u, Conv2& c, float& o0, float& o1) {
  float x0 = bflo(u), x1 = bfhi(u);
  float a0 = c.b0 + c.w0[0] * c.h0[0] + c.w0[1] * c.h0[1] + c.w0[2] * c.h0[2] + c.w0[3] * x0;
  float a1 = c.b1 + c.w1[0] * c.h1[0] + c.w1[1] * c.h1[1] + c.w1[2] * c.h1[2] + c.w1[3] * x1;
  c.h0[0] = c.h0[1]; c.h0[1] = c.h0[2]; c.h0[2] = x0;
  c.h1[0] = c.h1[1]; c.h1[1] = c.h1[2]; c.h1[2] = x1;
  o0 = siluf_(a0); o1 = siluf_(a1);
}
#define CONV_PRELOAD(raw, N, lfirst, nrows, ch)                                                           \
  unsigned raw[N];                                                                                        \
  _Pragma("unroll") for (int k_ = 0; k_ < N; k_++)                                                        \
    raw[k_] = (k_ < (nrows)) ? *(const unsigned*)(p.P + (tokb + (lfirst) + k_) * PW + C_XBC + (ch)) : 0u;

__device__ __forceinline__ void ssd_pass1(const Params& p, int layer, int task, char* sm) {
  const int tid = otid(), lane = tid & 63, w = tid >> 6, r32 = lane & 31, h5 = lane >> 5;
  const int gg = task & 1, c = (task >> 1) & 127, b = task >> 8;
  const size_t tokb = (size_t)b * LSEQ; const int lc0 = c * 128; const size_t tok0 = tokb + lc0;
  float* sAcs = (float*)sm; float* sDt = (float*)(sm + 4096);
  bf* sBT = (bf*)(sm + 8192); bf* sXT = (bf*)(sm + 43008);
  __syncthreads();
  ssd_dt_acs(p, layer, tok0, gg, sAcs, sDt);
  {
    const int cp = tid & 63, tg = tid >> 6; const int ch = 1024 + gg * 128 + 2 * cp;
    Conv2 cv; conv_init(p, layer, tokb, lc0 + tg * 32, ch, cv);
    CONV_PRELOAD(raw, 32, lc0 + tg * 32, 32, ch)
#pragma unroll
    for (int k = 0; k < 32; k += 2) {
      const int l = tg * 32 + k;
      float a0, a1, b0, b1;
      conv_val(raw[k], cv, a0, a1);
      conv_val(raw[k + 1], cv, b0, b1);
      *(unsigned*)(sBT + (2 * cp) * 136 + l) = pk2(a0, b0);
      *(unsigned*)(sBT + (2 * cp + 1) * 136 + l) = pk2(a1, b1);
    }
  }
  __syncthreads();
  if (tid < 8) p.CD[((size_t)(b * 128 + c)) * 16 + gg * 8 + tid] = __expf(sAcs[127 * 8 + tid]);
  for (int hh = 0; hh < 8; hh++) {
    const int hd = gg * 8 + hh;
    if (hh) __syncthreads();
    {
      const int cp = tid & 31, tg = tid >> 5; const int ch = gg * 512 + hh * 64 + 2 * cp;
      const float aend = sAcs[127 * 8 + hh];
      Conv2 cv; conv_init(p, layer, tokb, lc0 + tg * 16, ch, cv);
      CONV_PRELOAD(raw, 16, lc0 + tg * 16, 16, ch)
#pragma unroll
      for (int k = 0; k < 16; k += 2) {
        const int l = tg * 16 + k;
        float a0, a1, b0, b1;
        conv_val(raw[k], cv, a0, a1);
        conv_val(raw[k + 1], cv, b0, b1);
        float sa = sDt[l * 8 + hh] * __expf(aend - sAcs[l * 8 + hh]);
        float sb = sDt[(l + 1) * 8 + hh] * __expf(aend - sAcs[(l + 1) * 8 + hh]);
        *(unsigned*)(sXT + (2 * cp) * 136 + l) = pk2(a0 * sa, b0 * sb);
        *(unsigned*)(sXT + (2 * cp + 1) * 136 + l) = pk2(a1 * sa, b1 * sb);
      }
    }
    __syncthreads();
    f32x16 acc[2];
#pragma unroll
    for (int r = 0; r < 16; r++) { const float z_ = ozero(); acc[0][r] = z_; acc[1][r] = z_; }
#pragma unroll
    for (int ks = 0; ks < 8; ks++) {
      bf16x8 bfr = *(const bf16x8*)(sBT + (32 * w + r32) * 136 + ks * 16 + 8 * h5);
      bf16x8 x0 = *(const bf16x8*)(sXT + (r32) * 136 + ks * 16 + 8 * h5);
      bf16x8 x1 = *(const bf16x8*)(sXT + (32 + r32) * 136 + ks * 16 + 8 * h5);
      acc[0] = mfma32(x0, bfr, acc[0]);
      acc[1] = mfma32(x1, bfr, acc[1]);
    }
    float* st = p.ST + ((size_t)(b * 128 + c) * 16 + hd) * 64 * 128;
#pragma unroll
    for (int pi = 0; pi < 2; pi++)
#pragma unroll
      for (int r = 0; r < 16; r++) {
        int pp = 32 * pi + 8 * (r >> 2) + 4 * h5 + (r & 3);
        st[pp * 128 + 32 * w + r32] = acc[pi][r];
      }
  }
}

__device__ __forceinline__ void ssd_statepass(const Params& p, int task) {
  const int idx = task * 256 + otid();
  const int b = idx >> 15, e4 = idx & 32767;
  const int hd = e4 >> 11;
  const float zc_ = ozero(); float4 carry = make_float4(zc_, zc_, zc_, zc_);
  float* base = p.ST + (size_t)b * 128 * 131072 + (size_t)e4 * 4;
  const float* cd = p.CD + (size_t)b * 128 * 16 + hd;
  for (int c0 = 0; c0 < 128; c0 += 4) {
    float4 v[4]; float d[4];
#pragma unroll
    for (int k = 0; k < 4; k++) { v[k] = *(const float4*)(base + (size_t)(c0 + k) * 131072); d[k] = cd[(c0 + k) * 16]; }
#pragma unroll
    for (int k = 0; k < 4; k++) {
      *(float4*)(base + (size_t)(c0 + k) * 131072) = carry;
      carry.x = carry.x * d[k] + v[k].x; carry.y = carry.y * d[k] + v[k].y;
      carry.z = carry.z * d[k] + v[k].z; carry.w = carry.w * d[k] + v[k].w;
    }
  }
}

__device__ __forceinline__ void ssd_pass2(const Params& p, int layer, int task, char* sm) {
  const int tid = otid(), lane = tid & 63, w = tid >> 6, r32 = lane & 31, h5 = lane >> 5;
  const int lh = task & 1, gg = (task >> 1) & 1, c = (task >> 2) & 127, b = task >> 9;
  const size_t tokb = (size_t)b * LSEQ; const int lc0 = c * 128; const size_t tok0 = tokb + lc0;
  float* sAcs = (float*)sm; float* sDt = (float*)(sm + 4096);
  bf* sC = (bf*)(sm + 8192); bf* sB = (bf*)(sm + 25600); bf* sM = (bf*)(sm + 25600); bf* sXT = (bf*)(sm + 43008);
  float* sSsq = (float*)(sm + 60416);
  const int wr = w >> 1, wc = w & 1;
  const int nS = 64 * (lh + 1);
  __syncthreads();
  ssd_dt_acs(p, layer, tok0, gg, sAcs, sDt);
  {
    const int cp = tid & 63, tg = tid >> 6;
    {
      const int ch = 1280 + gg * 128 + 2 * cp;
      const int lst = 64 * lh + tg * 16;
      Conv2 cv; conv_init(p, layer, tokb, lc0 + lst, ch, cv);
      CONV_PRELOAD(raw, 16, lc0 + lst, 16, ch)
#pragma unroll
      for (int k = 0; k < 16; k++) {
        const int l = lst + k;
        float a0, a1; conv_val(raw[k], cv, a0, a1);
        *(unsigned*)(sC + (l - 64 * lh) * 136 + 2 * cp) = pk2(a0, a1);
      }
    }
    {
      const int ch = 1024 + gg * 128 + 2 * cp;
      const int per = nS >> 2; const int lst = tg * per;
      Conv2 cv; conv_init(p, layer, tokb, lc0 + lst, ch, cv);
      CONV_PRELOAD(raw, 32, lc0 + lst, per, ch)
#pragma unroll
      for (int k = 0; k < 32; k++) {
        if (k < per) {
          const int l = lst + k;
          float a0, a1; conv_val(raw[k], cv, a0, a1);
          *(unsigned*)(sB + l * 136 + 2 * cp) = pk2(a0, a1);
        }
      }
    }
  }
  __syncthreads();
  f32x16 cb[2];
#pragma unroll
  for (int r = 0; r < 16; r++) { const float z_ = ozero(); cb[0][r] = z_; cb[1][r] = z_; }
  if (64 * wc < nS) {
#pragma unroll
    for (int ks = 0; ks < 8; ks++) {
      bf16x8 af = *(const bf16x8*)(sC + (32 * wr + r32) * 136 + ks * 16 + 8 * h5);
      bf16x8 b0 = *(const bf16x8*)(sB + (64 * wc + r32) * 136 + ks * 16 + 8 * h5);
      bf16x8 b1 = *(const bf16x8*)(sB + (64 * wc + 32 + r32) * 136 + ks * 16 + 8 * h5);
      cb[0] = mfma32(af, b0, cb[0]);
      cb[1] = mfma32(af, b1, cb[1]);
    }
  }
  __syncthreads();
  const int wc2 = w & 1;
  for (int hh = 0; hh < 8; hh++) {
    const int hd = gg * 8 + hh;
    if (hh) __syncthreads();
    bf16x8 pfr[8];
    {
      const float* pv = p.ST + (((size_t)(b * 128 + c) * 16 + hd) * 64 + 32 * wc2 + r32) * 128 + 8 * h5;
#pragma unroll
      for (int ks = 0; ks < 8; ks++) {
        float4 u0 = *(const float4*)(pv + ks * 16), u1 = *(const float4*)(pv + ks * 16 + 4);
        unsigned q0 = pk2(u0.x, u0.y), q1 = pk2(u0.z, u0.w), q2 = pk2(u1.x, u1.y), q3 = pk2(u1.z, u1.w);
        pfr[ks][0] = (short)(q0 & 0xFFFF); pfr[ks][1] = (short)(q0 >> 16); pfr[ks][2] = (short)(q1 & 0xFFFF); pfr[ks][3] = (short)(q1 >> 16);
        pfr[ks][4] = (short)(q2 & 0xFFFF); pfr[ks][5] = (short)(q2 >> 16); pfr[ks][6] = (short)(q3 & 0xFFFF); pfr[ks][7] = (short)(q3 >> 16);
      }
    }
    {
      const float dsk = p.ssd_d[layer * 16 + hd];
#pragma unroll
      for (int j = 0; j < 2; j++) {
        const int s = 64 * wc + 32 * j + r32;
        if (s < nS) {
          const float as = sAcs[s * 8 + hh];
#pragma unroll
          for (int r = 0; r < 16; r++) {
            const int lp = 32 * wr + 8 * (r >> 2) + 4 * h5 + (r & 3); const int l = 64 * lh + lp;
            float v = 0.f;
            if (s <= l) v = cb[j][r] * __expf(sAcs[l * 8 + hh] - as);
            if (s == l) v += dsk * __builtin_amdgcn_rcpf(sDt[l * 8 + hh]);
            sM[lp * 136 + s] = f2bf(v);
          }
        }
      }
    }
    {
      const int cp = tid & 31, tg = tid >> 5; const int ch = gg * 512 + hh * 64 + 2 * cp;
      const int per = nS >> 3; const int lst = tg * per;
      Conv2 cv; conv_init(p, layer, tokb, lc0 + lst, ch, cv);
      CONV_PRELOAD(raw, 16, lc0 + lst, per, ch)
#pragma unroll
      for (int k = 0; k < 16; k += 2) {
        if (k >= per) break;
        const int l = lst + k;
        float a0, a1, b0, b1;
        conv_val(raw[k], cv, a0, a1);
        conv_val(raw[k + 1], cv, b0, b1);
        float sa = sDt[l * 8 + hh], sb = sDt[(l + 1) * 8 + hh];
        *(unsigned*)(sXT + (2 * cp) * 136 + l) = pk2(a0 * sa, b0 * sb);
        *(unsigned*)(sXT + (2 * cp + 1) * 136 + l) = pk2(a1 * sa, b1 * sb);
      }
    }
    __syncthreads();
    f32x16 yd, yo;
#pragma unroll
    for (int r = 0; r < 16; r++) { const float z_ = ozero(); yd[r] = z_; yo[r] = z_; }
    const int nks = nS >> 4;
    for (int ks = 0; ks < nks; ks++) {
      bf16x8 xf = *(const bf16x8*)(sXT + (32 * wc2 + r32) * 136 + ks * 16 + 8 * h5);
      bf16x8 mf = *(const bf16x8*)(sM + (32 * wr + r32) * 136 + ks * 16 + 8 * h5);
      yd = mfma32(xf, mf, yd);
    }
    {
#pragma unroll
      for (int ks = 0; ks < 8; ks++) {
        bf16x8 cf = *(const bf16x8*)(sC + (32 * wr + r32) * 136 + ks * 16 + 8 * h5);
        yo = mfma32(pfr[ks], cf, yo);
      }
    }
    {
      const int lp = 32 * wr + r32; const int l = 64 * lh + lp; const size_t tok = tok0 + l;
      const float eo = __expf(sAcs[l * 8 + hh]);
      float ss = 0.f;
#pragma unroll
      for (int q = 0; q < 4; q++) {
        const int pp = 32 * wc2 + 8 * q + 4 * h5;
        uint2 zz = *(const uint2*)(p.P + tok * PW + C_SSZ + hd * 64 + pp);
        float v0 = (yd[4 * q] + eo * yo[4 * q]) * siluf_(bflo(zz.x));
        float v1 = (yd[4 * q + 1] + eo * yo[4 * q + 1]) * siluf_(bfhi(zz.x));
        float v2 = (yd[4 * q + 2] + eo * yo[4 * q + 2]) * siluf_(bflo(zz.y));
        float v3 = (yd[4 * q + 3] + eo * yo[4 * q + 3]) * siluf_(bfhi(zz.y));
        ss += v0 * v0 + v1 * v1 + v2 * v2 + v3 * v3;
        *(uint2*)(p.Y + tok * YW + Y_SSD + hd * 64 + pp) = make_uint2(pk2(v0, v1), pk2(v2, v3));
      }
      sSsq[lp * 32 + hh * 4 + wc2 * 2 + h5] = ss;
    }
  }
  __syncthreads();
  {
    const int lp = tid >> 2, part = tid & 3; const size_t tok = tok0 + 64 * lh + lp;
    float tot = 0.f;
#pragma unroll
    for (int k = 0; k < 32; k += 4) { float4 v4 = *(const float4*)(sSsq + lp * 32 + k); tot += (v4.x + v4.y) + (v4.z + v4.w); }
    const float rs = rsqrtf(tot * (1.f / 512.f) + 1e-5f);
    bf* yp = p.Y + tok * YW + Y_SSD + gg * 512 + part * 128;
    const float* ng = p.norm_g + layer * 1024 + gg * 512 + part * 128;
#pragma unroll 4
    for (int i = 0; i < 16; i++) {
      uint4 u = *(const uint4*)(yp + i * 8);
      float4 g0 = *(const float4*)(ng + i * 8), g1 = *(const float4*)(ng + i * 8 + 4);
      u.x = pk2(bflo(u.x) * rs * g0.x, bfhi(u.x) * rs * g0.y);
      u.y = pk2(bflo(u.y) * rs * g0.z, bfhi(u.y) * rs * g0.w);
      u.z = pk2(bflo(u.z) * rs * g1.x, bfhi(u.z) * rs * g1.y);
      u.w = pk2(bflo(u.w) * rs * g1.z, bfhi(u.w) * rs * g1.w);
      *(uint4*)(yp + i * 8) = u;
    }
  }
}

__device__ __forceinline__ void s5_ld_u(const Params& p, size_t tok, int g, uint4& a, uint4& b) {
  const uint4* src = (const uint4*)(p.P + tok * PW + C_S5U + g * 16);
  a = src[0]; b = src[1];
}
__device__ __forceinline__ void s5_st_u(float* dst, const uint4 a, const uint4 b) {
  *(float4*)(dst + 0) = make_float4(bflo(a.x), bfhi(a.x), bflo(a.y), bfhi(a.y));
  *(float4*)(dst + 4) = make_float4(bflo(a.z), bfhi(a.z), bflo(a.w), bfhi(a.w));
  *(float4*)(dst + 8) = make_float4(bflo(b.x), bfhi(b.x), bflo(b.y), bfhi(b.y));
  *(float4*)(dst + 12) = make_float4(bflo(b.z), bfhi(b.z), bflo(b.w), bfhi(b.w));
}
__device__ __forceinline__ void s5_load_u(const Params& p, size_t tok, int g, float* dst) {
  const uint4* src = (const uint4*)(p.P + tok * PW + C_S5U + g * 16);
  uint4 a = src[0], b = src[1];
  *(float4*)(dst + 0) = make_float4(bflo(a.x), bfhi(a.x), bflo(a.y), bfhi(a.y));
  *(float4*)(dst + 4) = make_float4(bflo(a.z), bfhi(a.z), bflo(a.w), bfhi(a.w));
  *(float4*)(dst + 8) = make_float4(bflo(b.x), bfhi(b.x), bflo(b.y), bfhi(b.y));
  *(float4*)(dst + 12) = make_float4(bflo(b.z), bfhi(b.z), bflo(b.w), bfhi(b.w));
}
typedef float f32x2 __attribute__((ext_vector_type(2)));
#define S5_STEP(uu)                                                                     \
  {                                                                                     \
    float4 u0 = *(const float4*)((uu)), u1 = *(const float4*)((uu) + 4), u2 = *(const float4*)((uu) + 8), u3 = *(const float4*)((uu) + 12); \
    f32x2 bb = B2[0] * (f32x2){u0.x, u0.x};                                             \
    bb = B2[1] * (f32x2){u0.y, u0.y} + bb; bb = B2[2] * (f32x2){u0.z, u0.z} + bb; bb = B2[3] * (f32x2){u0.w, u0.w} + bb;     \
    bb = B2[4] * (f32x2){u1.x, u1.x} + bb; bb = B2[5] * (f32x2){u1.y, u1.y} + bb; bb = B2[6] * (f32x2){u1.z, u1.z} + bb; bb = B2[7] * (f32x2){u1.w, u1.w} + bb; \
    bb = B2[8] * (f32x2){u2.x, u2.x} + bb; bb = B2[9] * (f32x2){u2.y, u2.y} + bb; bb = B2[10] * (f32x2){u2.z, u2.z} + bb; bb = B2[11] * (f32x2){u2.w, u2.w} + bb; \
    bb = B2[12] * (f32x2){u3.x, u3.x} + bb; bb = B2[13] * (f32x2){u3.y, u3.y} + bb; bb = B2[14] * (f32x2){u3.z, u3.z} + bb; bb = B2[15] * (f32x2){u3.w, u3.w} + bb; \
    float nr_ = ar * sr - ai * si + bb.x; float ni_ = ar * si + ai * sr + bb.y; sr = nr_; si = ni_; \
  }

__device__ __forceinline__ void s5_pass1(const Params& p, int layer, int task, char* sm) {
  const int tid = otid(), lane = tid & 63, w = tid >> 6;
  const int gq = task & 7, c = (task >> 3) & 127, b = task >> 10;
  const int g = gq * 4 + w;
  const size_t tok0 = (size_t)b * LSEQ + c * 128;
  float* sU = (float*)(sm + w * 8192);
  __syncthreads();
  s5_load_u(p, tok0 + lane, g, sU + lane * 16);
  s5_load_u(p, tok0 + 64 + lane, g, sU + (64 + lane) * 16);
  const size_t pi = ((size_t)(layer * 32 + g)) * 64 + lane;
  f32x2 B2[16];
#pragma unroll
  for (int h = 0; h < 16; h++) { B2[h].x = p.SB[pi * 32 + h]; B2[h].y = p.SB[pi * 32 + 16 + h]; }
  const float ar = p.SA[pi * 4], ai = p.SA[pi * 4 + 1];
  float sr = 0.f, si = 0.f;
  __builtin_amdgcn_wave_barrier();
  for (int l = 0; l < 128; l++) S5_STEP(sU + l * 16)
  *(float2*)(p.END + (((size_t)(b * 128 + c) * 32 + g) * 64 + lane) * 2) = make_float2(sr, si);
}

__device__ __forceinline__ void s5_carry(const Params& p, int layer, int task) {
  const int idx = task * 256 + otid();
  const int b = idx >> 11, gp = idx & 2047;
  const size_t pi = (size_t)layer * 2048 + gp;
  const float a128r = p.SA[pi * 4 + 2], a128i = p.SA[pi * 4 + 3];
  float sr = ozero(), si = ozero();
  float2* e = (float2*)p.END + (size_t)b * 128 * 2048 + gp;
  for (int c0 = 0; c0 < 128; c0 += 4) {
    float2 v[4];
#pragma unroll
    for (int k = 0; k < 4; k++) v[k] = e[(size_t)(c0 + k) * 2048];
#pragma unroll
    for (int k = 0; k < 4; k++) {
      e[(size_t)(c0 + k) * 2048] = make_float2(sr, si);
      float nr = a128r * sr - a128i * si + v[k].x, ni = a128r * si + a128i * sr + v[k].y; sr = nr; si = ni;
    }
  }
}

__device__ __forceinline__ void s5_pass2(const Params& p, int layer, int task, char* sm) {
  const int tid = otid(), lane = tid & 63, w = tid >> 6;
  const int c = task & 127, b = task >> 7;
  const size_t tok0 = (size_t)b * LSEQ + c * 128;
  float* sU = (float*)(sm + w * 10752); bf* sS = (bf*)(sm + w * 10752 + 2048);
  __syncthreads();
  uint4 ua, ub;
  s5_ld_u(p, tok0 + (lane & 31), w * 8, ua, ub);
  for (int gi = 0; gi < 8; gi++) {
    const int g = w * 8 + gi;
    const size_t pi = ((size_t)(layer * 32 + g)) * 64 + lane;
    f32x2 B2[16];
#pragma unroll
    for (int h = 0; h < 16; h++) { B2[h].x = p.SB[pi * 32 + h]; B2[h].y = p.SB[pi * 32 + 16 + h]; }
    const float ar = p.SA[pi * 4], ai = p.SA[pi * 4 + 1];
    float2 s0 = *(const float2*)(p.END + (((size_t)(b * 128 + c) * 32 + g) * 64 + lane) * 2);
    float sr = s0.x, si = s0.y;
    bf16x8 cf[4];
    {
      const bf* cm = p.CM + (((size_t)(layer * 32 + g)) * 16 + (lane & 15)) * 128 + 8 * (lane >> 4);
#pragma unroll
      for (int ks = 0; ks < 4; ks++) cf[ks] = *(const bf16x8*)(cm + ks * 32);
    }
    const float dsk = p.s5_d[(layer * 32 + g) * 16 + (lane & 15)];
    for (int sub = 0; sub < 4; sub++) {
      __builtin_amdgcn_wave_barrier();
      if (lane < 32) s5_st_u(sU + lane * 16, ua, ub);
      {
        const int nsub = (sub + 1) & 3; const int ng = g + (sub == 3 ? 1 : 0);
        if (sub < 3 || gi < 7) s5_ld_u(p, tok0 + nsub * 32 + (lane & 31), ng, ua, ub);
      }
      __builtin_amdgcn_wave_barrier();
      for (int l = 0; l < 32; l++) {
        S5_STEP(sU + l * 16)
        sS[l * 136 + lane] = f2bf(sr); sS[l * 136 + 64 + lane] = f2bf(si);
      }
      __builtin_amdgcn_wave_barrier();
#pragma unroll
      for (int mb = 0; mb < 2; mb++) {
        const float z_ = ozero(); f32x4 acc = {z_, z_, z_, z_};
#pragma unroll
        for (int ks = 0; ks < 4; ks++) {
          bf16x8 af = *(const bf16x8*)(sS + (16 * mb + (lane & 15)) * 136 + ks * 32 + 8 * (lane >> 4));
          acc = mfma16(af, cf[ks], acc);
        }
#pragma unroll
        for (int r = 0; r < 4; r++) {
          const int l = 16 * mb + 4 * (lane >> 4) + r;
          float y = acc[r] + dsk * sU[l * 16 + (lane & 15)];
          p.YG[(tok0 + sub * 32 + l) * 512 + g * 16 + (lane & 15)] = f2bf(geluf_(y));
        }
      }
    }
  }
  __syncthreads();
  const int wr = w >> 1, wc = w & 1, r32 = lane & 31, h5 = lane >> 5;
  for (int tn = 0; tn < 4; tn++) {
    f32x16 acc[2][2]; ZERO_ACC(acc);
    gemm_acc<4>(p.YG + tok0 * 512, 512, p.WgluT + ((size_t)layer * 512 + tn * 128) * 512, 512, 512, acc, sm);
#pragma unroll
    for (int i = 0; i < 2; i++) {
      const size_t tok = tok0 + wr * 64 + i * 32 + r32;
#pragma unroll
      for (int j = 0; j < 2; j++)
#pragma unroll
        for (int q = 0; q < 4; q++) {
          const int n = tn * 128 + wc * 64 + j * 32 + q * 8 + h5 * 4;
          float4 bg = *(const float4*)(p.b_glu + layer * 512 + n);
          uint2 yy = *(const uint2*)(p.YG + tok * 512 + n);
          uint2 zz = *(const uint2*)(p.P + tok * PW + C_S5Z + n);
          float o0 = bflo(yy.x) * sigmoidf_(acc[i][j][4 * q] + bg.x) * siluf_(bflo(zz.x));
          float o1 = bfhi(yy.x) * sigmoidf_(acc[i][j][4 * q + 1] + bg.y) * siluf_(bfhi(zz.x));
          float o2 = bflo(yy.y) * sigmoidf_(acc[i][j][4 * q + 2] + bg.z) * siluf_(bflo(zz.y));
          float o3 = bfhi(yy.y) * sigmoidf_(acc[i][j][4 * q + 3] + bg.w) * siluf_(bfhi(zz.y));
          *(uint2*)(p.Y + tok * YW + Y_S5 + n) = make_uint2(pk2(o0, o1), pk2(o2, o3));
        }
    }
  }
}

__device__ __forceinline__ void mem_attn(const Params& p, int layer, int task) {
  const int tid = otid(), lane = tid & 63, h = tid >> 6;
  const int n16 = lane & 15, kq = lane >> 4;
  const size_t tok0 = (size_t)task * 16; const int b = (int)(tok0 >> 14);
  const bf* mk = p.MK + (((size_t)layer * 2 + b) * 4 + h) * 256 * 64;
  const bf* mvt = p.MVT + (((size_t)layer * 2 + b) * 4 + h) * 64 * 256;
  bf16x8 qf[2];
  {
    const bf* qp = p.P + (tok0 + n16) * PW + C_MEQ + h * 64 + 8 * kq;
    qf[0] = *(const bf16x8*)qp; qf[1] = *(const bf16x8*)(qp + 32);
  }
  f32x4 st[16];
#pragma unroll
  for (int kb = 0; kb < 16; kb++) {
    const bf* kp = mk + (size_t)(16 * kb + n16) * 64 + 8 * kq;
    bf16x8 a0 = *(const bf16x8*)kp, a1 = *(const bf16x8*)(kp + 32);
    const float z_ = ozero(); f32x4 acc = {z_, z_, z_, z_};
    acc = mfma16(a0, qf[0], acc); acc = mfma16(a1, qf[1], acc);
    st[kb] = acc * 0.125f;
  }
  float mx = -3.0e38f;
#pragma unroll
  for (int kb = 0; kb < 16; kb++)
#pragma unroll
    for (int r = 0; r < 4; r++) mx = fmaxf(mx, st[kb][r]);
  mx = fmaxf(mx, __shfl_xor(mx, 16)); mx = fmaxf(mx, __shfl_xor(mx, 32));
  float sum = 0.f;
#pragma unroll
  for (int kb = 0; kb < 16; kb++)
#pragma unroll
    for (int r = 0; r < 4; r++) { float e = __expf(st[kb][r] - mx); st[kb][r] = e; sum += e; }
  sum += __shfl_xor(sum, 16); sum += __shfl_xor(sum, 32);
  const float rinv = 1.f / sum;
  f32x4 o[4];
#pragma unroll
  for (int mb = 0; mb < 4; mb++) { const float z_ = ozero(); o[mb] = (f32x4){z_, z_, z_, z_}; }
#pragma unroll
  for (int k2 = 0; k2 < 8; k2++) {
    bf16x8 pf;
    unsigned q0 = pk2(st[2 * k2][0], st[2 * k2][1]), q1 = pk2(st[2 * k2][2], st[2 * k2][3]);
    unsigned q2 = pk2(st[2 * k2 + 1][0], st[2 * k2 + 1][1]), q3 = pk2(st[2 * k2 + 1][2], st[2 * k2 + 1][3]);
    pf[0] = (short)(q0 & 0xFFFF); pf[1] = (short)(q0 >> 16); pf[2] = (short)(q1 & 0xFFFF); pf[3] = (short)(q1 >> 16);
    pf[4] = (short)(q2 & 0xFFFF); pf[5] = (short)(q2 >> 16); pf[6] = (short)(q3 & 0xFFFF); pf[7] = (short)(q3 >> 16);
#pragma unroll
    for (int mb = 0; mb < 4; mb++) {
      const bf* vp = mvt + (size_t)(16 * mb + n16) * 256 + 32 * k2 + 4 * kq;
      uint2 v0 = *(const uint2*)vp, v1 = *(const uint2*)(vp + 16);
      bf16x8 af;
      af[0] = (short)(v0.x & 0xFFFF); af[1] = (short)(v0.x >> 16); af[2] = (short)(v0.y & 0xFFFF); af[3] = (short)(v0.y >> 16);
      af[4] = (short)(v1.x & 0xFFFF); af[5] = (short)(v1.x >> 16); af[6] = (short)(v1.y & 0xFFFF); af[7] = (short)(v1.y >> 16);
      o[mb] = mfma16(af, pf, o[mb]);
    }
  }
  const size_t tok = tok0 + n16;
#pragma unroll
  for (int mb = 0; mb < 4; mb++) {
    const int d = 16 * mb + 4 * kq;
    uint2 zz = *(const uint2*)(p.P + tok * PW + C_MEZ + h * 64 + d);
    float v0 = o[mb][0] * rinv * siluf_(bflo(zz.x)), v1 = o[mb][1] * rinv * siluf_(bfhi(zz.x));
    float v2 = o[mb][2] * rinv * siluf_(bflo(zz.y)), v3 = o[mb][3] * rinv * siluf_(bfhi(zz.y));
    *(uint2*)(p.Y + tok * YW + Y_MEM + h * 64 + d) = make_uint2(pk2(v0, v1), pk2(v2, v3));
  }
}

__device__ __forceinline__ void dsa_wave(const Params& p, int rank, char* sm) {
  const int tid = otid(), lane = tid & 63, w = tid >> 6, r32 = lane & 31, h5 = lane >> 5;
  const int b = rank & 1, qg = 2047 - (rank >> 1), l0 = qg * 8;
  const size_t tokb = (size_t)b * LSEQ;
  unsigned* cand = (unsigned*)(sm + w * (8 * CAP * 4));
  bf* Pb = (bf*)(sm + 61440 + w * 4096);
  bf16x8 aq[4];
  {
    const bf* qp = p.P + (tokb + l0 + (r32 >> 2)) * PW + C_IDQ + (r32 & 3) * 64 + 8 * h5;
#pragma unroll
    for (int ks = 0; ks < 4; ks++) aq[ks] = *(const bf16x8*)(qp + ks * 16);
  }
  float wv[4][4]; int ql[4];
#pragma unroll
  for (int g = 0; g < 4; g++) {
    ql[g] = l0 + 2 * g + h5;
    uint2 u = *(const uint2*)(p.P + (tokb + ql[g]) * PW + C_IDW);
    wv[g][0] = bflo(u.x) * 0.0625f; wv[g][1] = bfhi(u.x) * 0.0625f; wv[g][2] = bflo(u.y) * 0.0625f; wv[g][3] = bfhi(u.y) * 0.0625f;
  }
  unsigned Tg[4] = {0u, 0u, 0u, 0u}; float Tf[4];
  unsigned Tq = 0u; int cntv = 0;
  int nrep_ = (PROBE_MASK & 32) ? 2 : 1; asm volatile("" : "+s"(nrep_));
#pragma unroll 1
  for (int rep_ = 0; rep_ < nrep_; rep_++) {
  Tg[0] = Tg[1] = Tg[2] = Tg[3] = 0u; Tq = 0u; cntv = 0;
  Tf[0] = Tf[1] = Tf[2] = Tf[3] = -__builtin_inff();
  const int ntile = (l0 + 7) / 32 + 1;
  const bf* kif = p.KIF + (size_t)b * 512 * 2048 + lane * 8;
  bf16x8 bqA[4][4], bqB[4][4];
#pragma unroll
  for (int s = 0; s < 4; s++) {
    const int ts = s < ntile ? s : ntile - 1;
#pragma unroll
    for (int ks = 0; ks < 4; ks++) bqA[s][ks] = *(const bf16x8*)(kif + (size_t)ts * 2048 + ks * 512);
  }
  const unsigned ltmask = (1u << r32) - 1u;
#define DSA_COMPACT_CHECK()                                                                                              \
  {                                                                                                                     \
    unsigned long long over = __ballot(lane < 8 && cntv > CAP - 64);                                                    \
    if (over) {                                                                                                         \
      while (over) {                                                                                                    \
        const int q = __builtin_ctzll(over); over &= over - 1;                                                          \
        const int n = __builtin_amdgcn_readlane(cntv, q);                                                               \
        unsigned* cb_ = cand + q * CAP;                                                                                 \
        unsigned e[8];                                                                                                  \
        _Pragma("unroll") for (int i = 0; i < 8; i++) e[i] = (i * 64 + lane < n) ? cb_[i * 64 + lane] : 0u;             \
        unsigned T = 0u; int cT = n;                                                                                    \
        int nsr_ = (PROBE_MASK & 64) ? 2 : 1; asm volatile("" : "+s"(nsr_));                                            \
        _Pragma("unroll 1") for (int sr_ = 0; sr_ < nsr_; sr_++) { T = 0u; cT = n;                                      \
        const unsigned Told_ = (unsigned)__builtin_amdgcn_readlane((int)Tq, q);                                         \
        for (int bit = 31; bit >= 18; bit--) {                                                                          \
          const unsigned cnd = T | (1u << bit); int cc = 0;                                                             \
          if (cnd <= Told_) { T = cnd; continue; }                       \
          _Pragma("unroll") for (int i = 0; i < 8; i++) cc += __popcll(__ballot(e[i] >= cnd));                          \
          if (cc >= 256) { T = cnd; cT = cc; }                                                                          \
        } }                                                                                                             \
        if (cT > 320) {                                                                                                 \
          for (int bit = 17; bit >= 0; bit--) {                                                                         \
            const unsigned cnd = T | (1u << bit); int cc = 0;                                                           \
            _Pragma("unroll") for (int i = 0; i < 8; i++) cc += __popcll(__ballot(e[i] >= cnd));                        \
            if (cc >= 256) T = cnd;                                                                                     \
          }                                                                                                             \
        }                                                                                                               \
        int pos = 0;                                                                                                    \
        _Pragma("unroll") for (int i = 0; i < 8; i++) {                                                                 \
          const bool keep = e[i] >= T; const unsigned long long m = __ballot(keep);                                     \
          if (keep) cb_[pos + __popcll(m & ((1ull << lane) - 1ull))] = e[i];                                            \
          pos += __popcll(m);                                                                                           \
        }                                                                                                               \
        if (lane == q) { cntv = pos; Tq = T; }                                                                          \
      }                                                                                                                 \
      _Pragma("unroll") for (int g = 0; g < 4; g++) {                                                                   \
        unsigned tlo = __builtin_amdgcn_readlane(Tq, 2 * g), thi = __builtin_amdgcn_readlane(Tq, 2 * g + 1);            \
        Tg[g] = h5 ? thi : tlo;                                                                                         \
        const unsigned sh = Tg[g] & 0xFFFFC000u;                                                                        \
        const unsigned fb = (sh & 0x80000000u) ? (sh ^ 0x80000000u) : ~sh;                                              \
        Tf[g] = Tg[g] ? __uint_as_float(fb) : -__builtin_inff();                                                        \
      }                                                                                                                 \
    }                                                                                                                   \
  }
#define DSA_G(g, DIAG)                                                                                                  \
      {                                                                                                                 \
        const float r0 = __int_as_float(max(__float_as_int(acc[4 * g]), 0)), r1 = __int_as_float(max(__float_as_int(acc[4 * g + 1]), 0)); \
        const float r2 = __int_as_float(max(__float_as_int(acc[4 * g + 2]), 0)), r3 = __int_as_float(max(__float_as_int(acc[4 * g + 3]), 0)); \
        float sc = r0 * wv[g][0]; sc = fmaf(r1, wv[g][1], sc); sc = fmaf(r2, wv[g][2], sc); sc = fmaf(r3, wv[g][3], sc); \
        unsigned long long m0 = __builtin_amdgcn_fcmpf(sc, Tf[g], 3  );                                            \
        if (DIAG) m0 &= __builtin_amdgcn_sicmp(kidx, ql[g], 41  );                                                 \
        if (m0) {                                                                                                       \
          const float s2 = sc + 0.f;                                                                                    \
          unsigned uu = __float_as_uint(s2); uu ^= ((unsigned)((int)uu >> 31) | 0x80000000u);                           \
          const unsigned pk = (uu & 0xFFFFC000u) | (unsigned)(16383 - kidx);                                            \
          const unsigned long long m = m0 & __builtin_amdgcn_uicmp(pk, Tg[g], 35  );                              \
          if (m) {                                                                                                      \
            const unsigned lo = (unsigned)m, hi = (unsigned)(m >> 32);                                                  \
            const int cA = __builtin_amdgcn_readlane(cntv, 2 * g), cB = __builtin_amdgcn_readlane(cntv, 2 * g + 1);     \
            const unsigned mm = h5 ? hi : lo;                                                                           \
            if ((mm >> r32) & 1u) {                                                                                     \
              const int base = h5 ? cB : cA;                                                                            \
              cand[(2 * g + h5) * CAP + base + __popc(mm & ltmask)] = pk;                                               \
            }                                                                                                           \
            if (lane == 2 * g) cntv += __popc(lo);                                                                      \
            if (lane == 2 * g + 1) cntv += __popc(hi);                                                                  \
          }                                                                                                             \
        }                                                                                                               \
      }
#define DSA_GROUP(BC, BN, TB)                                                                                           \
  _Pragma("unroll") for (int u = 0; u < 4; u++) {                                                                       \
    if ((u & 1) == 0) DSA_COMPACT_CHECK()                                                                               \
    const int tile = (TB) + u;                                                                                          \
    f32x16 acc = {0.f, 0.f, 0.f, 0.f, 0.f, 0.f, 0.f, 0.f, 0.f, 0.f, 0.f, 0.f, 0.f, 0.f, 0.f, 0.f};                    \
    _Pragma("unroll") for (int ks = 0; ks < 4; ks++) acc = mfma32(aq[ks], BC[u][ks], acc);                              \
    if (u == 0) {                                                                                                       \
      _Pragma("unroll") for (int s = 0; s < 4; s++) {                                                                   \
        const int tn_ = ((TB) + 4 + s < ntile) ? (TB) + 4 + s : ntile - 1;                                              \
        _Pragma("unroll") for (int ks = 0; ks < 4; ks++) BN[s][ks] = *(const bf16x8*)(kif + (size_t)tn_ * 2048 + ks * 512); \
      }                                                                                                                 \
    }                                                                                                                   \
    const int kidx = tile * 32 + r32;                                                                                   \
    const bool diag = (tile * 32 + 31 > l0);                                                                            \
    if (!diag) { DSA_G(0, false) DSA_G(1, false) DSA_G(2, false) DSA_G(3, false) }                                      \
    else { DSA_G(0, true) DSA_G(1, true) DSA_G(2, true) DSA_G(3, true) }                                                \
  }
  for (int tile0 = 0; tile0 < ntile; tile0 += 8) {
    DSA_GROUP(bqA, bqB, tile0)
    DSA_GROUP(bqB, bqA, tile0 + 4)
  }
  {
    unsigned long long over = __ballot(lane < 8 && cntv > 256);
    while (over) {
      const int q = __builtin_ctzll(over); over &= over - 1;
      const int n = __builtin_amdgcn_readlane(cntv, q);
      unsigned* cb_ = cand + q * CAP;
      unsigned e[8];
#pragma unroll
      for (int i = 0; i < 8; i++) e[i] = (i * 64 + lane < n) ? cb_[i * 64 + lane] : 0u;
      unsigned T = 0u;
      const unsigned Told_ = (unsigned)__builtin_amdgcn_readlane((int)Tq, q);
      for (int bit = 31; bit >= 0; bit--) {
        const unsigned cnd = T | (1u << bit); int cc = 0;
        if (cnd <= Told_) { T = cnd; continue; }
#pragma unroll
        for (int i = 0; i < 8; i++) cc += __popcll(__ballot(e[i] >= cnd));
        if (cc >= 256) T = cnd;
      }
      int pos = 0;
#pragma unroll
      for (int i = 0; i < 8; i++) {
        const bool keep = e[i] >= T; const unsigned long long m = __ballot(keep);
        if (keep) cb_[pos + __popcll(m & ((1ull << lane) - 1ull))] = e[i];
        pos += __popcll(m);
      }
      if (lane == q) { cntv = pos; Tq = T; }
    }
  }
  }
  __builtin_amdgcn_wave_barrier();
  const int n16 = lane & 15, kq = lane >> 4;
#define DPP_ROR(v, n) __int_as_float(__builtin_amdgcn_update_dpp(0, __float_as_int(v), 0x120 + (n), 0xf, 0xf, false))
  for (int q = 0; q < 8; q++) {
    const int n = __builtin_amdgcn_readlane(cntv, q);
    const unsigned* sel = cand + q * CAP;
    const size_t tq = tokb + l0 + q;
    float ssum[2][4];
#pragma unroll
    for (int grp = 0; grp < 2; grp++) {
      bf16x8 qa0, qa1;
#pragma unroll
      for (int k = 0; k < 8; k++) { int zi_ = 0; asm volatile("" : "+v"(zi_)); qa0[k] = (short)zi_; qa1[k] = (short)zi_; }
      if (n16 < 4) {
        const bf* qp = p.P + tq * PW + C_ATQ + (grp * 4 + n16) * 64 + 8 * kq;
        qa0 = *(const bf16x8*)qp; qa1 = *(const bf16x8*)(qp + 32);
      }
      f32x4 lg[16];
#pragma unroll
      for (int t = 0; t < 16; t++) {
        const int slot = t * 16 + n16; const bool valid = slot < n;
        const int key = valid ? (16383 - (int)(sel[slot] & 0x3FFFu)) : 0;
        const bf* kp = p.KVC + (tokb + key) * 256 + grp * 64 + 8 * kq;
        bf16x8 b0 = *(const bf16x8*)kp, b1 = *(const bf16x8*)(kp + 32);
        const float zc_ = ozero(); f32x4 cc = {zc_, zc_, zc_, zc_};
        cc = mfma16(qa0, b0, cc); cc = mfma16(qa1, b1, cc);
        const bool ok = valid && (kq == 0);
#pragma unroll
        for (int r = 0; r < 4; r++) lg[t][r] = ok ? cc[r] * 0.125f : -3.0e38f;
      }
      float mx[4];
#pragma unroll
      for (int r = 0; r < 4; r++) {
        float m = lg[0][r];
#pragma unroll
        for (int t = 1; t < 16; t++) m = fmaxf(m, lg[t][r]);
        m = fmaxf(m, DPP_ROR(m, 8)); m = fmaxf(m, DPP_ROR(m, 4)); m = fmaxf(m, DPP_ROR(m, 2)); m = fmaxf(m, DPP_ROR(m, 1));
        mx[r] = __int_as_float(__builtin_amdgcn_readfirstlane(__float_as_int(m)));
      }
#pragma unroll
      for (int r = 0; r < 4; r++) {
        float s = 0.f;
#pragma unroll
        for (int t = 0; t < 16; t++) { float e = (lg[t][r] > -1.0e38f) ? __expf(lg[t][r] - mx[r]) : 0.f; lg[t][r] = e; s += e; }
        s += DPP_ROR(s, 8); s += DPP_ROR(s, 4); s += DPP_ROR(s, 2); s += DPP_ROR(s, 1);
        ssum[grp][r] = __int_as_float(__builtin_amdgcn_readfirstlane(__float_as_int(s)));
      }
      if (grp == 0) __builtin_amdgcn_wave_barrier();
      if (kq == 0) {
#pragma unroll
        for (int t = 0; t < 16; t++)
          *(uint2*)(Pb + (t * 16 + n16) * 8 + grp * 4) = make_uint2(pk2(lg[t][0], lg[t][1]), pk2(lg[t][2], lg[t][3]));
      }
    }
    __builtin_amdgcn_wave_barrier();
    float o[64];
#pragma unroll
    for (int i = 0; i < 64; i++) o[i] = ozero();
    const int ksg = lane >> 3, dc = lane & 7;
#pragma unroll 8
    for (int stp = 0; stp < 32; stp++) {
      const int slot = stp * 8 + ksg;
      const int key = (slot < n) ? (16383 - (int)(sel[slot] & 0x3FFFu)) : 0;
      uint4 pp = *(const uint4*)(Pb + slot * 8);
      const bf* vp = p.KVC + (tokb + key) * 256 + 128 + dc * 8;
      uint4 va = *(const uint4*)vp, vb = *(const uint4*)(vp + 64);
      float ph[8] = {bflo(pp.x), bfhi(pp.x), bflo(pp.y), bfhi(pp.y), bflo(pp.z), bfhi(pp.z), bflo(pp.w), bfhi(pp.w)};
      float v0[8] = {bflo(va.x), bfhi(va.x), bflo(va.y), bfhi(va.y), bflo(va.z), bfhi(va.z), bflo(va.w), bfhi(va.w)};
      float v1[8] = {bflo(vb.x), bfhi(vb.x), bflo(vb.y), bfhi(vb.y), bflo(vb.z), bfhi(vb.z), bflo(vb.w), bfhi(vb.w)};
#pragma unroll
      for (int hh = 0; hh < 4; hh++)
#pragma unroll
        for (int d = 0; d < 8; d++) { o[hh * 8 + d] += ph[hh] * v0[d]; o[(4 + hh) * 8 + d] += ph[4 + hh] * v1[d]; }
    }
    __builtin_amdgcn_wave_barrier();
    const bool b5 = (lane >> 5) & 1, b4 = (lane >> 4) & 1, b3 = (lane >> 3) & 1;
    float o32[32], o16[16], o8[8];
#pragma unroll
    for (int i = 0; i < 32; i++) { float lo = o[i], hi = o[32 + i]; float snd = b5 ? lo : hi; float kp = b5 ? hi : lo; o32[i] = kp + __shfl_xor(snd, 32); }
#pragma unroll
    for (int i = 0; i < 16; i++) { float lo = o32[i], hi = o32[16 + i]; float snd = b4 ? lo : hi; float kp = b4 ? hi : lo; o16[i] = kp + __shfl_xor(snd, 16); }
#pragma unroll
    for (int i = 0; i < 8; i++) { float lo = o16[i], hi = o16[8 + i]; float snd = b3 ? lo : hi; float kp = b3 ? hi : lo; o8[i] = kp + __shfl_xor(snd, 8); }
    const float s_g0 = b4 ? (b3 ? ssum[0][3] : ssum[0][2]) : (b3 ? ssum[0][1] : ssum[0][0]);
    const float s_g1 = b4 ? (b3 ? ssum[1][3] : ssum[1][2]) : (b3 ? ssum[1][1] : ssum[1][0]);
    const float rinv = 1.f / (b5 ? s_g1 : s_g0);
    const int hsel = (b5 ? 4 : 0) + (b4 ? 2 : 0) + (b3 ? 1 : 0);
    const int col = hsel * 64 + dc * 8;
    uint4 zz = *(const uint4*)(p.P + tq * PW + C_ATZ + col);
    uint4 ov;
    ov.x = pk2(o8[0] * rinv * siluf_(bflo(zz.x)), o8[1] * rinv * siluf_(bfhi(zz.x)));
    ov.y = pk2(o8[2] * rinv * siluf_(bflo(zz.y)), o8[3] * rinv * siluf_(bfhi(zz.y)));
    ov.z = pk2(o8[4] * rinv * siluf_(bflo(zz.z)), o8[5] * rinv * siluf_(bfhi(zz.z)));
    ov.w = pk2(o8[6] * rinv * siluf_(bflo(zz.w)), o8[7] * rinv * siluf_(bfhi(zz.w)));
    *(uint4*)(p.Y + tq * YW + Y_ATT + col) = ov;
  }
}

__device__ __forceinline__ void phaseB(const Params& p, int layer, char* sm0) {
  const int total = 512 + 2048 + 2048;
  char* sm = sm0 + HB * HALF_LDS;
  for (int t = VB; t < total; t += G2) {
    if (t < 512) ssd_pass1(p, layer, t, sm);
    else if (t < 2560) s5_pass1(p, layer, t - 512, sm);
    else mem_attn(p, layer, t - 2560);
  }
}
__device__ __forceinline__ void phaseC(const Params& p, int layer, char* sm0, bool dsa_only) {
  const int G = G2;
  const int total = dsa_only ? 1024 : 1024 + 256 + 16;
  char* sm = sm0 + HB * HALF_LDS;
  int rr = 0;
  for (int i = VB; i < total; i += G, rr++) {
    if (i < 1024) {
      int pos = i - rr * G; int idx = i;
      if ((rr & 1) && (rr * G + G <= 1024)) idx = rr * G + (G - 1 - pos);
      __syncthreads();
      dsa_wave(p, idx * 4 + (otid() >> 6), sm);
    } else if (i < 1280) ssd_statepass(p, i - 1024);
    else s5_carry(p, layer, i - 1280);
  }
}
__device__ __forceinline__ void phaseD(const Params& p, int layer, char* sm0) {
  const int total = 256 + 1024;
  char* sm = sm0 + HB * HALF_LDS;
  const int vb = VB;
  if (G2 == 512) {
    if (vb < 256) { s5_pass2(p, layer, vb, sm); ssd_pass2(p, layer, vb, sm); }
    else {
#pragma unroll 1
      for (int k = 0; k < 3; k++) ssd_pass2(p, layer, 256 + (vb - 256) * 3 + k, sm);
    }
  } else {
    for (int t = vb; t < total; t += G2) {
      if (t < 256) s5_pass2(p, layer, t, sm);
      else ssd_pass2(p, layer, t - 256, sm);
    }
  }
}

__device__ __forceinline__ void phaseE(const Params& p, int layer) {
  const int tidf = otid_full();
  const int wid = __builtin_amdgcn_readfirstlane(tidf >> 6), lane = tidf & 63, wr = wid >> 2, wc = wid & 3, fr = lane & 15, fq = lane >> 4;
  const bf* Wl = p.WinT + (size_t)layer * INW * 2048;
  const bf* Wb = p.WbrT + (size_t)layer * 2048 * YW;
  bf* merged = p.P;
  char* gsb = (char*)p.GS + (size_t)blockIdx.x * 131072;
  const unsigned gs_lane0 = (unsigned)tidf * 16u, lane_c40 = (unsigned)fq * 16u, lane_m0 = (unsigned)(fr * 2048 + fq * 4) * 2u;
  for (int L = blockIdx.x; L < 1024; L += gridDim.x) {
    int pm, pn; tile_order(L, 128, 8, pm, pn);
    const int brow = pm * 256, bcol = pn * 256;
#pragma unroll 1
    for (int s = 0; s < 8; s++) {
      const int br = s >> 1; const bool isBr = (s & 1) != 0;
      const int koff = br == 0 ? 0 : (br == 1 ? 512 : (br == 2 ? 1024 : 2048));
      const int kb = br == 2 ? 1024 : (br == 3 ? 256 : 512);
      const bf* A_ = isBr ? p.Y + koff : p.xb; const int lda_ = isBr ? YW : 2048;
      const bf* B_ = isBr ? Wb + koff : Wl + (size_t)(5716 + br * 2048) * 2048; const int ldb_ = isBr ? YW : 2048;
      const int K_ = isBr ? kb : 2048;
      f32x4 acc[2][2][4][2]; ZERO_ACC8(acc);
      gemm256(A_, lda_, B_, ldb_, K_, brow, bcol, acc);
      unsigned gs_lane = gs_lane0, lane_c4 = lane_c40, lane_m = lane_m0;
      asm volatile("" : "+v"(gs_lane), "+v"(lane_c4), "+v"(lane_m));
      if (!isBr) {
        const char* bgb = (const char*)(p.b_gate + (size_t)layer * 8192 + br * 2048 + bcol + wc * 32);
#pragma unroll
        for (int ai = 0; ai < 2; ai++)
#pragma unroll
          for (int bj = 0; bj < 2; bj++)
#pragma unroll
            for (int m = 0; m < 4; m++) {
              unsigned q[4];
#pragma unroll
              for (int n = 0; n < 2; n++) {
                float4 bg = *(const float4*)(bgb + (bj * 128 + n * 16) * 4 + lane_c4);
                f32x4 v = acc[ai][bj][m][n];
                q[2 * n] = pk2(sigmoidf_(v[0] + bg.x), sigmoidf_(v[1] + bg.y));
                q[2 * n + 1] = pk2(sigmoidf_(v[2] + bg.z), sigmoidf_(v[3] + bg.w));
              }
              *(uint4*)(gsb + ((ai * 2 + bj) * 4 + m) * 8192 + gs_lane) = make_uint4(q[0], q[1], q[2], q[3]);
              __builtin_amdgcn_sched_barrier(0);
            }
      } else {
        char* mb = (char*)merged + ((size_t)(brow + wr * 64) * 2048 + bcol + wc * 32) * 2;
#pragma unroll
        for (int ai = 0; ai < 2; ai++)
#pragma unroll
          for (int bj = 0; bj < 2; bj++) {
#pragma unroll
            for (int mh = 0; mh < 2; mh++) {
              uint4 g4[2]; uint2 old[2][2];
#pragma unroll
              for (int mm = 0; mm < 2; mm++) {
                const int m = mh * 2 + mm;
                g4[mm] = *(const uint4*)(gsb + ((ai * 2 + bj) * 4 + m) * 8192 + gs_lane);
                if (br) {
#pragma unroll
                  for (int n = 0; n < 2; n++)
                    old[mm][n] = *(const uint2*)(mb + ((size_t)(ai * 128 + m * 16) * 2048 + bj * 128 + n * 16) * 2 + lane_m);
                }
              }
#pragma unroll
              for (int mm = 0; mm < 2; mm++) {
                const int m = mh * 2 + mm;
                const unsigned gq[4] = {g4[mm].x, g4[mm].y, g4[mm].z, g4[mm].w};
#pragma unroll
                for (int n = 0; n < 2; n++) {
                  f32x4 v = acc[ai][bj][m][n];
                  float o0 = bflo(gq[2 * n]) * v[0], o1 = bfhi(gq[2 * n]) * v[1], o2 = bflo(gq[2 * n + 1]) * v[2], o3 = bfhi(gq[2 * n + 1]) * v[3];
                  char* mp = mb + ((size_t)(ai * 128 + m * 16) * 2048 + bj * 128 + n * 16) * 2 + lane_m;
                  if (br) { o0 += bflo(old[mm][n].x); o1 += bfhi(old[mm][n].x); o2 += bflo(old[mm][n].y); o3 += bfhi(old[mm][n].y); }
                  *(uint2*)mp = make_uint2(pk2(o0, o1), pk2(o2, o3));
                }
              }
              __builtin_amdgcn_sched_barrier(0);
            }
          }
      }
    }
  }
}

__device__ __forceinline__ void phaseF(const Params& p, int layer) {
  const int tidf = otid_full();
  const int wid = __builtin_amdgcn_readfirstlane(tidf >> 6), lane = tidf & 63, wr = wid >> 2, wc = wid & 3, fr = lane & 15, fq = lane >> 4;
  const bf* merged = p.P;
  const float* xres = layer == 0 ? p.x : p.out;
  for (int L = blockIdx.x; L < 1024; L += gridDim.x) {
    int pm, pn; tile_order(L, 128, 8, pm, pn);
    const int brow = pm * 256, bcol = pn * 256;
    f32x4 acc[2][2][4][2]; ZERO_ACC8(acc);
    gemm256(merged, 2048, p.WoutT + (size_t)layer * 2048 * 2048, 2048, 2048, brow, bcol, acc);
#pragma unroll
    for (int ai = 0; ai < 2; ai++)
#pragma unroll
      for (int m = 0; m < 4; m++) {
        const size_t tok = brow + ai * 128 + wr * 64 + m * 16 + fr;
#pragma unroll
        for (int bj = 0; bj < 2; bj++)
#pragma unroll
          for (int n = 0; n < 2; n++) {
            const int col = bcol + bj * 128 + wc * 32 + n * 16 + fq * 4;
            float4 xr = *(const float4*)(xres + tok * 2048 + col);
            f32x4 v = acc[ai][bj][m][n];
            float4 o;
            o.x = 1.41421356237f * xr.x + v[0]; o.y = 1.41421356237f * xr.y + v[1];
            o.z = 1.41421356237f * xr.z + v[2]; o.w = 1.41421356237f * xr.w + v[3];
            *(float4*)(p.out + tok * 2048 + col) = o;
          }
      }
  }
}

__device__ __forceinline__ void phaseG(const Params& p, int layer) {
  const int lane = otid() & 63, w = otid() >> 6;
  const float* g = p.ln_g + layer * 2048; const float* bb = p.ln_b + layer * 2048;
  for (int t = VB; t < TT / 4; t += G2) {
    const size_t row = (size_t)t * 4 + w;
    float* xp = p.out + row * 2048;
    float4 v[8]; float s = 0.f;
#pragma unroll
    for (int i = 0; i < 8; i++) { v[i] = *(const float4*)(xp + (i * 64 + lane) * 4); s += v[i].x + v[i].y + v[i].z + v[i].w; }
#pragma unroll
    for (int off = 1; off < 64; off <<= 1) s += __shfl_xor(s, off);
    const float mu = s * (1.f / 2048.f);
    float q = 0.f;
#pragma unroll
    for (int i = 0; i < 8; i++) {
      float a = v[i].x - mu, b = v[i].y - mu, c = v[i].z - mu, d = v[i].w - mu; q += a * a + b * b + c * c + d * d;
    }
#pragma unroll
    for (int off = 1; off < 64; off <<= 1) q += __shfl_xor(q, off);
    const float rs = rsqrtf(q * (1.f / 2048.f) + 1e-5f);
#pragma unroll
    for (int i = 0; i < 8; i++) {
      const int col = (i * 64 + lane) * 4;
      float4 gg = *(const float4*)(g + col), bv = *(const float4*)(bb + col);
      float4 o;
      o.x = (v[i].x - mu) * rs * gg.x + bv.x; o.y = (v[i].y - mu) * rs * gg.y + bv.y;
      o.z = (v[i].z - mu) * rs * gg.z + bv.z; o.w = (v[i].w - mu) * rs * gg.w + bv.w;
      *(float4*)(xp + col) = o;
      if (layer == 0) *(uint2*)(p.xb + row * 2048 + col) = make_uint2(pk2(o.x, o.y), pk2(o.z, o.w));
    }
  }
}

__global__ void __launch_bounds__(512, 2) mega_kernel(Params p) {
  char* sm = dynsm;
  cg::grid_group grid = cg::this_grid();
  phase0(p, sm); grid.sync();
#pragma unroll 1
  for (int layer = 0; layer < 2; layer++) {
    int nA = (PROBE_MASK & 1) ? 2 : 1, nB = (PROBE_MASK & 2) ? 2 : 1, nC = (PROBE_MASK & 4) ? 2 : 1, nD = (PROBE_MASK & 8) ? 2 : 1, nE = (PROBE_MASK & 16) ? 2 : 1;
    asm volatile("" : "+s"(nA), "+s"(nB), "+s"(nC), "+s"(nD), "+s"(nE));
#pragma unroll 1
    for (int r = 0; r < nA; r++) phaseA(p, layer);
    grid.sync();
#pragma unroll 1
    for (int r = 0; r < nB; r++) phaseB(p, layer, sm);
    grid.sync();
#pragma unroll 1
    for (int r = 0; r < nC; r++) phaseC(p, layer, sm, r + 1 < nC);
    grid.sync();
#pragma unroll 1
    for (int r = 0; r < nD; r++) phaseD(p, layer, sm);
    grid.sync();
#pragma unroll 1
    for (int r = 0; r < nE; r++) phaseE(p, layer);
    grid.sync();
    phaseF(p, layer); grid.sync();
    phaseG(p, layer);
    if (layer == 0) grid.sync();
  }
}

extern "C" void kernel_launch(void* const* d_in, const int* in_sizes, int n_in, void* d_out, int out_size, void* d_ws,
                              size_t ws_size, hipStream_t stream) {
  Params p{};
  p.x = (const float*)d_in[0]; p.mem = (const float*)d_in[1]; p.pos = (const int*)d_in[2];
  p.w_in = (const float*)d_in[3]; p.b_gate = (const float*)d_in[4]; p.lam_re = (const float*)d_in[5];
  p.lam_im = (const float*)d_in[6]; p.log_dt = (const float*)d_in[7]; p.b_re = (const float*)d_in[8];
  p.b_im = (const float*)d_in[9]; p.c_re = (const float*)d_in[10]; p.c_im = (const float*)d_in[11];
  p.s5_d = (const float*)d_in[12]; p.w_glu = (const float*)d_in[13]; p.b_glu = (const float*)d_in[14];
  p.conv_w = (const float*)d_in[15]; p.conv_b = (const float*)d_in[16]; p.dt_bias = (const float*)d_in[17];
  p.a_log = (const float*)d_in[18]; p.ssd_d = (const float*)d_in[19]; p.norm_g = (const float*)d_in[20];
  p.mem_w_kv = (const float*)d_in[21]; p.w_br_s5 = (const float*)d_in[22]; p.w_br_attn = (const float*)d_in[23];
  p.w_br_ssd = (const float*)d_in[24]; p.w_br_mem = (const float*)d_in[25]; p.w_out = (const float*)d_in[26];
  p.ln_g = (const float*)d_in[27]; p.ln_b = (const float*)d_in[28];
  p.out = (float*)d_out;
  char* ws = (char*)d_ws; size_t off = 0;
  auto carve = [&](size_t bytes) { char* r = ws + off; off += (bytes + 255) & ~(size_t)255; return r; };
  p.WinT = (bf*)carve((size_t)2 * INW * 2048 * 2);
  p.WbrT = (bf*)carve((size_t)2 * 2048 * YW * 2);
  p.WoutT = (bf*)carve((size_t)2 * 2048 * 2048 * 2);
  p.WgluT = (bf*)carve((size_t)2 * 512 * 512 * 2);
  p.WmemT = (bf*)carve((size_t)2 * 512 * 2048 * 2);
  p.memb = (bf*)carve((size_t)512 * 2048 * 2);
  p.xb = (bf*)carve((size_t)TT * 2048 * 2);
  p.P = (bf*)carve((size_t)TT * PW * 2);
  p.Y = (bf*)carve((size_t)TT * YW * 2);
  p.YG = (bf*)carve((size_t)TT * 512 * 2);
  p.KIF = (bf*)carve((size_t)TT * 64 * 2);
  p.MK = (bf*)carve((size_t)2 * 2 * 4 * 256 * 64 * 2);
  p.MVT = (bf*)carve((size_t)2 * 2 * 4 * 256 * 64 * 2);
  p.CM = (bf*)carve((size_t)2 * 32 * 16 * 128 * 2);
  p.ST = (float*)carve((size_t)2 * 128 * 131072 * 4);
  p.CS = (float*)carve((size_t)TT * 16 * 4);
  p.END = (float*)carve((size_t)2 * 128 * 32 * 64 * 2 * 4);
  p.CD = (float*)carve((size_t)2 * 128 * 16 * 4);
  p.SB = (float*)carve((size_t)2 * 32 * 64 * 32 * 4);
  p.SA = (float*)carve((size_t)2 * 32 * 64 * 4 * 4);
  p.KVC = (bf*)carve((size_t)TT * 256 * 2);
  p.GS = (bf*)carve((size_t)256 * 16 * 512 * 16);
  if (off > ws_size) { fprintf(stderr, "workspace too small: need %zu have %zu\n", off, ws_size); return; }
  for (int j = 0; j < 8; j++) p.inv[j] = (float)pow(500000.0, -(double)j / 8.0);
  const size_t kDynLds = 2 * HALF_LDS;
  static int grid_blocks = 0;
  if (!grid_blocks) {
    int dev = 0, cus = 0, per_cu = 0;
    (void)hipGetDevice(&dev);
    (void)hipDeviceGetAttribute(&cus, hipDeviceAttributeMultiprocessorCount, dev);
    (void)hipFuncSetAttribute((const void*)mega_kernel, hipFuncAttributeMaxDynamicSharedMemorySize, (int)kDynLds);
    (void)hipOccupancyMaxActiveBlocksPerMultiprocessor(&per_cu, mega_kernel, 512, kDynLds);
    if (per_cu > 1) per_cu = 1;
    grid_blocks = cus * per_cu;
    if (grid_blocks > 256) grid_blocks = 256;
    grid_blocks -= grid_blocks % 8;
  }
  void* args[] = {&p};
  hipError_t e = hipLaunchCooperativeKernel((void*)mega_kernel, dim3(grid_blocks), dim3(512), args, kDynLds, stream);
  if (e != hipSuccess) fprintf(stderr, "cooperative launch failed: %s (grid %d)\n", hipGetErrorString(e), grid_blocks);
}
```

```cpp
#include <hip/hip_runtime.h>
#include <hip/hip_cooperative_groups.h>
#include <cstdio>
#include <cmath>
namespace cg = cooperative_groups;

#ifndef MK_COOP
#define MK_COOP 1
#endif
#ifndef PROBE_MASK
#define PROBE_MASK 0
#endif

typedef unsigned short bf;
typedef short bf16x8 __attribute__((ext_vector_type(8)));
typedef float f32x16 __attribute__((ext_vector_type(16)));
typedef float f32x4 __attribute__((ext_vector_type(4)));

#define TT 32768
#define LSEQ 16384
#define DM 2048
#define INW 13908
#define PW 5760
#define C_S5U 0
#define C_S5Z 512
#define C_ATQ 1024
#define C_ATK 1536
#define C_ATV 1664
#define C_ATZ 1792
#define C_IDQ 2304
#define C_IDK 2560
#define C_IDW 2624
#define C_SSZ 2640
#define C_XBC 3664
#define C_SDT 5200
#define C_MEQ 5216
#define C_MEZ 5472
#define YW 2304
#define Y_S5 0
#define Y_ATT 512
#define Y_SSD 1024
#define Y_MEM 2048
#define CAP 480
#define HALF_LDS 77824

struct Params {
  const float *x, *mem; const int* pos;
  const float *w_in, *b_gate, *lam_re, *lam_im, *log_dt, *b_re, *b_im, *c_re, *c_im, *s5_d, *w_glu, *b_glu,
      *conv_w, *conv_b, *dt_bias, *a_log, *ssd_d, *norm_g, *mem_w_kv, *w_br_s5, *w_br_attn, *w_br_ssd, *w_br_mem,
      *w_out, *ln_g, *ln_b;
  float* out;
  bf *WinT, *WbrT, *WoutT, *WgluT, *WmemT, *memb, *xb, *P, *Y, *YG, *KIF, *MK, *MVT, *CM, *KVC, *GS;
  float *ST, *CS, *END, *CD, *SB, *SA;
  float inv[8];
};

__device__ __forceinline__ float ozero() { float z = 0.f; asm volatile("" : "+v"(z)); return z; }
__device__ __forceinline__ int otid_full() { int t = threadIdx.x; asm volatile("" : "+v"(t)); return t; }
__device__ __forceinline__ int otid() { return otid_full() & 255; }
#define HB (__builtin_amdgcn_readfirstlane(otid_full() >> 8))
#define VB ((int)blockIdx.x * 2 + HB)
#define G2 ((int)gridDim.x * 2)
__device__ __forceinline__ float bf2f(bf v) { return __uint_as_float(((unsigned)v) << 16); }
__device__ __forceinline__ float bflo(unsigned u) { return __uint_as_float(u << 16); }
__device__ __forceinline__ float bfhi(unsigned u) { return __uint_as_float(u & 0xFFFF0000u); }
typedef float f32x2p_t __attribute__((ext_vector_type(2)));
typedef __bf16 bf16x2p_t __attribute__((ext_vector_type(2)));
__device__ __forceinline__ unsigned pk2(float lo, float hi) {
  f32x2p_t v = {lo, hi};
  return __builtin_bit_cast(unsigned, __builtin_convertvector(v, bf16x2p_t));
}
__device__ __forceinline__ bf f2bf(float f) { return (bf)(pk2(f, 0.f) & 0xFFFFu); }
__device__ __forceinline__ float sigmoidf_(float x) { return __builtin_amdgcn_rcpf(1.f + __expf(-x)); }
__device__ __forceinline__ float siluf_(float x) { return x * __builtin_amdgcn_rcpf(1.f + __expf(-x)); }
__device__ __forceinline__ float geluf_(float x) {
  float u = 0.7978845608028654f * (x + 0.044715f * x * x * x);
  float t = 1.f - 2.f * __builtin_amdgcn_rcpf(1.f + __expf(2.f * u));
  return 0.5f * x * (1.f + t);
}
__device__ __forceinline__ f32x16 mfma32(bf16x8 a, bf16x8 b, f32x16 c) { return __builtin_amdgcn_mfma_f32_32x32x16_bf16(a, b, c, 0, 0, 0); }
__device__ __forceinline__ f32x4 mfma16(bf16x8 a, bf16x8 b, f32x4 c) { return __builtin_amdgcn_mfma_f32_16x16x32_bf16(a, b, c, 0, 0, 0); }

__device__ __forceinline__ bool tile_map(int L, int nMt, int nNt, int SM, int SN, int& tm, int& tn) {
  int per = SM * SN; int x = L & 7; int jj = L >> 3; int sl = jj / per; int j = jj - sl * per; int S = sl * 8 + x;
  int nSn = nNt / SN; int NS = (nMt / SM) * nSn;
  if (S >= NS) return false;
  int mg = S / nSn, ng = S - mg * nSn;
  tm = mg * SM + j / SN; tn = ng * SN + j % SN; return true;
}

typedef unsigned u32x4 __attribute__((ext_vector_type(4)));
struct GStage { u32x4 a0, a1, b0, b1; };
#define G_LOAD(S, ko) { S.a0 = *(const u32x4*)(ga + (ko)); S.a1 = *(const u32x4*)(ga + a64 + (ko)); S.b0 = *(const u32x4*)(gb + (ko)); S.b1 = *(const u32x4*)(gb + b64 + (ko)); }
#define G_WRITE(S, base) { *(u32x4*)(sA + (base) + woff) = S.a0; *(u32x4*)(sA + (base) + woff + 5120) = S.a1; *(u32x4*)(sB + (base) + woff) = S.b0; *(u32x4*)(sB + (base) + woff + 5120) = S.b1; }
#define G_ITER(kt, cur, S)                                                          \
  {                                                                                 \
    _Pragma("unroll") for (int ks = 0; ks < 2; ks++) {                              \
      bf16x8 a0 = *(const bf16x8*)(sA + (cur) + aoff + ks * 32);                    \
      bf16x8 a1 = *(const bf16x8*)(sA + (cur) + aoff + 2560 + ks * 32);             \
      bf16x8 b0 = *(const bf16x8*)(sB + (cur) + boff + ks * 32);                    \
      bf16x8 b1 = *(const bf16x8*)(sB + (cur) + boff + 2560 + ks * 32);             \
      acc[0][0] = mfma32(b0, a0, acc[0][0]);                                        \
      acc[0][1] = mfma32(b1, a0, acc[0][1]);                                        \
      acc[1][0] = mfma32(b0, a1, acc[1][0]);                                        \
      acc[1][1] = mfma32(b1, a1, acc[1][1]);                                        \
    }                                                                               \
    if ((kt) + 1 < nk) {                                                            \
      G_WRITE(S, 10240 - (cur))                                                     \
      if ((kt) + 1 + D < nk) G_LOAD(S, ((kt) + 1 + D) * 32)                         \
    }                                                                               \
    __syncthreads();                                                                \
  }
template <int D>
__device__ __forceinline__ void gemm_acc(const bf* __restrict__ A, int lda, const bf* __restrict__ Bt, int ldb, int K,
                                         f32x16 (&acc)[2][2], char* sm) {
  const int tid = otid(), lane = tid & 63, w = tid >> 6, wr = w >> 1, wc = w & 1, r32 = lane & 31, h5 = lane >> 5;
  const int lrow = tid >> 2, lch = tid & 3;
  const bf* ga = A + (size_t)lrow * lda + lch * 8;
  const bf* gb = Bt + (size_t)lrow * ldb + lch * 8;
  const size_t a64 = (size_t)64 * lda, b64 = (size_t)64 * ldb;
  const int nk = K >> 5;
  char* sA = sm; char* sB = sm + 20480;
  const int woff = lrow * 80 + lch * 16;
  const int aoff = (wr * 64 + r32) * 80 + h5 * 16, boff = (wc * 64 + r32) * 80 + h5 * 16;
  GStage S0, S1, S2, S3;
  G_LOAD(S0, 0) G_LOAD(S1, 32)
  if (D == 4) { G_LOAD(S2, 64) G_LOAD(S3, 96) }
  G_WRITE(S0, 0)
  if (D < nk) G_LOAD(S0, D * 32)
  __syncthreads();
  for (int kt0 = 0; kt0 < nk; kt0 += D) {
    if (D == 4) {
      G_ITER(kt0, 0, S1) G_ITER(kt0 + 1, 10240, S2) G_ITER(kt0 + 2, 0, S3) G_ITER(kt0 + 3, 10240, S0)
    } else {
      G_ITER(kt0, 0, S1) G_ITER(kt0 + 1, 10240, S0)
    }
  }
}
#define ZERO_ACC(a) { const float z_ = ozero(); for (int i_ = 0; i_ < 2; i_++) for (int j_ = 0; j_ < 2; j_++) for (int r_ = 0; r_ < 16; r_++) a[i_][j_][r_] = z_; }


extern __shared__ __attribute__((aligned(16))) char dynsm[];
#define G8_HT (128 * 64)
#define G8_SA(b, h) ((bf*)dynsm + ((b) * 2 + (h)) * G8_HT)
#define G8_SB(b, h) ((bf*)dynsm + (4 + (b) * 2 + (h)) * G8_HT)
__device__ __forceinline__ int g8_lds_byte(int r, int c) {
  int st = (r >> 4) * 2 + (c >> 5), rr = r & 15, cc = c & 31, ob = rr * 64 + cc * 2;
  return st * 1024 + (ob ^ (((ob >> 9) & 1) << 5));
}
__device__ __forceinline__ void g8_stage_rc(int b, int& R, int& C) {
  int st = b / 1024, sb = b % 1024, swz = sb ^ (((sb >> 9) & 1) << 5);
  R = (st >> 1) * 16 + swz / 64; C = (st & 1) * 32 + (swz % 64) / 2;
}
#define G8_LAS __attribute__((address_space(3)))
#define G8_HTB (128 * 64 * 2)
#define G8_OSA(b, h) (((b) * 2 + (h)) * G8_HTB)
#define G8_OSB(b, h) ((4 + (b) * 2 + (h)) * G8_HTB)
#define G8_STAGE(bufoff, gbase, voff) do { _Pragma("unroll") for (int _i = 0; _i < 2; ++_i) \
    __builtin_amdgcn_global_load_lds((const unsigned*)((const char*)(gbase) + (voff)[_i]), (G8_LAS unsigned*)(lds + (bufoff) + ldsw + _i * 8192), 16, 0, 0); } while (0)
#define G8_LDA(dst, b, h) do { _Pragma("unroll") for (int m = 0; m < 4; ++m) _Pragma("unroll") for (int k = 0; k < 2; ++k) dst[m][k] = *(const G8_LAS bf16x8*)(lds + G8_OSA(b, h) + aoff + m * 2048 + k * 1024); } while (0)
#define G8_LDB(dst, b, h) do { _Pragma("unroll") for (int n = 0; n < 2; ++n) _Pragma("unroll") for (int k = 0; k < 2; ++k) dst[n][k] = *(const G8_LAS bf16x8*)(lds + G8_OSB(b, h) + boff + n * 2048 + k * 1024); } while (0)
#define G8_MMA(ai, bj, At_, Bt_) do { __builtin_amdgcn_s_setprio(1);                                                 \
    _Pragma("unroll") for (int m = 0; m < 4; ++m) _Pragma("unroll") for (int n = 0; n < 2; ++n) _Pragma("unroll") for (int k = 0; k < 2; ++k) \
      acc[ai][bj][m][n] = __builtin_amdgcn_mfma_f32_16x16x32_bf16(Bt_[n][k], At_[m][k], acc[ai][bj][m][n], 0, 0, 0); \
    __builtin_amdgcn_s_setprio(0); } while (0)
#define G8_WAIT_V(n) asm volatile("s_waitcnt vmcnt(" #n ")" ::: "memory")
#define G8_WAIT_L(n) asm volatile("s_waitcnt lgkmcnt(" #n ")" ::: "memory")
#define G8_BAR __builtin_amdgcn_s_barrier()
#define G8_SCHED __builtin_amdgcn_sched_barrier(0)

__device__ __forceinline__ void gemm256(const bf* __restrict__ A, int lda, const bf* __restrict__ Bt, int ldb, int K,
                                        int brow, int bcol, f32x4 (&acc)[2][2][4][2]) {
  G8_LAS unsigned char* lds = (G8_LAS unsigned char*)dynsm;
  const int tid = otid_full(), wid = __builtin_amdgcn_readfirstlane(tid >> 6), lane = tid & 63, wr = wid >> 2, wc = wid & 3, fr = lane & 15, fq = lane >> 4;
  unsigned voffA[2], voffB[2];
#pragma unroll
  for (int i = 0; i < 2; ++i) { int R, C; g8_stage_rc(tid * 16 + i * 8192, R, C); voffA[i] = (unsigned)(R * lda + C) * 2u; voffB[i] = (unsigned)(R * ldb + C) * 2u; }
  const size_t kstep = 128;
  const size_t hstepA = (size_t)128 * lda * 2, hstepB = (size_t)128 * ldb * 2;
  const unsigned ldsw = (unsigned)wid * 1024u;
  const int aoff = g8_lds_byte(wr * 64 + fr, fq * 8), boff = g8_lds_byte(wc * 32 + fr, fq * 8);
  const char* cA = (const char*)A + (size_t)brow * lda * 2; const char* cB = (const char*)Bt + (size_t)bcol * ldb * 2;
  bf16x8 At[4][2], B0[2][2], B1[2][2];
  const int nt = K / 64;
  __syncthreads();
  G8_STAGE(G8_OSB(0, 0), cB, voffB); G8_STAGE(G8_OSA(0, 0), cA, voffA); G8_STAGE(G8_OSB(0, 1), cB + hstepB, voffB); G8_STAGE(G8_OSA(0, 1), cA + hstepA, voffA);
  if (wr == 1) G8_BAR;
  G8_WAIT_V(4); G8_BAR;
  G8_STAGE(G8_OSB(1, 0), cB + kstep, voffB); G8_STAGE(G8_OSA(1, 0), cA + kstep, voffA); G8_STAGE(G8_OSB(1, 1), cB + hstepB + kstep, voffB);
  G8_WAIT_V(6); G8_BAR;
  for (int t = 0; t < nt - 2; t += 2) {
    const char* a1 = cA + (size_t)(t + 1) * kstep;
    const char* a2 = cA + (size_t)(t + 2) * kstep; const char* b2 = cB + (size_t)(t + 2) * kstep;
    const char* a3 = a2 + kstep; const char* b3 = b2 + kstep;
    G8_LDB(B0, 0, 0); G8_SCHED; G8_LDA(At, 0, 0); G8_STAGE(G8_OSA(1, 1), a1 + hstepA, voffA);
    G8_WAIT_L(8); G8_BAR; G8_WAIT_L(0); G8_MMA(0, 0, At, B0); G8_BAR; G8_SCHED;
    G8_LDB(B1, 0, 1); G8_STAGE(G8_OSB(0, 0), b2, voffB);
    G8_BAR; G8_WAIT_L(0); G8_MMA(0, 1, At, B1); G8_BAR;
    G8_LDA(At, 0, 1); G8_STAGE(G8_OSA(0, 0), a2, voffA);
    G8_BAR; G8_WAIT_L(0); G8_MMA(1, 0, At, B0); G8_BAR; G8_SCHED;
    G8_STAGE(G8_OSB(0, 1), b2 + hstepB, voffB);
    G8_WAIT_V(6); G8_BAR; G8_MMA(1, 1, At, B1); G8_BAR;
    G8_LDB(B0, 1, 0); G8_SCHED; G8_LDA(At, 1, 0); G8_STAGE(G8_OSA(0, 1), a2 + hstepA, voffA);
    G8_WAIT_L(8); G8_BAR; G8_WAIT_L(0); G8_MMA(0, 0, At, B0); G8_BAR; G8_SCHED;
    G8_LDB(B1, 1, 1); G8_STAGE(G8_OSB(1, 0), b3, voffB);
    G8_BAR; G8_WAIT_L(0); G8_MMA(0, 1, At, B1); G8_BAR;
    G8_LDA(At, 1, 1); G8_STAGE(G8_OSA(1, 0), a3, voffA);
    G8_BAR; G8_WAIT_L(0); G8_MMA(1, 0, At, B0); G8_BAR; G8_SCHED;
    G8_STAGE(G8_OSB(1, 1), b3 + hstepB, voffB);
    G8_WAIT_V(6); G8_BAR; G8_MMA(1, 1, At, B1); G8_BAR;
  }
  { const char* a1 = cA + (size_t)(nt - 1) * kstep;
    G8_LDB(B0, 0, 0); G8_LDA(At, 0, 0); G8_STAGE(G8_OSA(1, 1), a1 + hstepA, voffA);
    G8_BAR; G8_WAIT_L(0); G8_MMA(0, 0, At, B0); G8_BAR;
    G8_LDB(B1, 0, 1); G8_BAR; G8_WAIT_L(0); G8_MMA(0, 1, At, B1); G8_BAR;
    G8_LDA(At, 0, 1); G8_WAIT_V(4); G8_BAR; G8_WAIT_L(0); G8_MMA(1, 0, At, B0); G8_MMA(1, 1, At, B1); G8_BAR; }
  { G8_LDB(B0, 1, 0); G8_LDA(At, 1, 0); G8_WAIT_V(2); G8_BAR; G8_WAIT_L(0); G8_MMA(0, 0, At, B0); G8_BAR;
    G8_LDB(B1, 1, 1); G8_WAIT_V(0); G8_BAR; G8_WAIT_L(0); G8_MMA(0, 1, At, B1); G8_BAR;
    G8_LDA(At, 1, 1); G8_BAR; G8_WAIT_L(0); G8_MMA(1, 0, At, B0); G8_MMA(1, 1, At, B1); G8_BAR; }
  if (wr == 0) G8_BAR;
}
#define ZERO_ACC8(a) { float z_ = 0.f; asm volatile("" : "+v"(z_)); _Pragma("unroll") for (int i_ = 0; i_ < 2; i_++) _Pragma("unroll") for (int j_ = 0; j_ < 2; j_++) _Pragma("unroll") for (int m_ = 0; m_ < 4; m_++) _Pragma("unroll") for (int n_ = 0; n_ < 2; n_++) a[i_][j_][m_][n_] = (f32x4){z_, z_, z_, z_}; }
__device__ __forceinline__ bool tile_order(int L, int nM, int nN, int& pm, int& pn) {
  const int nwg = nM * nN; if (L >= nwg) return false;
  int wgid = L; { const int q = nwg / 8, r = nwg % 8, xcd = wgid % 8, off = wgid / 8; wgid = (xcd < r ? xcd * (q + 1) : r * (q + 1) + (xcd - r) * q) + off; }
  const int nig = 8 * nN, gid = wgid / nig, fm = gid * 8, gsz = (nM - fm) < 8 ? (nM - fm) : 8;
  pm = fm + ((wgid % nig) % gsz); pn = (wgid % nig) / gsz; return true;
}

__device__ __forceinline__ void transpose_tile(const float* __restrict__ src, int R, int C, bf* __restrict__ dst, int ldd, int off, int tile, bf* sm) {
  const int tilesC = (C + 63) >> 6;
  const int tr = tile / tilesC, tc = tile - tr * tilesC;
  const int r0 = tr * 64, c0 = tc * 64;
  const int tid = otid();
#pragma unroll
  for (int i = 0; i < 4; i++) {
    int r = (tid >> 4) + 16 * i; int c = (tid & 15) * 4;
    const float zt_ = ozero(); float4 v = make_float4(zt_, zt_, zt_, zt_);
    if (c0 + c < C) v = *(const float4*)(src + (size_t)(r0 + r) * C + c0 + c);
    sm[(c + 0) * 66 + r] = f2bf(v.x); sm[(c + 1) * 66 + r] = f2bf(v.y);
    sm[(c + 2) * 66 + r] = f2bf(v.z); sm[(c + 3) * 66 + r] = f2bf(v.w);
  }
  __syncthreads();
  {
    int c = tid >> 2, ch = (tid & 3) * 16;
    if (c0 + c < C) {
      unsigned wv[8];
#pragma unroll
      for (int k = 0; k < 8; k++) wv[k] = *(const unsigned*)(sm + c * 66 + ch + 2 * k);
      bf* d = dst + (size_t)(c0 + c) * ldd + off + r0 + ch;
      *(uint4*)d = make_uint4(wv[0], wv[1], wv[2], wv[3]);
      *(uint4*)(d + 8) = make_uint4(wv[4], wv[5], wv[6], wv[7]);
    }
  }
  __syncthreads();
}

__device__ __forceinline__ bool try_tr(int& t, const float* src, int R, int C, bf* dst, int ldd, int off, bf* sm) {
  int nt = (R >> 6) * ((C + 63) >> 6);
  if (t < nt) { transpose_tile(src, R, C, dst, ldd, off, t, sm); return true; }
  t -= nt; return false;
}

__device__ __forceinline__ void phase0(const Params& p, char* smc) {
  bf* sm = (bf*)(smc + HB * HALF_LDS);
  const int perLayer = 32 * 218 + 256 + 256 + 512 + 128 + 1024 + 64 + 256;
  for (int task = VB; task < 2 * perLayer; task += G2) {
    int layer = task / perLayer; int t = task - layer * perLayer;
    bf* WbrL = p.WbrT + (size_t)layer * 2048 * YW;
    if (try_tr(t, p.w_in + (size_t)layer * DM * INW, 2048, INW, p.WinT + (size_t)layer * INW * 2048, 2048, 0, sm)) continue;
    if (try_tr(t, p.w_br_s5 + (size_t)layer * 512 * 2048, 512, 2048, WbrL, YW, 0, sm)) continue;
    if (try_tr(t, p.w_br_attn + (size_t)layer * 512 * 2048, 512, 2048, WbrL, YW, 512, sm)) continue;
    if (try_tr(t, p.w_br_ssd + (size_t)layer * 1024 * 2048, 1024, 2048, WbrL, YW, 1024, sm)) continue;
    if (try_tr(t, p.w_br_mem + (size_t)layer * 256 * 2048, 256, 2048, WbrL, YW, 2048, sm)) continue;
    if (try_tr(t, p.w_out + (size_t)layer * 2048 * 2048, 2048, 2048, p.WoutT + (size_t)layer * 2048 * 2048, 2048, 0, sm)) continue;
    if (try_tr(t, p.w_glu + (size_t)layer * 512 * 512, 512, 512, p.WgluT + (size_t)layer * 512 * 512, 512, 0, sm)) continue;
    if (try_tr(t, p.mem_w_kv + (size_t)layer * 2048 * 512, 2048, 512, p.WmemT + (size_t)layer * 512 * 2048, 2048, 0, sm)) continue;
  }
  const size_t gtid = (size_t)blockIdx.x * 512 + otid_full(), gstr = (size_t)gridDim.x * 512;
  for (size_t i0 = gtid; i0 < (size_t)TT * DM / 8; i0 += 4 * gstr) {
    float4 a[4], b[4];
#pragma unroll
    for (int k = 0; k < 4; k++) {
      const size_t i = i0 + k * gstr;
      if (i < (size_t)TT * DM / 8) { a[k] = *(const float4*)(p.x + i * 8); b[k] = *(const float4*)(p.x + i * 8 + 4); }
    }
#pragma unroll
    for (int k = 0; k < 4; k++) {
      const size_t i = i0 + k * gstr;
      if (i < (size_t)TT * DM / 8)
        *(uint4*)(p.xb + i * 8) = make_uint4(pk2(a[k].x, a[k].y), pk2(a[k].z, a[k].w), pk2(b[k].x, b[k].y), pk2(b[k].z, b[k].w));
    }
  }
  for (size_t i = gtid; i < (size_t)512 * DM / 8; i += gstr) {
    float4 a = *(const float4*)(p.mem + i * 8), b = *(const float4*)(p.mem + i * 8 + 4);
    *(uint4*)(p.memb + i * 8) = make_uint4(pk2(a.x, a.y), pk2(a.z, a.w), pk2(b.x, b.y), pk2(b.z, b.w));
  }
  for (size_t i = gtid; i < (size_t)TT; i += gstr) {
    const float ps = (float)p.pos[i];
#pragma unroll
    for (int j = 0; j < 8; j++) {
      float ang = ps * p.inv[j];
      float s, c; sincosf(ang, &s, &c);
      p.CS[i * 16 + j] = c; p.CS[i * 16 + 8 + j] = s;
    }
  }
  for (size_t i = gtid; i < 2 * 32 * 64; i += gstr) {
    int pp = (int)(i & 63), g = (int)((i >> 6) & 31), layer = (int)(i >> 11);
    float dt = expf(p.log_dt[layer * 32 + g]);
    float lr = p.lam_re[i], li = p.lam_im[i];
    float mag = expf(lr * dt);
    float sn, cs; sincosf(li * dt, &sn, &cs);
    float ar = mag * cs, ai = mag * sn;
    float den = lr * lr + li * li;
    float nr = ar - 1.f, ni = ai;
    float fr = (nr * lr + ni * li) / den, fi = (ni * lr - nr * li) / den;
    float* sb = p.SB + i * 32;
    const float* bre = p.b_re + i * 16; const float* bim = p.b_im + i * 16;
    for (int h = 0; h < 16; h++) {
      float br = bre[h], bi = bim[h];
      sb[h] = fr * br - fi * bi; sb[16 + h] = fr * bi + fi * br;
    }
    float pr = ar, pi = ai;
    for (int k = 0; k < 7; k++) { float nr2 = pr * pr - pi * pi, ni2 = 2.f * pr * pi; pr = nr2; pi = ni2; }
    p.SA[i * 4 + 0] = ar; p.SA[i * 4 + 1] = ai; p.SA[i * 4 + 2] = pr; p.SA[i * 4 + 3] = pi;
    for (int h = 0; h < 16; h++) {
      size_t ci = ((size_t)(layer * 32 + g) * 16 + h);
      p.CM[ci * 128 + pp] = f2bf(p.c_re[ci * 64 + pp]);
      p.CM[ci * 128 + 64 + pp] = f2bf(-p.c_im[ci * 64 + pp]);
    }
  }
}

__device__ __forceinline__ void phaseA(const Params& p, int layer) {
  const int tidf = otid_full();
  const int wid = __builtin_amdgcn_readfirstlane(tidf >> 6), lane = tidf & 63, wr = wid >> 2, wc = wid & 3, fr = lane & 15, fq = lane >> 4;
  const bf* Wl = p.WinT + (size_t)layer * INW * 2048;
  const int nA = 128 * 23;
  const int total = nA + (layer == 0 ? 8 : 0);
  for (int L = blockIdx.x; L < total; L += gridDim.x) {
    f32x4 acc[2][2][4][2]; ZERO_ACC8(acc);
    if (L < nA) {
      int pm, pn; tile_order(L, 128, 23, pm, pn);
      const int brow = pm * 256, bcol = pn * 256;
      gemm256(p.xb, 2048, Wl, 2048, 2048, brow, bcol, acc);
      int fr_o = fr; asm volatile("" : "+v"(fr_o));
#pragma unroll
      for (int ai = 0; ai < 2; ai++)
#pragma unroll
        for (int m = 0; m < 4; m++) {
          __builtin_amdgcn_sched_barrier(0);
          const int tok = brow + ai * 128 + wr * 64 + m * 16 + fr_o;
#pragma unroll
          for (int bj = 0; bj < 2; bj++)
#pragma unroll
            for (int n = 0; n < 2; n++) {
              const int cb = bcol + bj * 128 + wc * 32 + n * 16;
              f32x4 v = acc[ai][bj][m][n];
              if (n == 0 && (wc & 1) == 0 && ((cb >= C_ATQ && cb < C_ATV) || (cb >= C_IDQ && cb < C_IDW))) {
                f32x4 cs = *(const f32x4*)(p.CS + (size_t)tok * 16 + 4 * (fq & 1));
                f32x4 sn = *(const f32x4*)(p.CS + (size_t)tok * 16 + 8 + 4 * (fq & 1));
#pragma unroll
                for (int e = 0; e < 4; e++) {
                  float o = __shfl_xor(v[e], 32);
                  v[e] = (fq < 2) ? (v[e] * cs[e] - o * sn[e]) : (v[e] * cs[e] + o * sn[e]);
                }
              }
              const int nn = cb + fq * 4;
              if (nn < 5716) {
                const int dn = nn + (nn >= 2628 ? 12 : 0);
                uint2 pv = make_uint2(pk2(v[0], v[1]), pk2(v[2], v[3]));
                *(uint2*)(p.P + (size_t)tok * PW + dn) = pv;
                if (nn >= C_IDK && nn < C_IDW) {
                  const int d = nn - C_IDK; const int b = tok >> 14, li = tok & 16383;
                  size_t o = ((((size_t)(b * 512 + (li >> 5)) * 4 + (d >> 4)) * 64 + ((d >> 3) & 1) * 32 + (li & 31)) * 8) + (d & 7);
                  *(uint2*)(p.KIF + o) = pv;
                }
                if (nn >= C_ATK && nn < C_ATZ) *(uint2*)(p.KVC + (size_t)tok * 256 + (nn - C_ATK)) = pv;
              }
            }
        }
    } else {
      const int t8 = L - nA; const int ly = t8 >> 2, tm = (t8 >> 1) & 1, tn = t8 & 1;
      gemm256(p.memb, 2048, p.WmemT + (size_t)ly * 512 * 2048, 2048, 2048, tm * 256, tn * 256, acc);
#pragma unroll
      for (int ai = 0; ai < 2; ai++)
#pragma unroll
        for (int m = 0; m < 4; m++) {
          const int row = tm * 256 + ai * 128 + wr * 64 + m * 16 + fr; const int b = row >> 8, mm = row & 255;
#pragma unroll
          for (int bj = 0; bj < 2; bj++)
#pragma unroll
            for (int n = 0; n < 2; n++)
#pragma unroll
              for (int e = 0; e < 4; e++) {
                const int nn = tn * 256 + bj * 128 + wc * 32 + n * 16 + fq * 4 + e; const float v = acc[ai][bj][m][n][e];
                if (nn < 256) { int h = nn >> 6, d = nn & 63; p.MK[((((size_t)ly * 2 + b) * 4 + h) * 256 + mm) * 64 + d] = f2bf(v); }
                else { int h = (nn - 256) >> 6, d = nn & 63; p.MVT[((((size_t)ly * 2 + b) * 4 + h) * 64 + d) * 256 + mm] = f2bf(v); }
              }
        }
    }
  }
}

__device__ __forceinline__ float softplusf_(float x) {
  const float e = __expf(x);
  const float sp = (e < 0.01f) ? e * (1.f - 0.5f * e) : __logf(1.f + e);
  return x > 15.f ? x : sp;
}

__device__ __forceinline__ void ssd_dt_acs(const Params& p, int layer, size_t tok0, int gg, float* sAcs, float* sDt) {
  const int tid = otid(), lane = tid & 63, w = tid >> 6;
#pragma unroll
  for (int k = 0; k < 2; k++) {
    const int hh = 2 * w + k, hd = gg * 8 + hh;
    const float bias = p.dt_bias[layer * 16 + hd], a = -__expf(p.a_log[layer * 16 + hd]);
    const int l0 = 2 * lane;
    float d0 = softplusf_(bf2f(p.P[(tok0 + l0) * PW + C_SDT + hd]) + bias);
    float d1 = softplusf_(bf2f(p.P[(tok0 + l0 + 1) * PW + C_SDT + hd]) + bias);
    float s0 = d0 * a, s1 = s0 + d1 * a;
    float xs = s1;
#pragma unroll
    for (int off = 1; off < 64; off <<= 1) { float v = __shfl_up(xs, off); if (lane >= off) xs += v; }
    float ex = xs - s1;
    sAcs[l0 * 8 + hh] = ex + s0; sAcs[(l0 + 1) * 8 + hh] = ex + s1;
    sDt[l0 * 8 + hh] = d0; sDt[(l0 + 1) * 8 + hh] = d1;
  }
}

struct Conv2 { float w0[4], w1[4], b0, b1, h0[3], h1[3]; };
__device__ __forceinline__ void conv_init(const Params& p, int layer, size_t tokb, int l, int ch, Conv2& c) {
  const float* cw = p.conv_w + (size_t)layer * 4 * 1536 + ch;
#pragma unroll
  for (int k = 0; k < 4; k++) { c.w0[k] = cw[k * 1536]; c.w1[k] = cw[k * 1536 + 1]; }
  c.b0 = p.conv_b[layer * 1536 + ch]; c.b1 = p.conv_b[layer * 1536 + ch + 1];
#pragma unroll
  for (int k = 0; k < 3; k++) {
    int ll = l - 3 + k; unsigned u = 0;
    if (ll >= 0) u = *(const unsigned*)(p.P + (tokb + ll) * PW + C_XBC + ch);
    c.h0[k] = bflo(u); c.h1[k] = bfhi(u);
  }
}
__device__ __forceinline__ void conv_step(const Params& p, size_t tokb, int l, int ch, Conv2& c, float& o0, float& o1) {
  unsigned u = *(const unsigned*)(p.P + (tokb + l) * PW + C_XBC + ch);
  float x0 = bflo(u), x1 = bfhi(u);
  float a0 = c.b0 + c.w0[0] * c.h0[0] + c.w0[1] * c.h0[1] + c.w0[2] * c.h0[2] + c.w0[3] * x0;
  float a1 = c.b1 + c.w1[0] * c.h1[0] + c.w1[1] * c.h1[1] + c.w1[2] * c.h1[2] + c.w1[3] * x1;
  c.h0[0] = c.h0[1]; c.h0[1] = c.h0[2]; c.h0[2] = x0;
  c.h1[0] = c.h1[1]; c.h1[1] = c.h1[2]; c.h1[2] = x1;
  o0 = siluf_(a0); o1 = siluf_(a1);
}

__device__ __forceinline__ void conv_val(unsigned u, Conv2& c, float& o0, float& o1) {
  float x0 = bflo(u), x1 = bfhi(u);
  float a0 = c.b0 + c.w0[0] * c.h0[0] + c.w0[1] * c.h0[1] + c.w0[2] * c.h0[2] + c.w0[3] * x0;
  float a1 = c.b1 + c.w1[0] * c.h1[0] + c.w1[1] * c.h1[1] + c.w1[2] * c.h1[2] + c.w1[3] * x1;
  c.h0[0] = c.h0[1]; c.h0[1] = c.h0[2]; c.h0[2] = x0;
  c.h1[0] = c.h1[1]; c.h1[1] = c.h1[2]; c.h1[2] = x1;
  o0 = siluf_(a0); o1 = siluf_(a1);
}
#define CONV_PRELOAD(raw, N, lfirst, nrows, ch)                                                           \
  unsigned raw[N];                                                                                        \
  _Pragma("unroll") for (int k_ = 0; k_ < N; k_++)                                                        \
    raw[k_] = (k_ < (nrows)) ? *(const unsigned*)(p.P + (tokb + (lfirst) + k_) * PW + C_XBC + (ch)) : 0u;

__device__ __forceinline__ void ssd_pass1(const Params& p, int layer, int task, char* sm) {
  const int tid = otid(), lane = tid & 63, w = tid >> 6, r32 = lane & 31, h5 = lane >> 5;
  const int gg = task & 1, c = (task >> 1) & 127, b = task >> 8;
  const size_t tokb = (size_t)b * LSEQ; const int lc0 = c * 128; const size_t tok0 = tokb + lc0;
  float* sAcs = (float*)sm; float* sDt = (float*)(sm + 4096);
  bf* sBT = (bf*)(sm + 8192); bf* sXT = (bf*)(sm + 43008);
  __syncthreads();
  ssd_dt_acs(p, layer, tok0, gg, sAcs, sDt);
  {
    const int cp = tid & 63, tg = tid >> 6; const int ch = 1024 + gg * 128 + 2 * cp;
    Conv2 cv; conv_init(p, layer, tokb, lc0 + tg * 32, ch, cv);
    CONV_PRELOAD(raw, 32, lc0 + tg * 32, 32, ch)
#pragma unroll
    for (int k = 0; k < 32; k += 2) {
      const int l = tg * 32 + k;
      float a0, a1, b0, b1;
      conv_val(raw[k], cv, a0, a1);
      conv_val(raw[k + 1], cv, b0, b1);
      *(unsigned*)(sBT + (2 * cp) * 136 + l) = pk2(a0, b0);
      *(unsigned*)(sBT + (2 * cp + 1) * 136 + l) = pk2(a1, b1);
    }
  }
  __syncthreads();
  if (tid < 8) p.CD[((size_t)(b * 128 + c)) * 16 + gg * 8 + tid] = __expf(sAcs[127 * 8 + tid]);
  for (int hh = 0; hh < 8; hh++) {
    const int hd = gg * 8 + hh;
    if (hh) __syncthreads();
    {
      const int cp = tid & 31, tg = tid >> 5; const int ch = gg * 512 + hh * 64 + 2 * cp;
      const float aend = sAcs[127 * 8 + hh];
      Conv2 cv; conv_init(p, layer, tokb, lc0 + tg * 16, ch, cv);
      CONV_PRELOAD(raw, 16, lc0 + tg * 16, 16, ch)
#pragma unroll
      for (int k = 0; k < 16; k += 2) {
        const int l = tg * 16 + k;
        float a0, a1, b0, b1;
        conv_val(raw[k], cv, a0, a1);
        conv_val(raw[k + 1], cv, b0, b1);
        float sa = sDt[l * 8 + hh] * __expf(aend - sAcs[l * 8 + hh]);
        float sb = sDt[(l + 1) * 8 + hh] * __expf(aend - sAcs[(l + 1) * 8 + hh]);
        *(unsigned*)(sXT + (2 * cp) * 136 + l) = pk2(a0 * sa, b0 * sb);
        *(unsigned*)(sXT + (2 * cp + 1) * 136 + l) = pk2(a1 * sa, b1 * sb);
      }
    }
    __syncthreads();
    f32x16 acc[2];
#pragma unroll
    for (int r = 0; r < 16; r++) { const float z_ = ozero(); acc[0][r] = z_; acc[1][r] = z_; }
#pragma unroll
    for (int ks = 0; ks < 8; ks++) {
      bf16x8 bfr = *(const bf16x8*)(sBT + (32 * w + r32) * 136 + ks * 16 + 8 * h5);
      bf16x8 x0 = *(const bf16x8*)(sXT + (r32) * 136 + ks * 16 + 8 * h5);
      bf16x8 x1 = *(const bf16x8*)(sXT + (32 + r32) * 136 + ks * 16 + 8 * h5);
      acc[0] = mfma32(x0, bfr, acc[0]);
      acc[1] = mfma32(x1, bfr, acc[1]);
    }
    float* st = p.ST + ((size_t)(b * 128 + c) * 16 + hd) * 64 * 128;
#pragma unroll
    for (int pi = 0; pi < 2; pi++)
#pragma unroll
      for (int r = 0; r < 16; r++) {
        int pp = 32 * pi + 8 * (r >> 2) + 4 * h5 + (r & 3);
        st[pp * 128 + 32 * w + r32] = acc[pi][r];
      }
  }
}

__device__ __forceinline__ void ssd_statepass(const Params& p, int task) {
  const int idx = task * 256 + otid();
  const int b = idx >> 15, e4 = idx & 32767;
  const int hd = e4 >> 11;
  const float zc_ = ozero(); float4 carry = make_float4(zc_, zc_, zc_, zc_);
  float* base = p.ST + (size_t)b * 128 * 131072 + (size_t)e4 * 4;
  const float* cd = p.CD + (size_t)b * 128 * 16 + hd;
  for (int c0 = 0; c0 < 128; c0 += 4) {
    float4 v[4]; float d[4];
#pragma unroll
    for (int k = 0; k < 4; k++) { v[k] = *(const float4*)(base + (size_t)(c0 + k) * 131072); d[k] = cd[(c0 + k) * 16]; }
#pragma unroll
    for (int k = 0; k < 4; k++) {
      *(float4*)(base + (size_t)(c0 + k) * 131072) = carry;
      carry.x = carry.x * d[k] + v[k].x; carry.y = carry.y * d[k] + v[k].y;
      carry.z = carry.z * d[k] + v[k].z; carry.w = carry.w * d[k] + v[k].w;
    }
  }
}

__device__ __forceinline__ void ssd_pass2(const Params& p, int layer, int task, char* sm) {
  const int tid = otid(), lane = tid & 63, w = tid >> 6, r32 = lane & 31, h5 = lane >> 5;
  const int lh = task & 1, gg = (task >> 1) & 1, c = (task >> 2) & 127, b = task >> 9;
  const size_t tokb = (size_t)b * LSEQ; const int lc0 = c * 128; const size_t tok0 = tokb + lc0;
  float* sAcs = (float*)sm; float* sDt = (float*)(sm + 4096);
  bf* sC = (bf*)(sm + 8192); bf* sB = (bf*)(sm + 25600); bf* sM = (bf*)(sm + 25600); bf* sXT = (bf*)(sm + 43008);
  float* sSsq = (float*)(sm + 60416);
  const int wr = w >> 1, wc = w & 1;
  const int nS = 64 * (lh + 1);
  __syncthreads();
  ssd_dt_acs(p, layer, tok0, gg, sAcs, sDt);
  {
    const int cp = tid & 63, tg = tid >> 6;
    {
      const int ch = 1280 + gg * 128 + 2 * cp;
      const int lst = 64 * lh + tg * 16;
      Conv2 cv; conv_init(p, layer, tokb, lc0 + lst, ch, cv);
      CONV_PRELOAD(raw, 16, lc0 + lst, 16, ch)
#pragma unroll
      for (int k = 0; k < 16; k++) {
        const int l = lst + k;
        float a0, a1; conv_val(raw[k], cv, a0, a1);
        *(unsigned*)(sC + (l - 64 * lh) * 136 + 2 * cp) = pk2(a0, a1);
      }
    }
    {
      const int ch = 1024 + gg * 128 + 2 * cp;
      const int per = nS >> 2; const int lst = tg * per;
      Conv2 cv; conv_init(p, layer, tokb, lc0 + lst, ch, cv);
      CONV_PRELOAD(raw, 32, lc0 + lst, per, ch)
#pragma unroll
      for (int k = 0; k < 32; k++) {
        if (k < per) {
          const int l = lst + k;
          float a0, a1; conv_val(raw[k], cv, a0, a1);
          *(unsigned*)(sB + l * 136 + 2 * cp) = pk2(a0, a1);
        }
      }
    }
  }
  __syncthreads();
  f32x16 cb[2];
#pragma unroll
  for (int r = 0; r < 16; r++) { const float z_ = ozero(); cb[0][r] = z_; cb[1][r] = z_; }
  if (64 * wc < nS) {
#pragma unroll
    for (int ks = 0; ks < 8; ks++) {
      bf16x8 af = *(const bf16x8*)(sC + (32 * wr + r32) * 136 + ks * 16 + 8 * h5);
      bf16x8 b0 = *(const bf16x8*)(sB + (64 * wc + r32) * 136 + ks * 16 + 8 * h5);
      bf16x8 b1 = *(const bf16x8*)(sB + (64 * wc + 32 + r32) * 136 + ks * 16 + 8 * h5);
      cb[0] = mfma32(af, b0, cb[0]);
      cb[1] = mfma32(af, b1, cb[1]);
    }
  }
  __syncthreads();
  const int wc2 = w & 1;
  for (int hh = 0; hh < 8; hh++) {
    const int hd = gg * 8 + hh;
    if (hh) __syncthreads();
    bf16x8 pfr[8];
    {
      const float* pv = p.ST + (((size_t)(b * 128 + c) * 16 + hd) * 64 + 32 * wc2 + r32) * 128 + 8 * h5;
#pragma unroll
      for (int ks = 0; ks < 8; ks++) {
        float4 u0 = *(const float4*)(pv + ks * 16), u1 = *(const float4*)(pv + ks * 16 + 4);
        unsigned q0 = pk2(u0.x, u0.y), q1 = pk2(u0.z, u0.w), q2 = pk2(u1.x, u1.y), q3 = pk2(u1.z, u1.w);
        pfr[ks][0] = (short)(q0 & 0xFFFF); pfr[ks][1] = (short)(q0 >> 16); pfr[ks][2] = (short)(q1 & 0xFFFF); pfr[ks][3] = (short)(q1 >> 16);
        pfr[ks][4] = (short)(q2 & 0xFFFF); pfr[ks][5] = (short)(q2 >> 16); pfr[ks][6] = (short)(q3 & 0xFFFF); pfr[ks][7] = (short)(q3 >> 16);
      }
    }
    {
      const float dsk = p.ssd_d[layer * 16 + hd];
#pragma unroll
      for (int j = 0; j < 2; j++) {
        const int s = 64 * wc + 32 * j + r32;
        if (s < nS) {
          const float as = sAcs[s * 8 + hh];
#pragma unroll
          for (int r = 0; r < 16; r++) {
            const int lp = 32 * wr + 8 * (r >> 2) + 4 * h5 + (r & 3); const int l = 64 * lh + lp;
            float v = 0.f;
            if (s <= l) v = cb[j][r] * __expf(sAcs[l * 8 + hh] - as);
            if (s == l) v += dsk * __builtin_amdgcn_rcpf(sDt[l * 8 + hh]);
            sM[lp * 136 + s] = f2bf(v);
          }
        }
      }
    }
    {
      const int cp = tid & 31, tg = tid >> 5; const int ch = gg * 512 + hh * 64 + 2 * cp;
      const int per = nS >> 3; const int lst = tg * per;
      Conv2 cv; conv_init(p, layer, tokb, lc0 + lst, ch, cv);
      CONV_PRELOAD(raw, 16, lc0 + lst, per, ch)
#pragma unroll
      for (int k = 0; k < 16; k += 2) {
        if (k >= per) break;
        const int l = lst + k;
        float a0, a1, b0, b1;
        conv_val(raw[k], cv, a0, a1);
        conv_val(raw[k + 1], cv, b0, b1);
        float sa = sDt[l * 8 + hh], sb = sDt[(l + 1) * 8 + hh];
        *(unsigned*)(sXT + (2 * cp) * 136 + l) = pk2(a0 * sa, b0 * sb);
        *(unsigned*)(sXT + (2 * cp + 1) * 136 + l) = pk2(a1 * sa, b1 * sb);
      }
    }
    __syncthreads();
    f32x16 yd, yo;
#pragma unroll
    for (int r = 0; r < 16; r++) { const float z_ = ozero(); yd[r] = z_; yo[r] = z_; }
    const int nks = nS >> 4;
    for (int ks = 0; ks < nks; ks++) {
      bf16x8 xf = *(const bf16x8*)(sXT + (32 * wc2 + r32) * 136 + ks * 16 + 8 * h5);
      bf16x8 mf = *(const bf16x8*)(sM + (32 * wr + r32) * 136 + ks * 16 + 8 * h5);
      yd = mfma32(xf, mf, yd);
    }
    {
#pragma unroll
      for (int ks = 0; ks < 8; ks++) {
        bf16x8 cf = *(const bf16x8*)(sC + (32 * wr + r32) * 136 + ks * 16 + 8 * h5);
        yo = mfma32(pfr[ks], cf, yo);
      }
    }
    {
      const int lp = 32 * wr + r32; const int l = 64 * lh + lp; const size_t tok = tok0 + l;
      const float eo = __expf(sAcs[l * 8 + hh]);
      float ss = 0.f;
#pragma unroll
      for (int q = 0; q < 4; q++) {
        const int pp = 32 * wc2 + 8 * q + 4 * h5;
        uint2 zz = *(const uint2*)(p.P + tok * PW + C_SSZ + hd * 64 + pp);
        float v0 = (yd[4 * q] + eo * yo[4 * q]) * siluf_(bflo(zz.x));
        float v1 = (yd[4 * q + 1] + eo * yo[4 * q + 1]) * siluf_(bfhi(zz.x));
        float v2 = (yd[4 * q + 2] + eo * yo[4 * q + 2]) * siluf_(bflo(zz.y));
        float v3 = (yd[4 * q + 3] + eo * yo[4 * q + 3]) * siluf_(bfhi(zz.y));
        ss += v0 * v0 + v1 * v1 + v2 * v2 + v3 * v3;
        *(uint2*)(p.Y + tok * YW + Y_SSD + hd * 64 + pp) = make_uint2(pk2(v0, v1), pk2(v2, v3));
      }
      sSsq[lp * 32 + hh * 4 + wc2 * 2 + h5] = ss;
    }
  }
  __syncthreads();
  {
    const int lp = tid >> 2, part = tid & 3; const size_t tok = tok0 + 64 * lh + lp;
    float tot = 0.f;
#pragma unroll
    for (int k = 0; k < 32; k += 4) { float4 v4 = *(const float4*)(sSsq + lp * 32 + k); tot += (v4.x + v4.y) + (v4.z + v4.w); }
    const float rs = rsqrtf(tot * (1.f / 512.f) + 1e-5f);
    bf* yp = p.Y + tok * YW + Y_SSD + gg * 512 + part * 128;
    const float* ng = p.norm_g + layer * 1024 + gg * 512 + part * 128;
#pragma unroll 4
    for (int i = 0; i < 16; i++) {
      uint4 u = *(const uint4*)(yp + i * 8);
      float4 g0 = *(const float4*)(ng + i * 8), g1 = *(const float4*)(ng + i * 8 + 4);
      u.x = pk2(bflo(u.x) * rs * g0.x, bfhi(u.x) * rs * g0.y);
      u.y = pk2(bflo(u.y) * rs * g0.z, bfhi(u.y) * rs * g0.w);
      u.z = pk2(bflo(u.z) * rs * g1.x, bfhi(u.z) * rs * g1.y);
      u.w = pk2(bflo(u.w) * rs * g1.z, bfhi(u.w) * rs * g1.w);
      *(uint4*)(yp + i * 8) = u;
    }
  }
}

__device__ __forceinline__ void s5_ld_u(const Params& p, size_t tok, int g, uint4& a, uint4& b) {
  const uint4* src = (const uint4*)(p.P + tok * PW + C_S5U + g * 16);
  a = src[0]; b = src[1];
}
__device__ __forceinline__ void s5_st_u(float* dst, const uint4 a, const uint4 b) {
  *(float4*)(dst + 0) = make_float4(bflo(a.x), bfhi(a.x), bflo(a.y), bfhi(a.y));
  *(float4*)(dst + 4) = make_float4(bflo(a.z), bfhi(a.z), bflo(a.w), bfhi(a.w));
  *(float4*)(dst + 8) = make_float4(bflo(b.x), bfhi(b.x), bflo(b.y), bfhi(b.y));
  *(float4*)(dst + 12) = make_float4(bflo(b.z), bfhi(b.z), bflo(b.w), bfhi(b.w));
}
__device__ __forceinline__ void s5_load_u(const Params& p, size_t tok, int g, float* dst) {
  const uint4* src = (const uint4*)(p.P + tok * PW + C_S5U + g * 16);
  uint4 a = src[0], b = src[1];
  *(float4*)(dst + 0) = make_float4(bflo(a.x), bfhi(a.x), bflo(a.y), bfhi(a.y));
  *(float4*)(dst + 4) = make_float4(bflo(a.z), bfhi(a.z), bflo(a.w), bfhi(a.w));
  *(float4*)(dst + 8) = make_float4(bflo(b.x), bfhi(b.x), bflo(b.y), bfhi(b.y));
  *(float4*)(dst + 12) = make_float4(bflo(b.z), bfhi(b.z), bflo(b.w), bfhi(b.w));
}
typedef float f32x2 __attribute__((ext_vector_type(2)));
#define S5_STEP(uu)                                                                     \
  {                                                                                     \
    float4 u0 = *(const float4*)((uu)), u1 = *(const float4*)((uu) + 4), u2 = *(const float4*)((uu) + 8), u3 = *(const float4*)((uu) + 12); \
    f32x2 bb = B2[0] * (f32x2){u0.x, u0.x};                                             \
    bb = B2[1] * (f32x2){u0.y, u0.y} + bb; bb = B2[2] * (f32x2){u0.z, u0.z} + bb; bb = B2[3] * (f32x2){u0.w, u0.w} + bb;     \
    bb = B2[4] * (f32x2){u1.x, u1.x} + bb; bb = B2[5] * (f32x2){u1.y, u1.y} + bb; bb = B2[6] * (f32x2){u1.z, u1.z} + bb; bb = B2[7] * (f32x2){u1.w, u1.w} + bb; \
    bb = B2[8] * (f32x2){u2.x, u2.x} + bb; bb = B2[9] * (f32x2){u2.y, u2.y} + bb; bb = B2[10] * (f32x2){u2.z, u2.z} + bb; bb = B2[11] * (f32x2){u2.w, u2.w} + bb; \
    bb = B2[12] * (f32x2){u3.x, u3.x} + bb; bb = B2[13] * (f32x2){u3.y, u3.y} + bb; bb = B2[14] * (f32x2){u3.z, u3.z} + bb; bb = B2[15] * (f32x2){u3.w, u3.w} + bb; \
    float nr_ = ar * sr - ai * si + bb.x; float ni_ = ar * si + ai * sr + bb.y; sr = nr_; si = ni_; \
  }

__device__ __forceinline__ void s5_pass1(const Params& p, int layer, int task, char* sm) {
  const int tid = otid(), lane = tid & 63, w = tid >> 6;
  const int gq = task & 7, c = (task >> 3) & 127, b = task >> 10;
  const int g = gq * 4 + w;
  const size_t tok0 = (size_t)b * LSEQ + c * 128;
  float* sU = (float*)(sm + w * 8192);
  __syncthreads();
  s5_load_u(p, tok0 + lane, g, sU + lane * 16);
  s5_load_u(p, tok0 + 64 + lane, g, sU + (64 + lane) * 16);
  const size_t pi = ((size_t)(layer * 32 + g)) * 64 + lane;
  f32x2 B2[16];
#pragma unroll
  for (int h = 0; h < 16; h++) { B2[h].x = p.SB[pi * 32 + h]; B2[h].y = p.SB[pi * 32 + 16 + h]; }
  const float ar = p.SA[pi * 4], ai = p.SA[pi * 4 + 1];
  float sr = 0.f, si = 0.f;
  __builtin_amdgcn_wave_barrier();
  for (int l = 0; l < 128; l++) S5_STEP(sU + l * 16)
  *(float2*)(p.END + (((size_t)(b * 128 + c) * 32 + g) * 64 + lane) * 2) = make_float2(sr, si);
}

__device__ __forceinline__ void s5_carry(const Params& p, int layer, int task) {
  const int idx = task * 256 + otid();
  const int b = idx >> 11, gp = idx & 2047;
  const size_t pi = (size_t)layer * 2048 + gp;
  const float a128r = p.SA[pi * 4 + 2], a128i = p.SA[pi * 4 + 3];
  float sr = ozero(), si = ozero();
  float2* e = (float2*)p.END + (size_t)b * 128 * 2048 + gp;
  for (int c0 = 0; c0 < 128; c0 += 4) {
    float2 v[4];
#pragma unroll
    for (int k = 0; k < 4; k++) v[k] = e[(size_t)(c0 + k) * 2048];
#pragma unroll
    for (int k = 0; k < 4; k++) {
      e[(size_t)(c0 + k) * 2048] = make_float2(sr, si);
      float nr = a128r * sr - a128i * si + v[k].x, ni = a128r * si + a128i * sr + v[k].y; sr = nr; si = ni;
    }
  }
}

__device__ __forceinline__ void s5_pass2(const Params& p, int layer, int task, char* sm) {
  const int tid = otid(), lane = tid & 63, w = tid >> 6;
  const int c = task & 127, b = task >> 7;
  const size_t tok0 = (size_t)b * LSEQ + c * 128;
  float* sU = (float*)(sm + w * 10752); bf* sS = (bf*)(sm + w * 10752 + 2048);
  __syncthreads();
  uint4 ua, ub;
  s5_ld_u(p, tok0 + (lane & 31), w * 8, ua, ub);
  for (int gi = 0; gi < 8; gi++) {
    const int g = w * 8 + gi;
    const size_t pi = ((size_t)(layer * 32 + g)) * 64 + lane;
    f32x2 B2[16];
#pragma unroll
    for (int h = 0; h < 16; h++) { B2[h].x = p.SB[pi * 32 + h]; B2[h].y = p.SB[pi * 32 + 16 + h]; }
    const float ar = p.SA[pi * 4], ai = p.SA[pi * 4 + 1];
    float2 s0 = *(const float2*)(p.END + (((size_t)(b * 128 + c) * 32 + g) * 64 + lane) * 2);
    float sr = s0.x, si = s0.y;
    bf16x8 cf[4];
    {
      const bf* cm = p.CM + (((size_t)(layer * 32 + g)) * 16 + (lane & 15)) * 128 + 8 * (lane >> 4);
#pragma unroll
      for (int ks = 0; ks < 4; ks++) cf[ks] = *(const bf16x8*)(cm + ks * 32);
    }
    const float dsk = p.s5_d[(layer * 32 + g) * 16 + (lane & 15)];
    for (int sub = 0; sub < 4; sub++) {
      __builtin_amdgcn_wave_barrier();
      if (lane < 32) s5_st_u(sU + lane * 16, ua, ub);
      {
        const int nsub = (sub + 1) & 3; const int ng = g + (sub == 3 ? 1 : 0);
        if (sub < 3 || gi < 7) s5_ld_u(p, tok0 + nsub * 32 + (lane & 31), ng, ua, ub);
      }
      __builtin_amdgcn_wave_barrier();
      for (int l = 0; l < 32; l++) {
        S5_STEP(sU + l * 16)
        sS[l * 136 + lane] = f2bf(sr); sS[l * 136 + 64 + lane] = f2bf(si);
      }
      __builtin_amdgcn_wave_barrier();
#pragma unroll
      for (int mb = 0; mb < 2; mb++) {
        const float z_ = ozero(); f32x4 acc = {z_, z_, z_, z_};
#pragma unroll
        for (int ks = 0; ks < 4; ks++) {
          bf16x8 af = *(const bf16x8*)(sS + (16 * mb + (lane & 15)) * 136 + ks * 32 + 8 * (lane >> 4));
          acc = mfma16(af, cf[ks], acc);
        }
#pragma unroll
        for (int r = 0; r < 4; r++) {
          const int l = 16 * mb + 4 * (lane >> 4) + r;
          float y = acc[r] + dsk * sU[l * 16 + (lane & 15)];
          p.YG[(tok0 + sub * 32 + l) * 512 + g * 16 + (lane & 15)] = f2bf(geluf_(y));
        }
      }
    }
  }
  __syncthreads();
  const int wr = w >> 1, wc = w & 1, r32 = lane & 31, h5 = lane >> 5;
  for (int tn = 0; tn < 4; tn++) {
    f32x16 acc[2][2]; ZERO_ACC(acc);
    gemm_acc<4>(p.YG + tok0 * 512, 512, p.WgluT + ((size_t)layer * 512 + tn * 128) * 512, 512, 512, acc, sm);
#pragma unroll
    for (int i = 0; i < 2; i++) {
      const size_t tok = tok0 + wr * 64 + i * 32 + r32;
#pragma unroll
      for (int j = 0; j < 2; j++)
#pragma unroll
        for (int q = 0; q < 4; q++) {
          const int n = tn * 128 + wc * 64 + j * 32 + q * 8 + h5 * 4;
          float4 bg = *(const float4*)(p.b_glu + layer * 512 + n);
          uint2 yy = *(const uint2*)(p.YG + tok * 512 + n);
          uint2 zz = *(const uint2*)(p.P + tok * PW + C_S5Z + n);
          float o0 = bflo(yy.x) * sigmoidf_(acc[i][j][4 * q] + bg.x) * siluf_(bflo(zz.x));
          float o1 = bfhi(yy.x) * sigmoidf_(acc[i][j][4 * q + 1] + bg.y) * siluf_(bfhi(zz.x));
          float o2 = bflo(yy.y) * sigmoidf_(acc[i][j][4 * q + 2] + bg.z) * siluf_(bflo(zz.y));
          float o3 = bfhi(yy.y) * sigmoidf_(acc[i][j][4 * q + 3] + bg.w) * siluf_(bfhi(zz.y));
          *(uint2*)(p.Y + tok * YW + Y_S5 + n) = make_uint2(pk2(o0, o1), pk2(o2, o3));
        }
    }
  }
}

__device__ __forceinline__ void mem_attn(const Params& p, int layer, int task) {
  const int tid = otid(), lane = tid & 63, h = tid >> 6;
  const int n16 = lane & 15, kq = lane >> 4;
  const size_t tok0 = (size_t)task * 16; const int b = (int)(tok0 >> 14);
  const bf* mk = p.MK + (((size_t)layer * 2 + b) * 4 + h) * 256 * 64;
  const bf* mvt = p.MVT + (((size_t)layer * 2 + b) * 4 + h) * 64 * 256;
  bf16x8 qf[2];
  {
    const bf* qp = p.P + (tok0 + n16) * PW + C_MEQ + h * 64 + 8 * kq;
    qf[0] = *(const bf16x8*)qp; qf[1] = *(const bf16x8*)(qp + 32);
  }
  f32x4 st[16];
#pragma unroll
  for (int kb = 0; kb < 16; kb++) {
    const bf* kp = mk + (size_t)(16 * kb + n16) * 64 + 8 * kq;
    bf16x8 a0 = *(const bf16x8*)kp, a1 = *(const bf16x8*)(kp + 32);
    const float z_ = ozero(); f32x4 acc = {z_, z_, z_, z_};
    acc = mfma16(a0, qf[0], acc); acc = mfma16(a1, qf[1], acc);
    st[kb] = acc * 0.125f;
  }
  float mx = -3.0e38f;
#pragma unroll
  for (int kb = 0; kb < 16; kb++)
#pragma unroll
    for (int r = 0; r < 4; r++) mx = fmaxf(mx, st[kb][r]);
  mx = fmaxf(mx, __shfl_xor(mx, 16)); mx = fmaxf(mx, __shfl_xor(mx, 32));
  float sum = 0.f;
#pragma unroll
  for (int kb = 0; kb < 16; kb++)
#pragma unroll
    for (int r = 0; r < 4; r++) { float e = __expf(st[kb][r] - mx); st[kb][r] = e; sum += e; }
  sum += __shfl_xor(sum, 16); sum += __shfl_xor(sum, 32);
  const float rinv = 1.f / sum;
  f32x4 o[4];
#pragma unroll
  for (int mb = 0; mb < 4; mb++) { const float z_ = ozero(); o[mb] = (f32x4){z_, z_, z_, z_}; }
#pragma unroll
  for (int k2 = 0; k2 < 8; k2++) {
    bf16x8 pf;
    unsigned q0 = pk2(st[2 * k2][0], st[2 * k2][1]), q1 = pk2(st[2 * k2][2], st[2 * k2][3]);
    unsigned q2 = pk2(st[2 * k2 + 1][0], st[2 * k2 + 1][1]), q3 = pk2(st[2 * k2 + 1][2], st[2 * k2 + 1][3]);
    pf[0] = (short)(q0 & 0xFFFF); pf[1] = (short)(q0 >> 16); pf[2] = (short)(q1 & 0xFFFF); pf[3] = (short)(q1 >> 16);
    pf[4] = (short)(q2 & 0xFFFF); pf[5] = (short)(q2 >> 16); pf[6] = (short)(q3 & 0xFFFF); pf[7] = (short)(q3 >> 16);
#pragma unroll
    for (int mb = 0; mb < 4; mb++) {
      const bf* vp = mvt + (size_t)(16 * mb + n16) * 256 + 32 * k2 + 4 * kq;
      uint2 v0 = *(const uint2*)vp, v1 = *(const uint2*)(vp + 16);
      bf16x8 af;
      af[0] = (short)(v0.x & 0xFFFF); af[1] = (short)(v0.x >> 16); af[2] = (short)(v0.y & 0xFFFF); af[3] = (short)(v0.y >> 16);
      af[4] = (short)(v1.x & 0xFFFF); af[5] = (short)(v1.x >> 16); af[6] = (short)(v1.y & 0xFFFF); af[7] = (short)(v1.y >> 16);
      o[mb] = mfma16(af, pf, o[mb]);
    }
  }
  const size_t tok = tok0 + n16;
#pragma unroll
  for (int mb = 0; mb < 4; mb++) {
    const int d = 16 * mb + 4 * kq;
    uint2 zz = *(const uint2*)(p.P + tok * PW + C_MEZ + h * 64 + d);
    float v0 = o[mb][0] * rinv * siluf_(bflo(zz.x)), v1 = o[mb][1] * rinv * siluf_(bfhi(zz.x));
    float v2 = o[mb][2] * rinv * siluf_(bflo(zz.y)), v3 = o[mb][3] * rinv * siluf_(bfhi(zz.y));
    *(uint2*)(p.Y + tok * YW + Y_MEM + h * 64 + d) = make_uint2(pk2(v0, v1), pk2(v2, v3));
  }
}

__device__ __forceinline__ void dsa_wave(const Params& p, int rank, char* sm) {
  const int tid = otid(), lane = tid & 63, w = tid >> 6, r32 = lane & 31, h5 = lane >> 5;
  const int b = rank & 1, qg = 2047 - (rank >> 1), l0 = qg * 8;
  const size_t tokb = (size_t)b * LSEQ;
  unsigned* cand = (unsigned*)(sm + w * (8 * CAP * 4));
  bf* Pb = (bf*)(sm + 61440 + w * 4096);
  bf16x8 aq[4];
  {
    const bf* qp = p.P + (tokb + l0 + (r32 >> 2)) * PW + C_IDQ + (r32 & 3) * 64 + 8 * h5;
#pragma unroll
    for (int ks = 0; ks < 4; ks++) aq[ks] = *(const bf16x8*)(qp + ks * 16);
  }
  float wv[4][4]; int ql[4];
#pragma unroll
  for (int g = 0; g < 4; g++) {
    ql[g] = l0 + 2 * g + h5;
    uint2 u = *(const uint2*)(p.P + (tokb + ql[g]) * PW + C_IDW);
    wv[g][0] = bflo(u.x) * 0.0625f; wv[g][1] = bfhi(u.x) * 0.0625f; wv[g][2] = bflo(u.y) * 0.0625f; wv[g][3] = bfhi(u.y) * 0.0625f;
  }
  unsigned Tg[4] = {0u, 0u, 0u, 0u}; float Tf[4];
  unsigned Tq = 0u; int cntv = 0;
  int nrep_ = (PROBE_MASK & 32) ? 2 : 1; asm volatile("" : "+s"(nrep_));
#pragma unroll 1
  for (int rep_ = 0; rep_ < nrep_; rep_++) {
  Tg[0] = Tg[1] = Tg[2] = Tg[3] = 0u; Tq = 0u; cntv = 0;
  Tf[0] = Tf[1] = Tf[2] = Tf[3] = -__builtin_inff();
  const int ntile = (l0 + 7) / 32 + 1;
  const bf* kif = p.KIF + (size_t)b * 512 * 2048 + lane * 8;
  bf16x8 bqA[4][4], bqB[4][4];
#pragma unroll
  for (int s = 0; s < 4; s++) {
    const int ts = s < ntile ? s : ntile - 1;
#pragma unroll
    for (int ks = 0; ks < 4; ks++) bqA[s][ks] = *(const bf16x8*)(kif + (size_t)ts * 2048 + ks * 512);
  }
  const unsigned ltmask = (1u << r32) - 1u;
#define DSA_COMPACT_CHECK()                                                                                              \
  {                                                                                                                     \
    unsigned long long over = __ballot(lane < 8 && cntv > CAP - 64);                                                    \
    if (over) {                                                                                                         \
      while (over) {                                                                                                    \
        const int q = __builtin_ctzll(over); over &= over - 1;                                                          \
        const int n = __builtin_amdgcn_readlane(cntv, q);                                                               \
        unsigned* cb_ = cand + q * CAP;                                                                                 \
        unsigned e[8];                                                                                                  \
        _Pragma("unroll") for (int i = 0; i < 8; i++) e[i] = (i * 64 + lane < n) ? cb_[i * 64 + lane] : 0u;             \
        unsigned T = 0u; int cT = n;                                                                                    \
        int nsr_ = (PROBE_MASK & 64) ? 2 : 1; asm volatile("" : "+s"(nsr_));                                            \
        _Pragma("unroll 1") for (int sr_ = 0; sr_ < nsr_; sr_++) { T = 0u; cT = n;                                      \
        const unsigned Told_ = (unsigned)__builtin_amdgcn_readlane((int)Tq, q);                                         \
        for (int bit = 31; bit >= 18; bit--) {                                                                          \
          const unsigned cnd = T | (1u << bit); int cc = 0;                                                             \
          if (cnd <= Told_) { T = cnd; continue; }                       \
          _Pragma("unroll") for (int i = 0; i < 8; i++) cc += __popcll(__ballot(e[i] >= cnd));                          \
          if (cc >= 256) { T = cnd; cT = cc; }                                                                          \
        } }                                                                                                             \
        if (cT > 320) {                                                                                                 \
          for (int bit = 17; bit >= 0; bit--) {                                                                         \
            const unsigned cnd = T | (1u << bit); int cc = 0;                                                           \
            _Pragma("unroll") for (int i = 0; i < 8; i++) cc += __popcll(__ballot(e[i] >= cnd));                        \
            if (cc >= 256) T = cnd;                                                                                     \
          }                                                                                                             \
        }                                                                                                               \
        int pos = 0;                                                                                                    \
        _Pragma("unroll") for (int i = 0; i < 8; i++) {                                                                 \
          const bool keep = e[i] >= T; const unsigned long long m = __ballot(keep);                                     \
          if (keep) cb_[pos + __popcll(m & ((1ull << lane) - 1ull))] = e[i];                                            \
          pos += __popcll(m);                                                                                           \
        }                                                                                                               \
        if (lane == q) { cntv = pos; Tq = T; }                                                                          \
      }                                                                                                                 \
      _Pragma("unroll") for (int g = 0; g < 4; g++) {                                                                   \
        unsigned tlo = __builtin_amdgcn_readlane(Tq, 2 * g), thi = __builtin_amdgcn_readlane(Tq, 2 * g + 1);            \
        Tg[g] = h5 ? thi : tlo;                                                                                         \
        const unsigned sh = Tg[g] & 0xFFFFC000u;                                                                        \
        const unsigned fb = (sh & 0x80000000u) ? (sh ^ 0x80000000u) : ~sh;                                              \
        Tf[g] = Tg[g] ? __uint_as_float(fb) : -__builtin_inff();                                                        \
      }                                                                                                                 \
    }                                                                                                                   \
  }
#define DSA_G(g, DIAG)                                                                                                  \
      {                                                                                                                 \
        const float r0 = __int_as_float(max(__float_as_int(acc[4 * g]), 0)), r1 = __int_as_float(max(__float_as_int(acc[4 * g + 1]), 0)); \
        const float r2 = __int_as_float(max(__float_as_int(acc[4 * g + 2]), 0)), r3 = __int_as_float(max(__float_as_int(acc[4 * g + 3]), 0)); \
        float sc = r0 * wv[g][0]; sc = fmaf(r1, wv[g][1], sc); sc = fmaf(r2, wv[g][2], sc); sc = fmaf(r3, wv[g][3], sc); \
        unsigned long long m0 = __builtin_amdgcn_fcmpf(sc, Tf[g], 3  );                                            \
        if (DIAG) m0 &= __builtin_amdgcn_sicmp(kidx, ql[g], 41  );                                                 \
        if (m0) {                                                                                                       \
          const float s2 = sc + 0.f;                                                                                    \
          unsigned uu = __float_as_uint(s2); uu ^= ((unsigned)((int)uu >> 31) | 0x80000000u);                           \
          const unsigned pk = (uu & 0xFFFFC000u) | (unsigned)(16383 - kidx);                                            \
          const unsigned long long m = m0 & __builtin_amdgcn_uicmp(pk, Tg[g], 35  );                              \
          if (m) {                                                                                                      \
            const unsigned lo = (unsigned)m, hi = (unsigned)(m >> 32);                                                  \
            const int cA = __builtin_amdgcn_readlane(cntv, 2 * g), cB = __builtin_amdgcn_readlane(cntv, 2 * g + 1);     \
            const unsigned mm = h5 ? hi : lo;                                                                           \
            if ((mm >> r32) & 1u) {                                                                                     \
              const int base = h5 ? cB : cA;                                                                            \
              cand[(2 * g + h5) * CAP + base + __popc(mm & ltmask)] = pk;                                               \
            }                                                                                                           \
            if (lane == 2 * g) cntv += __popc(lo);                                                                      \
            if (lane == 2 * g + 1) cntv += __popc(hi);                                                                  \
          }                                                                                                             \
        }                                                                                                               \
      }
#define DSA_GROUP(BC, BN, TB)                                                                                           \
  _Pragma("unroll") for (int u = 0; u < 4; u++) {                                                                       \
    if ((u & 1) == 0) DSA_COMPACT_CHECK()                                                                               \
    const int tile = (TB) + u;                                                                                          \
    f32x16 acc = {0.f, 0.f, 0.f, 0.f, 0.f, 0.f, 0.f, 0.f, 0.f, 0.f, 0.f, 0.f, 0.f, 0.f, 0.f, 0.f};                    \
    _Pragma("unroll") for (int ks = 0; ks < 4; ks++) acc = mfma32(aq[ks], BC[u][ks], acc);                              \
    if (u == 0) {                                                                                                       \
      _Pragma("unroll") for (int s = 0; s < 4; s++) {                                                                   \
        const int tn_ = ((TB) + 4 + s < ntile) ? (TB) + 4 + s : ntile - 1;                                              \
        _Pragma("unroll") for (int ks = 0; ks < 4; ks++) BN[s][ks] = *(const bf16x8*)(kif + (size_t)tn_ * 2048 + ks * 512); \
      }                                                                                                                 \
    }                                                                                                                   \
    const int kidx = tile * 32 + r32;                                                                                   \
    const bool diag = (tile * 32 + 31 > l0);                                                                            \
    if (!diag) { DSA_G(0, false) DSA_G(1, false) DSA_G(2, false) DSA_G(3, false) }                                      \
    else { DSA_G(0, true) DSA_G(1, true) DSA_G(2, true) DSA_G(3, true) }                                                \
  }
  for (int tile0 = 0; tile0 < ntile; tile0 += 8) {
    DSA_GROUP(bqA, bqB, tile0)
    DSA_GROUP(bqB, bqA, tile0 + 4)
  }
  {
    unsigned long long over = __ballot(lane < 8 && cntv > 256);
    while (over) {
      const int q = __builtin_ctzll(over); over &= over - 1;
      const int n = __builtin_amdgcn_readlane(cntv, q);
      unsigned* cb_ = cand + q * CAP;
      unsigned e[8];
#pragma unroll
      for (int i = 0; i < 8; i++) e[i] = (i * 64 + lane < n) ? cb_[i * 64 + lane] : 0u;
      unsigned T = 0u;
      const unsigned Told_ = (unsigned)__builtin_amdgcn_readlane((int)Tq, q);
      for (int bit = 31; bit >= 0; bit--) {
        const unsigned cnd = T | (1u << bit); int cc = 0;
        if (cnd <= Told_) { T = cnd; continue; }
#pragma unroll
        for (int i = 0; i < 8; i++) cc += __popcll(__ballot(e[i] >= cnd));
        if (cc >= 256) T = cnd;
      }
      int pos = 0;
#pragma unroll
      for (int i = 0; i < 8; i++) {
        const bool keep = e[i] >= T; const unsigned long long m = __ballot(keep);
        if (keep) cb_[pos + __popcll(m & ((1ull << lane) - 1ull))] = e[i];
        pos += __popcll(m);
      }
      if (lane == q) { cntv = pos; Tq = T; }
    }
  }
  }
  __builtin_amdgcn_wave_barrier();
  const int n16 = lane & 15, kq = lane >> 4;
#define DPP_ROR(v, n) __int_as_float(__builtin_amdgcn_update_dpp(0, __float_as_int(v), 0x120 + (n), 0xf, 0xf, false))
  for (int q = 0; q < 8; q++) {
    const int n = __builtin_amdgcn_readlane(cntv, q);
    const unsigned* sel = cand + q * CAP;
    const size_t tq = tokb + l0 + q;
    float ssum[2][4];
    bf16x8 qa[2][2];
#pragma unroll
    for (int grp = 0; grp < 2; grp++) {
#pragma unroll
      for (int k = 0; k < 8; k++) { int zi_ = 0; asm volatile("" : "+v"(zi_)); qa[grp][0][k] = (short)zi_; qa[grp][1][k] = (short)zi_; }
      if (n16 < 4) {
        const bf* qp = p.P + tq * PW + C_ATQ + (grp * 4 + n16) * 64 + 8 * kq;
        qa[grp][0] = *(const bf16x8*)qp; qa[grp][1] = *(const bf16x8*)(qp + 32);
      }
    }
    f32x4 lgA[16], lgB[16];
#pragma unroll
    for (int t = 0; t < 16; t++) {
      const int slot = t * 16 + n16; const bool valid = slot < n;
      const int key = valid ? (16383 - (int)(sel[slot] & 0x3FFFu)) : 0;
      const bf* kp = p.KVC + (tokb + key) * 256 + 8 * kq;
      bf16x8 a0 = *(const bf16x8*)kp, a1 = *(const bf16x8*)(kp + 32), b0 = *(const bf16x8*)(kp + 64), b1 = *(const bf16x8*)(kp + 96);
      const float zc_ = ozero(); f32x4 ca = {zc_, zc_, zc_, zc_}, cb2 = {zc_, zc_, zc_, zc_};
      ca = mfma16(qa[0][0], a0, ca); ca = mfma16(qa[0][1], a1, ca);
      cb2 = mfma16(qa[1][0], b0, cb2); cb2 = mfma16(qa[1][1], b1, cb2);
      const bool ok = valid && (kq == 0);
#pragma unroll
      for (int r = 0; r < 4; r++) { lgA[t][r] = ok ? ca[r] * 0.125f : -3.0e38f; lgB[t][r] = ok ? cb2[r] * 0.125f : -3.0e38f; }
    }
    __builtin_amdgcn_wave_barrier();
#define DSA_SOFTMAX(LG, GRP)                                                                                            \
    {                                                                                                                   \
      float mx[4];                                                                                                      \
      _Pragma("unroll") for (int r = 0; r < 4; r++) {                                                                   \
        float m = LG[0][r];                                                                                             \
        _Pragma("unroll") for (int t = 1; t < 16; t++) m = fmaxf(m, LG[t][r]);                                          \
        m = fmaxf(m, DPP_ROR(m, 8)); m = fmaxf(m, DPP_ROR(m, 4)); m = fmaxf(m, DPP_ROR(m, 2)); m = fmaxf(m, DPP_ROR(m, 1)); \
        mx[r] = __int_as_float(__builtin_amdgcn_readfirstlane(__float_as_int(m)));                                      \
      }                                                                                                                 \
      _Pragma("unroll") for (int r = 0; r < 4; r++) {                                                                   \
        float s = 0.f;                                                                                                  \
        _Pragma("unroll") for (int t = 0; t < 16; t++) { float e = (LG[t][r] > -1.0e38f) ? __expf(LG[t][r] - mx[r]) : 0.f; LG[t][r] = e; s += e; } \
        s += DPP_ROR(s, 8); s += DPP_ROR(s, 4); s += DPP_ROR(s, 2); s += DPP_ROR(s, 1);                                  \
        ssum[GRP][r] = __int_as_float(__builtin_amdgcn_readfirstlane(__float_as_int(s)));                              \
      }                                                                                                                 \
      if (kq == 0) {                                                                                                    \
        _Pragma("unroll") for (int t = 0; t < 16; t++)                                                                  \
          *(uint2*)(Pb + (t * 16 + n16) * 8 + GRP * 4) = make_uint2(pk2(LG[t][0], LG[t][1]), pk2(LG[t][2], LG[t][3]));  \
      }                                                                                                                 \
    }
    DSA_SOFTMAX(lgA, 0)
    DSA_SOFTMAX(lgB, 1)
    __builtin_amdgcn_wave_barrier();
    float o[64];
#pragma unroll
    for (int i = 0; i < 64; i++) o[i] = ozero();
    const int ksg = lane >> 3, dc = lane & 7;
#pragma unroll 8
    for (int stp = 0; stp < 32; stp++) {
      const int slot = stp * 8 + ksg;
      const int key = (slot < n) ? (16383 - (int)(sel[slot] & 0x3FFFu)) : 0;
      uint4 pp = *(const uint4*)(Pb + slot * 8);
      const bf* vp = p.KVC + (tokb + key) * 256 + 128 + dc * 8;
      uint4 va = *(const uint4*)vp, vb = *(const uint4*)(vp + 64);
      float ph[8] = {bflo(pp.x), bfhi(pp.x), bflo(pp.y), bfhi(pp.y), bflo(pp.z), bfhi(pp.z), bflo(pp.w), bfhi(pp.w)};
      float v0[8] = {bflo(va.x), bfhi(va.x), bflo(va.y), bfhi(va.y), bflo(va.z), bfhi(va.z), bflo(va.w), bfhi(va.w)};
      float v1[8] = {bflo(vb.x), bfhi(vb.x), bflo(vb.y), bfhi(vb.y), bflo(vb.z), bfhi(vb.z), bflo(vb.w), bfhi(vb.w)};
#pragma unroll
      for (int hh = 0; hh < 4; hh++)
#pragma unroll
        for (int d = 0; d < 8; d++) { o[hh * 8 + d] += ph[hh] * v0[d]; o[(4 + hh) * 8 + d] += ph[4 + hh] * v1[d]; }
    }
    __builtin_amdgcn_wave_barrier();
    const bool b5 = (lane >> 5) & 1, b4 = (lane >> 4) & 1, b3 = (lane >> 3) & 1;
    float o32[32], o16[16], o8[8];
#pragma unroll
    for (int i = 0; i < 32; i++) { float lo = o[i], hi = o[32 + i]; float snd = b5 ? lo : hi; float kp = b5 ? hi : lo; o32[i] = kp + __shfl_xor(snd, 32); }
#pragma unroll
    for (int i = 0; i < 16; i++) { float lo = o32[i], hi = o32[16 + i]; float snd = b4 ? lo : hi; float kp = b4 ? hi : lo; o16[i] = kp + __shfl_xor(snd, 16); }
#pragma unroll
    for (int i = 0; i < 8; i++) { float lo = o16[i], hi = o16[8 + i]; float snd = b3 ? lo : hi; float kp = b3 ? hi : lo; o8[i] = kp + __shfl_xor(snd, 8); }
    const float s_g0 = b4 ? (b3 ? ssum[0][3] : ssum[0][2]) : (b3 ? ssum[0][1] : ssum[0][0]);
    const float s_g1 = b4 ? (b3 ? ssum[1][3] : ssum[1][2]) : (b3 ? ssum[1][1] : ssum[1][0]);
    const float rinv = 1.f / (b5 ? s_g1 : s_g0);
    const int hsel = (b5 ? 4 : 0) + (b4 ? 2 : 0) + (b3 ? 1 : 0);
    const int col = hsel * 64 + dc * 8;
    uint4 zz = *(const uint4*)(p.P + tq * PW + C_ATZ + col);
    uint4 ov;
    ov.x = pk2(o8[0] * rinv * siluf_(bflo(zz.x)), o8[1] * rinv * siluf_(bfhi(zz.x)));
    ov.y = pk2(o8[2] * rinv * siluf_(bflo(zz.y)), o8[3] * rinv * siluf_(bfhi(zz.y)));
    ov.z = pk2(o8[4] * rinv * siluf_(bflo(zz.z)), o8[5] * rinv * siluf_(bfhi(zz.z)));
    ov.w = pk2(o8[6] * rinv * siluf_(bflo(zz.w)), o8[7] * rinv * siluf_(bfhi(zz.w)));
    *(uint4*)(p.Y + tq * YW + Y_ATT + col) = ov;
  }
}

__device__ __forceinline__ void phaseB(const Params& p, int layer, char* sm0) {
  const int total = 512 + 2048 + 2048;
  char* sm = sm0 + HB * HALF_LDS;
  for (int t = VB; t < total; t += G2) {
    if (t < 512) ssd_pass1(p, layer, t, sm);
    else if (t < 2560) s5_pass1(p, layer, t - 512, sm);
    else mem_attn(p, layer, t - 2560);
  }
}
__device__ __forceinline__ void phaseC(const Params& p, int layer, char* sm0, bool dsa_only) {
  const int G = G2;
  const int total = dsa_only ? 1024 : 1024 + 256 + 16;
  char* sm = sm0 + HB * HALF_LDS;
  int rr = 0;
  for (int i = VB; i < total; i += G, rr++) {
    if (i < 1024) {
      int pos = i - rr * G; int idx = i;
      if ((rr & 1) && (rr * G + G <= 1024)) idx = rr * G + (G - 1 - pos);
      __syncthreads();
      dsa_wave(p, idx * 4 + (otid() >> 6), sm);
    } else if (i < 1280) ssd_statepass(p, i - 1024);
    else s5_carry(p, layer, i - 1280);
  }
}
__device__ __forceinline__ void phaseD(const Params& p, int layer, char* sm0) {
  const int total = 256 + 1024;
  char* sm = sm0 + HB * HALF_LDS;
  const int vb = VB;
  if (G2 == 512) {
    if (vb < 256) { s5_pass2(p, layer, vb, sm); ssd_pass2(p, layer, vb, sm); }
    else {
#pragma unroll 1
      for (int k = 0; k < 3; k++) ssd_pass2(p, layer, 256 + (vb - 256) * 3 + k, sm);
    }
  } else {
    for (int t = vb; t < total; t += G2) {
      if (t < 256) s5_pass2(p, layer, t, sm);
      else ssd_pass2(p, layer, t - 256, sm);
    }
  }
}

__device__ __forceinline__ void phaseE(const Params& p, int layer) {
  const int tidf = otid_full();
  const int wid = __builtin_amdgcn_readfirstlane(tidf >> 6), lane = tidf & 63, wr = wid >> 2, wc = wid & 3, fr = lane & 15, fq = lane >> 4;
  const bf* Wl = p.WinT + (size_t)layer * INW * 2048;
  const bf* Wb = p.WbrT + (size_t)layer * 2048 * YW;
  bf* merged = p.P;
  char* gsb = (char*)p.GS + (size_t)blockIdx.x * 131072;
  const unsigned gs_lane0 = (unsigned)tidf * 16u, lane_c40 = (unsigned)fq * 16u, lane_m0 = (unsigned)(fr * 2048 + fq * 4) * 2u;
  for (int L = blockIdx.x; L < 1024; L += gridDim.x) {
    int pm, pn; tile_order(L, 128, 8, pm, pn);
    const int brow = pm * 256, bcol = pn * 256;
#pragma unroll 1
    for (int s = 0; s < 8; s++) {
      const int br = s >> 1; const bool isBr = (s & 1) != 0;
      const int koff = br == 0 ? 0 : (br == 1 ? 512 : (br == 2 ? 1024 : 2048));
      const int kb = br == 2 ? 1024 : (br == 3 ? 256 : 512);
      const bf* A_ = isBr ? p.Y + koff : p.xb; const int lda_ = isBr ? YW : 2048;
      const bf* B_ = isBr ? Wb + koff : Wl + (size_t)(5716 + br * 2048) * 2048; const int ldb_ = isBr ? YW : 2048;
      const int K_ = isBr ? kb : 2048;
      f32x4 acc[2][2][4][2]; ZERO_ACC8(acc);
      gemm256(A_, lda_, B_, ldb_, K_, brow, bcol, acc);
      unsigned gs_lane = gs_lane0, lane_c4 = lane_c40, lane_m = lane_m0;
      asm volatile("" : "+v"(gs_lane), "+v"(lane_c4), "+v"(lane_m));
      if (!isBr) {
        const char* bgb = (const char*)(p.b_gate + (size_t)layer * 8192 + br * 2048 + bcol + wc * 32);
#pragma unroll
        for (int ai = 0; ai < 2; ai++)
#pragma unroll
          for (int bj = 0; bj < 2; bj++)
#pragma unroll
            for (int m = 0; m < 4; m++) {
              unsigned q[4];
#pragma unroll
              for (int n = 0; n < 2; n++) {
                float4 bg = *(const float4*)(bgb + (bj * 128 + n * 16) * 4 + lane_c4);
                f32x4 v = acc[ai][bj][m][n];
                q[2 * n] = pk2(sigmoidf_(v[0] + bg.x), sigmoidf_(v[1] + bg.y));
                q[2 * n + 1] = pk2(sigmoidf_(v[2] + bg.z), sigmoidf_(v[3] + bg.w));
              }
              *(uint4*)(gsb + ((ai * 2 + bj) * 4 + m) * 8192 + gs_lane) = make_uint4(q[0], q[1], q[2], q[3]);
              __builtin_amdgcn_sched_barrier(0);
            }
      } else {
        char* mb = (char*)merged + ((size_t)(brow + wr * 64) * 2048 + bcol + wc * 32) * 2;
#pragma unroll
        for (int ai = 0; ai < 2; ai++)
#pragma unroll
          for (int bj = 0; bj < 2; bj++) {
#pragma unroll
            for (int mh = 0; mh < 2; mh++) {
              uint4 g4[2]; uint2 old[2][2];
#pragma unroll
              for (int mm = 0; mm < 2; mm++) {
                const int m = mh * 2 + mm;
                g4[mm] = *(const uint4*)(gsb + ((ai * 2 + bj) * 4 + m) * 8192 + gs_lane);
                if (br) {
#pragma unroll
                  for (int n = 0; n < 2; n++)
                    old[mm][n] = *(const uint2*)(mb + ((size_t)(ai * 128 + m * 16) * 2048 + bj * 128 + n * 16) * 2 + lane_m);
                }
              }
#pragma unroll
              for (int mm = 0; mm < 2; mm++) {
                const int m = mh * 2 + mm;
                const unsigned gq[4] = {g4[mm].x, g4[mm].y, g4[mm].z, g4[mm].w};
#pragma unroll
                for (int n = 0; n < 2; n++) {
                  f32x4 v = acc[ai][bj][m][n];
                  float o0 = bflo(gq[2 * n]) * v[0], o1 = bfhi(gq[2 * n]) * v[1], o2 = bflo(gq[2 * n + 1]) * v[2], o3 = bfhi(gq[2 * n + 1]) * v[3];
                  char* mp = mb + ((size_t)(ai * 128 + m * 16) * 2048 + bj * 128 + n * 16) * 2 + lane_m;
                  if (br) { o0 += bflo(old[mm][n].x); o1 += bfhi(old[mm][n].x); o2 += bflo(old[mm][n].y); o3 += bfhi(old[mm][n].y); }
                  *(uint2*)mp = make_uint2(pk2(o0, o1), pk2(o2, o3));
                }
              }
              __builtin_amdgcn_sched_barrier(0);
            }
          }
      }
    }
  }
}

__device__ __forceinline__ void phaseF(const Params& p, int layer) {
  const int tidf = otid_full();
  const int wid = __builtin_amdgcn_readfirstlane(tidf >> 6), lane = tidf & 63, wr = wid >> 2, wc = wid & 3, fr = lane & 15, fq = lane >> 4;
  const bf* merged = p.P;
  const float* xres = layer == 0 ? p.x : p.out;
  for (int L = blockIdx.x; L < 1024; L += gridDim.x) {
    int pm, pn; tile_order(L, 128, 8, pm, pn);
    const int brow = pm * 256, bcol = pn * 256;
    f32x4 acc[2][2][4][2]; ZERO_ACC8(acc);
    gemm256(merged, 2048, p.WoutT + (size_t)layer * 2048 * 2048, 2048, 2048, brow, bcol, acc);
#pragma unroll
    for (int ai = 0; ai < 2; ai++)
#pragma unroll
      for (int m = 0; m < 4; m++) {
        const size_t tok = brow + ai * 128 + wr * 64 + m * 16 + fr;
#pragma unroll
        for (int bj = 0; bj < 2; bj++)
#pragma unroll
          for (int n = 0; n < 2; n++) {
            const int col = bcol + bj * 128 + wc * 32 + n * 16 + fq * 4;
            float4 xr = *(const float4*)(xres + tok * 2048 + col);
            f32x4 v = acc[ai][bj][m][n];
            float4 o;
            o.x = 1.41421356237f * xr.x + v[0]; o.y = 1.41421356237f * xr.y + v[1];
            o.z = 1.41421356237f * xr.z + v[2]; o.w = 1.41421356237f * xr.w + v[3];
            *(float4*)(p.out + tok * 2048 + col) = o;
          }
      }
  }
}

__device__ __forceinline__ void phaseG(const Params& p, int layer) {
  const int lane = otid() & 63, w = otid() >> 6;
  const float* g = p.ln_g + layer * 2048; const float* bb = p.ln_b + layer * 2048;
  for (int t = VB; t < TT / 4; t += G2) {
    const size_t row = (size_t)t * 4 + w;
    float* xp = p.out + row * 2048;
    float4 v[8]; float s = 0.f;
#pragma unroll
    for (int i = 0; i < 8; i++) { v[i] = *(const float4*)(xp + (i * 64 + lane) * 4); s += v[i].x + v[i].y + v[i].z + v[i].w; }
#pragma unroll
    for (int off = 1; off < 64; off <<= 1) s += __shfl_xor(s, off);
    const float mu = s * (1.f / 2048.f);
    float q = 0.f;
#pragma unroll
    for (int i = 0; i < 8; i++) {
      float a = v[i].x - mu, b = v[i].y - mu, c = v[i].z - mu, d = v[i].w - mu; q += a * a + b * b + c * c + d * d;
    }
#pragma unroll
    for (int off = 1; off < 64; off <<= 1) q += __shfl_xor(q, off);
    const float rs = rsqrtf(q * (1.f / 2048.f) + 1e-5f);
#pragma unroll
    for (int i = 0; i < 8; i++) {
      const int col = (i * 64 + lane) * 4;
      float4 gg = *(const float4*)(g + col), bv = *(const float4*)(bb + col);
      float4 o;
      o.x = (v[i].x - mu) * rs * gg.x + bv.x; o.y = (v[i].y - mu) * rs * gg.y + bv.y;
      o.z = (v[i].z - mu) * rs * gg.z + bv.z; o.w = (v[i].w - mu) * rs * gg.w + bv.w;
      *(float4*)(xp + col) = o;
      if (layer == 0) *(uint2*)(p.xb + row * 2048 + col) = make_uint2(pk2(o.x, o.y), pk2(o.z, o.w));
    }
  }
}

__global__ void __launch_bounds__(512, 2) mega_kernel(Params p) {
  char* sm = dynsm;
  cg::grid_group grid = cg::this_grid();
  phase0(p, sm); grid.sync();
#pragma unroll 1
  for (int layer = 0; layer < 2; layer++) {
    int nA = (PROBE_MASK & 1) ? 2 : 1, nB = (PROBE_MASK & 2) ? 2 : 1, nC = (PROBE_MASK & 4) ? 2 : 1, nD = (PROBE_MASK & 8) ? 2 : 1, nE = (PROBE_MASK & 16) ? 2 : 1;
    asm volatile("" : "+s"(nA), "+s"(nB), "+s"(nC), "+s"(nD), "+s"(nE));
#pragma unroll 1
    for (int r = 0; r < nA; r++) phaseA(p, layer);
    grid.sync();
#pragma unroll 1
    for (int r = 0; r < nB; r++) phaseB(p, layer, sm);
    grid.sync();
#pragma unroll 1
    for (int r = 0; r < nC; r++) phaseC(p, layer, sm, r + 1 < nC);
    grid.sync();
#pragma unroll 1
    for (int r = 0; r < nD; r++) phaseD(p, layer, sm);
    grid.sync();
#pragma unroll 1
    for (int r = 0; r < nE; r++) phaseE(p, layer);
    grid.sync();
    phaseF(p, layer); grid.sync();
    phaseG(p, layer);
    if (layer == 0) grid.sync();
  }
}

extern "C" void kernel_launch(void* const* d_in, const int* in_sizes, int n_in, void* d_out, int out_size, void* d_ws,
                              size_t ws_size, hipStream_t stream) {
  Params p{};
  p.x = (const float*)d_in[0]; p.mem = (const float*)d_in[1]; p.pos = (const int*)d_in[2];
  p.w_in = (const float*)d_in[3]; p.b_gate = (const float*)d_in[4]; p.lam_re = (const float*)d_in[5];
  p.lam_im = (const float*)d_in[6]; p.log_dt = (const float*)d_in[7]; p.b_re = (const float*)d_in[8];
  p.b_im = (const float*)d_in[9]; p.c_re = (const float*)d_in[10]; p.c_im = (const float*)d_in[11];
  p.s5_d = (const float*)d_in[12]; p.w_glu = (const float*)d_in[13]; p.b_glu = (const float*)d_in[14];
  p.conv_w = (const float*)d_in[15]; p.conv_b = (const float*)d_in[16]; p.dt_bias = (const float*)d_in[17];
  p.a_log = (const float*)d_in[18]; p.ssd_d = (const float*)d_in[19]; p.norm_g = (const float*)d_in[20];
  p.mem_w_kv = (const float*)d_in[21]; p.w_br_s5 = (const float*)d_in[22]; p.w_br_attn = (const float*)d_in[23];
  p.w_br_ssd = (const float*)d_in[24]; p.w_br_mem = (const float*)d_in[25]; p.w_out = (const float*)d_in[26];
  p.ln_g = (const float*)d_in[27]; p.ln_b = (const float*)d_in[28];
  p.out = (float*)d_out;
  char* ws = (char*)d_ws; size_t off = 0;
  auto carve = [&](size_t bytes) { char* r = ws + off; off += (bytes + 255) & ~(size_t)255; return r; };
  p.WinT = (bf*)carve((size_t)2 * INW * 2048 * 2);
  p.WbrT = (bf*)carve((size_t)2 * 2048 * YW * 2);
  p.WoutT = (bf*)carve((size_t)2 * 2048 * 2048 * 2);
  p.WgluT = (bf*)carve((size_t)2 * 512 * 512 * 2);
  p.WmemT = (bf*)carve((size_t)2 * 512 * 2048 * 2);
  p.memb = (bf*)carve((size_t)512 * 2048 * 2);
  p.xb = (bf*)carve((size_t)TT * 2048 * 2);
  p.P = (bf*)carve((size_t)TT * PW * 2);
  p.Y = (bf*)carve((size_t)TT * YW * 2);
  p.YG = (bf*)carve((size_t)TT * 512 * 2);
  p.KIF = (bf*)carve((size_t)TT * 64 * 2);
  p.MK = (bf*)carve((size_t)2 * 2 * 4 * 256 * 64 * 2);
  p.MVT = (bf*)carve((size_t)2 * 2 * 4 * 256 * 64 * 2);
  p.CM = (bf*)carve((size_t)2 * 32 * 16 * 128 * 2);
  p.ST = (float*)carve((size_t)2 * 128 * 131072 * 4);
  p.CS = (float*)carve((size_t)TT * 16 * 4);
  p.END = (float*)carve((size_t)2 * 128 * 32 * 64 * 2 * 4);
  p.CD = (float*)carve((size_t)2 * 128 * 16 * 4);
  p.SB = (float*)carve((size_t)2 * 32 * 64 * 32 * 4);
  p.SA = (float*)carve((size_t)2 * 32 * 64 * 4 * 4);
  p.KVC = (bf*)carve((size_t)TT * 256 * 2);
  p.GS = (bf*)carve((size_t)256 * 16 * 512 * 16);
  if (off > ws_size) { fprintf(stderr, "workspace too small: need %zu have %zu\n", off, ws_size); return; }
  for (int j = 0; j < 8; j++) p.inv[j] = (float)pow(500000.0, -(double)j / 8.0);
  const size_t kDynLds = 2 * HALF_LDS;
  static int grid_blocks = 0;
  if (!grid_blocks) {
    int dev = 0, cus = 0, per_cu = 0;
    (void)hipGetDevice(&dev);
    (void)hipDeviceGetAttribute(&cus, hipDeviceAttributeMultiprocessorCount, dev);
    (void)hipFuncSetAttribute((const void*)mega_kernel, hipFuncAttributeMaxDynamicSharedMemorySize, (int)kDynLds);
    (void)hipOccupancyMaxActiveBlocksPerMultiprocessor(&per_cu, mega_kernel, 512, kDynLds);
    if (per_cu > 1) per_cu = 1;
    grid_blocks = cus * per_cu;
    if (grid_blocks > 256) grid_blocks = 256;
    grid_blocks -= grid_blocks % 8;
  }
  void* args[] = {&p};
  hipError_t e = hipLaunchCooperativeKernel((void*)mega_kernel, dim3(grid_blocks), dim3(512), args, kDynLds, stream);
  if (e != hipSuccess) fprintf(stderr, "cooperative launch failed: %s (grid %d)\n", hipGetErrorString(e), grid_blocks);
}
```

```cpp
#include <hip/hip_runtime.h>
#include <hip/hip_cooperative_groups.h>
#include <cstdio>
#include <cmath>
namespace cg = cooperative_groups;

#ifndef MK_COOP
#define MK_COOP 1
#endif
#ifndef PROBE_MASK
#define PROBE_MASK 0
#endif

typedef unsigned short bf;
typedef short bf16x8 __attribute__((ext_vector_type(8)));
typedef float f32x16 __attribute__((ext_vector_type(16)));
typedef float f32x4 __attribute__((ext_vector_type(4)));

#define TT 32768
#define LSEQ 16384
#define DM 2048
#define INW 13908
#define PW 5760
#define C_S5U 0
#define C_S5Z 512
#define C_ATQ 1024
#define C_ATK 1536
#define C_ATV 1664
#define C_ATZ 1792
#define C_IDQ 2304
#define C_IDK 2560
#define C_IDW 2624
#define C_SSZ 2640
#define C_XBC 3664
#define C_SDT 5200
#define C_MEQ 5216
#define C_MEZ 5472
#define YW 2304
#define Y_S5 0
#define Y_ATT 512
#define Y_SSD 1024
#define Y_MEM 2048
#define CAP 480
#define HALF_LDS 77824

struct Params {
  const float *x, *mem; const int* pos;
  const float *w_in, *b_gate, *lam_re, *lam_im, *log_dt, *b_re, *b_im, *c_re, *c_im, *s5_d, *w_glu, *b_glu,
      *conv_w, *conv_b, *dt_bias, *a_log, *ssd_d, *norm_g, *mem_w_kv, *w_br_s5, *w_br_attn, *w_br_ssd, *w_br_mem,
      *w_out, *ln_g, *ln_b;
  float* out;
  bf *WinT, *WbrT, *WoutT, *WgluT, *WmemT, *memb, *xb, *P, *Y, *YG, *KIF, *MK, *MVT, *CM, *KVC, *GS;
  float *ST, *CS, *END, *CD, *SB, *SA;
  float inv[8];
};

__device__ __forceinline__ float ozero() { float z = 0.f; asm volatile("" : "+v"(z)); return z; }
__device__ __forceinline__ int otid_full() { int t = threadIdx.x; asm volatile("" : "+v"(t)); return t; }
__device__ __forceinline__ int otid() { return otid_full() & 255; }
#define HB (__builtin_amdgcn_readfirstlane(otid_full() >> 8))
#define VB ((int)blockIdx.x * 2 + HB)
#define G2 ((int)gridDim.x * 2)
__device__ __forceinline__ float bf2f(bf v) { return __uint_as_float(((unsigned)v) << 16); }
__device__ __forceinline__ float bflo(unsigned u) { return __uint_as_float(u << 16); }
__device__ __forceinline__ float bfhi(unsigned u) { return __uint_as_float(u & 0xFFFF0000u); }
typedef float f32x2p_t __attribute__((ext_vector_type(2)));
typedef __bf16 bf16x2p_t __attribute__((ext_vector_type(2)));
__device__ __forceinline__ unsigned pk2(float lo, float hi) {
  f32x2p_t v = {lo, hi};
  return __builtin_bit_cast(unsigned, __builtin_convertvector(v, bf16x2p_t));
}
__device__ __forceinline__ bf f2bf(float f) { return (bf)(pk2(f, 0.f) & 0xFFFFu); }
__device__ __forceinline__ float sigmoidf_(float x) { return __builtin_amdgcn_rcpf(1.f + __expf(-x)); }
__device__ __forceinline__ float siluf_(float x) { return x * __builtin_amdgcn_rcpf(1.f + __expf(-x)); }
__device__ __forceinline__ float geluf_(float x) {
  float u = 0.7978845608028654f * (x + 0.044715f * x * x * x);
  float t = 1.f - 2.f * __builtin_amdgcn_rcpf(1.f + __expf(2.f * u));
  return 0.5f * x * (1.f + t);
}
__device__ __forceinline__ f32x16 mfma32(bf16x8 a, bf16x8 b, f32x16 c) { return __builtin_amdgcn_mfma_f32_32x32x16_bf16(a, b, c, 0, 0, 0); }
__device__ __forceinline__ f32x4 mfma16(bf16x8 a, bf16x8 b, f32x4 c) { return __builtin_amdgcn_mfma_f32_16x16x32_bf16(a, b, c, 0, 0, 0); }

__device__ __forceinline__ bool tile_map(int L, int nMt, int nNt, int SM, int SN, int& tm, int& tn) {
  int per = SM * SN; int x = L & 7; int jj = L >> 3; int sl = jj / per; int j = jj - sl * per; int S = sl * 8 + x;
  int nSn = nNt / SN; int NS = (nMt / SM) * nSn;
  if (S >= NS) return false;
  int mg = S / nSn, ng = S - mg * nSn;
  tm = mg * SM + j / SN; tn = ng * SN + j % SN; return true;
}

typedef unsigned u32x4 __attribute__((ext_vector_type(4)));
struct GStage { u32x4 a0, a1, b0, b1; };
#define G_LOAD(S, ko) { S.a0 = *(const u32x4*)(ga + (ko)); S.a1 = *(const u32x4*)(ga + a64 + (ko)); S.b0 = *(const u32x4*)(gb + (ko)); S.b1 = *(const u32x4*)(gb + b64 + (ko)); }
#define G_WRITE(S, base) { *(u32x4*)(sA + (base) + woff) = S.a0; *(u32x4*)(sA + (base) + woff + 5120) = S.a1; *(u32x4*)(sB + (base) + woff) = S.b0; *(u32x4*)(sB + (base) + woff + 5120) = S.b1; }
#define G_ITER(kt, cur, S)                                                          \
  {                                                                                 \
    _Pragma("unroll") for (int ks = 0; ks < 2; ks++) {                              \
      bf16x8 a0 = *(const bf16x8*)(sA + (cur) + aoff + ks * 32);                    \
      bf16x8 a1 = *(const bf16x8*)(sA + (cur) + aoff + 2560 + ks * 32);             \
      bf16x8 b0 = *(const bf16x8*)(sB + (cur) + boff + ks * 32);                    \
      bf16x8 b1 = *(const bf16x8*)(sB + (cur) + boff + 2560 + ks * 32);             \
      acc[0][0] = mfma32(b0, a0, acc[0][0]);                                        \
      acc[0][1] = mfma32(b1, a0, acc[0][1]);                                        \
      acc[1][0] = mfma32(b0, a1, acc[1][0]);                                        \
      acc[1][1] = mfma32(b1, a1, acc[1][1]);                                        \
    }                                                                               \
    if ((kt) + 1 < nk) {                                                            \
      G_WRITE(S, 10240 - (cur))                                                     \
      if ((kt) + 1 + D < nk) G_LOAD(S, ((kt) + 1 + D) * 32)                         \
    }                                                                               \
    __syncthreads();                                                                \
  }
template <int D>
__device__ __forceinline__ void gemm_acc(const bf* __restrict__ A, int lda, const bf* __restrict__ Bt, int ldb, int K,
                                         f32x16 (&acc)[2][2], char* sm) {
  const int tid = otid(), lane = tid & 63, w = tid >> 6, wr = w >> 1, wc = w & 1, r32 = lane & 31, h5 = lane >> 5;
  const int lrow = tid >> 2, lch = tid & 3;
  const bf* ga = A + (size_t)lrow * lda + lch * 8;
  const bf* gb = Bt + (size_t)lrow * ldb + lch * 8;
  const size_t a64 = (size_t)64 * lda, b64 = (size_t)64 * ldb;
  const int nk = K >> 5;
  char* sA = sm; char* sB = sm + 20480;
  const int woff = lrow * 80 + lch * 16;
  const int aoff = (wr * 64 + r32) * 80 + h5 * 16, boff = (wc * 64 + r32) * 80 + h5 * 16;
  GStage S0, S1, S2, S3;
  G_LOAD(S0, 0) G_LOAD(S1, 32)
  if (D == 4) { G_LOAD(S2, 64) G_LOAD(S3, 96) }
  G_WRITE(S0, 0)
  if (D < nk) G_LOAD(S0, D * 32)
  __syncthreads();
  for (int kt0 = 0; kt0 < nk; kt0 += D) {
    if (D == 4) {
      G_ITER(kt0, 0, S1) G_ITER(kt0 + 1, 10240, S2) G_ITER(kt0 + 2, 0, S3) G_ITER(kt0 + 3, 10240, S0)
    } else {
      G_ITER(kt0, 0, S1) G_ITER(kt0 + 1, 10240, S0)
    }
  }
}
#define ZERO_ACC(a) { const float z_ = ozero(); for (int i_ = 0; i_ < 2; i_++) for (int j_ = 0; j_ < 2; j_++) for (int r_ = 0; r_ < 16; r_++) a[i_][j_][r_] = z_; }


extern __shared__ __attribute__((aligned(16))) char dynsm[];
#define G8_HT (128 * 64)
#define G8_SA(b, h) ((bf*)dynsm + ((b) * 2 + (h)) * G8_HT)
#define G8_SB(b, h) ((bf*)dynsm + (4 + (b) * 2 + (h)) * G8_HT)
__device__ __forceinline__ int g8_lds_byte(int r, int c) {
  int st = (r >> 4) * 2 + (c >> 5), rr = r & 15, cc = c & 31, ob = rr * 64 + cc * 2;
  return st * 1024 + (ob ^ (((ob >> 9) & 1) << 5));
}
__device__ __forceinline__ void g8_stage_rc(int b, int& R, int& C) {
  int st = b / 1024, sb = b % 1024, swz = sb ^ (((sb >> 9) & 1) << 5);
  R = (st >> 1) * 16 + swz / 64; C = (st & 1) * 32 + (swz % 64) / 2;
}
#define G8_LAS __attribute__((address_space(3)))
#define G8_HTB (128 * 64 * 2)
#define G8_OSA(b, h) (((b) * 2 + (h)) * G8_HTB)
#define G8_OSB(b, h) ((4 + (b) * 2 + (h)) * G8_HTB)
#define G8_STAGE(bufoff, gbase, voff) do { _Pragma("unroll") for (int _i = 0; _i < 2; ++_i) \
    __builtin_amdgcn_global_load_lds((const unsigned*)((const char*)(gbase) + (voff)[_i]), (G8_LAS unsigned*)(lds + (bufoff) + ldsw + _i * 8192), 16, 0, 0); } while (0)
#define G8_LDA(dst, b, h) do { _Pragma("unroll") for (int m = 0; m < 4; ++m) _Pragma("unroll") for (int k = 0; k < 2; ++k) dst[m][k] = *(const G8_LAS bf16x8*)(lds + G8_OSA(b, h) + aoff + m * 2048 + k * 1024); } while (0)
#define G8_LDB(dst, b, h) do { _Pragma("unroll") for (int n = 0; n < 2; ++n) _Pragma("unroll") for (int k = 0; k < 2; ++k) dst[n][k] = *(const G8_LAS bf16x8*)(lds + G8_OSB(b, h) + boff + n * 2048 + k * 1024); } while (0)
#define G8_MMA(ai, bj, At_, Bt_) do { __builtin_amdgcn_s_setprio(1);                                                 \
    _Pragma("unroll") for (int m = 0; m < 4; ++m) _Pragma("unroll") for (int n = 0; n < 2; ++n) _Pragma("unroll") for (int k = 0; k < 2; ++k) \
      acc[ai][bj][m][n] = __builtin_amdgcn_mfma_f32_16x16x32_bf16(Bt_[n][k], At_[m][k], acc[ai][bj][m][n], 0, 0, 0); \
    __builtin_amdgcn_s_setprio(0); } while (0)
#define G8_WAIT_V(n) asm volatile("s_waitcnt vmcnt(" #n ")" ::: "memory")
#define G8_WAIT_L(n) asm volatile("s_waitcnt lgkmcnt(" #n ")" ::: "memory")
#define G8_BAR __builtin_amdgcn_s_barrier()
#define G8_SCHED __builtin_amdgcn_sched_barrier(0)

__device__ __forceinline__ void gemm256(const bf* __restrict__ A, int lda, const bf* __restrict__ Bt, int ldb, int K,
                                        int brow, int bcol, f32x4 (&acc)[2][2][4][2]) {
  G8_LAS unsigned char* lds = (G8_LAS unsigned char*)dynsm;
  const int tid = otid_full(), wid = __builtin_amdgcn_readfirstlane(tid >> 6), lane = tid & 63, wr = wid >> 2, wc = wid & 3, fr = lane & 15, fq = lane >> 4;
  unsigned voffA[2], voffB[2];
#pragma unroll
  for (int i = 0; i < 2; ++i) { int R, C; g8_stage_rc(tid * 16 + i * 8192, R, C); voffA[i] = (unsigned)(R * lda + C) * 2u; voffB[i] = (unsigned)(R * ldb + C) * 2u; }
  const size_t kstep = 128;
  const size_t hstepA = (size_t)128 * lda * 2, hstepB = (size_t)128 * ldb * 2;
  const unsigned ldsw = (unsigned)wid * 1024u;
  const int aoff = g8_lds_byte(wr * 64 + fr, fq * 8), boff = g8_lds_byte(wc * 32 + fr, fq * 8);
  const char* cA = (const char*)A + (size_t)brow * lda * 2; const char* cB = (const char*)Bt + (size_t)bcol * ldb * 2;
  bf16x8 At[4][2], B0[2][2], B1[2][2];
  const int nt = K / 64;
  __syncthreads();
  G8_STAGE(G8_OSB(0, 0), cB, voffB); G8_STAGE(G8_OSA(0, 0), cA, voffA); G8_STAGE(G8_OSB(0, 1), cB + hstepB, voffB); G8_STAGE(G8_OSA(0, 1), cA + hstepA, voffA);
  if (wr == 1) G8_BAR;
  G8_WAIT_V(4); G8_BAR;
  G8_STAGE(G8_OSB(1, 0), cB + kstep, voffB); G8_STAGE(G8_OSA(1, 0), cA + kstep, voffA); G8_STAGE(G8_OSB(1, 1), cB + hstepB + kstep, voffB);
  G8_WAIT_V(6); G8_BAR;
  for (int t = 0; t < nt - 2; t += 2) {
    const char* a1 = cA + (size_t)(t + 1) * kstep;
    const char* a2 = cA + (size_t)(t + 2) * kstep; const char* b2 = cB + (size_t)(t + 2) * kstep;
    const char* a3 = a2 + kstep; const char* b3 = b2 + kstep;
    G8_LDB(B0, 0, 0); G8_SCHED; G8_LDA(At, 0, 0); G8_STAGE(G8_OSA(1, 1), a1 + hstepA, voffA);
    G8_WAIT_L(8); G8_BAR; G8_WAIT_L(0); G8_MMA(0, 0, At, B0); G8_BAR; G8_SCHED;
    G8_LDB(B1, 0, 1); G8_STAGE(G8_OSB(0, 0), b2, voffB);
    G8_BAR; G8_WAIT_L(0); G8_MMA(0, 1, At, B1); G8_BAR;
    G8_LDA(At, 0, 1); G8_STAGE(G8_OSA(0, 0), a2, voffA);
    G8_BAR; G8_WAIT_L(0); G8_MMA(1, 0, At, B0); G8_BAR; G8_SCHED;
    G8_STAGE(G8_OSB(0, 1), b2 + hstepB, voffB);
    G8_WAIT_V(6); G8_BAR; G8_MMA(1, 1, At, B1); G8_BAR;
    G8_LDB(B0, 1, 0); G8_SCHED; G8_LDA(At, 1, 0); G8_STAGE(G8_OSA(0, 1), a2 + hstepA, voffA);
    G8_WAIT_L(8); G8_BAR; G8_WAIT_L(0); G8_MMA(0, 0, At, B0); G8_BAR; G8_SCHED;
    G8_LDB(B1, 1, 1); G8_STAGE(G8_OSB(1, 0), b3, voffB);
    G8_BAR; G8_WAIT_L(0); G8_MMA(0, 1, At, B1); G8_BAR;
    G8_LDA(At, 1, 1); G8_STAGE(G8_OSA(1, 0), a3, voffA);
    G8_BAR; G8_WAIT_L(0); G8_MMA(1, 0, At, B0); G8_BAR; G8_SCHED;
    G8_STAGE(G8_OSB(1, 1), b3 + hstepB, voffB);
    G8_WAIT_V(6); G8_BAR; G8_MMA(1, 1, At, B1); G8_BAR;
  }
  { const char* a1 = cA + (size_t)(nt - 1) * kstep;
    G8_LDB(B0, 0, 0); G8_LDA(At, 0, 0); G8_STAGE(G8_OSA(1, 1), a1 + hstepA, voffA);
    G8_BAR; G8_WAIT_L(0); G8_MMA(0, 0, At, B0); G8_BAR;
    G8_LDB(B1, 0, 1); G8_BAR; G8_WAIT_L(0); G8_MMA(0, 1, At, B1); G8_BAR;
    G8_LDA(At, 0, 1); G8_WAIT_V(4); G8_BAR; G8_WAIT_L(0); G8_MMA(1, 0, At, B0); G8_MMA(1, 1, At, B1); G8_BAR; }
  { G8_LDB(B0, 1, 0); G8_LDA(At, 1, 0); G8_WAIT_V(2); G8_BAR; G8_WAIT_L(0); G8_MMA(0, 0, At, B0); G8_BAR;
    G8_LDB(B1, 1, 1); G8_WAIT_V(0); G8_BAR; G8_WAIT_L(0); G8_MMA(0, 1, At, B1); G8_BAR;
    G8_LDA(At, 1, 1); G8_BAR; G8_WAIT_L(0); G8_MMA(1, 0, At, B0); G8_MMA(1, 1, At, B1); G8_BAR; }
  if (wr == 0) G8_BAR;
}
#define ZERO_ACC8(a) { float z_ = 0.f; asm volatile("" : "+v"(z_)); _Pragma("unroll") for (int i_ = 0; i_ < 2; i_++) _Pragma("unroll") for (int j_ = 0; j_ < 2; j_++) _Pragma("unroll") for (int m_ = 0; m_ < 4; m_++) _Pragma("unroll") for (int n_ = 0; n_ < 2; n_++) a[i_][j_][m_][n_] = (f32x4){z_, z_, z_, z_}; }
__device__ __forceinline__ bool tile_order(int L, int nM, int nN, int& pm, int& pn) {
  const int nwg = nM * nN; if (L >= nwg) return false;
  int wgid = L; { const int q = nwg / 8, r = nwg % 8, xcd = wgid % 8, off = wgid / 8; wgid = (xcd < r ? xcd * (q + 1) : r * (q + 1) + (xcd - r) * q) + off; }
  const int nig = 8 * nN, gid = wgid / nig, fm = gid * 8, gsz = (nM - fm) < 8 ? (nM - fm) : 8;
  pm = fm + ((wgid % nig) % gsz); pn = (wgid % nig) / gsz; return true;
}

__device__ __forceinline__ void transpose_tile(const float* __restrict__ src, int R, int C, bf* __restrict__ dst, int ldd, int off, int tile, bf* sm) {
  const int tilesC = (C + 63) >> 6;
  const int tr = tile / tilesC, tc = tile - tr * tilesC;
  const int r0 = tr * 64, c0 = tc * 64;
  const int tid = otid();
#pragma unroll
  for (int i = 0; i < 4; i++) {
    int r = (tid >> 4) + 16 * i; int c = (tid & 15) * 4;
    const float zt_ = ozero(); float4 v = make_float4(zt_, zt_, zt_, zt_);
    if (c0 + c < C) v = *(const float4*)(src + (size_t)(r0 + r) * C + c0 + c);
    sm[(c + 0) * 66 + r] = f2bf(v.x); sm[(c + 1) * 66 + r] = f2bf(v.y);
    sm[(c + 2) * 66 + r] = f2bf(v.z); sm[(c + 3) * 66 + r] = f2bf(v.w);
  }
  __syncthreads();
  {
    int c = tid >> 2, ch = (tid & 3) * 16;
    if (c0 + c < C) {
      unsigned wv[8];
#pragma unroll
      for (int k = 0; k < 8; k++) wv[k] = *(const unsigned*)(sm + c * 66 + ch + 2 * k);
      bf* d = dst + (size_t)(c0 + c) * ldd + off + r0 + ch;
      *(uint4*)d = make_uint4(wv[0], wv[1], wv[2], wv[3]);
      *(uint4*)(d + 8) = make_uint4(wv[4], wv[5], wv[6], wv[7]);
    }
  }
  __syncthreads();
}

__device__ __forceinline__ bool try_tr(int& t, const float* src, int R, int C, bf* dst, int ldd, int off, bf* sm) {
  int nt = (R >> 6) * ((C + 63) >> 6);
  if (t < nt) { transpose_tile(src, R, C, dst, ldd, off, t, sm); return true; }
  t -= nt; return false;
}

__device__ __forceinline__ void phase0(const Params& p, char* smc) {
  bf* sm = (bf*)(smc + HB * HALF_LDS);
  const int perLayer = 32 * 218 + 256 + 256 + 512 + 128 + 1024 + 64 + 256;
  for (int task = VB; task < 2 * perLayer; task += G2) {
    int layer = task / perLayer; int t = task - layer * perLayer;
    bf* WbrL = p.WbrT + (size_t)layer * 2048 * YW;
    if (try_tr(t, p.w_in + (size_t)layer * DM * INW, 2048, INW, p.WinT + (size_t)layer * INW * 2048, 2048, 0, sm)) continue;
    if (try_tr(t, p.w_br_s5 + (size_t)layer * 512 * 2048, 512, 2048, WbrL, YW, 0, sm)) continue;
    if (try_tr(t, p.w_br_attn + (size_t)layer * 512 * 2048, 512, 2048, WbrL, YW, 512, sm)) continue;
    if (try_tr(t, p.w_br_ssd + (size_t)layer * 1024 * 2048, 1024, 2048, WbrL, YW, 1024, sm)) continue;
    if (try_tr(t, p.w_br_mem + (size_t)layer * 256 * 2048, 256, 2048, WbrL, YW, 2048, sm)) continue;
    if (try_tr(t, p.w_out + (size_t)layer * 2048 * 2048, 2048, 2048, p.WoutT + (size_t)layer * 2048 * 2048, 2048, 0, sm)) continue;
    if (try_tr(t, p.w_glu + (size_t)layer * 512 * 512, 512, 512, p.WgluT + (size_t)layer * 512 * 512, 512, 0, sm)) continue;
    if (try_tr(t, p.mem_w_kv + (size_t)layer * 2048 * 512, 2048, 512, p.WmemT + (size_t)layer * 512 * 2048, 2048, 0, sm)) continue;
  }
  const size_t gtid = (size_t)blockIdx.x * 512 + otid_full(), gstr = (size_t)gridDim.x * 512;
  for (size_t i0 = gtid; i0 < (size_t)TT * DM / 8; i0 += 4 * gstr) {
    float4 a[4], b[4];
#pragma unroll
    for (int k = 0; k < 4; k++) {
      const size_t i = i0 + k * gstr;
      if (i < (size_t)TT * DM / 8) { a[k] = *(const float4*)(p.x + i * 8); b[k] = *(const float4*)(p.x + i * 8 + 4); }
    }
#pragma unroll
    for (int k = 0; k < 4; k++) {
      const size_t i = i0 + k * gstr;
      if (i < (size_t)TT * DM / 8)
        *(uint4*)(p.xb + i * 8) = make_uint4(pk2(a[k].x, a[k].y), pk2(a[k].z, a[k].w), pk2(b[k].x, b[k].y), pk2(b[k].z, b[k].w));
    }
  }
  for (size_t i = gtid; i < (size_t)512 * DM / 8; i += gstr) {
    float4 a = *(const float4*)(p.mem + i * 8), b = *(const float4*)(p.mem + i * 8 + 4);
    *(uint4*)(p.memb + i * 8) = make_uint4(pk2(a.x, a.y), pk2(a.z, a.w), pk2(b.x, b.y), pk2(b.z, b.w));
  }
  for (size_t i = gtid; i < (size_t)TT; i += gstr) {
    const float ps = (float)p.pos[i];
#pragma unroll
    for (int j = 0; j < 8; j++) {
      float ang = ps * p.inv[j];
      float s, c; sincosf(ang, &s, &c);
      p.CS[i * 16 + j] = c; p.CS[i * 16 + 8 + j] = s;
    }
  }
  for (size_t i = gtid; i < 2 * 32 * 64; i += gstr) {
    int pp = (int)(i & 63), g = (int)((i >> 6) & 31), layer = (int)(i >> 11);
    float dt = expf(p.log_dt[layer * 32 + g]);
    float lr = p.lam_re[i], li = p.lam_im[i];
    float mag = expf(lr * dt);
    float sn, cs; sincosf(li * dt, &sn, &cs);
    float ar = mag * cs, ai = mag * sn;
    float den = lr * lr + li * li;
    float nr = ar - 1.f, ni = ai;
    float fr = (nr * lr + ni * li) / den, fi = (ni * lr - nr * li) / den;
    float* sb = p.SB + i * 32;
    const float* bre = p.b_re + i * 16; const float* bim = p.b_im + i * 16;
    for (int h = 0; h < 16; h++) {
      float br = bre[h], bi = bim[h];
      sb[h] = fr * br - fi * bi; sb[16 + h] = fr * bi + fi * br;
    }
    float pr = ar, pi = ai;
    for (int k = 0; k < 7; k++) { float nr2 = pr * pr - pi * pi, ni2 = 2.f * pr * pi; pr = nr2; pi = ni2; }
    p.SA[i * 4 + 0] = ar; p.SA[i * 4 + 1] = ai; p.SA[i * 4 + 2] = pr; p.SA[i * 4 + 3] = pi;
    for (int h = 0; h < 16; h++) {
      size_t ci = ((size_t)(layer * 32 + g) * 16 + h);
      p.CM[ci * 128 + pp] = f2bf(p.c_re[ci * 64 + pp]);
      p.CM[ci * 128 + 64 + pp] = f2bf(-p.c_im[ci * 64 + pp]);
    }
  }
}

__device__ __forceinline__ void phaseA(const Params& p, int layer) {
  const int tidf = otid_full();
  const int wid = __builtin_amdgcn_readfirstlane(tidf >> 6), lane = tidf & 63, wr = wid >> 2, wc = wid & 3, fr = lane & 15, fq = lane >> 4;
  const bf* Wl = p.WinT + (size_t)layer * INW * 2048;
  const int nA = 128 * 23;
  const int total = nA + (layer == 0 ? 8 : 0);
  for (int L = blockIdx.x; L < total; L += gridDim.x) {
    f32x4 acc[2][2][4][2]; ZERO_ACC8(acc);
    if (L < nA) {
      int pm, pn; tile_order(L, 128, 23, pm, pn);
      const int brow = pm * 256, bcol = pn * 256;
      gemm256(p.xb, 2048, Wl, 2048, 2048, brow, bcol, acc);
      int fr_o = fr; asm volatile("" : "+v"(fr_o));
#pragma unroll
      for (int ai = 0; ai < 2; ai++)
#pragma unroll
        for (int m = 0; m < 4; m++) {
          __builtin_amdgcn_sched_barrier(0);
          const int tok = brow + ai * 128 + wr * 64 + m * 16 + fr_o;
#pragma unroll
          for (int bj = 0; bj < 2; bj++)
#pragma unroll
            for (int n = 0; n < 2; n++) {
              const int cb = bcol + bj * 128 + wc * 32 + n * 16;
              f32x4 v = acc[ai][bj][m][n];
              if (n == 0 && (wc & 1) == 0 && ((cb >= C_ATQ && cb < C_ATV) || (cb >= C_IDQ && cb < C_IDW))) {
                f32x4 cs = *(const f32x4*)(p.CS + (size_t)tok * 16 + 4 * (fq & 1));
                f32x4 sn = *(const f32x4*)(p.CS + (size_t)tok * 16 + 8 + 4 * (fq & 1));
#pragma unroll
                for (int e = 0; e < 4; e++) {
                  float o = __shfl_xor(v[e], 32);
                  v[e] = (fq < 2) ? (v[e] * cs[e] - o * sn[e]) : (v[e] * cs[e] + o * sn[e]);
                }
              }
              const int nn = cb + fq * 4;
              if (nn < 5716) {
                const int dn = nn + (nn >= 2628 ? 12 : 0);
                uint2 pv = make_uint2(pk2(v[0], v[1]), pk2(v[2], v[3]));
                *(uint2*)(p.P + (size_t)tok * PW + dn) = pv;
                if (nn >= C_IDK && nn < C_IDW) {
                  const int d = nn - C_IDK; const int b = tok >> 14, li = tok & 16383;
                  size_t o = ((((size_t)(b * 512 + (li >> 5)) * 4 + (d >> 4)) * 64 + ((d >> 3) & 1) * 32 + (li & 31)) * 8) + (d & 7);
                  *(uint2*)(p.KIF + o) = pv;
                }
                if (nn >= C_ATK && nn < C_ATZ) *(uint2*)(p.KVC + (size_t)tok * 256 + (nn - C_ATK)) = pv;
              }
            }
        }
    } else {
      const int t8 = L - nA; const int ly = t8 >> 2, tm = (t8 >> 1) & 1, tn = t8 & 1;
      gemm256(p.memb, 2048, p.WmemT + (size_t)ly * 512 * 2048, 2048, 2048, tm * 256, tn * 256, acc);
#pragma unroll
      for (int ai = 0; ai < 2; ai++)
#pragma unroll
        for (int m = 0; m < 4; m++) {
          const int row = tm * 256 + ai * 128 + wr * 64 + m * 16 + fr; const int b = row >> 8, mm = row & 255;
#pragma unroll
          for (int bj = 0; bj < 2; bj++)
#pragma unroll
            for (int n = 0; n < 2; n++)
#pragma unroll
              for (int e = 0; e < 4; e++) {
                const int nn = tn * 256 + bj * 128 + wc * 32 + n * 16 + fq * 4 + e; const float v = acc[ai][bj][m][n][e];
                if (nn < 256) { int h = nn >> 6, d = nn & 63; p.MK[((((size_t)ly * 2 + b) * 4 + h) * 256 + mm) * 64 + d] = f2bf(v); }
                else { int h = (nn - 256) >> 6, d = nn & 63; p.MVT[((((size_t)ly * 2 + b) * 4 + h) * 64 + d) * 256 + mm] = f2bf(v); }
              }
        }
    }
  }
}

__device__ __forceinline__ float softplusf_(float x) {
  const float e = __expf(x);
  const float sp = (e < 0.01f) ? e * (1.f - 0.5f * e) : __logf(1.f + e);
  return x > 15.f ? x : sp;
}

__device__ __forceinline__ void ssd_dt_acs(const Params& p, int layer, size_t tok0, int gg, float* sAcs, float* sDt) {
  const int tid = otid(), lane = tid & 63, w = tid >> 6;
#pragma unroll
  for (int k = 0; k < 2; k++) {
    const int hh = 2 * w + k, hd = gg * 8 + hh;
    const float bias = p.dt_bias[layer * 16 + hd], a = -__expf(p.a_log[layer * 16 + hd]);
    const int l0 = 2 * lane;
    float d0 = softplusf_(bf2f(p.P[(tok0 + l0) * PW + C_SDT + hd]) + bias);
    float d1 = softplusf_(bf2f(p.P[(tok0 + l0 + 1) * PW + C_SDT + hd]) + bias);
    float s0 = d0 * a, s1 = s0 + d1 * a;
    float xs = s1;
#pragma unroll
    for (int off = 1; off < 64; off <<= 1) { float v = __shfl_up(xs, off); if (lane >= off) xs += v; }
    float ex = xs - s1;
    sAcs[l0 * 8 + hh] = ex + s0; sAcs[(l0 + 1) * 8 + hh] = ex + s1;
    sDt[l0 * 8 + hh] = d0; sDt[(l0 + 1) * 8 + hh] = d1;
  }
}

struct Conv2 { float w0[4], w1[4], b0, b1, h0[3], h1[3]; };
__device__ __forceinline__ void conv_init(const Params& p, int layer, size_t tokb, int l, int ch, Conv2& c) {
  const float* cw = p.conv_w + (size_t)layer * 4 * 1536 + ch;
#pragma unroll
  for (int k = 0; k < 4; k++) { c.w0[k] = cw[k * 1536]; c.w1[k] = cw[k * 1536 + 1]; }
  c.b0 = p.conv_b[layer * 1536 + ch]; c.b1 = p.conv_b[layer * 1536 + ch + 1];
#pragma unroll
  for (int k = 0; k < 3; k++) {
    int ll = l - 3 + k; unsigned u = 0;
    if (ll >= 0) u = *(const unsigned*)(p.P + (tokb + ll) * PW + C_XBC + ch);
    c.h0[k] = bflo(u); c.h1[k] = bfhi(u);
  }
}
__device__ __forceinline__ void conv_step(const Params& p, size_t tokb, int l, int ch, Conv2& c, float& o0, float& o1) {
  unsigned u = *(const unsigned*)(p.P + (tokb + l) * PW + C_XBC + ch);
  float x0 = bflo(u), x1 = bfhi(u);
  float a0 = c.b0 + c.w0[0] * c.h0[0] + c.w0[1] * c.h0[1] + c.w0[2] * c.h0[2] + c.w0[3] * x0;
  float a1 = c.b1 + c.w1[0] * c.h1[0] + c.w1[1] * c.h1[1] + c.w1[2] * c.h1[2] + c.w1[3] * x1;
  c.h0[0] = c.h0[1]; c.h0[1] = c.h0[2]; c.h0[2] = x0;
  c.h1[0] = c.h1[1]; c.h1[1] = c.h1[2]; c.h1[2] = x1;
  o0 = siluf_(a0); o1 = siluf_(a1);
}

__device__ __forceinline__ void conv_val(unsigned u, Conv2& c, float& o0, float& o1) {
  float x0 = bflo(u), x1 = bfhi(u);
  float a0 = c.b0 + c.w0[0] * c.h0[0] + c.w0[1] * c.h0[1] + c.w0[2] * c.h0[2] + c.w0[3] * x0;
  float a1 = c.b1 + c.w1[0] * c.h1[0] + c.w1[1] * c.h1[1] + c.w1[2] * c.h1[2] + c.w1[3] * x1;
  c.h0[0] = c.h0[1]; c.h0[1] = c.h0[2]; c.h0[2] = x0;
  c.h1[0] = c.h1[1]; c.h1[1] = c.h1[2]; c.h1[2] = x1;
  o0 = siluf_(a0); o1 = siluf_(a1);
}
#define CONV_PRELOAD(raw, N, lfirst, nrows, ch)                                                           \
  unsigned raw[N];                                                                                        \
  _Pragma("unroll") for (int k_ = 0; k_ < N; k_++)                                                        \
    raw[k_] = (k_ < (nrows)) ? *(const unsigned*)(p.P + (tokb + (lfirst) + k_) * PW + C_XBC + (ch)) : 0u;

__device__ __forceinline__ void ssd_pass1(const Params& p, int layer, int task, char* sm) {
  const int tid = otid(), lane = tid & 63, w = tid >> 6, r32 = lane & 31, h5 = lane >> 5;
  const int gg = task & 1, c = (task >> 1) & 127, b = task >> 8;
  const size_t tokb = (size_t)b * LSEQ; const int lc0 = c * 128; const size_t tok0 = tokb + lc0;
  float* sAcs = (float*)sm; float* sDt = (float*)(sm + 4096);
  bf* sBT = (bf*)(sm + 8192); bf* sXT = (bf*)(sm + 43008);
  __syncthreads();
  ssd_dt_acs(p, layer, tok0, gg, sAcs, sDt);
  {
    const int cp = tid & 63, tg = tid >> 6; const int ch = 1024 + gg * 128 + 2 * cp;
    Conv2 cv; conv_init(p, layer, tokb, lc0 + tg * 32, ch, cv);
    CONV_PRELOAD(raw, 32, lc0 + tg * 32, 32, ch)
#pragma unroll
    for (int k = 0; k < 32; k += 2) {
      const int l = tg * 32 + k;
      float a0, a1, b0, b1;
      conv_val(raw[k], cv, a0, a1);
      conv_val(raw[k + 1], cv, b0, b1);
      *(unsigned*)(sBT + (2 * cp) * 136 + l) = pk2(a0, b0);
      *(unsigned*)(sBT + (2 * cp + 1) * 136 + l) = pk2(a1, b1);
    }
  }
  __syncthreads();
  if (tid < 8) p.CD[((size_t)(b * 128 + c)) * 16 + gg * 8 + tid] = __expf(sAcs[127 * 8 + tid]);
  for (int hh = 0; hh < 8; hh++) {
    const int hd = gg * 8 + hh;
    if (hh) __syncthreads();
    {
      const int cp = tid & 31, tg = tid >> 5; const int ch = gg * 512 + hh * 64 + 2 * cp;
      const float aend = sAcs[127 * 8 + hh];
      Conv2 cv; conv_init(p, layer, tokb, lc0 + tg * 16, ch, cv);
      CONV_PRELOAD(raw, 16, lc0 + tg * 16, 16, ch)
#pragma unroll
      for (int k = 0; k < 16; k += 2) {
        const int l = tg * 16 + k;
        float a0, a1, b0, b1;
        conv_val(raw[k], cv, a0, a1);
        conv_val(raw[k + 1], cv, b0, b1);
        float sa = sDt[l * 8 + hh] * __expf(aend - sAcs[l * 8 + hh]);
        float sb = sDt[(l + 1) * 8 + hh] * __expf(aend - sAcs[(l + 1) * 8 + hh]);
        *(unsigned*)(sXT + (2 * cp) * 136 + l) = pk2(a0 * sa, b0 * sb);
        *(unsigned*)(sXT + (2 * cp + 1) * 136 + l) = pk2(a1 * sa, b1 * sb);
      }
    }
    __syncthreads();
    f32x16 acc[2];
#pragma unroll
    for (int r = 0; r < 16; r++) { const float z_ = ozero(); acc[0][r] = z_; acc[1][r] = z_; }
#pragma unroll
    for (int ks = 0; ks < 8; ks++) {
      bf16x8 bfr = *(const bf16x8*)(sBT + (32 * w + r32) * 136 + ks * 16 + 8 * h5);
      bf16x8 x0 = *(const bf16x8*)(sXT + (r32) * 136 + ks * 16 + 8 * h5);
      bf16x8 x1 = *(const bf16x8*)(sXT + (32 + r32) * 136 + ks * 16 + 8 * h5);
      acc[0] = mfma32(x0, bfr, acc[0]);
      acc[1] = mfma32(x1, bfr, acc[1]);
    }
    float* st = p.ST + ((size_t)(b * 128 + c) * 16 + hd) * 64 * 128;
#pragma unroll
    for (int pi = 0; pi < 2; pi++)
#pragma unroll
      for (int r = 0; r < 16; r++) {
        int pp = 32 * pi + 8 * (r >> 2) + 4 * h5 + (r & 3);
        st[pp * 128 + 32 * w + r32] = acc[pi][r];
      }
  }
}

__device__ __forceinline__ void ssd_statepass(const Params& p, int task) {
  const int idx = task * 256 + otid();
  const int b = idx >> 15, e4 = idx & 32767;
  const int hd = e4 >> 11;
  const float zc_ = ozero(); float4 carry = make_float4(zc_, zc_, zc_, zc_);
  float* base = p.ST + (size_t)b * 128 * 131072 + (size_t)e4 * 4;
  const float* cd = p.CD + (size_t)b * 128 * 16 + hd;
  for (int c0 = 0; c0 < 128; c0 += 4) {
    float4 v[4]; float d[4];
#pragma unroll
    for (int k = 0; k < 4; k++) { v[k] = *(const float4*)(base + (size_t)(c0 + k) * 131072); d[k] = cd[(c0 + k) * 16]; }
#pragma unroll
    for (int k = 0; k < 4; k++) {
      *(float4*)(base + (size_t)(c0 + k) * 131072) = carry;
      carry.x = carry.x * d[k] + v[k].x; carry.y = carry.y * d[k] + v[k].y;
      carry.z = carry.z * d[k] + v[k].z; carry.w = carry.w * d[k] + v[k].w;
    }
  }
}

__device__ __forceinline__ void ssd_pass2(const Params& p, int layer, int task, char* sm) {
  const int tid = otid(), lane = tid & 63, w = tid >> 6, r32 = lane & 31, h5 = lane >> 5;
  const int lh = task & 1, gg = (task >> 1) & 1, c = (task >> 2) & 127, b = task >> 9;
  const size_t tokb = (size_t)b * LSEQ; const int lc0 = c * 128; const size_t tok0 = tokb + lc0;
  float* sAcs = (float*)sm; float* sDt = (float*)(sm + 4096);
  bf* sC = (bf*)(sm + 8192); bf* sB = (bf*)(sm + 25600); bf* sM = (bf*)(sm + 25600); bf* sXT = (bf*)(sm + 43008);
  float* sSsq = (float*)(sm + 60416);
  const int wr = w >> 1, wc = w & 1;
  const int nS = 64 * (lh + 1);
  __syncthreads();
  ssd_dt_acs(p, layer, tok0, gg, sAcs, sDt);
  {
    const int cp = tid & 63, tg = tid >> 6;
    {
      const int ch = 1280 + gg * 128 + 2 * cp;
      const int lst = 64 * lh + tg * 16;
      Conv2 cv; conv_init(p, layer, tokb, lc0 + lst, ch, cv);
      CONV_PRELOAD(raw, 16, lc0 + lst, 16, ch)
#pragma unroll
      for (int k = 0; k < 16; k++) {
        const int l = lst + k;
        float a0, a1; conv_val(raw[k], cv, a0, a1);
        *(unsigned*)(sC + (l - 64 * lh) * 136 + 2 * cp) = pk2(a0, a1);
      }
    }
    {
      const int ch = 1024 + gg * 128 + 2 * cp;
      const int per = nS >> 2; const int lst = tg * per;
      Conv2 cv; conv_init(p, layer, tokb, lc0 + lst, ch, cv);
      CONV_PRELOAD(raw, 32, lc0 + lst, per, ch)
#pragma unroll
      for (int k = 0; k < 32; k++) {
        if (k < per) {
          const int l = lst + k;
          float a0, a1; conv_val(raw[k], cv, a0, a1);
          *(unsigned*)(sB + l * 136 + 2 * cp) = pk2(a0, a1);
        }
      }
    }
  }
  __syncthreads();
  f32x16 cb[2];
#pragma unroll
  for (int r = 0; r < 16; r++) { const float z_ = ozero(); cb[0][r] = z_; cb[1][r] = z_; }
  if (64 * wc < nS) {
#pragma unroll
    for (int ks = 0; ks < 8; ks++) {
      bf16x8 af = *(const bf16x8*)(sC + (32 * wr + r32) * 136 + ks * 16 + 8 * h5);
      bf16x8 b0 = *(const bf16x8*)(sB + (64 * wc + r32) * 136 + ks * 16 + 8 * h5);
      bf16x8 b1 = *(const bf16x8*)(sB + (64 * wc + 32 + r32) * 136 + ks * 16 + 8 * h5);
      cb[0] = mfma32(af, b0, cb[0]);
      cb[1] = mfma32(af, b1, cb[1]);
    }
  }
  __syncthreads();
  const int wc2 = w & 1;
  for (int hh = 0; hh < 8; hh++) {
    const int hd = gg * 8 + hh;
    if (hh) __syncthreads();
    bf16x8 pfr[8];
    {
      const float* pv = p.ST + (((size_t)(b * 128 + c) * 16 + hd) * 64 + 32 * wc2 + r32) * 128 + 8 * h5;
#pragma unroll
      for (int ks = 0; ks < 8; ks++) {
        float4 u0 = *(const float4*)(pv + ks * 16), u1 = *(const float4*)(pv + ks * 16 + 4);
        unsigned q0 = pk2(u0.x, u0.y), q1 = pk2(u0.z, u0.w), q2 = pk2(u1.x, u1.y), q3 = pk2(u1.z, u1.w);
        pfr[ks][0] = (short)(q0 & 0xFFFF); pfr[ks][1] = (short)(q0 >> 16); pfr[ks][2] = (short)(q1 & 0xFFFF); pfr[ks][3] = (short)(q1 >> 16);
        pfr[ks][4] = (short)(q2 & 0xFFFF); pfr[ks][5] = (short)(q2 >> 16); pfr[ks][6] = (short)(q3 & 0xFFFF); pfr[ks][7] = (short)(q3 >> 16);
      }
    }
    {
      const float dsk = p.ssd_d[layer * 16 + hd];
#pragma unroll
      for (int j = 0; j < 2; j++) {
        const int s = 64 * wc + 32 * j + r32;
        if (s < nS) {
          const float as = sAcs[s * 8 + hh];
#pragma unroll
          for (int r = 0; r < 16; r++) {
            const int lp = 32 * wr + 8 * (r >> 2) + 4 * h5 + (r & 3); const int l = 64 * lh + lp;
            float v = 0.f;
            if (s <= l) v = cb[j][r] * __expf(sAcs[l * 8 + hh] - as);
            if (s == l) v += dsk * __builtin_amdgcn_rcpf(sDt[l * 8 + hh]);
            sM[lp * 136 + s] = f2bf(v);
          }
        }
      }
    }
    {
      const int cp = tid & 31, tg = tid >> 5; const int ch = gg * 512 + hh * 64 + 2 * cp;
      const int per = nS >> 3; const int lst = tg * per;
      Conv2 cv; conv_init(p, layer, tokb, lc0 + lst, ch, cv);
      CONV_PRELOAD(raw, 16, lc0 + lst, per, ch)
#pragma unroll
      for (int k = 0; k < 16; k += 2) {
        if (k >= per) break;
        const int l = lst + k;
        float a0, a1, b0, b1;
        conv_val(raw[k], cv, a0, a1);
        conv_val(raw[k + 1], cv, b0, b1);
        float sa = sDt[l * 8 + hh], sb = sDt[(l + 1) * 8 + hh];
        *(unsigned*)(sXT + (2 * cp) * 136 + l) = pk2(a0 * sa, b0 * sb);
        *(unsigned*)(sXT + (2 * cp + 1) * 136 + l) = pk2(a1 * sa, b1 * sb);
      }
    }
    __syncthreads();
    f32x16 yd, yo;
#pragma unroll
    for (int r = 0; r < 16; r++) { const float z_ = ozero(); yd[r] = z_; yo[r] = z_; }
    const int nks = nS >> 4;
    for (int ks = 0; ks < nks; ks++) {
      bf16x8 xf = *(const bf16x8*)(sXT + (32 * wc2 + r32) * 136 + ks * 16 + 8 * h5);
      bf16x8 mf = *(const bf16x8*)(sM + (32 * wr + r32) * 136 + ks * 16 + 8 * h5);
      yd = mfma32(xf, mf, yd);
    }
    {
#pragma unroll
      for (int ks = 0; ks < 8; ks++) {
        bf16x8 cf = *(const bf16x8*)(sC + (32 * wr + r32) * 136 + ks * 16 + 8 * h5);
        yo = mfma32(pfr[ks], cf, yo);
      }
    }
    {
      const int lp = 32 * wr + r32; const int l = 64 * lh + lp; const size_t tok = tok0 + l;
      const float eo = __expf(sAcs[l * 8 + hh]);
      float ss = 0.f;
#pragma unroll
      for (int q = 0; q < 4; q++) {
        const int pp = 32 * wc2 + 8 * q + 4 * h5;
        uint2 zz = *(const uint2*)(p.P + tok * PW + C_SSZ + hd * 64 + pp);
        float v0 = (yd[4 * q] + eo * yo[4 * q]) * siluf_(bflo(zz.x));
        float v1 = (yd[4 * q + 1] + eo * yo[4 * q + 1]) * siluf_(bfhi(zz.x));
        float v2 = (yd[4 * q + 2] + eo * yo[4 * q + 2]) * siluf_(bflo(zz.y));
        float v3 = (yd[4 * q + 3] + eo * yo[4 * q + 3]) * siluf_(bfhi(zz.y));
        ss += v0 * v0 + v1 * v1 + v2 * v2 + v3 * v3;
        *(uint2*)(p.Y + tok * YW + Y_SSD + hd * 64 + pp) = make_uint2(pk2(v0, v1), pk2(v2, v3));
      }
      sSsq[lp * 32 + hh * 4 + wc2 * 2 + h5] = ss;
    }
  }
  __syncthreads();
  {
    const int lp = tid >> 2, part = tid & 3; const size_t tok = tok0 + 64 * lh + lp;
    float tot = 0.f;
#pragma unroll
    for (int k = 0; k < 32; k += 4) { float4 v4 = *(const float4*)(sSsq + lp * 32 + k); tot += (v4.x + v4.y) + (v4.z + v4.w); }
    const float rs = rsqrtf(tot * (1.f / 512.f) + 1e-5f);
    bf* yp = p.Y + tok * YW + Y_SSD + gg * 512 + part * 128;
    const float* ng = p.norm_g + layer * 1024 + gg * 512 + part * 128;
#pragma unroll 4
    for (int i = 0; i < 16; i++) {
      uint4 u = *(const uint4*)(yp + i * 8);
      float4 g0 = *(const float4*)(ng + i * 8), g1 = *(const float4*)(ng + i * 8 + 4);
      u.x = pk2(bflo(u.x) * rs * g0.x, bfhi(u.x) * rs * g0.y);
      u.y = pk2(bflo(u.y) * rs * g0.z, bfhi(u.y) * rs * g0.w);
      u.z = pk2(bflo(u.z) * rs * g1.x, bfhi(u.z) * rs * g1.y);
      u.w = pk2(bflo(u.w) * rs * g1.z, bfhi(u.w) * rs * g1.w);
      *(uint4*)(yp + i * 8) = u;
    }
  }
}

__device__ __forceinline__ void s5_ld_u(const Params& p, size_t tok, int g, uint4& a, uint4& b) {
  const uint4* src = (const uint4*)(p.P + tok * PW + C_S5U + g * 16);
  a = src[0]; b = src[1];
}
__device__ __forceinline__ void s5_st_u(float* dst, const uint4 a, const uint4 b) {
  *(float4*)(dst + 0) = make_float4(bflo(a.x), bfhi(a.x), bflo(a.y), bfhi(a.y));
  *(float4*)(dst + 4) = make_float4(bflo(a.z), bfhi(a.z), bflo(a.w), bfhi(a.w));
  *(float4*)(dst + 8) = make_float4(bflo(b.x), bfhi(b.x), bflo(b.y), bfhi(b.y));
  *(float4*)(dst + 12) = make_float4(bflo(b.z), bfhi(b.z), bflo(b.w), bfhi(b.w));
}
__device__ __forceinline__ void s5_load_u(const Params& p, size_t tok, int g, float* dst) {
  const uint4* src = (const uint4*)(p.P + tok * PW + C_S5U + g * 16);
  uint4 a = src[0], b = src[1];
  *(float4*)(dst + 0) = make_float4(bflo(a.x), bfhi(a.x), bflo(a.y), bfhi(a.y));
  *(float4*)(dst + 4) = make_float4(bflo(a.z), bfhi(a.z), bflo(a.w), bfhi(a.w));
  *(float4*)(dst + 8) = make_float4(bflo(b.x), bfhi(b.x), bflo(b.y), bfhi(b.y));
  *(float4*)(dst + 12) = make_float4(bflo(b.z), bfhi(b.z), bflo(b.w), bfhi(b.w));
}
typedef float f32x2 __attribute__((ext_vector_type(2)));
#define S5_STEP(uu)                                                                     \
  {                                                                                     \
    float4 u0 = *(const float4*)((uu)), u1 = *(const float4*)((uu) + 4), u2 = *(const float4*)((uu) + 8), u3 = *(const float4*)((uu) + 12); \
    f32x2 bb = B2[0] * (f32x2){u0.x, u0.x};                                             \
    bb = B2[1] * (f32x2){u0.y, u0.y} + bb; bb = B2[2] * (f32x2){u0.z, u0.z} + bb; bb = B2[3] * (f32x2){u0.w, u0.w} + bb;     \
    bb = B2[4] * (f32x2){u1.x, u1.x} + bb; bb = B2[5] * (f32x2){u1.y, u1.y} + bb; bb = B2[6] * (f32x2){u1.z, u1.z} + bb; bb = B2[7] * (f32x2){u1.w, u1.w} + bb; \
    bb = B2[8] * (f32x2){u2.x, u2.x} + bb; bb = B2[9] * (f32x2){u2.y, u2.y} + bb; bb = B2[10] * (f32x2){u2.z, u2.z} + bb; bb = B2[11] * (f32x2){u2.w, u2.w} + bb; \
    bb = B2[12] * (f32x2){u3.x, u3.x} + bb; bb = B2[13] * (f32x2){u3.y, u3.y} + bb; bb = B2[14] * (f32x2){u3.z, u3.z} + bb; bb = B2[15] * (f32x2){u3.w, u3.w} + bb; \
    float nr_ = ar * sr - ai * si + bb.x; float ni_ = ar * si + ai * sr + bb.y; sr = nr_; si = ni_; \
  }

__device__ __forceinline__ void s5_pass1(const Params& p, int layer, int task, char* sm) {
  const int tid = otid(), lane = tid & 63, w = tid >> 6;
  const int gq = task & 7, c = (task >> 3) & 127, b = task >> 10;
  const int g = gq * 4 + w;
  const size_t tok0 = (size_t)b * LSEQ + c * 128;
  float* sU = (float*)(sm + w * 8192);
  __syncthreads();
  s5_load_u(p, tok0 + lane, g, sU + lane * 16);
  s5_load_u(p, tok0 + 64 + lane, g, sU + (64 + lane) * 16);
  const size_t pi = ((size_t)(layer * 32 + g)) * 64 + lane;
  f32x2 B2[16];
#pragma unroll
  for (int h = 0; h < 16; h++) { B2[h].x = p.SB[pi * 32 + h]; B2[h].y = p.SB[pi * 32 + 16 + h]; }
  const float ar = p.SA[pi * 4], ai = p.SA[pi * 4 + 1];
  float sr = 0.f, si = 0.f;
  __builtin_amdgcn_wave_barrier();
  for (int l = 0; l < 128; l++) S5_STEP(sU + l * 16)
  *(float2*)(p.END + (((size_t)(b * 128 + c) * 32 + g) * 64 + lane) * 2) = make_float2(sr, si);
}

__device__ __forceinline__ void s5_carry(const Params& p, int layer, int task) {
  const int idx = task * 256 + otid();
  const int b = idx >> 11, gp = idx & 2047;
  const size_t pi = (size_t)layer * 2048 + gp;
  const float a128r = p.SA[pi * 4 + 2], a128i = p.SA[pi * 4 + 3];
  float sr = ozero(), si = ozero();
  float2* e = (float2*)p.END + (size_t)b * 128 * 2048 + gp;
  for (int c0 = 0; c0 < 128; c0 += 4) {
    float2 v[4];
#pragma unroll
    for (int k = 0; k < 4; k++) v[k] = e[(size_t)(c0 + k) * 2048];
#pragma unroll
    for (int k = 0; k < 4; k++) {
      e[(size_t)(c0 + k) * 2048] = make_float2(sr, si);
      float nr = a128r * sr - a128i * si + v[k].x, ni = a128r * si + a128i * sr + v[k].y; sr = nr; si = ni;
    }
  }
}

__device__ __forceinline__ void s5_pass2(const Params& p, int layer, int task, char* sm) {
  const int tid = otid(), lane = tid & 63, w = tid >> 6;
  const int c = task & 127, b = task >> 7;
  const size_t tok0 = (size_t)b * LSEQ + c * 128;
  float* sU = (float*)(sm + w * 10752); bf* sS = (bf*)(sm + w * 10752 + 2048);
  __syncthreads();
  uint4 ua, ub;
  s5_ld_u(p, tok0 + (lane & 31), w * 8, ua, ub);
  for (int gi = 0; gi < 8; gi++) {
    const int g = w * 8 + gi;
    const size_t pi = ((size_t)(layer * 32 + g)) * 64 + lane;
    f32x2 B2[16];
#pragma unroll
    for (int h = 0; h < 16; h++) { B2[h].x = p.SB[pi * 32 + h]; B2[h].y = p.SB[pi * 32 + 16 + h]; }
    const float ar = p.SA[pi * 4], ai = p.SA[pi * 4 + 1];
    float2 s0 = *(const float2*)(p.END + (((size_t)(b * 128 + c) * 32 + g) * 64 + lane) * 2);
    float sr = s0.x, si = s0.y;
    bf16x8 cf[4];
    {
      const bf* cm = p.CM + (((size_t)(layer * 32 + g)) * 16 + (lane & 15)) * 128 + 8 * (lane >> 4);
#pragma unroll
      for (int ks = 0; ks < 4; ks++) cf[ks] = *(const bf16x8*)(cm + ks * 32);
    }
    const float dsk = p.s5_d[(layer * 32 + g) * 16 + (lane & 15)];
    for (int sub = 0; sub < 4; sub++) {
      __builtin_amdgcn_wave_barrier();
      if (lane < 32) s5_st_u(sU + lane * 16, ua, ub);
      {
        const int nsub = (sub + 1) & 3; const int ng = g + (sub == 3 ? 1 : 0);
        if (sub < 3 || gi < 7) s5_ld_u(p, tok0 + nsub * 32 + (lane & 31), ng, ua, ub);
      }
      __builtin_amdgcn_wave_barrier();
      for (int l = 0; l < 32; l++) {
        S5_STEP(sU + l * 16)
        sS[l * 136 + lane] = f2bf(sr); sS[l * 136 + 64 + lane] = f2bf(si);
      }
      __builtin_amdgcn_wave_barrier();
#pragma unroll
      for (int mb = 0; mb < 2; mb++) {
        const float z_ = ozero(); f32x4 acc = {z_, z_, z_, z_};
#pragma unroll
        for (int ks = 0; ks < 4; ks++) {
          bf16x8 af = *(const bf16x8*)(sS + (16 * mb + (lane & 15)) * 136 + ks * 32 + 8 * (lane >> 4));
          acc = mfma16(af, cf[ks], acc);
        }
#pragma unroll
        for (int r = 0; r < 4; r++) {
          const int l = 16 * mb + 4 * (lane >> 4) + r;
          float y = acc[r] + dsk * sU[l * 16 + (lane & 15)];
          p.YG[(tok0 + sub * 32 + l) * 512 + g * 16 + (lane & 15)] = f2bf(geluf_(y));
        }
      }
    }
  }
  __syncthreads();
  const int wr = w >> 1, wc = w & 1, r32 = lane & 31, h5 = lane >> 5;
  for (int tn = 0; tn < 4; tn++) {
    f32x16 acc[2][2]; ZERO_ACC(acc);
    gemm_acc<4>(p.YG + tok0 * 512, 512, p.WgluT + ((size_t)layer * 512 + tn * 128) * 512, 512, 512, acc, sm);
#pragma unroll
    for (int i = 0; i < 2; i++) {
      const size_t tok = tok0 + wr * 64 + i * 32 + r32;
#pragma unroll
      for (int j = 0; j < 2; j++)
#pragma unroll
        for (int q = 0; q < 4; q++) {
          const int n = tn * 128 + wc * 64 + j * 32 + q * 8 + h5 * 4;
          float4 bg = *(const float4*)(p.b_glu + layer * 512 + n);
          uint2 yy = *(const uint2*)(p.YG + tok * 512 + n);
          uint2 zz = *(const uint2*)(p.P + tok * PW + C_S5Z + n);
          float o0 = bflo(yy.x) * sigmoidf_(acc[i][j][4 * q] + bg.x) * siluf_(bflo(zz.x));
          float o1 = bfhi(yy.x) * sigmoidf_(acc[i][j][4 * q + 1] + bg.y) * siluf_(bfhi(zz.x));
          float o2 = bflo(yy.y) * sigmoidf_(acc[i][j][4 * q + 2] + bg.z) * siluf_(bflo(zz.y));
          float o3 = bfhi(yy.y) * sigmoidf_(acc[i][j][4 * q + 3] + bg.w) * siluf_(bfhi(zz.y));
          *(uint2*)(p.Y + tok * YW + Y_S5 + n) = make_uint2(pk2(o0, o1), pk2(o2, o3));
        }
    }
  }
}

__device__ __forceinline__ void mem_attn(const Params& p, int layer, int task) {
  const int tid = otid(), lane = tid & 63, h = tid >> 6;
  const int n16 = lane & 15, kq = lane >> 4;
  const size_t tok0 = (size_t)task * 16; const int b = (int)(tok0 >> 14);
  const bf* mk = p.MK + (((size_t)layer * 2 + b) * 4 + h) * 256 * 64;
  const bf* mvt = p.MVT + (((size_t)layer * 2 + b) * 4 + h) * 64 * 256;
  bf16x8 qf[2];
  {
    const bf* qp = p.P + (tok0 + n16) * PW + C_MEQ + h * 64 + 8 * kq;
    qf[0] = *(const bf16x8*)qp; qf[1] = *(const bf16x8*)(qp + 32);
  }
  f32x4 st[16];
#pragma unroll
  for (int kb = 0; kb < 16; kb++) {
    const bf* kp = mk + (size_t)(16 * kb + n16) * 64 + 8 * kq;
    bf16x8 a0 = *(const bf16x8*)kp, a1 = *(const bf16x8*)(kp + 32);
    const float z_ = ozero(); f32x4 acc = {z_, z_, z_, z_};
    acc = mfma16(a0, qf[0], acc); acc = mfma16(a1, qf[1], acc);
    st[kb] = acc * 0.125f;
  }
  float mx = -3.0e38f;
#pragma unroll
  for (int kb = 0; kb < 16; kb++)
#pragma unroll
    for (int r = 0; r < 4; r++) mx = fmaxf(mx, st[kb][r]);
  mx = fmaxf(mx, __shfl_xor(mx, 16)); mx = fmaxf(mx, __shfl_xor(mx, 32));
  float sum = 0.f;
#pragma unroll
  for (int kb = 0; kb < 16; kb++)
#pragma unroll
    for (int r = 0; r < 4; r++) { float e = __expf(st[kb][r] - mx); st[kb][r] = e; sum += e; }
  sum += __shfl_xor(sum, 16); sum += __shfl_xor(sum, 32);
  const float rinv = 1.f / sum;
  f32x4 o[4];
#pragma unroll
  for (int mb = 0; mb < 4; mb++) { const float z_ = ozero(); o[mb] = (f32x4){z_, z_, z_, z_}; }
#pragma unroll
  for (int k2 = 0; k2 < 8; k2++) {
    bf16x8 pf;
    unsigned q0 = pk2(st[2 * k2][0], st[2 * k2][1]), q1 = pk2(st[2 * k2][2], st[2 * k2][3]);
    unsigned q2 = pk2(st[2 * k2 + 1][0], st[2 * k2 + 1][1]), q3 = pk2(st[2 * k2 + 1][2], st[2 * k2 + 1][3]);
    pf[0] = (short)(q0 & 0xFFFF); pf[1] = (short)(q0 >> 16); pf[2] = (short)(q1 & 0xFFFF); pf[3] = (short)(q1 >> 16);
    pf[4] = (short)(q2 & 0xFFFF); pf[5] = (short)(q2 >> 16); pf[6] = (short)(q3 & 0xFFFF); pf[7] = (short)(q3 >> 16);
#pragma unroll
    for (int mb = 0; mb < 4; mb++) {
      const bf* vp = mvt + (size_t)(16 * mb + n16) * 256 + 32 * k2 + 4 * kq;
      uint2 v0 = *(const uint2*)vp, v1 = *(const uint2*)(vp + 16);
      bf16x8 af;
      af[0] = (short)(v0.x & 0xFFFF); af[1] = (short)(v0.x >> 16); af[2] = (short)(v0.y & 0xFFFF); af[3] = (short)(v0.y >> 16);
      af[4] = (short)(v1.x & 0xFFFF); af[5] = (short)(v1.x >> 16); af[6] = (short)(v1.y & 0xFFFF); af[7] = (short)(v1.y >> 16);
      o[mb] = mfma16(af, pf, o[mb]);
    }
  }
  const size_t tok = tok0 + n16;
#pragma unroll
  for (int mb = 0; mb < 4; mb++) {
    const int d = 16 * mb + 4 * kq;
    uint2 zz = *(const uint2*)(p.P + tok * PW + C_MEZ + h * 64 + d);
    float v0 = o[mb][0] * rinv * siluf_(bflo(zz.x)), v1 = o[mb][1] * rinv * siluf_(bfhi(zz.x));
    float v2 = o[mb][2] * rinv * siluf_(bflo(zz.y)), v3 = o[mb][3] * rinv * siluf_(bfhi(zz.y));
    *(uint2*)(p.Y + tok * YW + Y_MEM + h * 64 + d) = make_uint2(pk2(v0, v1), pk2(v2, v3));
  }
}

__device__ __forceinline__ void dsa_wave(const Params& p, int rank, char* sm) {
  const int tid = otid(), lane = tid & 63, w = tid >> 6, r32 = lane & 31, h5 = lane >> 5;
  const int b = rank & 1, qg = 2047 - (rank >> 1), l0 = qg * 8;
  const size_t tokb = (size_t)b * LSEQ;
  unsigned* cand = (unsigned*)(sm + w * (8 * CAP * 4));
  bf* Pb = (bf*)(sm + 61440 + w * 4096);
  bf16x8 aq[4];
  {
    const bf* qp = p.P + (tokb + l0 + (r32 >> 2)) * PW + C_IDQ + (r32 & 3) * 64 + 8 * h5;
#pragma unroll
    for (int ks = 0; ks < 4; ks++) aq[ks] = *(const bf16x8*)(qp + ks * 16);
  }
  float wv[4][4]; int ql[4];
#pragma unroll
  for (int g = 0; g < 4; g++) {
    ql[g] = l0 + 2 * g + h5;
    uint2 u = *(const uint2*)(p.P + (tokb + ql[g]) * PW + C_IDW);
    wv[g][0] = bflo(u.x) * 0.0625f; wv[g][1] = bfhi(u.x) * 0.0625f; wv[g][2] = bflo(u.y) * 0.0625f; wv[g][3] = bfhi(u.y) * 0.0625f;
  }
  unsigned Tg[4] = {0u, 0u, 0u, 0u}; float Tf[4];
  unsigned Tq = 0u; int cntv = 0;
  int nrep_ = (PROBE_MASK & 32) ? 2 : 1; asm volatile("" : "+s"(nrep_));
#pragma unroll 1
  for (int rep_ = 0; rep_ < nrep_; rep_++) {
  Tg[0] = Tg[1] = Tg[2] = Tg[3] = 0u; Tq = 0u; cntv = 0;
  Tf[0] = Tf[1] = Tf[2] = Tf[3] = -__builtin_inff();
  const int ntile = (l0 + 7) / 32 + 1;
  const bf* kif = p.KIF + (size_t)b * 512 * 2048 + lane * 8;
  bf16x8 bqA[4][4], bqB[4][4];
#pragma unroll
  for (int s = 0; s < 4; s++) {
    const int ts = s < ntile ? s : ntile - 1;
#pragma unroll
    for (int ks = 0; ks < 4; ks++) bqA[s][ks] = *(const bf16x8*)(kif + (size_t)ts * 2048 + ks * 512);
  }
  const unsigned ltmask = (1u << r32) - 1u;
#define DSA_COMPACT_CHECK()                                                                                              \
  {                                                                                                                     \
    unsigned long long over = __ballot(lane < 8 && cntv > CAP - 64);                                                    \
    if (over) {                                                                                                         \
      while (over) {                                                                                                    \
        const int q = __builtin_ctzll(over); over &= over - 1;                                                          \
        const int n = __builtin_amdgcn_readlane(cntv, q);                                                               \
        unsigned* cb_ = cand + q * CAP;                                                                                 \
        unsigned e[8];                                                                                                  \
        _Pragma("unroll") for (int i = 0; i < 8; i++) e[i] = (i * 64 + lane < n) ? cb_[i * 64 + lane] : 0u;             \
        unsigned T = 0u; int cT = n;                                                                                    \
        int nsr_ = (PROBE_MASK & 64) ? 2 : 1; asm volatile("" : "+s"(nsr_));                                            \
        _Pragma("unroll 1") for (int sr_ = 0; sr_ < nsr_; sr_++) { T = 0u; cT = n;                                      \
        const unsigned Told_ = (unsigned)__builtin_amdgcn_readlane((int)Tq, q);                                         \
        for (int bit = 31; bit >= 18; bit--) {                                                                          \
          const unsigned cnd = T | (1u << bit); int cc = 0;                                                             \
          if (cnd <= Told_) { T = cnd; continue; }                       \
          _Pragma("unroll") for (int i = 0; i < 8; i++) cc += __popcll(__ballot(e[i] >= cnd));                          \
          if (cc >= 256) { T = cnd; cT = cc; }                                                                          \
        } }                                                                                                             \
        if (cT > 320) {                                                                                                 \
          for (int bit = 17; bit >= 0; bit--) {                                                                         \
            const unsigned cnd = T | (1u << bit); int cc = 0;                                                           \
            _Pragma("unroll") for (int i = 0; i < 8; i++) cc += __popcll(__ballot(e[i] >= cnd));                        \
            if (cc >= 256) T = cnd;                                                                                     \
          }                                                                                                             \
        }                                                                                                               \
        int pos = 0;                                                                                                    \
        _Pragma("unroll") for (int i = 0; i < 8; i++) {                                                                 \
          const bool keep = e[i] >= T; const unsigned long long m = __ballot(keep);                                     \
          if (keep) cb_[pos + __popcll(m & ((1ull << lane) - 1ull))] = e[i];                                            \
          pos += __popcll(m);                                                                                           \
        }                                                                                                               \
        if (lane == q) { cntv = pos; Tq = T; }                                                                          \
      }                                                                                                                 \
      _Pragma("unroll") for (int g = 0; g < 4; g++) {                                                                   \
        unsigned tlo = __builtin_amdgcn_readlane(Tq, 2 * g), thi = __builtin_amdgcn_readlane(Tq, 2 * g + 1);            \
        Tg[g] = h5 ? thi : tlo;                                                                                         \
        const unsigned sh = Tg[g] & 0xFFFFC000u;                                                                        \
        const unsigned fb = (sh & 0x80000000u) ? (sh ^ 0x80000000u) : ~sh;                                              \
        Tf[g] = Tg[g] ? __uint_as_float(fb) : -__builtin_inff();                                                        \
      }                                                                                                                 \
    }                                                                                                                   \
  }
#define DSA_G(g, DIAG)                                                                                                  \
      {                                                                                                                 \
        const float r0 = __int_as_float(max(__float_as_int(acc[4 * g]), 0)), r1 = __int_as_float(max(__float_as_int(acc[4 * g + 1]), 0)); \
        const float r2 = __int_as_float(max(__float_as_int(acc[4 * g + 2]), 0)), r3 = __int_as_float(max(__float_as_int(acc[4 * g + 3]), 0)); \
        float sc = r0 * wv[g][0]; sc = fmaf(r1, wv[g][1], sc); sc = fmaf(r2, wv[g][2], sc); sc = fmaf(r3, wv[g][3], sc); \
        unsigned long long m0 = __builtin_amdgcn_fcmpf(sc, Tf[g], 3  );                                            \
        if (DIAG) m0 &= __builtin_amdgcn_sicmp(kidx, ql[g], 41  );                                                 \
        if (m0) {                                                                                                       \
          const float s2 = sc + 0.f;                                                                                    \
          unsigned uu = __float_as_uint(s2); uu ^= ((unsigned)((int)uu >> 31) | 0x80000000u);                           \
          const unsigned pk = (uu & 0xFFFFC000u) | (unsigned)(16383 - kidx);                                            \
          const unsigned long long m = m0 & __builtin_amdgcn_uicmp(pk, Tg[g], 35  );                              \
          if (m) {                                                                                                      \
            const unsigned lo = (unsigned)m, hi = (unsigned)(m >> 32);                                                  \
            const int cA = __builtin_amdgcn_readlane(cntv, 2 * g), cB = __builtin_amdgcn_readlane(cntv, 2 * g + 1);     \
            const unsigned mm = h5 ? hi : lo;                                                                           \
            if ((mm >> r32) & 1u) {                                                                                     \
              const int base = h5 ? cB : cA;                                                                            \
              cand[(2 * g + h5) * CAP + base + __popc(mm & ltmask)] = pk;                                               \
            }                                                                                                           \
            if (lane == 2 * g) cntv += __popc(lo);                                                                      \
            if (lane == 2 * g + 1) cntv += __popc(hi);                                                                  \
          }                                                                                                             \
        }                                                                                                               \
      }
#define DSA_GROUP(BC, BN, TB)                                                                                           \
  _Pragma("unroll") for (int u = 0; u < 4; u++) {                                                                       \
    if ((u & 1) == 0) DSA_COMPACT_CHECK()                                                                               \
    const int tile = (TB) + u;                                                                                          \
    f32x16 acc = {0.f, 0.f, 0.f, 0.f, 0.f, 0.f, 0.f, 0.f, 0.f, 0.f, 0.f, 0.f, 0.f, 0.f, 0.f, 0.f};                    \
    _Pragma("unroll") for (int ks = 0; ks < 4; ks++) acc = mfma32(aq[ks], BC[u][ks], acc);                              \
    if (u == 0) {                                                                                                       \
      _Pragma("unroll") for (int s = 0; s < 4; s++) {                                                                   \
        const int tn_ = ((TB) + 4 + s < ntile) ? (TB) + 4 + s : ntile - 1;                                              \
        _Pragma("unroll") for (int ks = 0; ks < 4; ks++) BN[s][ks] = *(const bf16x8*)(kif + (size_t)tn_ * 2048 + ks * 512); \
      }                                                                                                                 \
    }                                                                                                                   \
    const int kidx = tile * 32 + r32;                                                                                   \
    const bool diag = (tile * 32 + 31 > l0);                                                                            \
    if (!diag) { DSA_G(0, false) DSA_G(1, false) DSA_G(2, false) DSA_G(3, false) }                                      \
    else { DSA_G(0, true) DSA_G(1, true) DSA_G(2, true) DSA_G(3, true) }                                                \
  }
  for (int tile0 = 0; tile0 < ntile; tile0 += 8) {
    DSA_GROUP(bqA, bqB, tile0)
    DSA_GROUP(bqB, bqA, tile0 + 4)
  }
  {
    unsigned long long over = __ballot(lane < 8 && cntv > 256);
    while (over) {
      const int q = __builtin_ctzll(over); over &= over - 1;
      const int n = __builtin_amdgcn_readlane(cntv, q);
      unsigned* cb_ = cand + q * CAP;
      unsigned e[8];
#pragma unroll
      for (int i = 0; i < 8; i++) e[i] = (i * 64 + lane < n) ? cb_[i * 64 + lane] : 0u;
      unsigned T = 0u;
      const unsigned Told_ = (unsigned)__builtin_amdgcn_readlane((int)Tq, q);
      for (int bit = 31; bit >= 0; bit--) {
        const unsigned cnd = T | (1u << bit); int cc = 0;
        if (cnd <= Told_) { T = cnd; continue; }
#pragma unroll
        for (int i = 0; i < 8; i++) cc += __popcll(__ballot(e[i] >= cnd));
        if (cc >= 256) T = cnd;
      }
      int pos = 0;
#pragma unroll
      for (int i = 0; i < 8; i++) {
        const bool keep = e[i] >= T; const unsigned long long m = __ballot(keep);
        if (keep) cb_[pos + __popcll(m & ((1ull << lane) - 1ull))] = e[i];
        pos += __popcll(m);
      }
      if (lane == q) { cntv = pos; Tq = T; }
    }
  }
  }
  __builtin_amdgcn_wave_barrier();
  const int n16 = lane & 15, kq = lane >> 4;
#define DPP_ROR(v, n) __int_as_float(__builtin_amdgcn_update_dpp(0, __float_as_int(v), 0x120 + (n), 0xf, 0xf, false))
  for (int q = 0; q < 8; q++) {
    const int n = __builtin_amdgcn_readlane(cntv, q);
    const unsigned* sel = cand + q * CAP;
    const size_t tq = tokb + l0 + q;
    float ssum[2][4];
    bf16x8 qa[2][2];
#pragma unroll
    for (int grp = 0; grp < 2; grp++) {
#pragma unroll
      for (int k = 0; k < 8; k++) { int zi_ = 0; asm volatile("" : "+v"(zi_)); qa[grp][0][k] = (short)zi_; qa[grp][1][k] = (short)zi_; }
      if (n16 < 4) {
        const bf* qp = p.P + tq * PW + C_ATQ + (grp * 4 + n16) * 64 + 8 * kq;
        qa[grp][0] = *(const bf16x8*)qp; qa[grp][1] = *(const bf16x8*)(qp + 32);
      }
    }
    f32x4 lgA[16], lgB[16];
#pragma unroll
    for (int t = 0; t < 16; t++) {
      const int slot = t * 16 + n16; const bool valid = slot < n;
      const int key = valid ? (16383 - (int)(sel[slot] & 0x3FFFu)) : 0;
      const bf* kp = p.KVC + (tokb + key) * 256 + 8 * kq;
      bf16x8 a0 = *(const bf16x8*)kp, a1 = *(const bf16x8*)(kp + 32), b0 = *(const bf16x8*)(kp + 64), b1 = *(const bf16x8*)(kp + 96);
      const float zc_ = ozero(); f32x4 ca = {zc_, zc_, zc_, zc_}, cb2 = {zc_, zc_, zc_, zc_};
      ca = mfma16(qa[0][0], a0, ca); ca = mfma16(qa[0][1], a1, ca);
      cb2 = mfma16(qa[1][0], b0, cb2); cb2 = mfma16(qa[1][1], b1, cb2);
      const bool ok = valid && (kq == 0);
#pragma unroll
      for (int r = 0; r < 4; r++) { lgA[t][r] = ok ? ca[r] * 0.125f : -3.0e38f; lgB[t][r] = ok ? cb2[r] * 0.125f : -3.0e38f; }
    }
    __builtin_amdgcn_wave_barrier();
#define DSA_SOFTMAX(LG, GRP)                                                                                            \
    {                                                                                                                   \
      float mx[4];                                                                                                      \
      _Pragma("unroll") for (int r = 0; r < 4; r++) {                                                                   \
        float m = LG[0][r];                                                                                             \
        _Pragma("unroll") for (int t = 1; t < 16; t++) m = fmaxf(m, LG[t][r]);                                          \
        m = fmaxf(m, DPP_ROR(m, 8)); m = fmaxf(m, DPP_ROR(m, 4)); m = fmaxf(m, DPP_ROR(m, 2)); m = fmaxf(m, DPP_ROR(m, 1)); \
        mx[r] = __int_as_float(__builtin_amdgcn_readfirstlane(__float_as_int(m)));                                      \
      }                                                                                                                 \
      _Pragma("unroll") for (int r = 0; r < 4; r++) {                                                                   \
        float s = 0.f;                                                                                                  \
        _Pragma("unroll") for (int t = 0; t < 16; t++) { float e = (LG[t][r] > -1.0e38f) ? __expf(LG[t][r] - mx[r]) : 0.f; LG[t][r] = e; s += e; } \
        s += DPP_ROR(s, 8); s += DPP_ROR(s, 4); s += DPP_ROR(s, 2); s += DPP_ROR(s, 1);                                  \
        ssum[GRP][r] = __int_as_float(__builtin_amdgcn_readfirstlane(__float_as_int(s)));                              \
      }                                                                                                                 \
      if (kq == 0) {                                                                                                    \
        _Pragma("unroll") for (int t = 0; t < 16; t++)                                                                  \
          *(uint2*)(Pb + (t * 16 + n16) * 8 + GRP * 4) = make_uint2(pk2(LG[t][0], LG[t][1]), pk2(LG[t][2], LG[t][3]));  \
      }                                                                                                                 \
    }
    DSA_SOFTMAX(lgA, 0)
    DSA_SOFTMAX(lgB, 1)
    __builtin_amdgcn_wave_barrier();
    float o[64];
#pragma unroll
    for (int i = 0; i < 64; i++) o[i] = ozero();
    const int ksg = lane >> 3, dc = lane & 7;
#pragma unroll 8
    for (int stp = 0; stp < 32; stp++) {
      const int slot = stp * 8 + ksg;
      const int key = (slot < n) ? (16383 - (int)(sel[slot] & 0x3FFFu)) : 0;
      uint4 pp = *(const uint4*)(Pb + slot * 8);
      const bf* vp = p.KVC + (tokb + key) * 256 + 128 + dc * 8;
      uint4 va = *(const uint4*)vp, vb = *(const uint4*)(vp + 64);
      float ph[8] = {bflo(pp.x), bfhi(pp.x), bflo(pp.y), bfhi(pp.y), bflo(pp.z), bfhi(pp.z), bflo(pp.w), bfhi(pp.w)};
      float v0[8] = {bflo(va.x), bfhi(va.x), bflo(va.y), bfhi(va.y), bflo(va.z), bfhi(va.z), bflo(va.w), bfhi(va.w)};
      float v1[8] = {bflo(vb.x), bfhi(vb.x), bflo(vb.y), bfhi(vb.y), bflo(vb.z), bfhi(vb.z), bflo(vb.w), bfhi(vb.w)};
#pragma unroll
      for (int hh = 0; hh < 4; hh++)
#pragma unroll
        for (int d = 0; d < 8; d++) { o[hh * 8 + d] += ph[hh] * v0[d]; o[(4 + hh) * 8 + d] += ph[4 + hh] * v1[d]; }
    }
    __builtin_amdgcn_wave_barrier();
    const bool b5 = (lane >> 5) & 1, b4 = (lane >> 4) & 1, b3 = (lane >> 3) & 1;
    float o32[32], o16[16], o8[8];
#pragma unroll
    for (int i = 0; i < 32; i++) { float lo = o[i], hi = o[32 + i]; float snd = b5 ? lo : hi; float kp = b5 ? hi : lo; o32[i] = kp + __shfl_xor(snd, 32); }
#pragma unroll
    for (int i = 0; i < 16; i++) { float lo = o32[i], hi = o32[16 + i]; float snd = b4 ? lo : hi; float kp = b4 ? hi : lo; o16[i] = kp + __shfl_xor(snd, 16); }
#pragma unroll
    for (int i = 0; i < 8; i++) { float lo = o16[i], hi = o16[8 + i]; float snd = b3 ? lo : hi; float kp = b3 ? hi : lo; o8[i] = kp + __shfl_xor(snd, 8); }
    const float s_g0 = b4 ? (b3 ? ssum[0][3] : ssum[0][2]) : (b3 ? ssum[0][1] : ssum[0][0]);
    const float s_g1 = b4 ? (b3 ? ssum[1][3] : ssum[1][2]) : (b3 ? ssum[1][1] : ssum[1][0]);
    const float rinv = 1.f / (b5 ? s_g1 : s_g0);
    const int hsel = (b5 ? 4 : 0) + (b4 ? 2 : 0) + (b3 ? 1 : 0);
    const int col = hsel * 64 + dc * 8;
    uint4 zz = *(const uint4*)(p.P + tq * PW + C_ATZ + col);
    uint4 ov;
    ov.x = pk2(o8[0] * rinv * siluf_(bflo(zz.x)), o8[1] * rinv * siluf_(bfhi(zz.x)));
    ov.y = pk2(o8[2] * rinv * siluf_(bflo(zz.y)), o8[3] * rinv * siluf_(bfhi(zz.y)));
    ov.z = pk2(o8[4] * rinv * siluf_(bflo(zz.z)), o8[5] * rinv * siluf_(bfhi(zz.z)));
    ov.w = pk2(o8[6] * rinv * siluf_(bflo(zz.w)), o8[7] * rinv * siluf_(bfhi(zz.w)));
    *(uint4*)(p.Y + tq * YW + Y_ATT + col) = ov;
  }
}

__device__ __forceinline__ void phaseB(const Params& p, int layer, char* sm0) {
  const int total = 512 + 2048 + 2048;
  char* sm = sm0 + HB * HALF_LDS;
  for (int t = VB; t < total; t += G2) {
    if (t < 512) ssd_pass1(p, layer, t, sm);
    else if (t < 2560) s5_pass1(p, layer, t - 512, sm);
    else mem_attn(p, layer, t - 2560);
  }
}
__device__ __forceinline__ void phaseC(const Params& p, int layer, char* sm0, bool dsa_only) {
  const int G = G2;
  const int total = dsa_only ? 1024 : 1024 + 256 + 16;
  char* sm = sm0 + HB * HALF_LDS;
  int rr = 0;
  for (int i = VB; i < total; i += G, rr++) {
    if (i < 1024) {
      int pos = i - rr * G; int idx = i;
      if ((rr & 1) && (rr * G + G <= 1024)) idx = rr * G + (G - 1 - pos);
      __syncthreads();
      dsa_wave(p, idx * 4 + (otid() >> 6), sm);
    } else if (i < 1280) ssd_statepass(p, i - 1024);
    else s5_carry(p, layer, i - 1280);
  }
}
__device__ __forceinline__ void phaseD(const Params& p, int layer, char* sm0) {
  const int total = 256 + 1024;
  char* sm = sm0 + HB * HALF_LDS;
  const int vb = VB;
  if (G2 == 512) {
    if (vb < 256) { s5_pass2(p, layer, vb, sm); ssd_pass2(p, layer, vb, sm); }
    else {
#pragma unroll 1
      for (int k = 0; k < 3; k++) ssd_pass2(p, layer, 256 + (vb - 256) * 3 + k, sm);
    }
  } else {
    for (int t = vb; t < total; t += G2) {
      if (t < 256) s5_pass2(p, layer, t, sm);
      else ssd_pass2(p, layer, t - 256, sm);
    }
  }
}

__device__ __forceinline__ void phaseE(const Params& p, int layer) {
  const int tidf = otid_full();
  const int wid = __builtin_amdgcn_readfirstlane(tidf >> 6), lane = tidf & 63, wr = wid >> 2, wc = wid & 3, fr = lane & 15, fq = lane >> 4;
  const bf* Wl = p.WinT + (size_t)layer * INW * 2048;
  const bf* Wb = p.WbrT + (size_t)layer * 2048 * YW;
  bf* merged = p.P;
  char* gsb = (char*)p.GS + (size_t)blockIdx.x * 131072;
  const unsigned gs_lane0 = (unsigned)tidf * 16u, lane_c40 = (unsigned)fq * 16u, lane_m0 = (unsigned)(fr * 2048 + fq * 4) * 2u;
  for (int L = blockIdx.x; L < 1024; L += gridDim.x) {
    int pm, pn; tile_order(L, 128, 8, pm, pn);
    const int brow = pm * 256, bcol = pn * 256;
#pragma unroll 1
    for (int s = 0; s < 8; s++) {
      const int br = s >> 1; const bool isBr = (s & 1) != 0;
      const int koff = br == 0 ? 0 : (br == 1 ? 512 : (br == 2 ? 1024 : 2048));
      const int kb = br == 2 ? 1024 : (br == 3 ? 256 : 512);
      const bf* A_ = isBr ? p.Y + koff : p.xb; const int lda_ = isBr ? YW : 2048;
      const bf* B_ = isBr ? Wb + koff : Wl + (size_t)(5716 + br * 2048) * 2048; const int ldb_ = isBr ? YW : 2048;
      const int K_ = isBr ? kb : 2048;
      f32x4 acc[2][2][4][2]; ZERO_ACC8(acc);
      gemm256(A_, lda_, B_, ldb_, K_, brow, bcol, acc);
      unsigned gs_lane = gs_lane0, lane_c4 = lane_c40, lane_m = lane_m0;
      asm volatile("" : "+v"(gs_lane), "+v"(lane_c4), "+v"(lane_m));
      if (!isBr) {
        const char* bgb = (const char*)(p.b_gate + (size_t)layer * 8192 + br * 2048 + bcol + wc * 32);
        float4 bgv[2][2];
#pragma unroll
        for (int bj = 0; bj < 2; bj++)
#pragma unroll
          for (int n = 0; n < 2; n++) bgv[bj][n] = *(const float4*)(bgb + (bj * 128 + n * 16) * 4 + lane_c4);
#pragma unroll
        for (int ai = 0; ai < 2; ai++)
#pragma unroll
          for (int bj = 0; bj < 2; bj++)
#pragma unroll
            for (int m = 0; m < 4; m++) {
              unsigned q[4];
#pragma unroll
              for (int n = 0; n < 2; n++) {
                const float4 bg = bgv[bj][n];
                f32x4 v = acc[ai][bj][m][n];
                q[2 * n] = pk2(sigmoidf_(v[0] + bg.x), sigmoidf_(v[1] + bg.y));
                q[2 * n + 1] = pk2(sigmoidf_(v[2] + bg.z), sigmoidf_(v[3] + bg.w));
              }
              *(uint4*)(gsb + ((ai * 2 + bj) * 4 + m) * 8192 + gs_lane) = make_uint4(q[0], q[1], q[2], q[3]);
              __builtin_amdgcn_sched_barrier(0);
            }
      } else {
        char* mb = (char*)merged + ((size_t)(brow + wr * 64) * 2048 + bcol + wc * 32) * 2;
#pragma unroll
        for (int ai = 0; ai < 2; ai++)
#pragma unroll
          for (int bj = 0; bj < 2; bj++) {
#pragma unroll
            for (int mh = 0; mh < 2; mh++) {
              uint4 g4[2]; uint2 old[2][2];
#pragma unroll
              for (int mm = 0; mm < 2; mm++) {
                const int m = mh * 2 + mm;
                g4[mm] = *(const uint4*)(gsb + ((ai * 2 + bj) * 4 + m) * 8192 + gs_lane);
                if (br) {
#pragma unroll
                  for (int n = 0; n < 2; n++)
                    old[mm][n] = *(const uint2*)(mb + ((size_t)(ai * 128 + m * 16) * 2048 + bj * 128 + n * 16) * 2 + lane_m);
                }
              }
#pragma unroll
              for (int mm = 0; mm < 2; mm++) {
                const int m = mh * 2 + mm;
                const unsigned gq[4] = {g4[mm].x, g4[mm].y, g4[mm].z, g4[mm].w};
#pragma unroll
                for (int n = 0; n < 2; n++) {
                  f32x4 v = acc[ai][bj][m][n];
                  float o0 = bflo(gq[2 * n]) * v[0], o1 = bfhi(gq[2 * n]) * v[1], o2 = bflo(gq[2 * n + 1]) * v[2], o3 = bfhi(gq[2 * n + 1]) * v[3];
                  char* mp = mb + ((size_t)(ai * 128 + m * 16) * 2048 + bj * 128 + n * 16) * 2 + lane_m;
                  if (br) { o0 += bflo(old[mm][n].x); o1 += bfhi(old[mm][n].x); o2 += bflo(old[mm][n].y); o3 += bfhi(old[mm][n].y); }
                  *(uint2*)mp = make_uint2(pk2(o0, o1), pk2(o2, o3));
                }
              }
              __builtin_amdgcn_sched_barrier(0);
            }
          }
      }
    }
  }
}

__device__ __forceinline__ void phaseF(const Params& p, int layer) {
  const int tidf = otid_full();
  const int wid = __builtin_amdgcn_readfirstlane(tidf >> 6), lane = tidf & 63, wr = wid >> 2, wc = wid & 3, fr = lane & 15, fq = lane >> 4;
  const bf* merged = p.P;
  const float* xres = layer == 0 ? p.x : p.out;
  for (int L = blockIdx.x; L < 1024; L += gridDim.x) {
    int pm, pn; tile_order(L, 128, 8, pm, pn);
    const int brow = pm * 256, bcol = pn * 256;
    f32x4 acc[2][2][4][2]; ZERO_ACC8(acc);
    gemm256(merged, 2048, p.WoutT + (size_t)layer * 2048 * 2048, 2048, 2048, brow, bcol, acc);
#pragma unroll
    for (int ai = 0; ai < 2; ai++)
#pragma unroll
      for (int m = 0; m < 4; m++) {
        const size_t tok = brow + ai * 128 + wr * 64 + m * 16 + fr;
#pragma unroll
        for (int bj = 0; bj < 2; bj++)
#pragma unroll
          for (int n = 0; n < 2; n++) {
            const int col = bcol + bj * 128 + wc * 32 + n * 16 + fq * 4;
            float4 xr = *(const float4*)(xres + tok * 2048 + col);
            f32x4 v = acc[ai][bj][m][n];
            float4 o;
            o.x = 1.41421356237f * xr.x + v[0]; o.y = 1.41421356237f * xr.y + v[1];
            o.z = 1.41421356237f * xr.z + v[2]; o.w = 1.41421356237f * xr.w + v[3];
            *(float4*)(p.out + tok * 2048 + col) = o;
          }
      }
  }
}

__device__ __forceinline__ void phaseG(const Params& p, int layer) {
  const int lane = otid() & 63, w = otid() >> 6;
  const float* g = p.ln_g + layer * 2048; const float* bb = p.ln_b + layer * 2048;
  float4 gg[8], bv[8];
#pragma unroll
  for (int i = 0; i < 8; i++) { gg[i] = *(const float4*)(g + (i * 64 + lane) * 4); bv[i] = *(const float4*)(bb + (i * 64 + lane) * 4); }
  for (int t = VB; t < TT / 8; t += G2) {
    float4 v[2][8];
#pragma unroll
    for (int rr = 0; rr < 2; rr++) {
      const float* xp = p.out + ((size_t)t * 8 + w * 2 + rr) * 2048;
#pragma unroll
      for (int i = 0; i < 8; i++) v[rr][i] = *(const float4*)(xp + (i * 64 + lane) * 4);
    }
#pragma unroll
    for (int rr = 0; rr < 2; rr++) {
      const size_t row = (size_t)t * 8 + w * 2 + rr;
      float* xp = p.out + row * 2048;
      float s = 0.f;
#pragma unroll
      for (int i = 0; i < 8; i++) s += v[rr][i].x + v[rr][i].y + v[rr][i].z + v[rr][i].w;
#pragma unroll
      for (int off = 1; off < 64; off <<= 1) s += __shfl_xor(s, off);
      const float mu = s * (1.f / 2048.f);
      float q = 0.f;
#pragma unroll
      for (int i = 0; i < 8; i++) {
        float a = v[rr][i].x - mu, b = v[rr][i].y - mu, c = v[rr][i].z - mu, d = v[rr][i].w - mu; q += a * a + b * b + c * c + d * d;
      }
#pragma unroll
      for (int off = 1; off < 64; off <<= 1) q += __shfl_xor(q, off);
      const float rs = rsqrtf(q * (1.f / 2048.f) + 1e-5f);
#pragma unroll
      for (int i = 0; i < 8; i++) {
        const int col = (i * 64 + lane) * 4;
        float4 o;
        o.x = (v[rr][i].x - mu) * rs * gg[i].x + bv[i].x; o.y = (v[rr][i].y - mu) * rs * gg[i].y + bv[i].y;
        o.z = (v[rr][i].z - mu) * rs * gg[i].z + bv[i].z; o.w = (v[rr][i].w - mu) * rs * gg[i].w + bv[i].w;
        *(float4*)(xp + col) = o;
        if (layer == 0) *(uint2*)(p.xb + row * 2048 + col) = make_uint2(pk2(o.x, o.y), pk2(o.z, o.w));
      }
    }
  }
}

__global__ void __launch_bounds__(512, 2) mega_kernel(Params p) {
  char* sm = dynsm;
  cg::grid_group grid = cg::this_grid();
  phase0(p, sm); grid.sync();
#pragma unroll 1
  for (int layer = 0; layer < 2; layer++) {
    int nA = (PROBE_MASK & 1) ? 2 : 1, nB = (PROBE_MASK & 2) ? 2 : 1, nC = (PROBE_MASK & 4) ? 2 : 1, nD = (PROBE_MASK & 8) ? 2 : 1, nE = (PROBE_MASK & 16) ? 2 : 1;
    asm volatile("" : "+s"(nA), "+s"(nB), "+s"(nC), "+s"(nD), "+s"(nE));
#pragma unroll 1
    for (int r = 0; r < nA; r++) phaseA(p, layer);
    grid.sync();
#pragma unroll 1
    for (int r = 0; r < nB; r++) phaseB(p, layer, sm);
    grid.sync();
#pragma unroll 1
    for (int r = 0; r < nC; r++) phaseC(p, layer, sm, r + 1 < nC);
    grid.sync();
#pragma unroll 1
    for (int r = 0; r < nD; r++) phaseD(p, layer, sm);
    grid.sync();
#pragma unroll 1
    for (int r = 0; r < nE; r++) phaseE(p, layer);
    grid.sync();
    phaseF(p, layer); grid.sync();
    phaseG(p, layer);
    if (layer == 0) grid.sync();
  }
}

extern "C" void kernel_launch(void* const* d_in, const int* in_sizes, int n_in, void* d_out, int out_size, void* d_ws,
                              size_t ws_size, hipStream_t stream) {
  Params p{};
  p.x = (const float*)d_in[0]; p.mem = (const float*)d_in[1]; p.pos = (const int*)d_in[2];
  p.w_in = (const float*)d_in[3]; p.b_gate = (const float*)d_in[4]; p.lam_re = (const float*)d_in[5];
  p.lam_im = (const float*)d_in[6]; p.log_dt = (const float*)d_in[7]; p.b_re = (const float*)d_in[8];
  p.b_im = (const float*)d_in[9]; p.c_re = (const float*)d_in[10]; p.c_im = (const float*)d_in[11];
  p.s5_d = (const float*)d_in[12]; p.w_glu = (const float*)d_in[13]; p.b_glu = (const float*)d_in[14];
  p.conv_w = (const float*)d_in[15]; p.conv_b = (const float*)d_in[16]; p.dt_bias = (const float*)d_in[17];
  p.a_log = (const float*)d_in[18]; p.ssd_d = (const float*)d_in[19]; p.norm_g = (const float*)d_in[20];
  p.mem_w_kv = (const float*)d_in[21]; p.w_br_s5 = (const float*)d_in[22]; p.w_br_attn = (const float*)d_in[23];
  p.w_br_ssd = (const float*)d_in[24]; p.w_br_mem = (const float*)d_in[25]; p.w_out = (const float*)d_in[26];
  p.ln_g = (const float*)d_in[27]; p.ln_b = (const float*)d_in[28];
  p.out = (float*)d_out;
  char* ws = (char*)d_ws; size_t off = 0;
  auto carve = [&](size_t bytes) { char* r = ws + off; off += (bytes + 255) & ~(size_t)255; return r; };
  p.WinT = (bf*)carve((size_t)2 * INW * 2048 * 2);
  p.WbrT = (bf*)carve((size_t)2 * 2048 * YW * 2);
  p.WoutT = (bf*)carve((size_t)2 * 2048 * 2048 * 2);
  p.WgluT = (bf*)carve((size_t)2 * 512 * 512 * 2);
  p.WmemT = (bf*)carve((size_t)2 * 512 * 2048 * 2);
  p.memb = (bf*)carve((size_t)512 * 2048 * 2);
  p.xb = (bf*)carve((size_t)TT * 2048 * 2);
  p.P = (bf*)carve((size_t)TT * PW * 2);
  p.Y = (bf*)carve((size_t)TT * YW * 2);
  p.YG = (bf*)carve((size_t)TT * 512 * 2);
  p.KIF = (bf*)carve((size_t)TT * 64 * 2);
  p.MK = (bf*)carve((size_t)2 * 2 * 4 * 256 * 64 * 2);
  p.MVT = (bf*)carve((size_t)2 * 2 * 4 * 256 * 64 * 2);
  p.CM = (bf*)carve((size_t)2 * 32 * 16 * 128 * 2);
  p.ST = (float*)carve((size_t)2 * 128 * 131072 * 4);
  p.CS = (float*)carve((size_t)TT * 16 * 4);
  p.END = (float*)carve((size_t)2 * 128 * 32 * 64 * 2 * 4);
  p.CD = (float*)carve((size_t)2 * 128 * 16 * 4);
  p.SB = (float*)carve((size_t)2 * 32 * 64 * 32 * 4);
  p.SA = (float*)carve((size_t)2 * 32 * 64 * 4 * 4);
  p.KVC = (bf*)carve((size_t)TT * 256 * 2);
  p.GS = (bf*)carve((size_t)256 * 16 * 512 * 16);
  if (off > ws_size) { fprintf(stderr, "workspace too small: need %zu have %zu\n", off, ws_size); return; }
  for (int j = 0; j < 8; j++) p.inv[j] = (float)pow(500000.0, -(double)j / 8.0);
  const size_t kDynLds = 2 * HALF_LDS;
  static int grid_blocks = 0;
  if (!grid_blocks) {
    int dev = 0, cus = 0, per_cu = 0;
    (void)hipGetDevice(&dev);
    (void)hipDeviceGetAttribute(&cus, hipDeviceAttributeMultiprocessorCount, dev);
    (void)hipFuncSetAttribute((const void*)mega_kernel, hipFuncAttributeMaxDynamicSharedMemorySize, (int)kDynLds);
    (void)hipOccupancyMaxActiveBlocksPerMultiprocessor(&per_cu, mega_kernel, 512, kDynLds);
    if (per_cu > 1) per_cu = 1;
    grid_blocks = cus * per_cu;
    if (grid_blocks > 256) grid_blocks = 256;
    grid_blocks -= grid_blocks % 8;
  }
  void* args[] = {&p};
  hipError_t e = hipLaunchCooperativeKernel((void*)mega_kernel, dim3(grid_blocks), dim3(512), args, kDynLds, stream);
  if (e != hipSuccess) fprintf(stderr, "cooperative launch failed: %s (grid %d)\n", hipGetErrorString(e), grid_blocks);
}
```

```cpp
#include <hip/hip_runtime.h>
#include <hip/hip_cooperative_groups.h>
#include <cstdio>
#include <cmath>
namespace cg = cooperative_groups;

#ifndef MK_COOP
#define MK_COOP 1
#endif
#ifndef PROBE_MASK
#define PROBE_MASK 0
#endif

typedef unsigned short bf;
typedef short bf16x8 __attribute__((ext_vector_type(8)));
typedef float f32x16 __attribute__((ext_vector_type(16)));
typedef float f32x4 __attribute__((ext_vector_type(4)));

#define TT 32768
#define LSEQ 16384
#define DM 2048
#define INW 13908
#define PW 5760
#define C_S5U 0
#define C_S5Z 512
#define C_ATQ 1024
#define C_ATK 1536
#define C_ATV 1664
#define C_ATZ 1792
#define C_IDQ 2304
#define C_IDK 2560
#define C_IDW 2624
#define C_SSZ 2640
#define C_XBC 3664
#define C_SDT 5200
#define C_MEQ 5216
#define C_MEZ 5472
#define YW 2304
#define Y_S5 0
#define Y_ATT 512
#define Y_SSD 1024
#define Y_MEM 2048
#define CAP 480
#define HALF_LDS 77824

struct Params {
  const float *x, *mem; const int* pos;
  const float *w_in, *b_gate, *lam_re, *lam_im, *log_dt, *b_re, *b_im, *c_re, *c_im, *s5_d, *w_glu, *b_glu,
      *conv_w, *conv_b, *dt_bias, *a_log, *ssd_d, *norm_g, *mem_w_kv, *w_br_s5, *w_br_attn, *w_br_ssd, *w_br_mem,
      *w_out, *ln_g, *ln_b;
  float* out;
  bf *WinT, *WbrT, *WoutT, *WgluT, *WmemT, *memb, *xb, *P, *Y, *YG, *KIF, *MK, *MVT, *CM, *KVC, *GS;
  float *ST, *CS, *END, *CD, *SB, *SA;
  float inv[8];
};

__device__ __forceinline__ float ozero() { float z = 0.f; asm volatile("" : "+v"(z)); return z; }
__device__ __forceinline__ int otid_full() { int t = threadIdx.x; asm volatile("" : "+v"(t)); return t; }
__device__ __forceinline__ int otid() { return otid_full() & 255; }
#define HB (__builtin_amdgcn_readfirstlane(otid_full() >> 8))
#define VB ((int)blockIdx.x * 2 + HB)
#define G2 ((int)gridDim.x * 2)
__device__ __forceinline__ float bf2f(bf v) { return __uint_as_float(((unsigned)v) << 16); }
__device__ __forceinline__ float bflo(unsigned u) { return __uint_as_float(u << 16); }
__device__ __forceinline__ float bfhi(unsigned u) { return __uint_as_float(u & 0xFFFF0000u); }
typedef float f32x2p_t __attribute__((ext_vector_type(2)));
typedef __bf16 bf16x2p_t __attribute__((ext_vector_type(2)));
__device__ __forceinline__ unsigned pk2(float lo, float hi) {
  f32x2p_t v = {lo, hi};
  return __builtin_bit_cast(unsigned, __builtin_convertvector(v, bf16x2p_t));
}
__device__ __forceinline__ bf f2bf(float f) { return (bf)(pk2(f, 0.f) & 0xFFFFu); }
__device__ __forceinline__ float sigmoidf_(float x) { return __builtin_amdgcn_rcpf(1.f + __expf(-x)); }
__device__ __forceinline__ float siluf_(float x) { return x * __builtin_amdgcn_rcpf(1.f + __expf(-x)); }
__device__ __forceinline__ float geluf_(float x) {
  float u = 0.7978845608028654f * (x + 0.044715f * x * x * x);
  float t = 1.f - 2.f * __builtin_amdgcn_rcpf(1.f + __expf(2.f * u));
  return 0.5f * x * (1.f + t);
}
__device__ __forceinline__ f32x16 mfma32(bf16x8 a, bf16x8 b, f32x16 c) { return __builtin_amdgcn_mfma_f32_32x32x16_bf16(a, b, c, 0, 0, 0); }
__device__ __forceinline__ f32x4 mfma16(bf16x8 a, bf16x8 b, f32x4 c) { return __builtin_amdgcn_mfma_f32_16x16x32_bf16(a, b, c, 0, 0, 0); }

__device__ __forceinline__ bool tile_map(int L, int nMt, int nNt, int SM, int SN, int& tm, int& tn) {
  int per = SM * SN; int x = L & 7; int jj = L >> 3; int sl = jj / per; int j = jj - sl * per; int S = sl * 8 + x;
  int nSn = nNt / SN; int NS = (nMt / SM) * nSn;
  if (S >= NS) return false;
  int mg = S / nSn, ng = S - mg * nSn;
  tm = mg * SM + j / SN; tn = ng * SN + j % SN; return true;
}

typedef unsigned u32x4 __attribute__((ext_vector_type(4)));
struct GStage { u32x4 a0, a1, b0, b1; };
#define G_LOAD(S, ko) { S.a0 = *(const u32x4*)(ga + (ko)); S.a1 = *(const u32x4*)(ga + a64 + (ko)); S.b0 = *(const u32x4*)(gb + (ko)); S.b1 = *(const u32x4*)(gb + b64 + (ko)); }
#define G_WRITE(S, base) { *(u32x4*)(sA + (base) + woff) = S.a0; *(u32x4*)(sA + (base) + woff + 5120) = S.a1; *(u32x4*)(sB + (base) + woff) = S.b0; *(u32x4*)(sB + (base) + woff + 5120) = S.b1; }
#define G_ITER(kt, cur, S)                                                          \
  {                                                                                 \
    _Pragma("unroll") for (int ks = 0; ks < 2; ks++) {                              \
      bf16x8 a0 = *(const bf16x8*)(sA + (cur) + aoff + ks * 32);                    \
      bf16x8 a1 = *(const bf16x8*)(sA + (cur) + aoff + 2560 + ks * 32);             \
      bf16x8 b0 = *(const bf16x8*)(sB + (cur) + boff + ks * 32);                    \
      bf16x8 b1 = *(const bf16x8*)(sB + (cur) + boff + 2560 + ks * 32);             \
      acc[0][0] = mfma32(b0, a0, acc[0][0]);                                        \
      acc[0][1] = mfma32(b1, a0, acc[0][1]);                                        \
      acc[1][0] = mfma32(b0, a1, acc[1][0]);                                        \
      acc[1][1] = mfma32(b1, a1, acc[1][1]);                                        \
    }                                                                               \
    if ((kt) + 1 < nk) {                                                            \
      G_WRITE(S, 10240 - (cur))                                                     \
      if ((kt) + 1 + D < nk) G_LOAD(S, ((kt) + 1 + D) * 32)                         \
    }                                                                               \
    __syncthreads();                                                                \
  }
template <int D>
__device__ __forceinline__ void gemm_acc(const bf* __restrict__ A, int lda, const bf* __restrict__ Bt, int ldb, int K,
                                         f32x16 (&acc)[2][2], char* sm) {
  const int tid = otid(), lane = tid & 63, w = tid >> 6, wr = w >> 1, wc = w & 1, r32 = lane & 31, h5 = lane >> 5;
  const int lrow = tid >> 2, lch = tid & 3;
  const bf* ga = A + (size_t)lrow * lda + lch * 8;
  const bf* gb = Bt + (size_t)lrow * ldb + lch * 8;
  const size_t a64 = (size_t)64 * lda, b64 = (size_t)64 * ldb;
  const int nk = K >> 5;
  char* sA = sm; char* sB = sm + 20480;
  const int woff = lrow * 80 + lch * 16;
  const int aoff = (wr * 64 + r32) * 80 + h5 * 16, boff = (wc * 64 + r32) * 80 + h5 * 16;
  GStage S0, S1, S2, S3;
  G_LOAD(S0, 0) G_LOAD(S1, 32)
  if (D == 4) { G_LOAD(S2, 64) G_LOAD(S3, 96) }
  G_WRITE(S0, 0)
  if (D < nk) G_LOAD(S0, D * 32)
  __syncthreads();
  for (int kt0 = 0; kt0 < nk; kt0 += D) {
    if (D == 4) {
      G_ITER(kt0, 0, S1) G_ITER(kt0 + 1, 10240, S2) G_ITER(kt0 + 2, 0, S3) G_ITER(kt0 + 3, 10240, S0)
    } else {
      G_ITER(kt0, 0, S1) G_ITER(kt0 + 1, 10240, S0)
    }
  }
}
#define ZERO_ACC(a) { const float z_ = ozero(); for (int i_ = 0; i_ < 2; i_++) for (int j_ = 0; j_ < 2; j_++) for (int r_ = 0; r_ < 16; r_++) a[i_][j_][r_] = z_; }


extern __shared__ __attribute__((aligned(16))) char dynsm[];
#define G8_HT (128 * 64)
#define G8_SA(b, h) ((bf*)dynsm + ((b) * 2 + (h)) * G8_HT)
#define G8_SB(b, h) ((bf*)dynsm + (4 + (b) * 2 + (h)) * G8_HT)
__device__ __forceinline__ int g8_lds_byte(int r, int c) {
  int st = (r >> 4) * 2 + (c >> 5), rr = r & 15, cc = c & 31, ob = rr * 64 + cc * 2;
  return st * 1024 + (ob ^ (((ob >> 9) & 1) << 5));
}
__device__ __forceinline__ void g8_stage_rc(int b, int& R, int& C) {
  int st = b / 1024, sb = b % 1024, swz = sb ^ (((sb >> 9) & 1) << 5);
  R = (st >> 1) * 16 + swz / 64; C = (st & 1) * 32 + (swz % 64) / 2;
}
#define G8_LAS __attribute__((address_space(3)))
#define G8_HTB (128 * 64 * 2)
#define G8_OSA(b, h) (((b) * 2 + (h)) * G8_HTB)
#define G8_OSB(b, h) ((4 + (b) * 2 + (h)) * G8_HTB)
#define G8_STAGE(bufoff, gbase, voff) do { _Pragma("unroll") for (int _i = 0; _i < 2; ++_i) \
    __builtin_amdgcn_global_load_lds((const unsigned*)((const char*)(gbase) + (voff)[_i]), (G8_LAS unsigned*)(lds + (bufoff) + ldsw + _i * 8192), 16, 0, 0); } while (0)
#define G8_LDA(dst, b, h) do { _Pragma("unroll") for (int m = 0; m < 4; ++m) _Pragma("unroll") for (int k = 0; k < 2; ++k) dst[m][k] = *(const G8_LAS bf16x8*)(lds + G8_OSA(b, h) + aoff + m * 2048 + k * 1024); } while (0)
#define G8_LDB(dst, b, h) do { _Pragma("unroll") for (int n = 0; n < 2; ++n) _Pragma("unroll") for (int k = 0; k < 2; ++k) dst[n][k] = *(const G8_LAS bf16x8*)(lds + G8_OSB(b, h) + boff + n * 2048 + k * 1024); } while (0)
#define G8_MMA(ai, bj, At_, Bt_) do { __builtin_amdgcn_s_setprio(1);                                                 \
    _Pragma("unroll") for (int m = 0; m < 4; ++m) _Pragma("unroll") for (int n = 0; n < 2; ++n) _Pragma("unroll") for (int k = 0; k < 2; ++k) \
      acc[ai][bj][m][n] = __builtin_amdgcn_mfma_f32_16x16x32_bf16(Bt_[n][k], At_[m][k], acc[ai][bj][m][n], 0, 0, 0); \
    __builtin_amdgcn_s_setprio(0); } while (0)
#define G8_WAIT_V(n) asm volatile("s_waitcnt vmcnt(" #n ")" ::: "memory")
#define G8_WAIT_L(n) asm volatile("s_waitcnt lgkmcnt(" #n ")" ::: "memory")
#define G8_BAR __builtin_amdgcn_s_barrier()
#define G8_SCHED __builtin_amdgcn_sched_barrier(0)

__device__ __forceinline__ void gemm256(const bf* __restrict__ A, int lda, const bf* __restrict__ Bt, int ldb, int K,
                                        int brow, int bcol, f32x4 (&acc)[2][2][4][2]) {
  G8_LAS unsigned char* lds = (G8_LAS unsigned char*)dynsm;
  const int tid = otid_full(), wid = __builtin_amdgcn_readfirstlane(tid >> 6), lane = tid & 63, wr = wid >> 2, wc = wid & 3, fr = lane & 15, fq = lane >> 4;
  unsigned voffA[2], voffB[2];
#pragma unroll
  for (int i = 0; i < 2; ++i) { int R, C; g8_stage_rc(tid * 16 + i * 8192, R, C); voffA[i] = (unsigned)(R * lda + C) * 2u; voffB[i] = (unsigned)(R * ldb + C) * 2u; }
  const size_t kstep = 128;
  const size_t hstepA = (size_t)128 * lda * 2, hstepB = (size_t)128 * ldb * 2;
  const unsigned ldsw = (unsigned)wid * 1024u;
  const int aoff = g8_lds_byte(wr * 64 + fr, fq * 8), boff = g8_lds_byte(wc * 32 + fr, fq * 8);
  const char* cA = (const char*)A + (size_t)brow * lda * 2; const char* cB = (const char*)Bt + (size_t)bcol * ldb * 2;
  bf16x8 At[4][2], B0[2][2], B1[2][2];
  const int nt = K / 64;
  __syncthreads();
  G8_STAGE(G8_OSB(0, 0), cB, voffB); G8_STAGE(G8_OSA(0, 0), cA, voffA); G8_STAGE(G8_OSB(0, 1), cB + hstepB, voffB); G8_STAGE(G8_OSA(0, 1), cA + hstepA, voffA);
  if (wr == 1) G8_BAR;
  G8_WAIT_V(4); G8_BAR;
  G8_STAGE(G8_OSB(1, 0), cB + kstep, voffB); G8_STAGE(G8_OSA(1, 0), cA + kstep, voffA); G8_STAGE(G8_OSB(1, 1), cB + hstepB + kstep, voffB);
  G8_WAIT_V(6); G8_BAR;
  for (int t = 0; t < nt - 2; t += 2) {
    const char* a1 = cA + (size_t)(t + 1) * kstep;
    const char* a2 = cA + (size_t)(t + 2) * kstep; const char* b2 = cB + (size_t)(t + 2) * kstep;
    const char* a3 = a2 + kstep; const char* b3 = b2 + kstep;
    G8_LDB(B0, 0, 0); G8_SCHED; G8_LDA(At, 0, 0); G8_STAGE(G8_OSA(1, 1), a1 + hstepA, voffA);
    G8_WAIT_L(8); G8_BAR; G8_WAIT_L(0); G8_MMA(0, 0, At, B0); G8_BAR; G8_SCHED;
    G8_LDB(B1, 0, 1); G8_STAGE(G8_OSB(0, 0), b2, voffB);
    G8_BAR; G8_WAIT_L(0); G8_MMA(0, 1, At, B1); G8_BAR;
    G8_LDA(At, 0, 1); G8_STAGE(G8_OSA(0, 0), a2, voffA);
    G8_BAR; G8_WAIT_L(0); G8_MMA(1, 0, At, B0); G8_BAR; G8_SCHED;
    G8_STAGE(G8_OSB(0, 1), b2 + hstepB, voffB);
    G8_WAIT_V(6); G8_BAR; G8_MMA(1, 1, At, B1); G8_BAR;
    G8_LDB(B0, 1, 0); G8_SCHED; G8_LDA(At, 1, 0); G8_STAGE(G8_OSA(0, 1), a2 + hstepA, voffA);
    G8_WAIT_L(8); G8_BAR; G8_WAIT_L(0); G8_MMA(0, 0, At, B0); G8_BAR; G8_SCHED;
    G8_LDB(B1, 1, 1); G8_STAGE(G8_OSB(1, 0), b3, voffB);
    G8_BAR; G8_WAIT_L(0); G8_MMA(0, 1, At, B1); G8_BAR;
    G8_LDA(At, 1, 1); G8_STAGE(G8_OSA(1, 0), a3, voffA);
    G8_BAR; G8_WAIT_L(0); G8_MMA(1, 0, At, B0); G8_BAR; G8_SCHED;
    G8_STAGE(G8_OSB(1, 1), b3 + hstepB, voffB);
    G8_WAIT_V(6); G8_BAR; G8_MMA(1, 1, At, B1); G8_BAR;
  }
  { const char* a1 = cA + (size_t)(nt - 1) * kstep;
    G8_LDB(B0, 0, 0); G8_LDA(At, 0, 0); G8_STAGE(G8_OSA(1, 1), a1 + hstepA, voffA);
    G8_BAR; G8_WAIT_L(0); G8_MMA(0, 0, At, B0); G8_BAR;
    G8_LDB(B1, 0, 1); G8_BAR; G8_WAIT_L(0); G8_MMA(0, 1, At, B1); G8_BAR;
    G8_LDA(At, 0, 1); G8_WAIT_V(4); G8_BAR; G8_WAIT_L(0); G8_MMA(1, 0, At, B0); G8_MMA(1, 1, At, B1); G8_BAR; }
  { G8_LDB(B0, 1, 0); G8_LDA(At, 1, 0); G8_WAIT_V(2); G8_BAR; G8_WAIT_L(0); G8_MMA(0, 0, At, B0); G8_BAR;
    G8_LDB(B1, 1, 1); G8_WAIT_V(0); G8_BAR; G8_WAIT_L(0); G8_MMA(0, 1, At, B1); G8_BAR;
    G8_LDA(At, 1, 1); G8_BAR; G8_WAIT_L(0); G8_MMA(1, 0, At, B0); G8_MMA(1, 1, At, B1); G8_BAR; }
  if (wr == 0) G8_BAR;
}
#define ZERO_ACC8(a) { float z_ = 0.f; asm volatile("" : "+v"(z_)); _Pragma("unroll") for (int i_ = 0; i_ < 2; i_++) _Pragma("unroll") for (int j_ = 0; j_ < 2; j_++) _Pragma("unroll") for (int m_ = 0; m_ < 4; m_++) _Pragma("unroll") for (int n_ = 0; n_ < 2; n_++) a[i_][j_][m_][n_] = (f32x4){z_, z_, z_, z_}; }
__device__ __forceinline__ bool tile_order(int L, int nM, int nN, int& pm, int& pn) {
  const int nwg = nM * nN; if (L >= nwg) return false;
  int wgid = L; { const int q = nwg / 8, r = nwg % 8, xcd = wgid % 8, off = wgid / 8; wgid = (xcd < r ? xcd * (q + 1) : r * (q + 1) + (xcd - r) * q) + off; }
  const int nig = 8 * nN, gid = wgid / nig, fm = gid * 8, gsz = (nM - fm) < 8 ? (nM - fm) : 8;
  pm = fm + ((wgid % nig) % gsz); pn = (wgid % nig) / gsz; return true;
}

__device__ __forceinline__ void transpose_tile(const float* __restrict__ src, int R, int C, bf* __restrict__ dst, int ldd, int off, int tile, bf* sm) {
  const int tilesC = (C + 63) >> 6;
  const int tr = tile / tilesC, tc = tile - tr * tilesC;
  const int r0 = tr * 64, c0 = tc * 64;
  const int tid = otid();
#pragma unroll
  for (int i = 0; i < 4; i++) {
    int r = (tid >> 4) + 16 * i; int c = (tid & 15) * 4;
    const float zt_ = ozero(); float4 v = make_float4(zt_, zt_, zt_, zt_);
    if (c0 + c < C) v = *(const float4*)(src + (size_t)(r0 + r) * C + c0 + c);
    sm[(c + 0) * 66 + r] = f2bf(v.x); sm[(c + 1) * 66 + r] = f2bf(v.y);
    sm[(c + 2) * 66 + r] = f2bf(v.z); sm[(c + 3) * 66 + r] = f2bf(v.w);
  }
  __syncthreads();
  {
    int c = tid >> 2, ch = (tid & 3) * 16;
    if (c0 + c < C) {
      unsigned wv[8];
#pragma unroll
      for (int k = 0; k < 8; k++) wv[k] = *(const unsigned*)(sm + c * 66 + ch + 2 * k);
      bf* d = dst + (size_t)(c0 + c) * ldd + off + r0 + ch;
      *(uint4*)d = make_uint4(wv[0], wv[1], wv[2], wv[3]);
      *(uint4*)(d + 8) = make_uint4(wv[4], wv[5], wv[6], wv[7]);
    }
  }
  __syncthreads();
}

__device__ __forceinline__ bool try_tr(int& t, const float* src, int R, int C, bf* dst, int ldd, int off, bf* sm) {
  int nt = (R >> 6) * ((C + 63) >> 6);
  if (t < nt) { transpose_tile(src, R, C, dst, ldd, off, t, sm); return true; }
  t -= nt; return false;
}

__device__ __forceinline__ void phase0(const Params& p, char* smc) {
  bf* sm = (bf*)(smc + HB * HALF_LDS);
  const int perLayer = 32 * 218 + 256 + 256 + 512 + 128 + 1024 + 64 + 256;
  for (int task = VB; task < 2 * perLayer; task += G2) {
    int layer = task / perLayer; int t = task - layer * perLayer;
    bf* WbrL = p.WbrT + (size_t)layer * 2048 * YW;
    if (try_tr(t, p.w_in + (size_t)layer * DM * INW, 2048, INW, p.WinT + (size_t)layer * INW * 2048, 2048, 0, sm)) continue;
    if (try_tr(t, p.w_br_s5 + (size_t)layer * 512 * 2048, 512, 2048, WbrL, YW, 0, sm)) continue;
    if (try_tr(t, p.w_br_attn + (size_t)layer * 512 * 2048, 512, 2048, WbrL, YW, 512, sm)) continue;
    if (try_tr(t, p.w_br_ssd + (size_t)layer * 1024 * 2048, 1024, 2048, WbrL, YW, 1024, sm)) continue;
    if (try_tr(t, p.w_br_mem + (size_t)layer * 256 * 2048, 256, 2048, WbrL, YW, 2048, sm)) continue;
    if (try_tr(t, p.w_out + (size_t)layer * 2048 * 2048, 2048, 2048, p.WoutT + (size_t)layer * 2048 * 2048, 2048, 0, sm)) continue;
    if (try_tr(t, p.w_glu + (size_t)layer * 512 * 512, 512, 512, p.WgluT + (size_t)layer * 512 * 512, 512, 0, sm)) continue;
    if (try_tr(t, p.mem_w_kv + (size_t)layer * 2048 * 512, 2048, 512, p.WmemT + (size_t)layer * 512 * 2048, 2048, 0, sm)) continue;
  }
  const size_t gtid = (size_t)blockIdx.x * 512 + otid_full(), gstr = (size_t)gridDim.x * 512;
  for (size_t i0 = gtid; i0 < (size_t)TT * DM / 8; i0 += 4 * gstr) {
    float4 a[4], b[4];
#pragma unroll
    for (int k = 0; k < 4; k++) {
      const size_t i = i0 + k * gstr;
      if (i < (size_t)TT * DM / 8) { a[k] = *(const float4*)(p.x + i * 8); b[k] = *(const float4*)(p.x + i * 8 + 4); }
    }
#pragma unroll
    for (int k = 0; k < 4; k++) {
      const size_t i = i0 + k * gstr;
      if (i < (size_t)TT * DM / 8)
        *(uint4*)(p.xb + i * 8) = make_uint4(pk2(a[k].x, a[k].y), pk2(a[k].z, a[k].w), pk2(b[k].x, b[k].y), pk2(b[k].z, b[k].w));
    }
  }
  for (size_t i = gtid; i < (size_t)512 * DM / 8; i += gstr) {
    float4 a = *(const float4*)(p.mem + i * 8), b = *(const float4*)(p.mem + i * 8 + 4);
    *(uint4*)(p.memb + i * 8) = make_uint4(pk2(a.x, a.y), pk2(a.z, a.w), pk2(b.x, b.y), pk2(b.z, b.w));
  }
  for (size_t i = gtid; i < (size_t)TT; i += gstr) {
    const float ps = (float)p.pos[i];
#pragma unroll
    for (int j = 0; j < 8; j++) {
      float ang = ps * p.inv[j];
      float s, c; sincosf(ang, &s, &c);
      p.CS[i * 16 + j] = c; p.CS[i * 16 + 8 + j] = s;
    }
  }
  for (size_t i = gtid; i < 2 * 32 * 64; i += gstr) {
    int pp = (int)(i & 63), g = (int)((i >> 6) & 31), layer = (int)(i >> 11);
    float dt = expf(p.log_dt[layer * 32 + g]);
    float lr = p.lam_re[i], li = p.lam_im[i];
    float mag = expf(lr * dt);
    float sn, cs; sincosf(li * dt, &sn, &cs);
    float ar = mag * cs, ai = mag * sn;
    float den = lr * lr + li * li;
    float nr = ar - 1.f, ni = ai;
    float fr = (nr * lr + ni * li) / den, fi = (ni * lr - nr * li) / den;
    float* sb = p.SB + i * 32;
    const float* bre = p.b_re + i * 16; const float* bim = p.b_im + i * 16;
    for (int h = 0; h < 16; h++) {
      float br = bre[h], bi = bim[h];
      sb[h] = fr * br - fi * bi; sb[16 + h] = fr * bi + fi * br;
    }
    float pr = ar, pi = ai;
    for (int k = 0; k < 7; k++) { float nr2 = pr * pr - pi * pi, ni2 = 2.f * pr * pi; pr = nr2; pi = ni2; }
    p.SA[i * 4 + 0] = ar; p.SA[i * 4 + 1] = ai; p.SA[i * 4 + 2] = pr; p.SA[i * 4 + 3] = pi;
    for (int h = 0; h < 16; h++) {
      size_t ci = ((size_t)(layer * 32 + g) * 16 + h);
      p.CM[ci * 128 + pp] = f2bf(p.c_re[ci * 64 + pp]);
      p.CM[ci * 128 + 64 + pp] = f2bf(-p.c_im[ci * 64 + pp]);
    }
  }
}

__device__ __forceinline__ void phaseA(const Params& p, int layer) {
  const int tidf = otid_full();
  const int wid = __builtin_amdgcn_readfirstlane(tidf >> 6), lane = tidf & 63, wr = wid >> 2, wc = wid & 3, fr = lane & 15, fq = lane >> 4;
  const bf* Wl = p.WinT + (size_t)layer * INW * 2048;
  const int nA = 128 * 23;
  const int total = nA + (layer == 0 ? 8 : 0);
  for (int L = blockIdx.x; L < total; L += gridDim.x) {
    f32x4 acc[2][2][4][2]; ZERO_ACC8(acc);
    if (L < nA) {
      int pm, pn; tile_order(L, 128, 23, pm, pn);
      const int brow = pm * 256, bcol = pn * 256;
      gemm256(p.xb, 2048, Wl, 2048, 2048, brow, bcol, acc);
      int fr_o = fr; asm volatile("" : "+v"(fr_o));
#pragma unroll
      for (int ai = 0; ai < 2; ai++)
#pragma unroll
        for (int m = 0; m < 4; m++) {
          __builtin_amdgcn_sched_barrier(0);
          const int tok = brow + ai * 128 + wr * 64 + m * 16 + fr_o;
#pragma unroll
          for (int bj = 0; bj < 2; bj++)
#pragma unroll
            for (int n = 0; n < 2; n++) {
              const int cb = bcol + bj * 128 + wc * 32 + n * 16;
              f32x4 v = acc[ai][bj][m][n];
              if (n == 0 && (wc & 1) == 0 && ((cb >= C_ATQ && cb < C_ATV) || (cb >= C_IDQ && cb < C_IDW))) {
                f32x4 cs = *(const f32x4*)(p.CS + (size_t)tok * 16 + 4 * (fq & 1));
                f32x4 sn = *(const f32x4*)(p.CS + (size_t)tok * 16 + 8 + 4 * (fq & 1));
#pragma unroll
                for (int e = 0; e < 4; e++) {
                  float o = __shfl_xor(v[e], 32);
                  v[e] = (fq < 2) ? (v[e] * cs[e] - o * sn[e]) : (v[e] * cs[e] + o * sn[e]);
                }
              }
              const int nn = cb + fq * 4;
              if (nn < 5716) {
                const int dn = nn + (nn >= 2628 ? 12 : 0);
                uint2 pv = make_uint2(pk2(v[0], v[1]), pk2(v[2], v[3]));
                *(uint2*)(p.P + (size_t)tok * PW + dn) = pv;
                if (nn >= C_IDK && nn < C_IDW) {
                  const int d = nn - C_IDK; const int b = tok >> 14, li = tok & 16383;
                  size_t o = ((((size_t)(b * 512 + (li >> 5)) * 4 + (d >> 4)) * 64 + ((d >> 3) & 1) * 32 + (li & 31)) * 8) + (d & 7);
                  *(uint2*)(p.KIF + o) = pv;
                }
                if (nn >= C_ATK && nn < C_ATZ) *(uint2*)(p.KVC + (size_t)tok * 256 + (nn - C_ATK)) = pv;
              }
            }
        }
    } else {
      const int t8 = L - nA; const int ly = t8 >> 2, tm = (t8 >> 1) & 1, tn = t8 & 1;
      gemm256(p.memb, 2048, p.WmemT + (size_t)ly * 512 * 2048, 2048, 2048, tm * 256, tn * 256, acc);
#pragma unroll
      for (int ai = 0; ai < 2; ai++)
#pragma unroll
        for (int m = 0; m < 4; m++) {
          const int row = tm * 256 + ai * 128 + wr * 64 + m * 16 + fr; const int b = row >> 8, mm = row & 255;
#pragma unroll
          for (int bj = 0; bj < 2; bj++)
#pragma unroll
            for (int n = 0; n < 2; n++)
#pragma unroll
              for (int e = 0; e < 4; e++) {
                const int nn = tn * 256 + bj * 128 + wc * 32 + n * 16 + fq * 4 + e; const float v = acc[ai][bj][m][n][e];
                if (nn < 256) { int h = nn >> 6, d = nn & 63; p.MK[((((size_t)ly * 2 + b) * 4 + h) * 256 + mm) * 64 + d] = f2bf(v); }
                else { int h = (nn - 256) >> 6, d = nn & 63; p.MVT[((((size_t)ly * 2 + b) * 4 + h) * 64 + d) * 256 + mm] = f2bf(v); }
              }
        }
    }
  }
}

__device__ __forceinline__ float softplusf_(float x) {
  const float e = __expf(x);
  const float sp = (e < 0.01f) ? e * (1.f - 0.5f * e) : __logf(1.f + e);
  return x > 15.f ? x : sp;
}

__device__ __forceinline__ void ssd_dt_acs(const Params& p, int layer, size_t tok0, int gg, float* sAcs, float* sDt) {
  const int tid = otid(), lane = tid & 63, w = tid >> 6;
#pragma unroll
  for (int k = 0; k < 2; k++) {
    const int hh = 2 * w + k, hd = gg * 8 + hh;
    const float bias = p.dt_bias[layer * 16 + hd], a = -__expf(p.a_log[layer * 16 + hd]);
    const int l0 = 2 * lane;
    float d0 = softplusf_(bf2f(p.P[(tok0 + l0) * PW + C_SDT + hd]) + bias);
    float d1 = softplusf_(bf2f(p.P[(tok0 + l0 + 1) * PW + C_SDT + hd]) + bias);
    float s0 = d0 * a, s1 = s0 + d1 * a;
    float xs = s1;
#pragma unroll
    for (int off = 1; off < 64; off <<= 1) { float v = __shfl_up(xs, off); if (lane >= off) xs += v; }
    float ex = xs - s1;
    sAcs[l0 * 8 + hh] = ex + s0; sAcs[(l0 + 1) * 8 + hh] = ex + s1;
    sDt[l0 * 8 + hh] = d0; sDt[(l0 + 1) * 8 + hh] = d1;
  }
}

struct Conv2 { float w0[4], w1[4], b0, b1, h0[3], h1[3]; };
__device__ __forceinline__ void conv_init(const Params& p, int layer, size_t tokb, int l, int ch, Conv2& c) {
  const float* cw = p.conv_w + (size_t)layer * 4 * 1536 + ch;
#pragma unroll
  for (int k = 0; k < 4; k++) { c.w0[k] = cw[k * 1536]; c.w1[k] = cw[k * 1536 + 1]; }
  c.b0 = p.conv_b[layer * 1536 + ch]; c.b1 = p.conv_b[layer * 1536 + ch + 1];
#pragma unroll
  for (int k = 0; k < 3; k++) {
    int ll = l - 3 + k; unsigned u = 0;
    if (ll >= 0) u = *(const unsigned*)(p.P + (tokb + ll) * PW + C_XBC + ch);
    c.h0[k] = bflo(u); c.h1[k] = bfhi(u);
  }
}
__device__ __forceinline__ void conv_step(const Params& p, size_t tokb, int l, int ch, Conv2& c, float& o0, float& o1) {
  unsigned u = *(const unsigned*)(p.P + (tokb + l) * PW + C_XBC + ch);
  float x0 = bflo(u), x1 = bfhi(u);
  float a0 = c.b0 + c.w0[0] * c.h0[0] + c.w0[1] * c.h0[1] + c.w0[2] * c.h0[2] + c.w0[3] * x0;
  float a1 = c.b1 + c.w1[0] * c.h1[0] + c.w1[1] * c.h1[1] + c.w1[2] * c.h1[2] + c.w1[3] * x1;
  c.h0[0] = c.h0[1]; c.h0[1] = c.h0[2]; c.h0[2] = x0;
  c.h1[0] = c.h1[1]; c.h1[1] = c.h1[2]; c.h1[2] = x1;
  o0 = siluf_(a0); o1 = siluf_(a1);
}

__device__ __forceinline__ void conv_val(unsigned u, Conv2& c, float& o0, float& o1) {
  float x0 = bflo(u), x1 = bfhi(u);
  float a0 = c.b0 + c.w0[0] * c.h0[0] + c.w0[1] * c.h0[1] + c.w0[2] * c.h0[2] + c.w0[3] * x0;
  float a1 = c.b1 + c.w1[0] * c.h1[0] + c.w1[1] * c.h1[1] + c.w1[2] * c.h1[2] + c.w1[3] * x1;
  c.h0[0] = c.h0[1]; c.h0[1] = c.h0[2]; c.h0[2] = x0;
  c.h1[0] = c.h1[1]; c.h1[1] = c.h1[2]; c.h1[2] = x1;
  o0 = siluf_(a0); o1 = siluf_(a1);
}
#define CONV_PRELOAD(raw, N, lfirst, nrows, ch)                                                           \
  unsigned raw[N];                                                                                        \
  _Pragma("unroll") for (int k_ = 0; k_ < N; k_++)                                                        \
    raw[k_] = (k_ < (nrows)) ? *(const unsigned*)(p.P + (tokb + (lfirst) + k_) * PW + C_XBC + (ch)) : 0u;

__device__ __forceinline__ void ssd_pass1(const Params& p, int layer, int task, char* sm) {
  const int tid = otid(), lane = tid & 63, w = tid >> 6, r32 = lane & 31, h5 = lane >> 5;
  const int gg = task & 1, c = (task >> 1) & 127, b = task >> 8;
  const size_t tokb = (size_t)b * LSEQ; const int lc0 = c * 128; const size_t tok0 = tokb + lc0;
  float* sAcs = (float*)sm; float* sDt = (float*)(sm + 4096);
  bf* sBT = (bf*)(sm + 8192); bf* sXT = (bf*)(sm + 43008);
  __syncthreads();
  ssd_dt_acs(p, layer, tok0, gg, sAcs, sDt);
  {
    const int cp = tid & 63, tg = tid >> 6; const int ch = 1024 + gg * 128 + 2 * cp;
    Conv2 cv; conv_init(p, layer, tokb, lc0 + tg * 32, ch, cv);
    CONV_PRELOAD(raw, 32, lc0 + tg * 32, 32, ch)
#pragma unroll
    for (int k = 0; k < 32; k += 2) {
      const int l = tg * 32 + k;
      float a0, a1, b0, b1;
      conv_val(raw[k], cv, a0, a1);
      conv_val(raw[k + 1], cv, b0, b1);
      *(unsigned*)(sBT + (2 * cp) * 136 + l) = pk2(a0, b0);
      *(unsigned*)(sBT + (2 * cp + 1) * 136 + l) = pk2(a1, b1);
    }
  }
  __syncthreads();
  if (tid < 8) p.CD[((size_t)(b * 128 + c)) * 16 + gg * 8 + tid] = __expf(sAcs[127 * 8 + tid]);
  for (int hh = 0; hh < 8; hh++) {
    const int hd = gg * 8 + hh;
    if (hh) __syncthreads();
    {
      const int cp = tid & 31, tg = tid >> 5; const int ch = gg * 512 + hh * 64 + 2 * cp;
      const float aend = sAcs[127 * 8 + hh];
      Conv2 cv; conv_init(p, layer, tokb, lc0 + tg * 16, ch, cv);
      CONV_PRELOAD(raw, 16, lc0 + tg * 16, 16, ch)
#pragma unroll
      for (int k = 0; k < 16; k += 2) {
        const int l = tg * 16 + k;
        float a0, a1, b0, b1;
        conv_val(raw[k], cv, a0, a1);
        conv_val(raw[k + 1], cv, b0, b1);
        float sa = sDt[l * 8 + hh] * __expf(aend - sAcs[l * 8 + hh]);
        float sb = sDt[(l + 1) * 8 + hh] * __expf(aend - sAcs[(l + 1) * 8 + hh]);
        *(unsigned*)(sXT + (2 * cp) * 136 + l) = pk2(a0 * sa, b0 * sb);
        *(unsigned*)(sXT + (2 * cp + 1) * 136 + l) = pk2(a1 * sa, b1 * sb);
      }
    }
    __syncthreads();
    f32x16 acc[2];
#pragma unroll
    for (int r = 0; r < 16; r++) { const float z_ = ozero(); acc[0][r] = z_; acc[1][r] = z_; }
#pragma unroll
    for (int ks = 0; ks < 8; ks++) {
      bf16x8 bfr = *(const bf16x8*)(sBT + (32 * w + r32) * 136 + ks * 16 + 8 * h5);
      bf16x8 x0 = *(const bf16x8*)(sXT + (r32) * 136 + ks * 16 + 8 * h5);
      bf16x8 x1 = *(const bf16x8*)(sXT + (32 + r32) * 136 + ks * 16 + 8 * h5);
      acc[0] = mfma32(x0, bfr, acc[0]);
      acc[1] = mfma32(x1, bfr, acc[1]);
    }
    float* st = p.ST + ((size_t)(b * 128 + c) * 16 + hd) * 64 * 128;
#pragma unroll
    for (int pi = 0; pi < 2; pi++)
#pragma unroll
      for (int r = 0; r < 16; r++) {
        int pp = 32 * pi + 8 * (r >> 2) + 4 * h5 + (r & 3);
        st[pp * 128 + 32 * w + r32] = acc[pi][r];
      }
  }
}

__device__ __forceinline__ void ssd_statepass(const Params& p, int task) {
  const int idx = task * 256 + otid();
  const int b = idx >> 15, e4 = idx & 32767;
  const int hd = e4 >> 11;
  const float zc_ = ozero(); float4 carry = make_float4(zc_, zc_, zc_, zc_);
  float* base = p.ST + (size_t)b * 128 * 131072 + (size_t)e4 * 4;
  const float* cd = p.CD + (size_t)b * 128 * 16 + hd;
  for (int c0 = 0; c0 < 128; c0 += 4) {
    float4 v[4]; float d[4];
#pragma unroll
    for (int k = 0; k < 4; k++) { v[k] = *(const float4*)(base + (size_t)(c0 + k) * 131072); d[k] = cd[(c0 + k) * 16]; }
#pragma unroll
    for (int k = 0; k < 4; k++) {
      *(float4*)(base + (size_t)(c0 + k) * 131072) = carry;
      carry.x = carry.x * d[k] + v[k].x; carry.y = carry.y * d[k] + v[k].y;
      carry.z = carry.z * d[k] + v[k].z; carry.w = carry.w * d[k] + v[k].w;
    }
  }
}

__device__ __forceinline__ void ssd_pass2(const Params& p, int layer, int task, char* sm) {
  const int tid = otid(), lane = tid & 63, w = tid >> 6, r32 = lane & 31, h5 = lane >> 5;
  const int lh = task & 1, gg = (task >> 1) & 1, c = (task >> 2) & 127, b = task >> 9;
  const size_t tokb = (size_t)b * LSEQ; const int lc0 = c * 128; const size_t tok0 = tokb + lc0;
  float* sAcs = (float*)sm; float* sDt = (float*)(sm + 4096);
  bf* sC = (bf*)(sm + 8192); bf* sB = (bf*)(sm + 25600); bf* sM = (bf*)(sm + 25600); bf* sXT = (bf*)(sm + 43008);
  float* sSsq = (float*)(sm + 60416);
  const int wr = w >> 1, wc = w & 1;
  const int nS = 64 * (lh + 1);
  __syncthreads();
  ssd_dt_acs(p, layer, tok0, gg, sAcs, sDt);
  {
    const int cp = tid & 63, tg = tid >> 6;
    {
      const int ch = 1280 + gg * 128 + 2 * cp;
      const int lst = 64 * lh + tg * 16;
      Conv2 cv; conv_init(p, layer, tokb, lc0 + lst, ch, cv);
      CONV_PRELOAD(raw, 16, lc0 + lst, 16, ch)
#pragma unroll
      for (int k = 0; k < 16; k++) {
        const int l = lst + k;
        float a0, a1; conv_val(raw[k], cv, a0, a1);
        *(unsigned*)(sC + (l - 64 * lh) * 136 + 2 * cp) = pk2(a0, a1);
      }
    }
    {
      const int ch = 1024 + gg * 128 + 2 * cp;
      const int per = nS >> 2; const int lst = tg * per;
      Conv2 cv; conv_init(p, layer, tokb, lc0 + lst, ch, cv);
      CONV_PRELOAD(raw, 32, lc0 + lst, per, ch)
#pragma unroll
      for (int k = 0; k < 32; k++) {
        if (k < per) {
          const int l = lst + k;
          float a0, a1; conv_val(raw[k], cv, a0, a1);
          *(unsigned*)(sB + l * 136 + 2 * cp) = pk2(a0, a1);
        }
      }
    }
  }
  __syncthreads();
  f32x16 cb[2];
#pragma unroll
  for (int r = 0; r < 16; r++) { const float z_ = ozero(); cb[0][r] = z_; cb[1][r] = z_; }
  if (64 * wc < nS) {
#pragma unroll
    for (int ks = 0; ks < 8; ks++) {
      bf16x8 af = *(const bf16x8*)(sC + (32 * wr + r32) * 136 + ks * 16 + 8 * h5);
      bf16x8 b0 = *(const bf16x8*)(sB + (64 * wc + r32) * 136 + ks * 16 + 8 * h5);
      bf16x8 b1 = *(const bf16x8*)(sB + (64 * wc + 32 + r32) * 136 + ks * 16 + 8 * h5);
      cb[0] = mfma32(af, b0, cb[0]);
      cb[1] = mfma32(af, b1, cb[1]);
    }
  }
  __syncthreads();
  const int wc2 = w & 1;
  for (int hh = 0; hh < 8; hh++) {
    const int hd = gg * 8 + hh;
    if (hh) __syncthreads();
    bf16x8 pfr[8];
    {
      const float* pv = p.ST + (((size_t)(b * 128 + c) * 16 + hd) * 64 + 32 * wc2 + r32) * 128 + 8 * h5;
#pragma unroll
      for (int ks = 0; ks < 8; ks++) {
        float4 u0 = *(const float4*)(pv + ks * 16), u1 = *(const float4*)(pv + ks * 16 + 4);
        unsigned q0 = pk2(u0.x, u0.y), q1 = pk2(u0.z, u0.w), q2 = pk2(u1.x, u1.y), q3 = pk2(u1.z, u1.w);
        pfr[ks][0] = (short)(q0 & 0xFFFF); pfr[ks][1] = (short)(q0 >> 16); pfr[ks][2] = (short)(q1 & 0xFFFF); pfr[ks][3] = (short)(q1 >> 16);
        pfr[ks][4] = (short)(q2 & 0xFFFF); pfr[ks][5] = (short)(q2 >> 16); pfr[ks][6] = (short)(q3 & 0xFFFF); pfr[ks][7] = (short)(q3 >> 16);
      }
    }
    {
      const float dsk = p.ssd_d[layer * 16 + hd];
#pragma unroll
      for (int j = 0; j < 2; j++) {
        const int s = 64 * wc + 32 * j + r32;
        if (s < nS) {
          const float as = sAcs[s * 8 + hh];
#pragma unroll
          for (int r = 0; r < 16; r++) {
            const int lp = 32 * wr + 8 * (r >> 2) + 4 * h5 + (r & 3); const int l = 64 * lh + lp;
            float v = 0.f;
            if (s <= l) v = cb[j][r] * __expf(sAcs[l * 8 + hh] - as);
            if (s == l) v += dsk * __builtin_amdgcn_rcpf(sDt[l * 8 + hh]);
            sM[lp * 136 + s] = f2bf(v);
          }
        }
      }
    }
    {
      const int cp = tid & 31, tg = tid >> 5; const int ch = gg * 512 + hh * 64 + 2 * cp;
      const int per = nS >> 3; const int lst = tg * per;
      Conv2 cv; conv_init(p, layer, tokb, lc0 + lst, ch, cv);
      CONV_PRELOAD(raw, 16, lc0 + lst, per, ch)
#pragma unroll
      for (int k = 0; k < 16; k += 2) {
        if (k >= per) break;
        const int l = lst + k;
        float a0, a1, b0, b1;
        conv_val(raw[k], cv, a0, a1);
        conv_val(raw[k + 1], cv, b0, b1);
        float sa = sDt[l * 8 + hh], sb = sDt[(l + 1) * 8 + hh];
        *(unsigned*)(sXT + (2 * cp) * 136 + l) = pk2(a0 * sa, b0 * sb);
        *(unsigned*)(sXT + (2 * cp + 1) * 136 + l) = pk2(a1 * sa, b1 * sb);
      }
    }
    __syncthreads();
    f32x16 yd, yo;
#pragma unroll
    for (int r = 0; r < 16; r++) { const float z_ = ozero(); yd[r] = z_; yo[r] = z_; }
    const int nks = nS >> 4;
    for (int ks = 0; ks < nks; ks++) {
      bf16x8 xf = *(const bf16x8*)(sXT + (32 * wc2 + r32) * 136 + ks * 16 + 8 * h5);
      bf16x8 mf = *(const bf16x8*)(sM + (32 * wr + r32) * 136 + ks * 16 + 8 * h5);
      yd = mfma32(xf, mf, yd);
    }
    {
#pragma unroll
      for (int ks = 0; ks < 8; ks++) {
        bf16x8 cf = *(const bf16x8*)(sC + (32 * wr + r32) * 136 + ks * 16 + 8 * h5);
        yo = mfma32(pfr[ks], cf, yo);
      }
    }
    {
      const int lp = 32 * wr + r32; const int l = 64 * lh + lp; const size_t tok = tok0 + l;
      const float eo = __expf(sAcs[l * 8 + hh]);
      float ss = 0.f;
#pragma unroll
      for (int q = 0; q < 4; q++) {
        const int pp = 32 * wc2 + 8 * q + 4 * h5;
        uint2 zz = *(const uint2*)(p.P + tok * PW + C_SSZ + hd * 64 + pp);
        float v0 = (yd[4 * q] + eo * yo[4 * q]) * siluf_(bflo(zz.x));
        float v1 = (yd[4 * q + 1] + eo * yo[4 * q + 1]) * siluf_(bfhi(zz.x));
        float v2 = (yd[4 * q + 2] + eo * yo[4 * q + 2]) * siluf_(bflo(zz.y));
        float v3 = (yd[4 * q + 3] + eo * yo[4 * q + 3]) * siluf_(bfhi(zz.y));
        ss += v0 * v0 + v1 * v1 + v2 * v2 + v3 * v3;
        *(uint2*)(p.Y + tok * YW + Y_SSD + hd * 64 + pp) = make_uint2(pk2(v0, v1), pk2(v2, v3));
      }
      sSsq[lp * 32 + hh * 4 + wc2 * 2 + h5] = ss;
    }
  }
  __syncthreads();
  {
    const int lp = tid >> 2, part = tid & 3; const size_t tok = tok0 + 64 * lh + lp;
    float tot = 0.f;
#pragma unroll
    for (int k = 0; k < 32; k += 4) { float4 v4 = *(const float4*)(sSsq + lp * 32 + k); tot += (v4.x + v4.y) + (v4.z + v4.w); }
    const float rs = rsqrtf(tot * (1.f / 512.f) + 1e-5f);
    bf* yp = p.Y + tok * YW + Y_SSD + gg * 512 + part * 128;
    const float* ng = p.norm_g + layer * 1024 + gg * 512 + part * 128;
#pragma unroll 4
    for (int i = 0; i < 16; i++) {
      uint4 u = *(const uint4*)(yp + i * 8);
      float4 g0 = *(const float4*)(ng + i * 8), g1 = *(const float4*)(ng + i * 8 + 4);
      u.x = pk2(bflo(u.x) * rs * g0.x, bfhi(u.x) * rs * g0.y);
      u.y = pk2(bflo(u.y) * rs * g0.z, bfhi(u.y) * rs * g0.w);
      u.z = pk2(bflo(u.z) * rs * g1.x, bfhi(u.z) * rs * g1.y);
      u.w = pk2(bflo(u.w) * rs * g1.z, bfhi(u.w) * rs * g1.w);
      *(uint4*)(yp + i * 8) = u;
    }
  }
}

__device__ __forceinline__ void s5_ld_u(const Params& p, size_t tok, int g, uint4& a, uint4& b) {
  const uint4* src = (const uint4*)(p.P + tok * PW + C_S5U + g * 16);
  a = src[0]; b = src[1];
}
__device__ __forceinline__ void s5_st_u(float* dst, const uint4 a, const uint4 b) {
  *(float4*)(dst + 0) = make_float4(bflo(a.x), bfhi(a.x), bflo(a.y), bfhi(a.y));
  *(float4*)(dst + 4) = make_float4(bflo(a.z), bfhi(a.z), bflo(a.w), bfhi(a.w));
  *(float4*)(dst + 8) = make_float4(bflo(b.x), bfhi(b.x), bflo(b.y), bfhi(b.y));
  *(float4*)(dst + 12) = make_float4(bflo(b.z), bfhi(b.z), bflo(b.w), bfhi(b.w));
}
__device__ __forceinline__ void s5_load_u(const Params& p, size_t tok, int g, float* dst) {
  const uint4* src = (const uint4*)(p.P + tok * PW + C_S5U + g * 16);
  uint4 a = src[0], b = src[1];
  *(float4*)(dst + 0) = make_float4(bflo(a.x), bfhi(a.x), bflo(a.y), bfhi(a.y));
  *(float4*)(dst + 4) = make_float4(bflo(a.z), bfhi(a.z), bflo(a.w), bfhi(a.w));
  *(float4*)(dst + 8) = make_float4(bflo(b.x), bfhi(b.x), bflo(b.y), bfhi(b.y));
  *(float4*)(dst + 12) = make_float4(bflo(b.z), bfhi(b.z), bflo(b.w), bfhi(b.w));
}
typedef float f32x2 __attribute__((ext_vector_type(2)));
#define S5_STEP(uu)                                                                     \
  {                                                                                     \
    float4 u0 = *(const float4*)((uu)), u1 = *(const float4*)((uu) + 4), u2 = *(const float4*)((uu) + 8), u3 = *(const float4*)((uu) + 12); \
    f32x2 bb = B2[0] * (f32x2){u0.x, u0.x};                                             \
    bb = B2[1] * (f32x2){u0.y, u0.y} + bb; bb = B2[2] * (f32x2){u0.z, u0.z} + bb; bb = B2[3] * (f32x2){u0.w, u0.w} + bb;     \
    bb = B2[4] * (f32x2){u1.x, u1.x} + bb; bb = B2[5] * (f32x2){u1.y, u1.y} + bb; bb = B2[6] * (f32x2){u1.z, u1.z} + bb; bb = B2[7] * (f32x2){u1.w, u1.w} + bb; \
    bb = B2[8] * (f32x2){u2.x, u2.x} + bb; bb = B2[9] * (f32x2){u2.y, u2.y} + bb; bb = B2[10] * (f32x2){u2.z, u2.z} + bb; bb = B2[11] * (f32x2){u2.w, u2.w} + bb; \
    bb = B2[12] * (f32x2){u3.x, u3.x} + bb; bb = B2[13] * (f32x2){u3.y, u3.y} + bb; bb = B2[14] * (f32x2){u3.z, u3.z} + bb; bb = B2[15] * (f32x2){u3.w, u3.w} + bb; \
    float nr_ = ar * sr - ai * si + bb.x; float ni_ = ar * si + ai * sr + bb.y; sr = nr_; si = ni_; \
  }

__device__ __forceinline__ void s5_pass1(const Params& p, int layer, int task, char* sm) {
  const int tid = otid(), lane = tid & 63, w = tid >> 6;
  const int gq = task & 7, c = (task >> 3) & 127, b = task >> 10;
  const int g = gq * 4 + w;
  const size_t tok0 = (size_t)b * LSEQ + c * 128;
  float* sU = (float*)(sm + w * 8192);
  __syncthreads();
  s5_load_u(p, tok0 + lane, g, sU + lane * 16);
  s5_load_u(p, tok0 + 64 + lane, g, sU + (64 + lane) * 16);
  const size_t pi = ((size_t)(layer * 32 + g)) * 64 + lane;
  f32x2 B2[16];
#pragma unroll
  for (int h = 0; h < 16; h++) { B2[h].x = p.SB[pi * 32 + h]; B2[h].y = p.SB[pi * 32 + 16 + h]; }
  const float ar = p.SA[pi * 4], ai = p.SA[pi * 4 + 1];
  float sr = 0.f, si = 0.f;
  __builtin_amdgcn_wave_barrier();
  for (int l = 0; l < 128; l++) S5_STEP(sU + l * 16)
  *(float2*)(p.END + (((size_t)(b * 128 + c) * 32 + g) * 64 + lane) * 2) = make_float2(sr, si);
}

__device__ __forceinline__ void s5_carry(const Params& p, int layer, int task) {
  const int idx = task * 256 + otid();
  const int b = idx >> 11, gp = idx & 2047;
  const size_t pi = (size_t)layer * 2048 + gp;
  const float a128r = p.SA[pi * 4 + 2], a128i = p.SA[pi * 4 + 3];
  float sr = ozero(), si = ozero();
  float2* e = (float2*)p.END + (size_t)b * 128 * 2048 + gp;
  for (int c0 = 0; c0 < 128; c0 += 4) {
    float2 v[4];
#pragma unroll
    for (int k = 0; k < 4; k++) v[k] = e[(size_t)(c0 + k) * 2048];
#pragma unroll
    for (int k = 0; k < 4; k++) {
      e[(size_t)(c0 + k) * 2048] = make_float2(sr, si);
      float nr = a128r * sr - a128i * si + v[k].x, ni = a128r * si + a128i * sr + v[k].y; sr = nr; si = ni;
    }
  }
}

__device__ __forceinline__ void s5_pass2(const Params& p, int layer, int task, char* sm) {
  const int tid = otid(), lane = tid & 63, w = tid >> 6;
  const int c = task & 127, b = task >> 7;
  const size_t tok0 = (size_t)b * LSEQ + c * 128;
  float* sU = (float*)(sm + w * 10752); bf* sS = (bf*)(sm + w * 10752 + 2048);
  __syncthreads();
  uint4 ua, ub;
  s5_ld_u(p, tok0 + (lane & 31), w * 8, ua, ub);
  for (int gi = 0; gi < 8; gi++) {
    const int g = w * 8 + gi;
    const size_t pi = ((size_t)(layer * 32 + g)) * 64 + lane;
    f32x2 B2[16];
#pragma unroll
    for (int h = 0; h < 16; h++) { B2[h].x = p.SB[pi * 32 + h]; B2[h].y = p.SB[pi * 32 + 16 + h]; }
    const float ar = p.SA[pi * 4], ai = p.SA[pi * 4 + 1];
    float2 s0 = *(const float2*)(p.END + (((size_t)(b * 128 + c) * 32 + g) * 64 + lane) * 2);
    float sr = s0.x, si = s0.y;
    bf16x8 cf[4];
    {
      const bf* cm = p.CM + (((size_t)(layer * 32 + g)) * 16 + (lane & 15)) * 128 + 8 * (lane >> 4);
#pragma unroll
      for (int ks = 0; ks < 4; ks++) cf[ks] = *(const bf16x8*)(cm + ks * 32);
    }
    const float dsk = p.s5_d[(layer * 32 + g) * 16 + (lane & 15)];
    for (int sub = 0; sub < 4; sub++) {
      __builtin_amdgcn_wave_barrier();
      if (lane < 32) s5_st_u(sU + lane * 16, ua, ub);
      {
        const int nsub = (sub + 1) & 3; const int ng = g + (sub == 3 ? 1 : 0);
        if (sub < 3 || gi < 7) s5_ld_u(p, tok0 + nsub * 32 + (lane & 31), ng, ua, ub);
      }
      __builtin_amdgcn_wave_barrier();
      for (int l = 0; l < 32; l++) {
        S5_STEP(sU + l * 16)
        sS[l * 136 + lane] = f2bf(sr); sS[l * 136 + 64 + lane] = f2bf(si);
      }
      __builtin_amdgcn_wave_barrier();
#pragma unroll
      for (int mb = 0; mb < 2; mb++) {
        const float z_ = ozero(); f32x4 acc = {z_, z_, z_, z_};
#pragma unroll
        for (int ks = 0; ks < 4; ks++) {
          bf16x8 af = *(const bf16x8*)(sS + (16 * mb + (lane & 15)) * 136 + ks * 32 + 8 * (lane >> 4));
          acc = mfma16(af, cf[ks], acc);
        }
#pragma unroll
        for (int r = 0; r < 4; r++) {
          const int l = 16 * mb + 4 * (lane >> 4) + r;
          float y = acc[r] + dsk * sU[l * 16 + (lane & 15)];
          p.YG[(tok0 + sub * 32 + l) * 512 + g * 16 + (lane & 15)] = f2bf(geluf_(y));
        }
      }
    }
  }
  __syncthreads();
  const int wr = w >> 1, wc = w & 1, r32 = lane & 31, h5 = lane >> 5;
  for (int tn = 0; tn < 4; tn++) {
    f32x16 acc[2][2]; ZERO_ACC(acc);
    gemm_acc<4>(p.YG + tok0 * 512, 512, p.WgluT + ((size_t)layer * 512 + tn * 128) * 512, 512, 512, acc, sm);
#pragma unroll
    for (int i = 0; i < 2; i++) {
      const size_t tok = tok0 + wr * 64 + i * 32 + r32;
#pragma unroll
      for (int j = 0; j < 2; j++)
#pragma unroll
        for (int q = 0; q < 4; q++) {
          const int n = tn * 128 + wc * 64 + j * 32 + q * 8 + h5 * 4;
          float4 bg = *(const float4*)(p.b_glu + layer * 512 + n);
          uint2 yy = *(const uint2*)(p.YG + tok * 512 + n);
          uint2 zz = *(const uint2*)(p.P + tok * PW + C_S5Z + n);
          float o0 = bflo(yy.x) * sigmoidf_(acc[i][j][4 * q] + bg.x) * siluf_(bflo(zz.x));
          float o1 = bfhi(yy.x) * sigmoidf_(acc[i][j][4 * q + 1] + bg.y) * siluf_(bfhi(zz.x));
          float o2 = bflo(yy.y) * sigmoidf_(acc[i][j][4 * q + 2] + bg.z) * siluf_(bflo(zz.y));
          float o3 = bfhi(yy.y) * sigmoidf_(acc[i][j][4 * q + 3] + bg.w) * siluf_(bfhi(zz.y));
          *(uint2*)(p.Y + tok * YW + Y_S5 + n) = make_uint2(pk2(o0, o1), pk2(o2, o3));
        }
    }
  }
}

__device__ __forceinline__ void mem_attn(const Params& p, int layer, int task) {
  const int tid = otid(), lane = tid & 63, h = tid >> 6;
  const int n16 = lane & 15, kq = lane >> 4;
  const size_t tok0 = (size_t)task * 16; const int b = (int)(tok0 >> 14);
  const bf* mk = p.MK + (((size_t)layer * 2 + b) * 4 + h) * 256 * 64;
  const bf* mvt = p.MVT + (((size_t)layer * 2 + b) * 4 + h) * 64 * 256;
  bf16x8 qf[2];
  {
    const bf* qp = p.P + (tok0 + n16) * PW + C_MEQ + h * 64 + 8 * kq;
    qf[0] = *(const bf16x8*)qp; qf[1] = *(const bf16x8*)(qp + 32);
  }
  f32x4 st[16];
#pragma unroll
  for (int kb = 0; kb < 16; kb++) {
    const bf* kp = mk + (size_t)(16 * kb + n16) * 64 + 8 * kq;
    bf16x8 a0 = *(const bf16x8*)kp, a1 = *(const bf16x8*)(kp + 32);
    const float z_ = ozero(); f32x4 acc = {z_, z_, z_, z_};
    acc = mfma16(a0, qf[0], acc); acc = mfma16(a1, qf[1], acc);
    st[kb] = acc * 0.125f;
  }
  float mx = -3.0e38f;
#pragma unroll
  for (int kb = 0; kb < 16; kb++)
#pragma unroll
    for (int r = 0; r < 4; r++) mx = fmaxf(mx, st[kb][r]);
  mx = fmaxf(mx, __shfl_xor(mx, 16)); mx = fmaxf(mx, __shfl_xor(mx, 32));
  float sum = 0.f;
#pragma unroll
  for (int kb = 0; kb < 16; kb++)
#pragma unroll
    for (int r = 0; r < 4; r++) { float e = __expf(st[kb][r] - mx); st[kb][r] = e; sum += e; }
  sum += __shfl_xor(sum, 16); sum += __shfl_xor(sum, 32);
  const float rinv = 1.f / sum;
  f32x4 o[4];
#pragma unroll
  for (int mb = 0; mb < 4; mb++) { const float z_ = ozero(); o[mb] = (f32x4){z_, z_, z_, z_}; }
#pragma unroll
  for (int k2 = 0; k2 < 8; k2++) {
    bf16x8 pf;
    unsigned q0 = pk2(st[2 * k2][0], st[2 * k2][1]), q1 = pk2(st[2 * k2][2], st[2 * k2][3]);
    unsigned q2 = pk2(st[2 * k2 + 1][0], st[2 * k2 + 1][1]), q3 = pk2(st[2 * k2 + 1][2], st[2 * k2 + 1][3]);
    pf[0] = (short)(q0 & 0xFFFF); pf[1] = (short)(q0 >> 16); pf[2] = (short)(q1 & 0xFFFF); pf[3] = (short)(q1 >> 16);
    pf[4] = (short)(q2 & 0xFFFF); pf[5] = (short)(q2 >> 16); pf[6] = (short)(q3 & 0xFFFF); pf[7] = (short)(q3 >> 16);
#pragma unroll
    for (int mb = 0; mb < 4; mb++) {
      const bf* vp = mvt + (size_t)(16 * mb + n16) * 256 + 32 * k2 + 4 * kq;
      uint2 v0 = *(const uint2*)vp, v1 = *(const uint2*)(vp + 16);
      bf16x8 af;
      af[0] = (short)(v0.x & 0xFFFF); af[1] = (short)(v0.x >> 16); af[2] = (short)(v0.y & 0xFFFF); af[3] = (short)(v0.y >> 16);
      af[4] = (short)(v1.x & 0xFFFF); af[5] = (short)(v1.x >> 16); af[6] = (short)(v1.y & 0xFFFF); af[7] = (short)(v1.y >> 16);
      o[mb] = mfma16(af, pf, o[mb]);
    }
  }
  const size_t tok = tok0 + n16;
#pragma unroll
  for (int mb = 0; mb < 4; mb++) {
    const int d = 16 * mb + 4 * kq;
    uint2 zz = *(const uint2*)(p.P + tok * PW + C_MEZ + h * 64 + d);
    float v0 = o[mb][0] * rinv * siluf_(bflo(zz.x)), v1 = o[mb][1] * rinv * siluf_(bfhi(zz.x));
    float v2 = o[mb][2] * rinv * siluf_(bflo(zz.y)), v3 = o[mb][3] * rinv * siluf_(bfhi(zz.y));
    *(uint2*)(p.Y + tok * YW + Y_MEM + h * 64 + d) = make_uint2(pk2(v0, v1), pk2(v2, v3));
  }
}

__device__ __forceinline__ void dsa_wave(const Params& p, int rank, char* sm) {
  const int tid = otid(), lane = tid & 63, w = tid >> 6, r32 = lane & 31, h5 = lane >> 5;
  const int b = rank & 1, qg = 2047 - (rank >> 1), l0 = qg * 8;
  const size_t tokb = (size_t)b * LSEQ;
  unsigned* cand = (unsigned*)(sm + w * (8 * CAP * 4));
  bf* Pb = (bf*)(sm + 61440 + w * 4096);
  bf16x8 aq[4];
  {
    const bf* qp = p.P + (tokb + l0 + (r32 >> 2)) * PW + C_IDQ + (r32 & 3) * 64 + 8 * h5;
#pragma unroll
    for (int ks = 0; ks < 4; ks++) aq[ks] = *(const bf16x8*)(qp + ks * 16);
  }
  float wv[4][4]; int ql[4];
#pragma unroll
  for (int g = 0; g < 4; g++) {
    ql[g] = l0 + 2 * g + h5;
    uint2 u = *(const uint2*)(p.P + (tokb + ql[g]) * PW + C_IDW);
    wv[g][0] = bflo(u.x) * 0.0625f; wv[g][1] = bfhi(u.x) * 0.0625f; wv[g][2] = bflo(u.y) * 0.0625f; wv[g][3] = bfhi(u.y) * 0.0625f;
  }
  unsigned Tg[4] = {0u, 0u, 0u, 0u}; float Tf[4];
  unsigned Tq = 0u; int cntv = 0;
  int nrep_ = (PROBE_MASK & 32) ? 2 : 1; asm volatile("" : "+s"(nrep_));
#pragma unroll 1
  for (int rep_ = 0; rep_ < nrep_; rep_++) {
  Tg[0] = Tg[1] = Tg[2] = Tg[3] = 0u; Tq = 0u; cntv = 0;
  Tf[0] = Tf[1] = Tf[2] = Tf[3] = -__builtin_inff();
  const int ntile = (l0 + 7) / 32 + 1;
  const bf* kif = p.KIF + (size_t)b * 512 * 2048 + lane * 8;
  bf16x8 bqA[4][4], bqB[4][4];
#pragma unroll
  for (int s = 0; s < 4; s++) {
    const int ts = s < ntile ? s : ntile - 1;
#pragma unroll
    for (int ks = 0; ks < 4; ks++) bqA[s][ks] = *(const bf16x8*)(kif + (size_t)ts * 2048 + ks * 512);
  }
  const unsigned ltmask = (1u << r32) - 1u;
#define DSA_COMPACT_CHECK()                                                                                              \
  {                                                                                                                     \
    unsigned long long over = __ballot(lane < 8 && cntv > CAP - 64);                                                    \
    if (over) {                                                                                                         \
      while (over) {                                                                                                    \
        const int q = __builtin_ctzll(over); over &= over - 1;                                                          \
        const int n = __builtin_amdgcn_readlane(cntv, q);                                                               \
        unsigned* cb_ = cand + q * CAP;                                                                                 \
        unsigned e[8];                                                                                                  \
        _Pragma("unroll") for (int i = 0; i < 8; i++) e[i] = (i * 64 + lane < n) ? cb_[i * 64 + lane] : 0u;             \
        unsigned T = 0u; int cT = n;                                                                                    \
        int nsr_ = (PROBE_MASK & 64) ? 2 : 1; asm volatile("" : "+s"(nsr_));                                            \
        _Pragma("unroll 1") for (int sr_ = 0; sr_ < nsr_; sr_++) { T = 0u; cT = n;                                      \
        const unsigned Told_ = (unsigned)__builtin_amdgcn_readlane((int)Tq, q);                                         \
        for (int bit = 31; bit >= 18; bit--) {                                                                          \
          const unsigned cnd = T | (1u << bit); int cc = 0;                                                             \
          if (cnd <= Told_) { T = cnd; continue; }                       \
          _Pragma("unroll") for (int i = 0; i < 8; i++) cc += __popcll(__ballot(e[i] >= cnd));                          \
          if (cc >= 256) { T = cnd; cT = cc; }                                                                          \
        } }                                                                                                             \
        if (cT > 320) {                                                                                                 \
          for (int bit = 17; bit >= 0; bit--) {                                                                         \
            const unsigned cnd = T | (1u << bit); int cc = 0;                                                           \
            _Pragma("unroll") for (int i = 0; i < 8; i++) cc += __popcll(__ballot(e[i] >= cnd));                        \
            if (cc >= 256) T = cnd;                                                                                     \
          }                                                                                                             \
        }                                                                                                               \
        int pos = 0;                                                                                                    \
        _Pragma("unroll") for (int i = 0; i < 8; i++) {                                                                 \
          const bool keep = e[i] >= T; const unsigned long long m = __ballot(keep);                                     \
          if (keep) cb_[pos + __popcll(m & ((1ull << lane) - 1ull))] = e[i];                                            \
          pos += __popcll(m);                                                                                           \
        }                                                                                                               \
        if (lane == q) { cntv = pos; Tq = T; }                                                                          \
      }                                                                                                                 \
      _Pragma("unroll") for (int g = 0; g < 4; g++) {                                                                   \
        unsigned tlo = __builtin_amdgcn_readlane(Tq, 2 * g), thi = __builtin_amdgcn_readlane(Tq, 2 * g + 1);            \
        Tg[g] = h5 ? thi : tlo;                                                                                         \
        const unsigned sh = Tg[g] & 0xFFFFC000u;                                                                        \
        const unsigned fb = (sh & 0x80000000u) ? (sh ^ 0x80000000u) : ~sh;                                              \
        Tf[g] = Tg[g] ? __uint_as_float(fb) : -__builtin_inff();                                                        \
      }                                                                                                                 \
    }                                                                                                                   \
  }
#define DSA_G(g, DIAG)                                                                                                  \
      {                                                                                                                 \
        const float r0 = __int_as_float(max(__float_as_int(acc[4 * g]), 0)), r1 = __int_as_float(max(__float_as_int(acc[4 * g + 1]), 0)); \
        const float r2 = __int_as_float(max(__float_as_int(acc[4 * g + 2]), 0)), r3 = __int_as_float(max(__float_as_int(acc[4 * g + 3]), 0)); \
        float sc = r0 * wv[g][0]; sc = fmaf(r1, wv[g][1], sc); sc = fmaf(r2, wv[g][2], sc); sc = fmaf(r3, wv[g][3], sc); \
        unsigned long long m0 = __builtin_amdgcn_fcmpf(sc, Tf[g], 3  );                                            \
        if (DIAG) m0 &= __builtin_amdgcn_sicmp(kidx, ql[g], 41  );                                                 \
        if (m0) {                                                                                                       \
          const float s2 = sc + 0.f;                                                                                    \
          unsigned uu = __float_as_uint(s2); uu ^= ((unsigned)((int)uu >> 31) | 0x80000000u);                           \
          const unsigned pk = (uu & 0xFFFFC000u) | (unsigned)(16383 - kidx);                                            \
          const unsigned long long m = m0 & __builtin_amdgcn_uicmp(pk, Tg[g], 35  );                              \
          if (m) {                                                                                                      \
            const unsigned lo = (unsigned)m, hi = (unsigned)(m >> 32);                                                  \
            const int cA = __builtin_amdgcn_readlane(cntv, 2 * g), cB = __builtin_amdgcn_readlane(cntv, 2 * g + 1);     \
            const unsigned mm = h5 ? hi : lo;                                                                           \
            if ((mm >> r32) & 1u) {                                                                                     \
              const int base = h5 ? cB : cA;                                                                            \
              cand[(2 * g + h5) * CAP + base + __popc(mm & ltmask)] = pk;                                               \
            }                                                                                                           \
            if (lane == 2 * g) cntv += __popc(lo);                                                                      \
            if (lane == 2 * g + 1) cntv += __popc(hi);                                                                  \
          }                                                                                                             \
        }                                                                                                               \
      }
#define DSA_GROUP(BC, BN, TB)                                                                                           \
  _Pragma("unroll") for (int u = 0; u < 4; u++) {                                                                       \
    if ((u & 1) == 0) DSA_COMPACT_CHECK()                                                                               \
    const int tile = (TB) + u;                                                                                          \
    f32x16 acc = {0.f, 0.f, 0.f, 0.f, 0.f, 0.f, 0.f, 0.f, 0.f, 0.f, 0.f, 0.f, 0.f, 0.f, 0.f, 0.f};                    \
    _Pragma("unroll") for (int ks = 0; ks < 4; ks++) acc = mfma32(aq[ks], BC[u][ks], acc);                              \
    if (u == 0) {                                                                                                       \
      _Pragma("unroll") for (int s = 0; s < 4; s++) {                                                                   \
        const int tn_ = ((TB) + 4 + s < ntile) ? (TB) + 4 + s : ntile - 1;                                              \
        _Pragma("unroll") for (int ks = 0; ks < 4; ks++) BN[s][ks] = *(const bf16x8*)(kif + (size_t)tn_ * 2048 + ks * 512); \
      }                                                                                                                 \
    }                                                                                                                   \
    const int kidx = tile * 32 + r32;                                                                                   \
    const bool diag = (tile * 32 + 31 > l0);                                                                            \
    if (!diag) { DSA_G(0, false) DSA_G(1, false) DSA_G(2, false) DSA_G(3, false) }                                      \
    else { DSA_G(0, true) DSA_G(1, true) DSA_G(2, true) DSA_G(3, true) }                                                \
  }
  for (int tile0 = 0; tile0 < ntile; tile0 += 8) {
    DSA_GROUP(bqA, bqB, tile0)
    DSA_GROUP(bqB, bqA, tile0 + 4)
  }
  {
    unsigned long long over = __ballot(lane < 8 && cntv > 256);
    while (over) {
      const int q = __builtin_ctzll(over); over &= over - 1;
      const int n = __builtin_amdgcn_readlane(cntv, q);
      unsigned* cb_ = cand + q * CAP;
      unsigned e[8];
#pragma unroll
      for (int i = 0; i < 8; i++) e[i] = (i * 64 + lane < n) ? cb_[i * 64 + lane] : 0u;
      unsigned T = 0u;
      const unsigned Told_ = (unsigned)__builtin_amdgcn_readlane((int)Tq, q);
      for (int bit = 31; bit >= 0; bit--) {
        const unsigned cnd = T | (1u << bit); int cc = 0;
        if (cnd <= Told_) { T = cnd; continue; }
#pragma unroll
        for (int i = 0; i < 8; i++) cc += __popcll(__ballot(e[i] >= cnd));
        if (cc >= 256) T = cnd;
      }
      int pos = 0;
#pragma unroll
      for (int i = 0; i < 8; i++) {
        const bool keep = e[i] >= T; const unsigned long long m = __ballot(keep);
        if (keep) cb_[pos + __popcll(m & ((1ull << lane) - 1ull))] = e[i];
        pos += __popcll(m);
      }
      if (lane == q) { cntv = pos; Tq = T; }
    }
  }
  }
  __builtin_amdgcn_wave_barrier();
  const int n16 = lane & 15, kq = lane >> 4;
#define DPP_ROR(v, n) __int_as_float(__builtin_amdgcn_update_dpp(0, __float_as_int(v), 0x120 + (n), 0xf, 0xf, false))
  for (int q = 0; q < 8; q++) {
    const int n = __builtin_amdgcn_readlane(cntv, q);
    const unsigned* sel = cand + q * CAP;
    const size_t tq = tokb + l0 + q;
    float ssum[2][4];
    bf16x8 qa[2][2];
#pragma unroll
    for (int grp = 0; grp < 2; grp++) {
#pragma unroll
      for (int k = 0; k < 8; k++) { int zi_ = 0; asm volatile("" : "+v"(zi_)); qa[grp][0][k] = (short)zi_; qa[grp][1][k] = (short)zi_; }
      if (n16 < 4) {
        const bf* qp = p.P + tq * PW + C_ATQ + (grp * 4 + n16) * 64 + 8 * kq;
        qa[grp][0] = *(const bf16x8*)qp; qa[grp][1] = *(const bf16x8*)(qp + 32);
      }
    }
    f32x4 lgA[16], lgB[16];
#pragma unroll
    for (int t = 0; t < 16; t++) {
      const int slot = t * 16 + n16; const bool valid = slot < n;
      const int key = valid ? (16383 - (int)(sel[slot] & 0x3FFFu)) : 0;
      const bf* kp = p.KVC + (tokb + key) * 256 + 8 * kq;
      bf16x8 a0 = *(const bf16x8*)kp, a1 = *(const bf16x8*)(kp + 32), b0 = *(const bf16x8*)(kp + 64), b1 = *(const bf16x8*)(kp + 96);
      const float zc_ = ozero(); f32x4 ca = {zc_, zc_, zc_, zc_}, cb2 = {zc_, zc_, zc_, zc_};
      ca = mfma16(qa[0][0], a0, ca); ca = mfma16(qa[0][1], a1, ca);
      cb2 = mfma16(qa[1][0], b0, cb2); cb2 = mfma16(qa[1][1], b1, cb2);
      const bool ok = valid && (kq == 0);
#pragma unroll
      for (int r = 0; r < 4; r++) { lgA[t][r] = ok ? ca[r] * 0.125f : -3.0e38f; lgB[t][r] = ok ? cb2[r] * 0.125f : -3.0e38f; }
    }
    __builtin_amdgcn_wave_barrier();
#define DSA_SOFTMAX(LG, GRP)                                                                                            \
    {                                                                                                                   \
      float mx[4];                                                                                                      \
      _Pragma("unroll") for (int r = 0; r < 4; r++) {                                                                   \
        float m = LG[0][r];                                                                                             \
        _Pragma("unroll") for (int t = 1; t < 16; t++) m = fmaxf(m, LG[t][r]);                                          \
        m = fmaxf(m, DPP_ROR(m, 8)); m = fmaxf(m, DPP_ROR(m, 4)); m = fmaxf(m, DPP_ROR(m, 2)); m = fmaxf(m, DPP_ROR(m, 1)); \
        mx[r] = __int_as_float(__builtin_amdgcn_readfirstlane(__float_as_int(m)));                                      \
      }                                                                                                                 \
      _Pragma("unroll") for (int r = 0; r < 4; r++) {                                                                   \
        float s = 0.f;                                                                                                  \
        _Pragma("unroll") for (int t = 0; t < 16; t++) { float e = (LG[t][r] > -1.0e38f) ? __expf(LG[t][r] - mx[r]) : 0.f; LG[t][r] = e; s += e; } \
        s += DPP_ROR(s, 8); s += DPP_ROR(s, 4); s += DPP_ROR(s, 2); s += DPP_ROR(s, 1);                                  \
        ssum[GRP][r] = __int_as_float(__builtin_amdgcn_readfirstlane(__float_as_int(s)));                              \
      }                                                                                                                 \
      if (kq == 0) {                                                                                                    \
        _Pragma("unroll") for (int t = 0; t < 16; t++)                                                                  \
          *(uint2*)(Pb + (t * 16 + n16) * 8 + GRP * 4) = make_uint2(pk2(LG[t][0], LG[t][1]), pk2(LG[t][2], LG[t][3]));  \
      }                                                                                                                 \
    }
    DSA_SOFTMAX(lgA, 0)
    DSA_SOFTMAX(lgB, 1)
    __builtin_amdgcn_wave_barrier();
    float o[64];
#pragma unroll
    for (int i = 0; i < 64; i++) o[i] = ozero();
    const int ksg = lane >> 3, dc = lane & 7;
#pragma unroll 8
    for (int stp = 0; stp < 32; stp++) {
      const int slot = stp * 8 + ksg;
      const int key = (slot < n) ? (16383 - (int)(sel[slot] & 0x3FFFu)) : 0;
      uint4 pp = *(const uint4*)(Pb + slot * 8);
      const bf* vp = p.KVC + (tokb + key) * 256 + 128 + dc * 8;
      uint4 va = *(const uint4*)vp, vb = *(const uint4*)(vp + 64);
      float ph[8] = {bflo(pp.x), bfhi(pp.x), bflo(pp.y), bfhi(pp.y), bflo(pp.z), bfhi(pp.z), bflo(pp.w), bfhi(pp.w)};
      float v0[8] = {bflo(va.x), bfhi(va.x), bflo(va.y), bfhi(va.y), bflo(va.z), bfhi(va.z), bflo(va.w), bfhi(va.w)};
      float v1[8] = {bflo(vb.x), bfhi(vb.x), bflo(vb.y), bfhi(vb.y), bflo(vb.z), bfhi(vb.z), bflo(vb.w), bfhi(vb.w)};
#pragma unroll
      for (int hh = 0; hh < 4; hh++)
#pragma unroll
        for (int d = 0; d < 8; d++) { o[hh * 8 + d] += ph[hh] * v0[d]; o[(4 + hh) * 8 + d] += ph[4 + hh] * v1[d]; }
    }
    __builtin_amdgcn_wave_barrier();
    const bool b5 = (lane >> 5) & 1, b4 = (lane >> 4) & 1, b3 = (lane >> 3) & 1;
    float o32[32], o16[16], o8[8];
#pragma unroll
    for (int i = 0; i < 32; i++) { float lo = o[i], hi = o[32 + i]; float snd = b5 ? lo : hi; float kp = b5 ? hi : lo; o32[i] = kp + __shfl_xor(snd, 32); }
#pragma unroll
    for (int i = 0; i < 16; i++) { float lo = o32[i], hi = o32[16 + i]; float snd = b4 ? lo : hi; float kp = b4 ? hi : lo; o16[i] = kp + __shfl_xor(snd, 16); }
#pragma unroll
    for (int i = 0; i < 8; i++) { float lo = o16[i], hi = o16[8 + i]; float snd = b3 ? lo : hi; float kp = b3 ? hi : lo; o8[i] = kp + __shfl_xor(snd, 8); }
    const float s_g0 = b4 ? (b3 ? ssum[0][3] : ssum[0][2]) : (b3 ? ssum[0][1] : ssum[0][0]);
    const float s_g1 = b4 ? (b3 ? ssum[1][3] : ssum[1][2]) : (b3 ? ssum[1][1] : ssum[1][0]);
    const float rinv = 1.f / (b5 ? s_g1 : s_g0);
    const int hsel = (b5 ? 4 : 0) + (b4 ? 2 : 0) + (b3 ? 1 : 0);
    const int col = hsel * 64 + dc * 8;
    uint4 zz = *(const uint4*)(p.P + tq * PW + C_ATZ + col);
    uint4 ov;
    ov.x = pk2(o8[0] * rinv * siluf_(bflo(zz.x)), o8[1] * rinv * siluf_(bfhi(zz.x)));
    ov.y = pk2(o8[2] * rinv * siluf_(bflo(zz.y)), o8[3] * rinv * siluf_(bfhi(zz.y)));
    ov.z = pk2(o8[4] * rinv * siluf_(bflo(zz.z)), o8[5] * rinv * siluf_(bfhi(zz.z)));
    ov.w = pk2(o8[6] * rinv * siluf_(bflo(zz.w)), o8[7] * rinv * siluf_(bfhi(zz.w)));
    *(uint4*)(p.Y + tq * YW + Y_ATT + col) = ov;
  }
}

__device__ __forceinline__ void phaseB(const Params& p, int layer, char* sm0) {
  const int total = 512 + 2048 + 2048;
  char* sm = sm0 + HB * HALF_LDS;
  for (int t = VB; t < total; t += G2) {
    if (t < 512) ssd_pass1(p, layer, t, sm);
    else if (t < 2560) s5_pass1(p, layer, t - 512, sm);
    else mem_attn(p, layer, t - 2560);
  }
}
__device__ __forceinline__ void phaseC(const Params& p, int layer, char* sm0, bool dsa_only) {
  const int G = G2;
  const int total = dsa_only ? 1024 : 1024 + 256 + 16;
  char* sm = sm0 + HB * HALF_LDS;
  int rr = 0;
  for (int i = VB; i < total; i += G, rr++) {
    if (i < 1024) {
      int pos = i - rr * G; int idx = i;
      if ((rr & 1) && (rr * G + G <= 1024)) idx = rr * G + (G - 1 - pos);
      __syncthreads();
      dsa_wave(p, idx * 4 + (otid() >> 6), sm);
    } else if (i < 1280) ssd_statepass(p, i - 1024);
    else s5_carry(p, layer, i - 1280);
  }
}
__device__ __forceinline__ void phaseD(const Params& p, int layer, char* sm0) {
  const int total = 256 + 1024;
  char* sm = sm0 + HB * HALF_LDS;
  const int vb = VB;
  if (G2 == 512) {
    if (vb < 256) { s5_pass2(p, layer, vb, sm); ssd_pass2(p, layer, vb, sm); }
    else {
#pragma unroll 1
      for (int k = 0; k < 3; k++) ssd_pass2(p, layer, 256 + (vb - 256) * 3 + k, sm);
    }
  } else {
    for (int t = vb; t < total; t += G2) {
      if (t < 256) s5_pass2(p, layer, t, sm);
      else ssd_pass2(p, layer, t - 256, sm);
    }
  }
}

__device__ __forceinline__ void phaseE(const Params& p, int layer) {
  const int tidf = otid_full();
  const int wid = __builtin_amdgcn_readfirstlane(tidf >> 6), lane = tidf & 63, wr = wid >> 2, wc = wid & 3, fr = lane & 15, fq = lane >> 4;
  const bf* Wl = p.WinT + (size_t)layer * INW * 2048;
  const bf* Wb = p.WbrT + (size_t)layer * 2048 * YW;
  bf* merged = p.P;
  char* gsb = (char*)p.GS + (size_t)blockIdx.x * 131072;
  const unsigned gs_lane0 = (unsigned)tidf * 16u, lane_c40 = (unsigned)fq * 16u, lane_m0 = (unsigned)(fr * 2048 + fq * 4) * 2u;
  for (int L = blockIdx.x; L < 1024; L += gridDim.x) {
    int pm, pn; tile_order(L, 128, 8, pm, pn);
    const int brow = pm * 256, bcol = pn * 256;
#pragma unroll 1
    for (int s = 0; s < 8; s++) {
      const int br = s >> 1; const bool isBr = (s & 1) != 0;
      const int koff = br == 0 ? 0 : (br == 1 ? 512 : (br == 2 ? 1024 : 2048));
      const int kb = br == 2 ? 1024 : (br == 3 ? 256 : 512);
      const bf* A_ = isBr ? p.Y + koff : p.xb; const int lda_ = isBr ? YW : 2048;
      const bf* B_ = isBr ? Wb + koff : Wl + (size_t)(5716 + br * 2048) * 2048; const int ldb_ = isBr ? YW : 2048;
      const int K_ = isBr ? kb : 2048;
      f32x4 acc[2][2][4][2]; ZERO_ACC8(acc);
      gemm256(A_, lda_, B_, ldb_, K_, brow, bcol, acc);
      unsigned gs_lane = gs_lane0, lane_c4 = lane_c40, lane_m = lane_m0;
      asm volatile("" : "+v"(gs_lane), "+v"(lane_c4), "+v"(lane_m));
      if (!isBr) {
        const char* bgb = (const char*)(p.b_gate + (size_t)layer * 8192 + br * 2048 + bcol + wc * 32);
        float4 bgv[2][2];
#pragma unroll
        for (int bj = 0; bj < 2; bj++)
#pragma unroll
          for (int n = 0; n < 2; n++) bgv[bj][n] = *(const float4*)(bgb + (bj * 128 + n * 16) * 4 + lane_c4);
#pragma unroll
        for (int ai = 0; ai < 2; ai++)
#pragma unroll
          for (int bj = 0; bj < 2; bj++)
#pragma unroll
            for (int m = 0; m < 4; m++) {
              unsigned q[4];
#pragma unroll
              for (int n = 0; n < 2; n++) {
                const float4 bg = bgv[bj][n];
                f32x4 v = acc[ai][bj][m][n];
                q[2 * n] = pk2(sigmoidf_(v[0] + bg.x), sigmoidf_(v[1] + bg.y));
                q[2 * n + 1] = pk2(sigmoidf_(v[2] + bg.z), sigmoidf_(v[3] + bg.w));
              }
              *(uint4*)(gsb + ((ai * 2 + bj) * 4 + m) * 8192 + gs_lane) = make_uint4(q[0], q[1], q[2], q[3]);
              __builtin_amdgcn_sched_barrier(0);
            }
      } else {
        char* mb = (char*)merged + ((size_t)(brow + wr * 64) * 2048 + bcol + wc * 32) * 2;
#pragma unroll
        for (int ai = 0; ai < 2; ai++)
#pragma unroll
          for (int bj = 0; bj < 2; bj++) {
#pragma unroll
            for (int mh = 0; mh < 2; mh++) {
              uint4 g4[2]; uint2 old[2][2];
#pragma unroll
              for (int mm = 0; mm < 2; mm++) {
                const int m = mh * 2 + mm;
                g4[mm] = *(const uint4*)(gsb + ((ai * 2 + bj) * 4 + m) * 8192 + gs_lane);
                if (br) {
#pragma unroll
                  for (int n = 0; n < 2; n++)
                    old[mm][n] = *(const uint2*)(mb + ((size_t)(ai * 128 + m * 16) * 2048 + bj * 128 + n * 16) * 2 + lane_m);
                }
              }
#pragma unroll
              for (int mm = 0; mm < 2; mm++) {
                const int m = mh * 2 + mm;
                const unsigned gq[4] = {g4[mm].x, g4[mm].y, g4[mm].z, g4[mm].w};
#pragma unroll
                for (int n = 0; n < 2; n++) {
                  f32x4 v = acc[ai][bj][m][n];
                  float o0 = bflo(gq[2 * n]) * v[0], o1 = bfhi(gq[2 * n]) * v[1], o2 = bflo(gq[2 * n + 1]) * v[2], o3 = bfhi(gq[2 * n + 1]) * v[3];
                  char* mp = mb + ((size_t)(ai * 128 + m * 16) * 2048 + bj * 128 + n * 16) * 2 + lane_m;
                  if (br) { o0 += bflo(old[mm][n].x); o1 += bfhi(old[mm][n].x); o2 += bflo(old[mm][n].y); o3 += bfhi(old[mm][n].y); }
                  *(uint2*)mp = make_uint2(pk2(o0, o1), pk2(o2, o3));
                }
              }
            }
            __builtin_amdgcn_sched_barrier(0);
          }
      }
    }
  }
}

__device__ __forceinline__ void phaseF(const Params& p, int layer) {
  const int tidf = otid_full();
  const int wid = __builtin_amdgcn_readfirstlane(tidf >> 6), lane = tidf & 63, wr = wid >> 2, wc = wid & 3, fr = lane & 15, fq = lane >> 4;
  const bf* merged = p.P;
  const float* xres = layer == 0 ? p.x : p.out;
  for (int L = blockIdx.x; L < 1024; L += gridDim.x) {
    int pm, pn; tile_order(L, 128, 8, pm, pn);
    const int brow = pm * 256, bcol = pn * 256;
    f32x4 acc[2][2][4][2]; ZERO_ACC8(acc);
    gemm256(merged, 2048, p.WoutT + (size_t)layer * 2048 * 2048, 2048, 2048, brow, bcol, acc);
#pragma unroll
    for (int ai = 0; ai < 2; ai++)
#pragma unroll
      for (int m = 0; m < 4; m++) {
        const size_t tok = brow + ai * 128 + wr * 64 + m * 16 + fr;
#pragma unroll
        for (int bj = 0; bj < 2; bj++)
#pragma unroll
          for (int n = 0; n < 2; n++) {
            const int col = bcol + bj * 128 + wc * 32 + n * 16 + fq * 4;
            float4 xr = *(const float4*)(xres + tok * 2048 + col);
            f32x4 v = acc[ai][bj][m][n];
            float4 o;
            o.x = 1.41421356237f * xr.x + v[0]; o.y = 1.41421356237f * xr.y + v[1];
            o.z = 1.41421356237f * xr.z + v[2]; o.w = 1.41421356237f * xr.w + v[3];
            *(float4*)(p.out + tok * 2048 + col) = o;
          }
      }
  }
}

__device__ __forceinline__ void phaseG(const Params& p, int layer) {
  const int lane = otid() & 63, w = otid() >> 6;
  const float* g = p.ln_g + layer * 2048; const float* bb = p.ln_b + layer * 2048;
  float4 gg[8], bv[8];
#pragma unroll
  for (int i = 0; i < 8; i++) { gg[i] = *(const float4*)(g + (i * 64 + lane) * 4); bv[i] = *(const float4*)(bb + (i * 64 + lane) * 4); }
  for (int t = VB; t < TT / 8; t += G2) {
    float4 v[2][8];
#pragma unroll
    for (int rr = 0; rr < 2; rr++) {
      const float* xp = p.out + ((size_t)t * 8 + w * 2 + rr) * 2048;
#pragma unroll
      for (int i = 0; i < 8; i++) v[rr][i] = *(const float4*)(xp + (i * 64 + lane) * 4);
    }
#pragma unroll
    for (int rr = 0; rr < 2; rr++) {
      const size_t row = (size_t)t * 8 + w * 2 + rr;
      float* xp = p.out + row * 2048;
      float s = 0.f;
#pragma unroll
      for (int i = 0; i < 8; i++) s += v[rr][i].x + v[rr][i].y + v[rr][i].z + v[rr][i].w;
#pragma unroll
      for (int off = 1; off < 64; off <<= 1) s += __shfl_xor(s, off);
      const float mu = s * (1.f / 2048.f);
      float q = 0.f;
#pragma unroll
      for (int i = 0; i < 8; i++) {
        float a = v[rr][i].x - mu, b = v[rr][i].y - mu, c = v[rr][i].z - mu, d = v[rr][i].w - mu; q += a * a + b * b + c * c + d * d;
      }
#pragma unroll
      for (int off = 1; off < 64; off <<= 1) q += __shfl_xor(q, off);
      const float rs = rsqrtf(q * (1.f / 2048.f) + 1e-5f);
#pragma unroll
      for (int i = 0; i < 8; i++) {
        const int col = (i * 64 + lane) * 4;
        float4 o;
        o.x = (v[rr][i].x - mu) * rs * gg[i].x + bv[i].x; o.y = (v[rr][i].y - mu) * rs * gg[i].y + bv[i].y;
        o.z = (v[rr][i].z - mu) * rs * gg[i].z + bv[i].z; o.w = (v[rr][i].w - mu) * rs * gg[i].w + bv[i].w;
        *(float4*)(xp + col) = o;
        if (layer == 0) *(uint2*)(p.xb + row * 2048 + col) = make_uint2(pk2(o.x, o.y), pk2(o.z, o.w));
      }
    }
  }
}

__global__ void __launch_bounds__(512, 2) mega_kernel(Params p) {
  char* sm = dynsm;
  cg::grid_group grid = cg::this_grid();
  phase0(p, sm); grid.sync();
#pragma unroll 1
  for (int layer = 0; layer < 2; layer++) {
    int nA = (PROBE_MASK & 1) ? 2 : 1, nB = (PROBE_MASK & 2) ? 2 : 1, nC = (PROBE_MASK & 4) ? 2 : 1, nD = (PROBE_MASK & 8) ? 2 : 1, nE = (PROBE_MASK & 16) ? 2 : 1;
    asm volatile("" : "+s"(nA), "+s"(nB), "+s"(nC), "+s"(nD), "+s"(nE));
#pragma unroll 1
    for (int r = 0; r < nA; r++) phaseA(p, layer);
    grid.sync();
#pragma unroll 1
    for (int r = 0; r < nB; r++) phaseB(p, layer, sm);
    grid.sync();
#pragma unroll 1
    for (int r = 0; r < nC; r++) phaseC(p, layer, sm, r + 1 < nC);
    grid.sync();
#pragma unroll 1
    for (int r = 0; r < nD; r++) phaseD(p, layer, sm);
    grid.sync();
#pragma unroll 1
    for (int r = 0; r < nE; r++) phaseE(p, layer);
    grid.sync();
    phaseF(p, layer); grid.sync();
    phaseG(p, layer);
    if (layer == 0) grid.sync();
  }
}

extern "C" void kernel_launch(void* const* d_in, const int* in_sizes, int n_in, void* d_out, int out_size, void* d_ws,
                              size_t ws_size, hipStream_t stream) {
  Params p{};
  p.x = (const float*)d_in[0]; p.mem = (const float*)d_in[1]; p.pos = (const int*)d_in[2];
  p.w_in = (const float*)d_in[3]; p.b_gate = (const float*)d_in[4]; p.lam_re = (const float*)d_in[5];
  p.lam_im = (const float*)d_in[6]; p.log_dt = (const float*)d_in[7]; p.b_re = (const float*)d_in[8];
  p.b_im = (const float*)d_in[9]; p.c_re = (const float*)d_in[10]; p.c_im = (const float*)d_in[11];
  p.s5_d = (const float*)d_in[12]; p.w_glu = (const float*)d_in[13]; p.b_glu = (const float*)d_in[14];
  p.conv_w = (const float*)d_in[15]; p.conv_b = (const float*)d_in[16]; p.dt_bias = (const float*)d_in[17];
  p.a_log = (const float*)d_in[18]; p.ssd_d = (const float*)d_in[19]; p.norm_g = (const float*)d_in[20];
  p.mem_w_kv = (const float*)d_in[21]; p.w_br_s5 = (const float*)d_in[22]; p.w_br_attn = (const float*)d_in[23];
  p.w_br_ssd = (const float*)d_in[24]; p.w_br_mem = (const float*)d_in[25]; p.w_out = (const float*)d_in[26];
  p.ln_g = (const float*)d_in[27]; p.ln_b = (const float*)d_in[28];
  p.out = (float*)d_out;
  char* ws = (char*)d_ws; size_t off = 0;
  auto carve = [&](size_t bytes) { char* r = ws + off; off += (bytes + 255) & ~(size_t)255; return r; };
  p.WinT = (bf*)carve((size_t)2 * INW * 2048 * 2);
  p.WbrT = (bf*)carve((size_t)2 * 2048 * YW * 2);
  p.WoutT = (bf*)carve((size_t)2 * 2048 * 2048 * 2);
  p.WgluT = (bf*)carve((size_t)2 * 512 * 512 * 2);
  p.WmemT = (bf*)carve((size_t)2 * 512 * 2048 * 2);
  p.memb = (bf*)carve((size_t)512 * 2048 * 2);
  p.xb = (bf*)carve((size_t)TT * 2048 * 2);
  p.P = (bf*)carve((size_t)TT * PW * 2);
  p.Y = (bf*)carve((size_t)TT * YW * 2);
  p.YG = (bf*)carve((size_t)TT * 512 * 2);
  p.KIF = (bf*)carve((size_t)TT * 64 * 2);
  p.MK = (bf*)carve((size_t)2 * 2 * 4 * 256 * 64 * 2);
  p.MVT = (bf*)carve((size_t)2 * 2 * 4 * 256 * 64 * 2);
  p.CM = (bf*)carve((size_t)2 * 32 * 16 * 128 * 2);
  p.ST = (float*)carve((size_t)2 * 128 * 131072 * 4);
  p.CS = (float*)carve((size_t)TT * 16 * 4);
  p.END = (float*)carve((size_t)2 * 128 * 32 * 64 * 2 * 4);
  p.CD = (float*)carve((size_t)2 * 128 * 16 * 4);
  p.SB = (float*)carve((size_t)2 * 32 * 64 * 32 * 4);
  p.SA = (float*)carve((size_t)2 * 32 * 64 * 4 * 4);
  p.KVC = (bf*)carve((size_t)TT * 256 * 2);
  p.GS = (bf*)carve((size_t)256 * 16 * 512 * 16);
  if (off > ws_size) { fprintf(stderr, "workspace too small: need %zu have %zu\n", off, ws_size); return; }
  for (int j = 0; j < 8; j++) p.inv[j] = (float)pow(500000.0, -(double)j / 8.0);
  const size_t kDynLds = 2 * HALF_LDS;
  static int grid_blocks = 0;
  if (!grid_blocks) {
    int dev = 0, cus = 0, per_cu = 0;
    (void)hipGetDevice(&dev);
    (void)hipDeviceGetAttribute(&cus, hipDeviceAttributeMultiprocessorCount, dev);
    (void)hipFuncSetAttribute((const void*)mega_kernel, hipFuncAttributeMaxDynamicSharedMemorySize, (int)kDynLds);
    (void)hipOccupancyMaxActiveBlocksPerMultiprocessor(&per_cu, mega_kernel, 512, kDynLds);
    if (per_cu > 1) per_cu = 1;
    grid_blocks = cus * per_cu;
    if (grid_blocks > 256) grid_blocks = 256;
    grid_blocks -= grid_blocks % 8;
  }
  void* args[] = {&p};
  hipError_t e = hipLaunchCooperativeKernel((void*)mega_kernel, dim3(grid_blocks), dim3(512), args, kDynLds, stream);
  if (e != hipSuccess) fprintf(stderr, "cooperative launch failed: %s (grid %d)\n", hipGetErrorString(e), grid_blocks);
}
```

```cpp
#include <hip/hip_runtime.h>
#include <hip/hip_cooperative_groups.h>
#include <cstdio>
#include <cmath>
namespace cg = cooperative_groups;

#ifndef MK_COOP
#define MK_COOP 1
#endif
#ifndef PROBE_MASK
#define PROBE_MASK 0
#endif

typedef unsigned short bf;
typedef short bf16x8 __attribute__((ext_vector_type(8)));
typedef float f32x16 __attribute__((ext_vector_type(16)));
typedef float f32x4 __attribute__((ext_vector_type(4)));

#define TT 32768
#define LSEQ 16384
#define DM 2048
#define INW 13908
#define PW 5760
#define C_S5U 0
#define C_S5Z 512
#define C_ATQ 1024
#define C_ATK 1536
#define C_ATV 1664
#define C_ATZ 1792
#define C_IDQ 2304
#define C_IDK 2560
#define C_IDW 2624
#define C_SSZ 2640
#define C_XBC 3664
#define C_SDT 5200
#define C_MEQ 5216
#define C_MEZ 5472
#define YW 2304
#define Y_S5 0
#define Y_ATT 512
#define Y_SSD 1024
#define Y_MEM 2048
#define CAP 512
#define HALF_LDS 81920

struct Params {
  const float *x, *mem; const int* pos;
  const float *w_in, *b_gate, *lam_re, *lam_im, *log_dt, *b_re, *b_im, *c_re, *c_im, *s5_d, *w_glu, *b_glu,
      *conv_w, *conv_b, *dt_bias, *a_log, *ssd_d, *norm_g, *mem_w_kv, *w_br_s5, *w_br_attn, *w_br_ssd, *w_br_mem,
      *w_out, *ln_g, *ln_b;
  float* out;
  bf *WinT, *WbrT, *WoutT, *WgluT, *WmemT, *memb, *xb, *P, *Y, *YG, *KIF, *MK, *MVT, *CM, *KVC, *GS;
  float *ST, *CS, *END, *CD, *SB, *SA;
  float inv[8];
};

__device__ __forceinline__ float ozero() { float z = 0.f; asm volatile("" : "+v"(z)); return z; }
__device__ __forceinline__ int otid_full() { int t = threadIdx.x; asm volatile("" : "+v"(t)); return t; }
__device__ __forceinline__ int otid() { return otid_full() & 255; }
#define HB (__builtin_amdgcn_readfirstlane(otid_full() >> 8))
#define VB ((int)blockIdx.x * 2 + HB)
#define G2 ((int)gridDim.x * 2)
__device__ __forceinline__ float bf2f(bf v) { return __uint_as_float(((unsigned)v) << 16); }
__device__ __forceinline__ float bflo(unsigned u) { return __uint_as_float(u << 16); }
__device__ __forceinline__ float bfhi(unsigned u) { return __uint_as_float(u & 0xFFFF0000u); }
typedef float f32x2p_t __attribute__((ext_vector_type(2)));
typedef __bf16 bf16x2p_t __attribute__((ext_vector_type(2)));
__device__ __forceinline__ unsigned pk2(float lo, float hi) {
  f32x2p_t v = {lo, hi};
  return __builtin_bit_cast(unsigned, __builtin_convertvector(v, bf16x2p_t));
}
__device__ __forceinline__ bf f2bf(float f) { return (bf)(pk2(f, 0.f) & 0xFFFFu); }
__device__ __forceinline__ float sigmoidf_(float x) { return __builtin_amdgcn_rcpf(1.f + __expf(-x)); }
__device__ __forceinline__ float siluf_(float x) { return x * __builtin_amdgcn_rcpf(1.f + __expf(-x)); }
__device__ __forceinline__ float geluf_(float x) {
  float u = 0.7978845608028654f * (x + 0.044715f * x * x * x);
  float t = 1.f - 2.f * __builtin_amdgcn_rcpf(1.f + __expf(2.f * u));
  return 0.5f * x * (1.f + t);
}
__device__ __forceinline__ f32x16 mfma32(bf16x8 a, bf16x8 b, f32x16 c) { return __builtin_amdgcn_mfma_f32_32x32x16_bf16(a, b, c, 0, 0, 0); }
__device__ __forceinline__ f32x4 mfma16(bf16x8 a, bf16x8 b, f32x4 c) { return __builtin_amdgcn_mfma_f32_16x16x32_bf16(a, b, c, 0, 0, 0); }

__device__ __forceinline__ bool tile_map(int L, int nMt, int nNt, int SM, int SN, int& tm, int& tn) {
  int per = SM * SN; int x = L & 7; int jj = L >> 3; int sl = jj / per; int j = jj - sl * per; int S = sl * 8 + x;
  int nSn = nNt / SN; int NS = (nMt / SM) * nSn;
  if (S >= NS) return false;
  int mg = S / nSn, ng = S - mg * nSn;
  tm = mg * SM + j / SN; tn = ng * SN + j % SN; return true;
}

typedef unsigned u32x4 __attribute__((ext_vector_type(4)));
struct GStage { u32x4 a0, a1, b0, b1; };
#define G_LOAD(S, ko) { S.a0 = *(const u32x4*)(ga + (ko)); S.a1 = *(const u32x4*)(ga + a64 + (ko)); S.b0 = *(const u32x4*)(gb + (ko)); S.b1 = *(const u32x4*)(gb + b64 + (ko)); }
#define G_WRITE(S, base) { *(u32x4*)(sA + (base) + woff) = S.a0; *(u32x4*)(sA + (base) + woff + 5120) = S.a1; *(u32x4*)(sB + (base) + woff) = S.b0; *(u32x4*)(sB + (base) + woff + 5120) = S.b1; }
#define G_ITER(kt, cur, S)                                                          \
  {                                                                                 \
    _Pragma("unroll") for (int ks = 0; ks < 2; ks++) {                              \
      bf16x8 a0 = *(const bf16x8*)(sA + (cur) + aoff + ks * 32);                    \
      bf16x8 a1 = *(const bf16x8*)(sA + (cur) + aoff + 2560 + ks * 32);             \
      bf16x8 b0 = *(const bf16x8*)(sB + (cur) + boff + ks * 32);                    \
      bf16x8 b1 = *(const bf16x8*)(sB + (cur) + boff + 2560 + ks * 32);             \
      acc[0][0] = mfma32(b0, a0, acc[0][0]);                                        \
      acc[0][1] = mfma32(b1, a0, acc[0][1]);                                        \
      acc[1][0] = mfma32(b0, a1, acc[1][0]);                                        \
      acc[1][1] = mfma32(b1, a1, acc[1][1]);                                        \
    }                                                                               \
    if ((kt) + 1 < nk) {                                                            \
      G_WRITE(S, 10240 - (cur))                                                     \
      if ((kt) + 1 + D < nk) G_LOAD(S, ((kt) + 1 + D) * 32)                         \
    }                                                                               \
    __syncthreads();                                                                \
  }
template <int D>
__device__ __forceinline__ void gemm_acc(const bf* __restrict__ A, int lda, const bf* __restrict__ Bt, int ldb, int K,
                                         f32x16 (&acc)[2][2], char* sm) {
  const int tid = otid(), lane = tid & 63, w = tid >> 6, wr = w >> 1, wc = w & 1, r32 = lane & 31, h5 = lane >> 5;
  const int lrow = tid >> 2, lch = tid & 3;
  const bf* ga = A + (size_t)lrow * lda + lch * 8;
  const bf* gb = Bt + (size_t)lrow * ldb + lch * 8;
  const size_t a64 = (size_t)64 * lda, b64 = (size_t)64 * ldb;
  const int nk = K >> 5;
  char* sA = sm; char* sB = sm + 20480;
  const int woff = lrow * 80 + lch * 16;
  const int aoff = (wr * 64 + r32) * 80 + h5 * 16, boff = (wc * 64 + r32) * 80 + h5 * 16;
  GStage S0, S1, S2, S3;
  G_LOAD(S0, 0) G_LOAD(S1, 32)
  if (D == 4) { G_LOAD(S2, 64) G_LOAD(S3, 96) }
  G_WRITE(S0, 0)
  if (D < nk) G_LOAD(S0, D * 32)
  __syncthreads();
  for (int kt0 = 0; kt0 < nk; kt0 += D) {
    if (D == 4) {
      G_ITER(kt0, 0, S1) G_ITER(kt0 + 1, 10240, S2) G_ITER(kt0 + 2, 0, S3) G_ITER(kt0 + 3, 10240, S0)
    } else {
      G_ITER(kt0, 0, S1) G_ITER(kt0 + 1, 10240, S0)
    }
  }
}
#define ZERO_ACC(a) { const float z_ = ozero(); for (int i_ = 0; i_ < 2; i_++) for (int j_ = 0; j_ < 2; j_++) for (int r_ = 0; r_ < 16; r_++) a[i_][j_][r_] = z_; }


extern __shared__ __attribute__((aligned(16))) char dynsm[];
#define G8_HT (128 * 64)
#define G8_SA(b, h) ((bf*)dynsm + ((b) * 2 + (h)) * G8_HT)
#define G8_SB(b, h) ((bf*)dynsm + (4 + (b) * 2 + (h)) * G8_HT)
__device__ __forceinline__ int g8_lds_byte(int r, int c) {
  int st = (r >> 4) * 2 + (c >> 5), rr = r & 15, cc = c & 31, ob = rr * 64 + cc * 2;
  return st * 1024 + (ob ^ (((ob >> 9) & 1) << 5));
}
__device__ __forceinline__ void g8_stage_rc(int b, int& R, int& C) {
  int st = b / 1024, sb = b % 1024, swz = sb ^ (((sb >> 9) & 1) << 5);
  R = (st >> 1) * 16 + swz / 64; C = (st & 1) * 32 + (swz % 64) / 2;
}
#define G8_LAS __attribute__((address_space(3)))
#define G8_HTB (128 * 64 * 2)
#define G8_OSA(b, h) (((b) * 2 + (h)) * G8_HTB)
#define G8_OSB(b, h) ((4 + (b) * 2 + (h)) * G8_HTB)
#define G8_STAGE(bufoff, gbase, voff) do { _Pragma("unroll") for (int _i = 0; _i < 2; ++_i) \
    __builtin_amdgcn_global_load_lds((const unsigned*)((const char*)(gbase) + (voff)[_i]), (G8_LAS unsigned*)(lds + (bufoff) + ldsw + _i * 8192), 16, 0, 0); } while (0)
#define G8_LDA(dst, b, h) do { _Pragma("unroll") for (int m = 0; m < 4; ++m) _Pragma("unroll") for (int k = 0; k < 2; ++k) dst[m][k] = *(const G8_LAS bf16x8*)(lds + G8_OSA(b, h) + aoff + m * 2048 + k * 1024); } while (0)
#define G8_LDB(dst, b, h) do { _Pragma("unroll") for (int n = 0; n < 2; ++n) _Pragma("unroll") for (int k = 0; k < 2; ++k) dst[n][k] = *(const G8_LAS bf16x8*)(lds + G8_OSB(b, h) + boff + n * 2048 + k * 1024); } while (0)
#define G8_MMA(ai, bj, At_, Bt_) do { __builtin_amdgcn_s_setprio(1);                                                 \
    _Pragma("unroll") for (int m = 0; m < 4; ++m) _Pragma("unroll") for (int n = 0; n < 2; ++n) _Pragma("unroll") for (int k = 0; k < 2; ++k) \
      acc[ai][bj][m][n] = __builtin_amdgcn_mfma_f32_16x16x32_bf16(Bt_[n][k], At_[m][k], acc[ai][bj][m][n], 0, 0, 0); \
    __builtin_amdgcn_s_setprio(0); } while (0)
#define G8_WAIT_V(n) asm volatile("s_waitcnt vmcnt(" #n ")" ::: "memory")
#define G8_WAIT_L(n) asm volatile("s_waitcnt lgkmcnt(" #n ")" ::: "memory")
#define G8_BAR __builtin_amdgcn_s_barrier()
#define G8_SCHED __builtin_amdgcn_sched_barrier(0)

__device__ __forceinline__ void gemm256(const bf* __restrict__ A, int lda, const bf* __restrict__ Bt, int ldb, int K,
                                        int brow, int bcol, f32x4 (&acc)[2][2][4][2]) {
  G8_LAS unsigned char* lds = (G8_LAS unsigned char*)dynsm;
  const int tid = otid_full(), wid = __builtin_amdgcn_readfirstlane(tid >> 6), lane = tid & 63, wr = wid >> 2, wc = wid & 3, fr = lane & 15, fq = lane >> 4;
  unsigned voffA[2], voffB[2];
#pragma unroll
  for (int i = 0; i < 2; ++i) { int R, C; g8_stage_rc(tid * 16 + i * 8192, R, C); voffA[i] = (unsigned)(R * lda + C) * 2u; voffB[i] = (unsigned)(R * ldb + C) * 2u; }
  const size_t kstep = 128;
  const size_t hstepA = (size_t)128 * lda * 2, hstepB = (size_t)128 * ldb * 2;
  const unsigned ldsw = (unsigned)wid * 1024u;
  const int aoff = g8_lds_byte(wr * 64 + fr, fq * 8), boff = g8_lds_byte(wc * 32 + fr, fq * 8);
  const char* cA = (const char*)A + (size_t)brow * lda * 2; const char* cB = (const char*)Bt + (size_t)bcol * ldb * 2;
  bf16x8 At[4][2], B0[2][2], B1[2][2];
  const int nt = K / 64;
  __syncthreads();
  G8_STAGE(G8_OSB(0, 0), cB, voffB); G8_STAGE(G8_OSA(0, 0), cA, voffA); G8_STAGE(G8_OSB(0, 1), cB + hstepB, voffB); G8_STAGE(G8_OSA(0, 1), cA + hstepA, voffA);
  if (wr == 1) G8_BAR;
  G8_WAIT_V(4); G8_BAR;
  G8_STAGE(G8_OSB(1, 0), cB + kstep, voffB); G8_STAGE(G8_OSA(1, 0), cA + kstep, voffA); G8_STAGE(G8_OSB(1, 1), cB + hstepB + kstep, voffB);
  G8_WAIT_V(6); G8_BAR;
  for (int t = 0; t < nt - 2; t += 2) {
    const char* a1 = cA + (size_t)(t + 1) * kstep;
    const char* a2 = cA + (size_t)(t + 2) * kstep; const char* b2 = cB + (size_t)(t + 2) * kstep;
    const char* a3 = a2 + kstep; const char* b3 = b2 + kstep;
    G8_LDB(B0, 0, 0); G8_SCHED; G8_LDA(At, 0, 0); G8_STAGE(G8_OSA(1, 1), a1 + hstepA, voffA);
    G8_WAIT_L(8); G8_BAR; G8_WAIT_L(0); G8_MMA(0, 0, At, B0); G8_BAR; G8_SCHED;
    G8_LDB(B1, 0, 1); G8_STAGE(G8_OSB(0, 0), b2, voffB);
    G8_BAR; G8_WAIT_L(0); G8_MMA(0, 1, At, B1); G8_BAR;
    G8_LDA(At, 0, 1); G8_STAGE(G8_OSA(0, 0), a2, voffA);
    G8_BAR; G8_WAIT_L(0); G8_MMA(1, 0, At, B0); G8_BAR; G8_SCHED;
    G8_STAGE(G8_OSB(0, 1), b2 + hstepB, voffB);
    G8_WAIT_V(6); G8_BAR; G8_MMA(1, 1, At, B1); G8_BAR;
    G8_LDB(B0, 1, 0); G8_SCHED; G8_LDA(At, 1, 0); G8_STAGE(G8_OSA(0, 1), a2 + hstepA, voffA);
    G8_WAIT_L(8); G8_BAR; G8_WAIT_L(0); G8_MMA(0, 0, At, B0); G8_BAR; G8_SCHED;
    G8_LDB(B1, 1, 1); G8_STAGE(G8_OSB(1, 0), b3, voffB);
    G8_BAR; G8_WAIT_L(0); G8_MMA(0, 1, At, B1); G8_BAR;
    G8_LDA(At, 1, 1); G8_STAGE(G8_OSA(1, 0), a3, voffA);
    G8_BAR; G8_WAIT_L(0); G8_MMA(1, 0, At, B0); G8_BAR; G8_SCHED;
    G8_STAGE(G8_OSB(1, 1), b3 + hstepB, voffB);
    G8_WAIT_V(6); G8_BAR; G8_MMA(1, 1, At, B1); G8_BAR;
  }
  { const char* a1 = cA + (size_t)(nt - 1) * kstep;
    G8_LDB(B0, 0, 0); G8_LDA(At, 0, 0); G8_STAGE(G8_OSA(1, 1), a1 + hstepA, voffA);
    G8_BAR; G8_WAIT_L(0); G8_MMA(0, 0, At, B0); G8_BAR;
    G8_LDB(B1, 0, 1); G8_BAR; G8_WAIT_L(0); G8_MMA(0, 1, At, B1); G8_BAR;
    G8_LDA(At, 0, 1); G8_WAIT_V(4); G8_BAR; G8_WAIT_L(0); G8_MMA(1, 0, At, B0); G8_MMA(1, 1, At, B1); G8_BAR; }
  { G8_LDB(B0, 1, 0); G8_LDA(At, 1, 0); G8_WAIT_V(2); G8_BAR; G8_WAIT_L(0); G8_MMA(0, 0, At, B0); G8_BAR;
    G8_LDB(B1, 1, 1); G8_WAIT_V(0); G8_BAR; G8_WAIT_L(0); G8_MMA(0, 1, At, B1); G8_BAR;
    G8_LDA(At, 1, 1); G8_BAR; G8_WAIT_L(0); G8_MMA(1, 0, At, B0); G8_MMA(1, 1, At, B1); G8_BAR; }
  if (wr == 0) G8_BAR;
}
#define ZERO_ACC8(a) { float z_ = 0.f; asm volatile("" : "+v"(z_)); _Pragma("unroll") for (int i_ = 0; i_ < 2; i_++) _Pragma("unroll") for (int j_ = 0; j_ < 2; j_++) _Pragma("unroll") for (int m_ = 0; m_ < 4; m_++) _Pragma("unroll") for (int n_ = 0; n_ < 2; n_++) a[i_][j_][m_][n_] = (f32x4){z_, z_, z_, z_}; }
__device__ __forceinline__ bool tile_order(int L, int nM, int nN, int& pm, int& pn) {
  const int nwg = nM * nN; if (L >= nwg) return false;
  int wgid = L; { const int q = nwg / 8, r = nwg % 8, xcd = wgid % 8, off = wgid / 8; wgid = (xcd < r ? xcd * (q + 1) : r * (q + 1) + (xcd - r) * q) + off; }
  const int nig = 8 * nN, gid = wgid / nig, fm = gid * 8, gsz = (nM - fm) < 8 ? (nM - fm) : 8;
  pm = fm + ((wgid % nig) % gsz); pn = (wgid % nig) / gsz; return true;
}

__device__ __forceinline__ void transpose_tile(const float* __restrict__ src, int R, int C, bf* __restrict__ dst, int ldd, int off, int tile, bf* sm) {
  const int tilesC = (C + 63) >> 6;
  const int tr = tile / tilesC, tc = tile - tr * tilesC;
  const int r0 = tr * 64, c0 = tc * 64;
  const int tid = otid();
#pragma unroll
  for (int i = 0; i < 4; i++) {
    int r = (tid >> 4) + 16 * i; int c = (tid & 15) * 4;
    const float zt_ = ozero(); float4 v = make_float4(zt_, zt_, zt_, zt_);
    if (c0 + c < C) v = *(const float4*)(src + (size_t)(r0 + r) * C + c0 + c);
    sm[(c + 0) * 66 + r] = f2bf(v.x); sm[(c + 1) * 66 + r] = f2bf(v.y);
    sm[(c + 2) * 66 + r] = f2bf(v.z); sm[(c + 3) * 66 + r] = f2bf(v.w);
  }
  __syncthreads();
  {
    int c = tid >> 2, ch = (tid & 3) * 16;
    if (c0 + c < C) {
      unsigned wv[8];
#pragma unroll
      for (int k = 0; k < 8; k++) wv[k] = *(const unsigned*)(sm + c * 66 + ch + 2 * k);
      bf* d = dst + (size_t)(c0 + c) * ldd + off + r0 + ch;
      *(uint4*)d = make_uint4(wv[0], wv[1], wv[2], wv[3]);
      *(uint4*)(d + 8) = make_uint4(wv[4], wv[5], wv[6], wv[7]);
    }
  }
  __syncthreads();
}

__device__ __forceinline__ bool try_tr(int& t, const float* src, int R, int C, bf* dst, int ldd, int off, bf* sm) {
  int nt = (R >> 6) * ((C + 63) >> 6);
  if (t < nt) { transpose_tile(src, R, C, dst, ldd, off, t, sm); return true; }
  t -= nt; return false;
}

__device__ __forceinline__ void phase0(const Params& p, char* smc) {
  bf* sm = (bf*)(smc + HB * HALF_LDS);
  const int perLayer = 32 * 218 + 256 + 256 + 512 + 128 + 1024 + 64 + 256;
  for (int task = VB; task < 2 * perLayer; task += G2) {
    int layer = task / perLayer; int t = task - layer * perLayer;
    bf* WbrL = p.WbrT + (size_t)layer * 2048 * YW;
    if (try_tr(t, p.w_in + (size_t)layer * DM * INW, 2048, INW, p.WinT + (size_t)layer * INW * 2048, 2048, 0, sm)) continue;
    if (try_tr(t, p.w_br_s5 + (size_t)layer * 512 * 2048, 512, 2048, WbrL, YW, 0, sm)) continue;
    if (try_tr(t, p.w_br_attn + (size_t)layer * 512 * 2048, 512, 2048, WbrL, YW, 512, sm)) continue;
    if (try_tr(t, p.w_br_ssd + (size_t)layer * 1024 * 2048, 1024, 2048, WbrL, YW, 1024, sm)) continue;
    if (try_tr(t, p.w_br_mem + (size_t)layer * 256 * 2048, 256, 2048, WbrL, YW, 2048, sm)) continue;
    if (try_tr(t, p.w_out + (size_t)layer * 2048 * 2048, 2048, 2048, p.WoutT + (size_t)layer * 2048 * 2048, 2048, 0, sm)) continue;
    if (try_tr(t, p.w_glu + (size_t)layer * 512 * 512, 512, 512, p.WgluT + (size_t)layer * 512 * 512, 512, 0, sm)) continue;
    if (try_tr(t, p.mem_w_kv + (size_t)layer * 2048 * 512, 2048, 512, p.WmemT + (size_t)layer * 512 * 2048, 2048, 0, sm)) continue;
  }
  const size_t gtid = (size_t)blockIdx.x * 512 + otid_full(), gstr = (size_t)gridDim.x * 512;
  for (size_t i0 = gtid; i0 < (size_t)TT * DM / 8; i0 += 4 * gstr) {
    float4 a[4], b[4];
#pragma unroll
    for (int k = 0; k < 4; k++) {
      const size_t i = i0 + k * gstr;
      if (i < (size_t)TT * DM / 8) { a[k] = *(const float4*)(p.x + i * 8); b[k] = *(const float4*)(p.x + i * 8 + 4); }
    }
#pragma unroll
    for (int k = 0; k < 4; k++) {
      const size_t i = i0 + k * gstr;
      if (i < (size_t)TT * DM / 8)
        *(uint4*)(p.xb + i * 8) = make_uint4(pk2(a[k].x, a[k].y), pk2(a[k].z, a[k].w), pk2(b[k].x, b[k].y), pk2(b[k].z, b[k].w));
    }
  }
  for (size_t i = gtid; i < (size_t)512 * DM / 8; i += gstr) {
    float4 a = *(const float4*)(p.mem + i * 8), b = *(const float4*)(p.mem + i * 8 + 4);
    *(uint4*)(p.memb + i * 8) = make_uint4(pk2(a.x, a.y), pk2(a.z, a.w), pk2(b.x, b.y), pk2(b.z, b.w));
  }
  for (size_t i = gtid; i < (size_t)TT; i += gstr) {
    const float ps = (float)p.pos[i];
#pragma unroll
    for (int j = 0; j < 8; j++) {
      float ang = ps * p.inv[j];
      float s, c; sincosf(ang, &s, &c);
      p.CS[i * 16 + j] = c; p.CS[i * 16 + 8 + j] = s;
    }
  }
  for (size_t i = gtid; i < 2 * 32 * 64; i += gstr) {
    int pp = (int)(i & 63), g = (int)((i >> 6) & 31), layer = (int)(i >> 11);
    float dt = expf(p.log_dt[layer * 32 + g]);
    float lr = p.lam_re[i], li = p.lam_im[i];
    float mag = expf(lr * dt);
    float sn, cs; sincosf(li * dt, &sn, &cs);
    float ar = mag * cs, ai = mag * sn;
    float den = lr * lr + li * li;
    float nr = ar - 1.f, ni = ai;
    float fr = (nr * lr + ni * li) / den, fi = (ni * lr - nr * li) / den;
    float* sb = p.SB + i * 32;
    const float* bre = p.b_re + i * 16; const float* bim = p.b_im + i * 16;
    for (int h = 0; h < 16; h++) {
      float br = bre[h], bi = bim[h];
      sb[h] = fr * br - fi * bi; sb[16 + h] = fr * bi + fi * br;
    }
    float pr = ar, pi = ai;
    for (int k = 0; k < 7; k++) { float nr2 = pr * pr - pi * pi, ni2 = 2.f * pr * pi; pr = nr2; pi = ni2; }
    p.SA[i * 4 + 0] = ar; p.SA[i * 4 + 1] = ai; p.SA[i * 4 + 2] = pr; p.SA[i * 4 + 3] = pi;
    for (int h = 0; h < 16; h++) {
      size_t ci = ((size_t)(layer * 32 + g) * 16 + h);
      p.CM[ci * 128 + pp] = f2bf(p.c_re[ci * 64 + pp]);
      p.CM[ci * 128 + 64 + pp] = f2bf(-p.c_im[ci * 64 + pp]);
    }
  }
}

__device__ __forceinline__ void phaseA(const Params& p, int layer) {
  const int tidf = otid_full();
  const int wid = __builtin_amdgcn_readfirstlane(tidf >> 6), lane = tidf & 63, wr = wid >> 2, wc = wid & 3, fr = lane & 15, fq = lane >> 4;
  const bf* Wl = p.WinT + (size_t)layer * INW * 2048;
  const int nA = 128 * 23;
  const int total = nA + (layer == 0 ? 8 : 0);
  for (int L = blockIdx.x; L < total; L += gridDim.x) {
    f32x4 acc[2][2][4][2]; ZERO_ACC8(acc);
    if (L < nA) {
      int pm, pn; tile_order(L, 128, 23, pm, pn);
      const int brow = pm * 256, bcol = pn * 256;
      gemm256(p.xb, 2048, Wl, 2048, 2048, brow, bcol, acc);
      int fr_o = fr; asm volatile("" : "+v"(fr_o));
#pragma unroll
      for (int ai = 0; ai < 2; ai++)
#pragma unroll
        for (int m = 0; m < 4; m++) {
          __builtin_amdgcn_sched_barrier(0);
          const int tok = brow + ai * 128 + wr * 64 + m * 16 + fr_o;
#pragma unroll
          for (int bj = 0; bj < 2; bj++)
#pragma unroll
            for (int n = 0; n < 2; n++) {
              const int cb = bcol + bj * 128 + wc * 32 + n * 16;
              f32x4 v = acc[ai][bj][m][n];
              if (n == 0 && (wc & 1) == 0 && ((cb >= C_ATQ && cb < C_ATV) || (cb >= C_IDQ && cb < C_IDW))) {
                f32x4 cs = *(const f32x4*)(p.CS + (size_t)tok * 16 + 4 * (fq & 1));
                f32x4 sn = *(const f32x4*)(p.CS + (size_t)tok * 16 + 8 + 4 * (fq & 1));
#pragma unroll
                for (int e = 0; e < 4; e++) {
                  float o = __shfl_xor(v[e], 32);
                  v[e] = (fq < 2) ? (v[e] * cs[e] - o * sn[e]) : (v[e] * cs[e] + o * sn[e]);
                }
              }
              const int nn = cb + fq * 4;
              if (nn < 5716) {
                const int dn = nn + (nn >= 2628 ? 12 : 0);
                uint2 pv = make_uint2(pk2(v[0], v[1]), pk2(v[2], v[3]));
                *(uint2*)(p.P + (size_t)tok * PW + dn) = pv;
                if (nn >= C_IDK && nn < C_IDW) {
                  const int d = nn - C_IDK; const int b = tok >> 14, li = tok & 16383;
                  size_t o = ((((size_t)(b * 512 + (li >> 5)) * 4 + (d >> 4)) * 64 + ((d >> 3) & 1) * 32 + (li & 31)) * 8) + (d & 7);
                  *(uint2*)(p.KIF + o) = pv;
                }
                if (nn >= C_ATK && nn < C_ATZ) *(uint2*)(p.KVC + (size_t)tok * 256 + (nn - C_ATK)) = pv;
              }
            }
        }
    } else {
      const int t8 = L - nA; const int ly = t8 >> 2, tm = (t8 >> 1) & 1, tn = t8 & 1;
      gemm256(p.memb, 2048, p.WmemT + (size_t)ly * 512 * 2048, 2048, 2048, tm * 256, tn * 256, acc);
#pragma unroll
      for (int ai = 0; ai < 2; ai++)
#pragma unroll
        for (int m = 0; m < 4; m++) {
          const int row = tm * 256 + ai * 128 + wr * 64 + m * 16 + fr; const int b = row >> 8, mm = row & 255;
#pragma unroll
          for (int bj = 0; bj < 2; bj++)
#pragma unroll
            for (int n = 0; n < 2; n++)
#pragma unroll
              for (int e = 0; e < 4; e++) {
                const int nn = tn * 256 + bj * 128 + wc * 32 + n * 16 + fq * 4 + e; const float v = acc[ai][bj][m][n][e];
                if (nn < 256) { int h = nn >> 6, d = nn & 63; p.MK[((((size_t)ly * 2 + b) * 4 + h) * 256 + mm) * 64 + d] = f2bf(v); }
                else { int h = (nn - 256) >> 6, d = nn & 63; p.MVT[((((size_t)ly * 2 + b) * 4 + h) * 64 + d) * 256 + mm] = f2bf(v); }
              }
        }
    }
  }
}

__device__ __forceinline__ float softplusf_(float x) {
  const float e = __expf(x);
  const float sp = (e < 0.01f) ? e * (1.f - 0.5f * e) : __logf(1.f + e);
  return x > 15.f ? x : sp;
}

__device__ __forceinline__ void ssd_dt_acs(const Params& p, int layer, size_t tok0, int gg, float* sAcs, float* sDt) {
  const int tid = otid(), lane = tid & 63, w = tid >> 6;
#pragma unroll
  for (int k = 0; k < 2; k++) {
    const int hh = 2 * w + k, hd = gg * 8 + hh;
    const float bias = p.dt_bias[layer * 16 + hd], a = -__expf(p.a_log[layer * 16 + hd]);
    const int l0 = 2 * lane;
    float d0 = softplusf_(bf2f(p.P[(tok0 + l0) * PW + C_SDT + hd]) + bias);
    float d1 = softplusf_(bf2f(p.P[(tok0 + l0 + 1) * PW + C_SDT + hd]) + bias);
    float s0 = d0 * a, s1 = s0 + d1 * a;
    float xs = s1;
#pragma unroll
    for (int off = 1; off < 64; off <<= 1) { float v = __shfl_up(xs, off); if (lane >= off) xs += v; }
    float ex = xs - s1;
    sAcs[l0 * 8 + hh] = ex + s0; sAcs[(l0 + 1) * 8 + hh] = ex + s1;
    sDt[l0 * 8 + hh] = d0; sDt[(l0 + 1) * 8 + hh] = d1;
  }
}

struct Conv2 { float w0[4], w1[4], b0, b1, h0[3], h1[3]; };
__device__ __forceinline__ void conv_init(const Params& p, int layer, size_t tokb, int l, int ch, Conv2& c) {
  const float* cw = p.conv_w + (size_t)layer * 4 * 1536 + ch;
#pragma unroll
  for (int k = 0; k < 4; k++) { c.w0[k] = cw[k * 1536]; c.w1[k] = cw[k * 1536 + 1]; }
  c.b0 = p.conv_b[layer * 1536 + ch]; c.b1 = p.conv_b[layer * 1536 + ch + 1];
#pragma unroll
  for (int k = 0; k < 3; k++) {
    int ll = l - 3 + k; unsigned u = 0;
    if (ll >= 0) u = *(const unsigned*)(p.P + (tokb + ll) * PW + C_XBC + ch);
    c.h0[k] = bflo(u); c.h1[k] = bfhi(u);
  }
}
__device__ __forceinline__ void conv_step(const Params& p, size_t tokb, int l, int ch, Conv2& c, float& o0, float& o1) {
  unsigned u = *(const unsigned*)(p.P + (tokb + l) * PW + C_XBC + ch);
  float x0 = bflo(u), x1 = bfhi(u);
  float a0 = c.b0 + c.w0[0] * c.h0[0] + c.w0[1] * c.h0[1] + c.w0[2] * c.h0[2] + c.w0[3] * x0;
  float a1 = c.b1 + c.w1[0] * c.h1[0] + c.w1[1] * c.h1[1] + c.w1[2] * c.h1[2] + c.w1[3] * x1;
  c.h0[0] = c.h0[1]; c.h0[1] = c.h0[2]; c.h0[2] = x0;
  c.h1[0] = c.h1[1]; c.h1[1] = c.h1[2]; c.h1[2] = x1;
  o0 = siluf_(a0); o1 = siluf_(a1);
}

__device__ __forceinline__ void conv_val(unsigned u, Conv2& c, float& o0, float& o1) {
  float x0 = bflo(u), x1 = bfhi(u);
  float a0 = c.b0 + c.w0[0] * c.h0[0] + c.w0[1] * c.h0[1] + c.w0[2] * c.h0[2] + c.w0[3] * x0;
  float a1 = c.b1 + c.w1[0] * c.h1[0] + c.w1[1] * c.h1[1] + c.w1[2] * c.h1[2] + c.w1[3] * x1;
  c.h0[0] = c.h0[1]; c.h0[1] = c.h0[2]; c.h0[2] = x0;
  c.h1[0] = c.h1[1]; c.h1[1] = c.h1[2]; c.h1[2] = x1;
  o0 = siluf_(a0); o1 = siluf_(a1);
}
#define CONV_PRELOAD(raw, N, lfirst, nrows, ch)                                                           \
  unsigned raw[N];                                                                                        \
  _Pragma("unroll") for (int k_ = 0; k_ < N; k_++)                                                        \
    raw[k_] = (k_ < (nrows)) ? *(const unsigned*)(p.P + (tokb + (lfirst) + k_) * PW + C_XBC + (ch)) : 0u;

__device__ __forceinline__ void ssd_pass1(const Params& p, int layer, int task, char* sm) {
  const int tid = otid(), lane = tid & 63, w = tid >> 6, r32 = lane & 31, h5 = lane >> 5;
  const int gg = task & 1, c = (task >> 1) & 127, b = task >> 8;
  const size_t tokb = (size_t)b * LSEQ; const int lc0 = c * 128; const size_t tok0 = tokb + lc0;
  float* sAcs = (float*)sm; float* sDt = (float*)(sm + 4096);
  bf* sBT = (bf*)(sm + 8192); bf* sXT = (bf*)(sm + 43008);
  __syncthreads();
  ssd_dt_acs(p, layer, tok0, gg, sAcs, sDt);
  {
    const int cp = tid & 63, tg = tid >> 6; const int ch = 1024 + gg * 128 + 2 * cp;
    Conv2 cv; conv_init(p, layer, tokb, lc0 + tg * 32, ch, cv);
    CONV_PRELOAD(raw, 32, lc0 + tg * 32, 32, ch)
#pragma unroll
    for (int k = 0; k < 32; k += 2) {
      const int l = tg * 32 + k;
      float a0, a1, b0, b1;
      conv_val(raw[k], cv, a0, a1);
      conv_val(raw[k + 1], cv, b0, b1);
      *(unsigned*)(sBT + (2 * cp) * 136 + l) = pk2(a0, b0);
      *(unsigned*)(sBT + (2 * cp + 1) * 136 + l) = pk2(a1, b1);
    }
  }
  __syncthreads();
  if (tid < 8) p.CD[((size_t)(b * 128 + c)) * 16 + gg * 8 + tid] = __expf(sAcs[127 * 8 + tid]);
  for (int hh = 0; hh < 8; hh++) {
    const int hd = gg * 8 + hh;
    if (hh) __syncthreads();
    {
      const int cp = tid & 31, tg = tid >> 5; const int ch = gg * 512 + hh * 64 + 2 * cp;
      const float aend = sAcs[127 * 8 + hh];
      Conv2 cv; conv_init(p, layer, tokb, lc0 + tg * 16, ch, cv);
      CONV_PRELOAD(raw, 16, lc0 + tg * 16, 16, ch)
#pragma unroll
      for (int k = 0; k < 16; k += 2) {
        const int l = tg * 16 + k;
        float a0, a1, b0, b1;
        conv_val(raw[k], cv, a0, a1);
        conv_val(raw[k + 1], cv, b0, b1);
        float sa = sDt[l * 8 + hh] * __expf(aend - sAcs[l * 8 + hh]);
        float sb = sDt[(l + 1) * 8 + hh] * __expf(aend - sAcs[(l + 1) * 8 + hh]);
        *(unsigned*)(sXT + (2 * cp) * 136 + l) = pk2(a0 * sa, b0 * sb);
        *(unsigned*)(sXT + (2 * cp + 1) * 136 + l) = pk2(a1 * sa, b1 * sb);
      }
    }
    __syncthreads();
    f32x16 acc[2];
#pragma unroll
    for (int r = 0; r < 16; r++) { const float z_ = ozero(); acc[0][r] = z_; acc[1][r] = z_; }
#pragma unroll
    for (int ks = 0; ks < 8; ks++) {
      bf16x8 bfr = *(const bf16x8*)(sBT + (32 * w + r32) * 136 + ks * 16 + 8 * h5);
      bf16x8 x0 = *(const bf16x8*)(sXT + (r32) * 136 + ks * 16 + 8 * h5);
      bf16x8 x1 = *(const bf16x8*)(sXT + (32 + r32) * 136 + ks * 16 + 8 * h5);
      acc[0] = mfma32(x0, bfr, acc[0]);
      acc[1] = mfma32(x1, bfr, acc[1]);
    }
    float* st = p.ST + ((size_t)(b * 128 + c) * 16 + hd) * 64 * 128;
#pragma unroll
    for (int pi = 0; pi < 2; pi++)
#pragma unroll
      for (int r = 0; r < 16; r++) {
        int pp = 32 * pi + 8 * (r >> 2) + 4 * h5 + (r & 3);
        st[pp * 128 + 32 * w + r32] = acc[pi][r];
      }
  }
}

__device__ __forceinline__ void ssd_statepass(const Params& p, int task) {
  const int idx = task * 256 + otid();
  const int b = idx >> 15, e4 = idx & 32767;
  const int hd = e4 >> 11;
  const float zc_ = ozero(); float4 carry = make_float4(zc_, zc_, zc_, zc_);
  float* base = p.ST + (size_t)b * 128 * 131072 + (size_t)e4 * 4;
  const float* cd = p.CD + (size_t)b * 128 * 16 + hd;
  for (int c0 = 0; c0 < 128; c0 += 4) {
    float4 v[4]; float d[4];
#pragma unroll
    for (int k = 0; k < 4; k++) { v[k] = *(const float4*)(base + (size_t)(c0 + k) * 131072); d[k] = cd[(c0 + k) * 16]; }
#pragma unroll
    for (int k = 0; k < 4; k++) {
      *(float4*)(base + (size_t)(c0 + k) * 131072) = carry;
      carry.x = carry.x * d[k] + v[k].x; carry.y = carry.y * d[k] + v[k].y;
      carry.z = carry.z * d[k] + v[k].z; carry.w = carry.w * d[k] + v[k].w;
    }
  }
}

__device__ __forceinline__ void ssd_pass2(const Params& p, int layer, int task, char* sm) {
  const int tid = otid(), lane = tid & 63, w = tid >> 6, r32 = lane & 31, h5 = lane >> 5;
  const int lh = task & 1, gg = (task >> 1) & 1, c = (task >> 2) & 127, b = task >> 9;
  const size_t tokb = (size_t)b * LSEQ; const int lc0 = c * 128; const size_t tok0 = tokb + lc0;
  float* sAcs = (float*)sm; float* sDt = (float*)(sm + 4096);
  bf* sC = (bf*)(sm + 8192); bf* sB = (bf*)(sm + 25600); bf* sM = (bf*)(sm + 25600); bf* sXT = (bf*)(sm + 43008);
  float* sSsq = (float*)(sm + 60416);
  const int wr = w >> 1, wc = w & 1;
  const int nS = 64 * (lh + 1);
  __syncthreads();
  ssd_dt_acs(p, layer, tok0, gg, sAcs, sDt);
  {
    const int cp = tid & 63, tg = tid >> 6;
    {
      const int ch = 1280 + gg * 128 + 2 * cp;
      const int lst = 64 * lh + tg * 16;
      Conv2 cv; conv_init(p, layer, tokb, lc0 + lst, ch, cv);
      CONV_PRELOAD(raw, 16, lc0 + lst, 16, ch)
#pragma unroll
      for (int k = 0; k < 16; k++) {
        const int l = lst + k;
        float a0, a1; conv_val(raw[k], cv, a0, a1);
        *(unsigned*)(sC + (l - 64 * lh) * 136 + 2 * cp) = pk2(a0, a1);
      }
    }
    {
      const int ch = 1024 + gg * 128 + 2 * cp;
      const int per = nS >> 2; const int lst = tg * per;
      Conv2 cv; conv_init(p, layer, tokb, lc0 + lst, ch, cv);
      CONV_PRELOAD(raw, 32, lc0 + lst, per, ch)
#pragma unroll
      for (int k = 0; k < 32; k++) {
        if (k < per) {
          const int l = lst + k;
          float a0, a1; conv_val(raw[k], cv, a0, a1);
          *(unsigned*)(sB + l * 136 + 2 * cp) = pk2(a0, a1);
        }
      }
    }
  }
  __syncthreads();
  f32x16 cb[2];
#pragma unroll
  for (int r = 0; r < 16; r++) { const float z_ = ozero(); cb[0][r] = z_; cb[1][r] = z_; }
  if (64 * wc < nS) {
#pragma unroll
    for (int ks = 0; ks < 8; ks++) {
      bf16x8 af = *(const bf16x8*)(sC + (32 * wr + r32) * 136 + ks * 16 + 8 * h5);
      bf16x8 b0 = *(const bf16x8*)(sB + (64 * wc + r32) * 136 + ks * 16 + 8 * h5);
      bf16x8 b1 = *(const bf16x8*)(sB + (64 * wc + 32 + r32) * 136 + ks * 16 + 8 * h5);
      cb[0] = mfma32(af, b0, cb[0]);
      cb[1] = mfma32(af, b1, cb[1]);
    }
  }
  __syncthreads();
  const int wc2 = w & 1;
  for (int hh = 0; hh < 8; hh++) {
    const int hd = gg * 8 + hh;
    if (hh) __syncthreads();
    bf16x8 pfr[8];
    {
      const float* pv = p.ST + (((size_t)(b * 128 + c) * 16 + hd) * 64 + 32 * wc2 + r32) * 128 + 8 * h5;
#pragma unroll
      for (int ks = 0; ks < 8; ks++) {
        float4 u0 = *(const float4*)(pv + ks * 16), u1 = *(const float4*)(pv + ks * 16 + 4);
        unsigned q0 = pk2(u0.x, u0.y), q1 = pk2(u0.z, u0.w), q2 = pk2(u1.x, u1.y), q3 = pk2(u1.z, u1.w);
        pfr[ks][0] = (short)(q0 & 0xFFFF); pfr[ks][1] = (short)(q0 >> 16); pfr[ks][2] = (short)(q1 & 0xFFFF); pfr[ks][3] = (short)(q1 >> 16);
        pfr[ks][4] = (short)(q2 & 0xFFFF); pfr[ks][5] = (short)(q2 >> 16); pfr[ks][6] = (short)(q3 & 0xFFFF); pfr[ks][7] = (short)(q3 >> 16);
      }
    }
    {
      const float dsk = p.ssd_d[layer * 16 + hd];
#pragma unroll
      for (int j = 0; j < 2; j++) {
        const int s = 64 * wc + 32 * j + r32;
        if (s < nS) {
          const float as = sAcs[s * 8 + hh];
#pragma unroll
          for (int r = 0; r < 16; r++) {
            const int lp = 32 * wr + 8 * (r >> 2) + 4 * h5 + (r & 3); const int l = 64 * lh + lp;
            float v = 0.f;
            if (s <= l) v = cb[j][r] * __expf(sAcs[l * 8 + hh] - as);
            if (s == l) v += dsk * __builtin_amdgcn_rcpf(sDt[l * 8 + hh]);
            sM[lp * 136 + s] = f2bf(v);
          }
        }
      }
    }
    {
      const int cp = tid & 31, tg = tid >> 5; const int ch = gg * 512 + hh * 64 + 2 * cp;
      const int per = nS >> 3; const int lst = tg * per;
      Conv2 cv; conv_init(p, layer, tokb, lc0 + lst, ch, cv);
      CONV_PRELOAD(raw, 16, lc0 + lst, per, ch)
#pragma unroll
      for (int k = 0; k < 16; k += 2) {
        if (k >= per) break;
        const int l = lst + k;
        float a0, a1, b0, b1;
        conv_val(raw[k], cv, a0, a1);
        conv_val(raw[k + 1], cv, b0, b1);
        float sa = sDt[l * 8 + hh], sb = sDt[(l + 1) * 8 + hh];
        *(unsigned*)(sXT + (2 * cp) * 136 + l) = pk2(a0 * sa, b0 * sb);
        *(unsigned*)(sXT + (2 * cp + 1) * 136 + l) = pk2(a1 * sa, b1 * sb);
      }
    }
    __syncthreads();
    f32x16 yd, yo;
#pragma unroll
    for (int r = 0; r < 16; r++) { const float z_ = ozero(); yd[r] = z_; yo[r] = z_; }
    const int nks = nS >> 4;
    for (int ks = 0; ks < nks; ks++) {
      bf16x8 xf = *(const bf16x8*)(sXT + (32 * wc2 + r32) * 136 + ks * 16 + 8 * h5);
      bf16x8 mf = *(const bf16x8*)(sM + (32 * wr + r32) * 136 + ks * 16 + 8 * h5);
      yd = mfma32(xf, mf, yd);
    }
    {
#pragma unroll
      for (int ks = 0; ks < 8; ks++) {
        bf16x8 cf = *(const bf16x8*)(sC + (32 * wr + r32) * 136 + ks * 16 + 8 * h5);
        yo = mfma32(pfr[ks], cf, yo);
      }
    }
    {
      const int lp = 32 * wr + r32; const int l = 64 * lh + lp; const size_t tok = tok0 + l;
      const float eo = __expf(sAcs[l * 8 + hh]);
      float ss = 0.f;
#pragma unroll
      for (int q = 0; q < 4; q++) {
        const int pp = 32 * wc2 + 8 * q + 4 * h5;
        uint2 zz = *(const uint2*)(p.P + tok * PW + C_SSZ + hd * 64 + pp);
        float v0 = (yd[4 * q] + eo * yo[4 * q]) * siluf_(bflo(zz.x));
        float v1 = (yd[4 * q + 1] + eo * yo[4 * q + 1]) * siluf_(bfhi(zz.x));
        float v2 = (yd[4 * q + 2] + eo * yo[4 * q + 2]) * siluf_(bflo(zz.y));
        float v3 = (yd[4 * q + 3] + eo * yo[4 * q + 3]) * siluf_(bfhi(zz.y));
        ss += v0 * v0 + v1 * v1 + v2 * v2 + v3 * v3;
        *(uint2*)(p.Y + tok * YW + Y_SSD + hd * 64 + pp) = make_uint2(pk2(v0, v1), pk2(v2, v3));
      }
      sSsq[lp * 32 + hh * 4 + wc2 * 2 + h5] = ss;
    }
  }
  __syncthreads();
  {
    const int lp = tid >> 2, part = tid & 3; const size_t tok = tok0 + 64 * lh + lp;
    float tot = 0.f;
#pragma unroll
    for (int k = 0; k < 32; k += 4) { float4 v4 = *(const float4*)(sSsq + lp * 32 + k); tot += (v4.x + v4.y) + (v4.z + v4.w); }
    const float rs = rsqrtf(tot * (1.f / 512.f) + 1e-5f);
    bf* yp = p.Y + tok * YW + Y_SSD + gg * 512 + part * 128;
    const float* ng = p.norm_g + layer * 1024 + gg * 512 + part * 128;
#pragma unroll 4
    for (int i = 0; i < 16; i++) {
      uint4 u = *(const uint4*)(yp + i * 8);
      float4 g0 = *(const float4*)(ng + i * 8), g1 = *(const float4*)(ng + i * 8 + 4);
      u.x = pk2(bflo(u.x) * rs * g0.x, bfhi(u.x) * rs * g0.y);
      u.y = pk2(bflo(u.y) * rs * g0.z, bfhi(u.y) * rs * g0.w);
      u.z = pk2(bflo(u.z) * rs * g1.x, bfhi(u.z) * rs * g1.y);
      u.w = pk2(bflo(u.w) * rs * g1.z, bfhi(u.w) * rs * g1.w);
      *(uint4*)(yp + i * 8) = u;
    }
  }
}

__device__ __forceinline__ void s5_ld_u(const Params& p, size_t tok, int g, uint4& a, uint4& b) {
  const uint4* src = (const uint4*)(p.P + tok * PW + C_S5U + g * 16);
  a = src[0]; b = src[1];
}
__device__ __forceinline__ void s5_st_u(float* dst, const uint4 a, const uint4 b) {
  *(float4*)(dst + 0) = make_float4(bflo(a.x), bfhi(a.x), bflo(a.y), bfhi(a.y));
  *(float4*)(dst + 4) = make_float4(bflo(a.z), bfhi(a.z), bflo(a.w), bfhi(a.w));
  *(float4*)(dst + 8) = make_float4(bflo(b.x), bfhi(b.x), bflo(b.y), bfhi(b.y));
  *(float4*)(dst + 12) = make_float4(bflo(b.z), bfhi(b.z), bflo(b.w), bfhi(b.w));
}
__device__ __forceinline__ void s5_load_u(const Params& p, size_t tok, int g, float* dst) {
  const uint4* src = (const uint4*)(p.P + tok * PW + C_S5U + g * 16);
  uint4 a = src[0], b = src[1];
  *(float4*)(dst + 0) = make_float4(bflo(a.x), bfhi(a.x), bflo(a.y), bfhi(a.y));
  *(float4*)(dst + 4) = make_float4(bflo(a.z), bfhi(a.z), bflo(a.w), bfhi(a.w));
  *(float4*)(dst + 8) = make_float4(bflo(b.x), bfhi(b.x), bflo(b.y), bfhi(b.y));
  *(float4*)(dst + 12) = make_float4(bflo(b.z), bfhi(b.z), bflo(b.w), bfhi(b.w));
}
typedef float f32x2 __attribute__((ext_vector_type(2)));
#define S5_STEP(uu)                                                                     \
  {                                                                                     \
    float4 u0 = *(const float4*)((uu)), u1 = *(const float4*)((uu) + 4), u2 = *(const float4*)((uu) + 8), u3 = *(const float4*)((uu) + 12); \
    f32x2 bb = B2[0] * (f32x2){u0.x, u0.x};                                             \
    bb = B2[1] * (f32x2){u0.y, u0.y} + bb; bb = B2[2] * (f32x2){u0.z, u0.z} + bb; bb = B2[3] * (f32x2){u0.w, u0.w} + bb;     \
    bb = B2[4] * (f32x2){u1.x, u1.x} + bb; bb = B2[5] * (f32x2){u1.y, u1.y} + bb; bb = B2[6] * (f32x2){u1.z, u1.z} + bb; bb = B2[7] * (f32x2){u1.w, u1.w} + bb; \
    bb = B2[8] * (f32x2){u2.x, u2.x} + bb; bb = B2[9] * (f32x2){u2.y, u2.y} + bb; bb = B2[10] * (f32x2){u2.z, u2.z} + bb; bb = B2[11] * (f32x2){u2.w, u2.w} + bb; \
    bb = B2[12] * (f32x2){u3.x, u3.x} + bb; bb = B2[13] * (f32x2){u3.y, u3.y} + bb; bb = B2[14] * (f32x2){u3.z, u3.z} + bb; bb = B2[15] * (f32x2){u3.w, u3.w} + bb; \
    float nr_ = ar * sr - ai * si + bb.x; float ni_ = ar * si + ai * sr + bb.y; sr = nr_; si = ni_; \
  }

__device__ __forceinline__ void s5_pass1(const Params& p, int layer, int task, char* sm) {
  const int tid = otid(), lane = tid & 63, w = tid >> 6;
  const int gq = task & 7, c = (task >> 3) & 127, b = task >> 10;
  const int g = gq * 4 + w;
  const size_t tok0 = (size_t)b * LSEQ + c * 128;
  float* sU = (float*)(sm + w * 8192);
  __syncthreads();
  s5_load_u(p, tok0 + lane, g, sU + lane * 16);
  s5_load_u(p, tok0 + 64 + lane, g, sU + (64 + lane) * 16);
  const size_t pi = ((size_t)(layer * 32 + g)) * 64 + lane;
  f32x2 B2[16];
#pragma unroll
  for (int h = 0; h < 16; h++) { B2[h].x = p.SB[pi * 32 + h]; B2[h].y = p.SB[pi * 32 + 16 + h]; }
  const float ar = p.SA[pi * 4], ai = p.SA[pi * 4 + 1];
  float sr = 0.f, si = 0.f;
  __builtin_amdgcn_wave_barrier();
  for (int l = 0; l < 128; l++) S5_STEP(sU + l * 16)
  *(float2*)(p.END + (((size_t)(b * 128 + c) * 32 + g) * 64 + lane) * 2) = make_float2(sr, si);
}

__device__ __forceinline__ void s5_carry(const Params& p, int layer, int task) {
  const int idx = task * 256 + otid();
  const int b = idx >> 11, gp = idx & 2047;
  const size_t pi = (size_t)layer * 2048 + gp;
  const float a128r = p.SA[pi * 4 + 2], a128i = p.SA[pi * 4 + 3];
  float sr = ozero(), si = ozero();
  float2* e = (float2*)p.END + (size_t)b * 128 * 2048 + gp;
  for (int c0 = 0; c0 < 128; c0 += 4) {
    float2 v[4];
#pragma unroll
    for (int k = 0; k < 4; k++) v[k] = e[(size_t)(c0 + k) * 2048];
#pragma unroll
    for (int k = 0; k < 4; k++) {
      e[(size_t)(c0 + k) * 2048] = make_float2(sr, si);
      float nr = a128r * sr - a128i * si + v[k].x, ni = a128r * si + a128i * sr + v[k].y; sr = nr; si = ni;
    }
  }
}

__device__ __forceinline__ void s5_pass2(const Params& p, int layer, int task, char* sm) {
  const int tid = otid(), lane = tid & 63, w = tid >> 6;
  const int c = task & 127, b = task >> 7;
  const size_t tok0 = (size_t)b * LSEQ + c * 128;
  float* sU = (float*)(sm + w * 10752); bf* sS = (bf*)(sm + w * 10752 + 2048);
  __syncthreads();
  uint4 ua, ub;
  s5_ld_u(p, tok0 + (lane & 31), w * 8, ua, ub);
  for (int gi = 0; gi < 8; gi++) {
    const int g = w * 8 + gi;
    const size_t pi = ((size_t)(layer * 32 + g)) * 64 + lane;
    f32x2 B2[16];
#pragma unroll
    for (int h = 0; h < 16; h++) { B2[h].x = p.SB[pi * 32 + h]; B2[h].y = p.SB[pi * 32 + 16 + h]; }
    const float ar = p.SA[pi * 4], ai = p.SA[pi * 4 + 1];
    float2 s0 = *(const float2*)(p.END + (((size_t)(b * 128 + c) * 32 + g) * 64 + lane) * 2);
    float sr = s0.x, si = s0.y;
    bf16x8 cf[4];
    {
      const bf* cm = p.CM + (((size_t)(layer * 32 + g)) * 16 + (lane & 15)) * 128 + 8 * (lane >> 4);
#pragma unroll
      for (int ks = 0; ks < 4; ks++) cf[ks] = *(const bf16x8*)(cm + ks * 32);
    }
    const float dsk = p.s5_d[(layer * 32 + g) * 16 + (lane & 15)];
    for (int sub = 0; sub < 4; sub++) {
      __builtin_amdgcn_wave_barrier();
      if (lane < 32) s5_st_u(sU + lane * 16, ua, ub);
      {
        const int nsub = (sub + 1) & 3; const int ng = g + (sub == 3 ? 1 : 0);
        if (sub < 3 || gi < 7) s5_ld_u(p, tok0 + nsub * 32 + (lane & 31), ng, ua, ub);
      }
      __builtin_amdgcn_wave_barrier();
      for (int l = 0; l < 32; l++) {
        S5_STEP(sU + l * 16)
        sS[l * 136 + lane] = f2bf(sr); sS[l * 136 + 64 + lane] = f2bf(si);
      }
      __builtin_amdgcn_wave_barrier();
#pragma unroll
      for (int mb = 0; mb < 2; mb++) {
        const float z_ = ozero(); f32x4 acc = {z_, z_, z_, z_};
#pragma unroll
        for (int ks = 0; ks < 4; ks++) {
          bf16x8 af = *(const bf16x8*)(sS + (16 * mb + (lane & 15)) * 136 + ks * 32 + 8 * (lane >> 4));
          acc = mfma16(af, cf[ks], acc);
        }
#pragma unroll
        for (int r = 0; r < 4; r++) {
          const int l = 16 * mb + 4 * (lane >> 4) + r;
          float y = acc[r] + dsk * sU[l * 16 + (lane & 15)];
          p.YG[(tok0 + sub * 32 + l) * 512 + g * 16 + (lane & 15)] = f2bf(geluf_(y));
        }
      }
    }
  }
  __syncthreads();
  const int wr = w >> 1, wc = w & 1, r32 = lane & 31, h5 = lane >> 5;
  for (int tn = 0; tn < 4; tn++) {
    f32x16 acc[2][2]; ZERO_ACC(acc);
    gemm_acc<4>(p.YG + tok0 * 512, 512, p.WgluT + ((size_t)layer * 512 + tn * 128) * 512, 512, 512, acc, sm);
#pragma unroll
    for (int i = 0; i < 2; i++) {
      const size_t tok = tok0 + wr * 64 + i * 32 + r32;
#pragma unroll
      for (int j = 0; j < 2; j++)
#pragma unroll
        for (int q = 0; q < 4; q++) {
          const int n = tn * 128 + wc * 64 + j * 32 + q * 8 + h5 * 4;
          float4 bg = *(const float4*)(p.b_glu + layer * 512 + n);
          uint2 yy = *(const uint2*)(p.YG + tok * 512 + n);
          uint2 zz = *(const uint2*)(p.P + tok * PW + C_S5Z + n);
          float o0 = bflo(yy.x) * sigmoidf_(acc[i][j][4 * q] + bg.x) * siluf_(bflo(zz.x));
          float o1 = bfhi(yy.x) * sigmoidf_(acc[i][j][4 * q + 1] + bg.y) * siluf_(bfhi(zz.x));
          float o2 = bflo(yy.y) * sigmoidf_(acc[i][j][4 * q + 2] + bg.z) * siluf_(bflo(zz.y));
          float o3 = bfhi(yy.y) * sigmoidf_(acc[i][j][4 * q + 3] + bg.w) * siluf_(bfhi(zz.y));
          *(uint2*)(p.Y + tok * YW + Y_S5 + n) = make_uint2(pk2(o0, o1), pk2(o2, o3));
        }
    }
  }
}

__device__ __forceinline__ void mem_attn(const Params& p, int layer, int task) {
  const int tid = otid(), lane = tid & 63, h = tid >> 6;
  const int n16 = lane & 15, kq = lane >> 4;
  const size_t tok0 = (size_t)task * 16; const int b = (int)(tok0 >> 14);
  const bf* mk = p.MK + (((size_t)layer * 2 + b) * 4 + h) * 256 * 64;
  const bf* mvt = p.MVT + (((size_t)layer * 2 + b) * 4 + h) * 64 * 256;
  bf16x8 qf[2];
  {
    const bf* qp = p.P + (tok0 + n16) * PW + C_MEQ + h * 64 + 8 * kq;
    qf[0] = *(const bf16x8*)qp; qf[1] = *(const bf16x8*)(qp + 32);
  }
  f32x4 st[16];
#pragma unroll
  for (int kb = 0; kb < 16; kb++) {
    const bf* kp = mk + (size_t)(16 * kb + n16) * 64 + 8 * kq;
    bf16x8 a0 = *(const bf16x8*)kp, a1 = *(const bf16x8*)(kp + 32);
    const float z_ = ozero(); f32x4 acc = {z_, z_, z_, z_};
    acc = mfma16(a0, qf[0], acc); acc = mfma16(a1, qf[1], acc);
    st[kb] = acc * 0.125f;
  }
  float mx = -3.0e38f;
#pragma unroll
  for (int kb = 0; kb < 16; kb++)
#pragma unroll
    for (int r = 0; r < 4; r++) mx = fmaxf(mx, st[kb][r]);
  mx = fmaxf(mx, __shfl_xor(mx, 16)); mx = fmaxf(mx, __shfl_xor(mx, 32));
  float sum = 0.f;
#pragma unroll
  for (int kb = 0; kb < 16; kb++)
#pragma unroll
    for (int r = 0; r < 4; r++) { float e = __expf(st[kb][r] - mx); st[kb][r] = e; sum += e; }
  sum += __shfl_xor(sum, 16); sum += __shfl_xor(sum, 32);
  const float rinv = 1.f / sum;
  f32x4 o[4];
#pragma unroll
  for (int mb = 0; mb < 4; mb++) { const float z_ = ozero(); o[mb] = (f32x4){z_, z_, z_, z_}; }
#pragma unroll
  for (int k2 = 0; k2 < 8; k2++) {
    bf16x8 pf;
    unsigned q0 = pk2(st[2 * k2][0], st[2 * k2][1]), q1 = pk2(st[2 * k2][2], st[2 * k2][3]);
    unsigned q2 = pk2(st[2 * k2 + 1][0], st[2 * k2 + 1][1]), q3 = pk2(st[2 * k2 + 1][2], st[2 * k2 + 1][3]);
    pf[0] = (short)(q0 & 0xFFFF); pf[1] = (short)(q0 >> 16); pf[2] = (short)(q1 & 0xFFFF); pf[3] = (short)(q1 >> 16);
    pf[4] = (short)(q2 & 0xFFFF); pf[5] = (short)(q2 >> 16); pf[6] = (short)(q3 & 0xFFFF); pf[7] = (short)(q3 >> 16);
#pragma unroll
    for (int mb = 0; mb < 4; mb++) {
      const bf* vp = mvt + (size_t)(16 * mb + n16) * 256 + 32 * k2 + 4 * kq;
      uint2 v0 = *(const uint2*)vp, v1 = *(const uint2*)(vp + 16);
      bf16x8 af;
      af[0] = (short)(v0.x & 0xFFFF); af[1] = (short)(v0.x >> 16); af[2] = (short)(v0.y & 0xFFFF); af[3] = (short)(v0.y >> 16);
      af[4] = (short)(v1.x & 0xFFFF); af[5] = (short)(v1.x >> 16); af[6] = (short)(v1.y & 0xFFFF); af[7] = (short)(v1.y >> 16);
      o[mb] = mfma16(af, pf, o[mb]);
    }
  }
  const size_t tok = tok0 + n16;
#pragma unroll
  for (int mb = 0; mb < 4; mb++) {
    const int d = 16 * mb + 4 * kq;
    uint2 zz = *(const uint2*)(p.P + tok * PW + C_MEZ + h * 64 + d);
    float v0 = o[mb][0] * rinv * siluf_(bflo(zz.x)), v1 = o[mb][1] * rinv * siluf_(bfhi(zz.x));
    float v2 = o[mb][2] * rinv * siluf_(bflo(zz.y)), v3 = o[mb][3] * rinv * siluf_(bfhi(zz.y));
    *(uint2*)(p.Y + tok * YW + Y_MEM + h * 64 + d) = make_uint2(pk2(v0, v1), pk2(v2, v3));
  }
}

__device__ __forceinline__ void dsa_wave(const Params& p, int rank, char* sm) {
  const int tid = otid(), lane = tid & 63, w = tid >> 6, r32 = lane & 31, h5 = lane >> 5;
  const int b = rank & 1, qg = 2047 - (rank >> 1), l0 = qg * 8;
  const size_t tokb = (size_t)b * LSEQ;
  unsigned* cand = (unsigned*)(sm + w * (8 * CAP * 4));
  bf* Pb = (bf*)(sm + 65536 + w * 4096);
  bf16x8 aq[4];
  {
    const bf* qp = p.P + (tokb + l0 + (r32 >> 2)) * PW + C_IDQ + (r32 & 3) * 64 + 8 * h5;
#pragma unroll
    for (int ks = 0; ks < 4; ks++) aq[ks] = *(const bf16x8*)(qp + ks * 16);
  }
  float wv[4][4]; int ql[4];
#pragma unroll
  for (int g = 0; g < 4; g++) {
    ql[g] = l0 + 2 * g + h5;
    uint2 u = *(const uint2*)(p.P + (tokb + ql[g]) * PW + C_IDW);
    wv[g][0] = bflo(u.x) * 0.0625f; wv[g][1] = bfhi(u.x) * 0.0625f; wv[g][2] = bflo(u.y) * 0.0625f; wv[g][3] = bfhi(u.y) * 0.0625f;
  }
  unsigned Tg[4] = {0u, 0u, 0u, 0u}; float Tf[4];
  unsigned Tq = 0u; int cntv = 0;
  int nrep_ = (PROBE_MASK & 32) ? 2 : 1; asm volatile("" : "+s"(nrep_));
#pragma unroll 1
  for (int rep_ = 0; rep_ < nrep_; rep_++) {
  Tg[0] = Tg[1] = Tg[2] = Tg[3] = 0u; Tq = 0u; cntv = 0;
  Tf[0] = Tf[1] = Tf[2] = Tf[3] = -__builtin_inff();
  const int ntile = (l0 + 7) / 32 + 1;
  const bf* kif = p.KIF + (size_t)b * 512 * 2048 + lane * 8;
  bf16x8 bqA[4][4], bqB[4][4];
#pragma unroll
  for (int s = 0; s < 4; s++) {
    const int ts = s < ntile ? s : ntile - 1;
#pragma unroll
    for (int ks = 0; ks < 4; ks++) bqA[s][ks] = *(const bf16x8*)(kif + (size_t)ts * 2048 + ks * 512);
  }
  const unsigned ltmask = (1u << r32) - 1u;
#define DSA_COMPACT_CHECK()                                                                                              \
  {                                                                                                                     \
    unsigned long long over = __ballot(lane < 8 && cntv > CAP - 64);                                                    \
    if (over) {                                                                                                         \
      while (over) {                                                                                                    \
        const int q = __builtin_ctzll(over); over &= over - 1;                                                          \
        const int n = __builtin_amdgcn_readlane(cntv, q);                                                               \
        unsigned* cb_ = cand + q * CAP;                                                                                 \
        unsigned e[8];                                                                                                  \
        _Pragma("unroll") for (int i = 0; i < 8; i++) e[i] = (i * 64 + lane < n) ? cb_[i * 64 + lane] : 0u;             \
        unsigned T = 0u; int cT = n;                                                                                    \
        int nsr_ = (PROBE_MASK & 64) ? 2 : 1; asm volatile("" : "+s"(nsr_));                                            \
        _Pragma("unroll 1") for (int sr_ = 0; sr_ < nsr_; sr_++) { T = 0u; cT = n;                                      \
        const unsigned Told_ = (unsigned)__builtin_amdgcn_readlane((int)Tq, q);                                         \
        for (int bit = 31; bit >= 18; bit--) {                                                                          \
          const unsigned cnd = T | (1u << bit); int cc = 0;                                                             \
          if (cnd <= Told_) { T = cnd; continue; }                       \
          _Pragma("unroll") for (int i = 0; i < 8; i++) cc += __popcll(__ballot(e[i] >= cnd));                          \
          if (cc >= 256) { T = cnd; cT = cc; }                                                                          \
        } }                                                                                                             \
        if (cT > 320) {                                                                                                 \
          for (int bit = 17; bit >= 0; bit--) {                                                                         \
            const unsigned cnd = T | (1u << bit); int cc = 0;                                                           \
            _Pragma("unroll") for (int i = 0; i < 8; i++) cc += __popcll(__ballot(e[i] >= cnd));                        \
            if (cc >= 256) T = cnd;                                                                                     \
          }                                                                                                             \
        }                                                                                                               \
        int pos = 0;                                                                                                    \
        _Pragma("unroll") for (int i = 0; i < 8; i++) {                                                                 \
          const bool keep = e[i] >= T; const unsigned long long m = __ballot(keep);                                     \
          if (keep) cb_[pos + __popcll(m & ((1ull << lane) - 1ull))] = e[i];                                            \
          pos += __popcll(m);                                                                                           \
        }                                                                                                               \
        if (lane == q) { cntv = pos; Tq = T; }                                                                          \
      }                                                                                                                 \
      _Pragma("unroll") for (int g = 0; g < 4; g++) {                                                                   \
        unsigned tlo = __builtin_amdgcn_readlane(Tq, 2 * g), thi = __builtin_amdgcn_readlane(Tq, 2 * g + 1);            \
        Tg[g] = h5 ? thi : tlo;                                                                                         \
        const unsigned sh = Tg[g] & 0xFFFFC000u;                                                                        \
        const unsigned fb = (sh & 0x80000000u) ? (sh ^ 0x80000000u) : ~sh;                                              \
        Tf[g] = Tg[g] ? __uint_as_float(fb) : -__builtin_inff();                                                        \
      }                                                                                                                 \
    }                                                                                                                   \
  }
#define DSA_G(g, DIAG)                                                                                                  \
      {                                                                                                                 \
        const float r0 = __int_as_float(max(__float_as_int(acc[4 * g]), 0)), r1 = __int_as_float(max(__float_as_int(acc[4 * g + 1]), 0)); \
        const float r2 = __int_as_float(max(__float_as_int(acc[4 * g + 2]), 0)), r3 = __int_as_float(max(__float_as_int(acc[4 * g + 3]), 0)); \
        float sc = r0 * wv[g][0]; sc = fmaf(r1, wv[g][1], sc); sc = fmaf(r2, wv[g][2], sc); sc = fmaf(r3, wv[g][3], sc); \
        unsigned long long m0 = __builtin_amdgcn_fcmpf(sc, Tf[g], 3  );                                            \
        if (DIAG) m0 &= __builtin_amdgcn_sicmp(kidx, ql[g], 41  );                                                 \
        if (m0) {                                                                                                       \
          const float s2 = sc + 0.f;                                                                                    \
          unsigned uu = __float_as_uint(s2); uu ^= ((unsigned)((int)uu >> 31) | 0x80000000u);                           \
          const unsigned pk = (uu & 0xFFFFC000u) | (unsigned)(16383 - kidx);                                            \
          const unsigned long long m = m0 & __builtin_amdgcn_uicmp(pk, Tg[g], 35  );                              \
          if (m) {                                                                                                      \
            const unsigned lo = (unsigned)m, hi = (unsigned)(m >> 32);                                                  \
            const int cA = __builtin_amdgcn_readlane(cntv, 2 * g), cB = __builtin_amdgcn_readlane(cntv, 2 * g + 1);     \
            const unsigned mm = h5 ? hi : lo;                                                                           \
            if ((mm >> r32) & 1u) {                                                                                     \
              const int base = h5 ? cB : cA;                                                                            \
              cand[(2 * g + h5) * CAP + base + __popc(mm & ltmask)] = pk;                                               \
            }                                                                                                           \
            if (lane == 2 * g) cntv += __popc(lo);                                                                      \
            if (lane == 2 * g + 1) cntv += __popc(hi);                                                                  \
          }                                                                                                             \
        }                                                                                                               \
      }
#define DSA_GROUP(BC, BN, TB)                                                                                           \
  _Pragma("unroll") for (int u = 0; u < 4; u++) {                                                                       \
    if ((u & 1) == 0) DSA_COMPACT_CHECK()                                                                               \
    const int tile = (TB) + u;                                                                                          \
    f32x16 acc = {0.f, 0.f, 0.f, 0.f, 0.f, 0.f, 0.f, 0.f, 0.f, 0.f, 0.f, 0.f, 0.f, 0.f, 0.f, 0.f};                    \
    _Pragma("unroll") for (int ks = 0; ks < 4; ks++) acc = mfma32(aq[ks], BC[u][ks], acc);                              \
    if (u == 0) {                                                                                                       \
      _Pragma("unroll") for (int s = 0; s < 4; s++) {                                                                   \
        const int tn_ = ((TB) + 4 + s < ntile) ? (TB) + 4 + s : ntile - 1;                                              \
        _Pragma("unroll") for (int ks = 0; ks < 4; ks++) BN[s][ks] = *(const bf16x8*)(kif + (size_t)tn_ * 2048 + ks * 512); \
      }                                                                                                                 \
    }                                                                                                                   \
    const int kidx = tile * 32 + r32;                                                                                   \
    const bool diag = (tile * 32 + 31 > l0);                                                                            \
    if (!diag) { DSA_G(0, false) DSA_G(1, false) DSA_G(2, false) DSA_G(3, false) }                                      \
    else { DSA_G(0, true) DSA_G(1, true) DSA_G(2, true) DSA_G(3, true) }                                                \
  }
  for (int tile0 = 0; tile0 < ntile; tile0 += 8) {
    DSA_GROUP(bqA, bqB, tile0)
    DSA_GROUP(bqB, bqA, tile0 + 4)
  }
  {
    unsigned long long over = __ballot(lane < 8 && cntv > 256);
    while (over) {
      const int q = __builtin_ctzll(over); over &= over - 1;
      const int n = __builtin_amdgcn_readlane(cntv, q);
      unsigned* cb_ = cand + q * CAP;
      unsigned e[8];
#pragma unroll
      for (int i = 0; i < 8; i++) e[i] = (i * 64 + lane < n) ? cb_[i * 64 + lane] : 0u;
      unsigned T = 0u;
      const unsigned Told_ = (unsigned)__builtin_amdgcn_readlane((int)Tq, q);
      for (int bit = 31; bit >= 0; bit--) {
        const unsigned cnd = T | (1u << bit); int cc = 0;
        if (cnd <= Told_) { T = cnd; continue; }
#pragma unroll
        for (int i = 0; i < 8; i++) cc += __popcll(__ballot(e[i] >= cnd));
        if (cc >= 256) T = cnd;
      }
      int pos = 0;
#pragma unroll
      for (int i = 0; i < 8; i++) {
        const bool keep = e[i] >= T; const unsigned long long m = __ballot(keep);
        if (keep) cb_[pos + __popcll(m & ((1ull << lane) - 1ull))] = e[i];
        pos += __popcll(m);
      }
      if (lane == q) { cntv = pos; Tq = T; }
    }
  }
  }
  __builtin_amdgcn_wave_barrier();
  const int n16 = lane & 15, kq = lane >> 4;
#define DPP_ROR(v, n) __int_as_float(__builtin_amdgcn_update_dpp(0, __float_as_int(v), 0x120 + (n), 0xf, 0xf, false))
  for (int q = 0; q < 8; q++) {
    const int n = __builtin_amdgcn_readlane(cntv, q);
    const unsigned* sel = cand + q * CAP;
    const size_t tq = tokb + l0 + q;
    float ssum[2][4];
    bf16x8 qa[2][2];
#pragma unroll
    for (int grp = 0; grp < 2; grp++) {
#pragma unroll
      for (int k = 0; k < 8; k++) { int zi_ = 0; asm volatile("" : "+v"(zi_)); qa[grp][0][k] = (short)zi_; qa[grp][1][k] = (short)zi_; }
      if (n16 < 4) {
        const bf* qp = p.P + tq * PW + C_ATQ + (grp * 4 + n16) * 64 + 8 * kq;
        qa[grp][0] = *(const bf16x8*)qp; qa[grp][1] = *(const bf16x8*)(qp + 32);
      }
    }
    f32x4 lgA[16], lgB[16];
#pragma unroll
    for (int t = 0; t < 16; t++) {
      const int slot = t * 16 + n16; const bool valid = slot < n;
      const int key = valid ? (16383 - (int)(sel[slot] & 0x3FFFu)) : 0;
      const bf* kp = p.KVC + (tokb + key) * 256 + 8 * kq;
      bf16x8 a0 = *(const bf16x8*)kp, a1 = *(const bf16x8*)(kp + 32), b0 = *(const bf16x8*)(kp + 64), b1 = *(const bf16x8*)(kp + 96);
      const float zc_ = ozero(); f32x4 ca = {zc_, zc_, zc_, zc_}, cb2 = {zc_, zc_, zc_, zc_};
      ca = mfma16(qa[0][0], a0, ca); ca = mfma16(qa[0][1], a1, ca);
      cb2 = mfma16(qa[1][0], b0, cb2); cb2 = mfma16(qa[1][1], b1, cb2);
      const bool ok = valid && (kq == 0);
#pragma unroll
      for (int r = 0; r < 4; r++) { lgA[t][r] = ok ? ca[r] * 0.125f : -3.0e38f; lgB[t][r] = ok ? cb2[r] * 0.125f : -3.0e38f; }
    }
    __builtin_amdgcn_wave_barrier();
#define DSA_SOFTMAX(LG, GRP)                                                                                            \
    {                                                                                                                   \
      float mx[4];                                                                                                      \
      _Pragma("unroll") for (int r = 0; r < 4; r++) {                                                                   \
        float m = LG[0][r];                                                                                             \
        _Pragma("unroll") for (int t = 1; t < 16; t++) m = fmaxf(m, LG[t][r]);                                          \
        m = fmaxf(m, DPP_ROR(m, 8)); m = fmaxf(m, DPP_ROR(m, 4)); m = fmaxf(m, DPP_ROR(m, 2)); m = fmaxf(m, DPP_ROR(m, 1)); \
        mx[r] = __int_as_float(__builtin_amdgcn_readfirstlane(__float_as_int(m)));                                      \
      }                                                                                                                 \
      _Pragma("unroll") for (int r = 0; r < 4; r++) {                                                                   \
        float s = 0.f;                                                                                                  \
        _Pragma("unroll") for (int t = 0; t < 16; t++) { float e = (LG[t][r] > -1.0e38f) ? __expf(LG[t][r] - mx[r]) : 0.f; LG[t][r] = e; s += e; } \
        s += DPP_ROR(s, 8); s += DPP_ROR(s, 4); s += DPP_ROR(s, 2); s += DPP_ROR(s, 1);                                  \
        ssum[GRP][r] = __int_as_float(__builtin_amdgcn_readfirstlane(__float_as_int(s)));                              \
      }                                                                                                                 \
      if (kq == 0) {                                                                                                    \
        _Pragma("unroll") for (int t = 0; t < 16; t++)                                                                  \
          *(uint2*)(Pb + (t * 16 + n16) * 8 + GRP * 4) = make_uint2(pk2(LG[t][0], LG[t][1]), pk2(LG[t][2], LG[t][3]));  \
      }                                                                                                                 \
    }
    DSA_SOFTMAX(lgA, 0)
    DSA_SOFTMAX(lgB, 1)
    __builtin_amdgcn_wave_barrier();
    float o[64];
#pragma unroll
    for (int i = 0; i < 64; i++) o[i] = ozero();
    const int ksg = lane >> 3, dc = lane & 7;
#pragma unroll 8
    for (int stp = 0; stp < 32; stp++) {
      const int slot = stp * 8 + ksg;
      const int key = (slot < n) ? (16383 - (int)(sel[slot] & 0x3FFFu)) : 0;
      uint4 pp = *(const uint4*)(Pb + slot * 8);
      const bf* vp = p.KVC + (tokb + key) * 256 + 128 + dc * 8;
      uint4 va = *(const uint4*)vp, vb = *(const uint4*)(vp + 64);
      float ph[8] = {bflo(pp.x), bfhi(pp.x), bflo(pp.y), bfhi(pp.y), bflo(pp.z), bfhi(pp.z), bflo(pp.w), bfhi(pp.w)};
      float v0[8] = {bflo(va.x), bfhi(va.x), bflo(va.y), bfhi(va.y), bflo(va.z), bfhi(va.z), bflo(va.w), bfhi(va.w)};
      float v1[8] = {bflo(vb.x), bfhi(vb.x), bflo(vb.y), bfhi(vb.y), bflo(vb.z), bfhi(vb.z), bflo(vb.w), bfhi(vb.w)};
#pragma unroll
      for (int hh = 0; hh < 4; hh++)
#pragma unroll
        for (int d = 0; d < 8; d++) { o[hh * 8 + d] += ph[hh] * v0[d]; o[(4 + hh) * 8 + d] += ph[4 + hh] * v1[d]; }
    }
    __builtin_amdgcn_wave_barrier();
    const bool b5 = (lane >> 5) & 1, b4 = (lane >> 4) & 1, b3 = (lane >> 3) & 1;
    float o32[32], o16[16], o8[8];
#pragma unroll
    for (int i = 0; i < 32; i++) { float lo = o[i], hi = o[32 + i]; float snd = b5 ? lo : hi; float kp = b5 ? hi : lo; o32[i] = kp + __shfl_xor(snd, 32); }
#pragma unroll
    for (int i = 0; i < 16; i++) { float lo = o32[i], hi = o32[16 + i]; float snd = b4 ? lo : hi; float kp = b4 ? hi : lo; o16[i] = kp + __shfl_xor(snd, 16); }
#pragma unroll
    for (int i = 0; i < 8; i++) { float lo = o16[i], hi = o16[8 + i]; float snd = b3 ? lo : hi; float kp = b3 ? hi : lo; o8[i] = kp + __shfl_xor(snd, 8); }
    const float s_g0 = b4 ? (b3 ? ssum[0][3] : ssum[0][2]) : (b3 ? ssum[0][1] : ssum[0][0]);
    const float s_g1 = b4 ? (b3 ? ssum[1][3] : ssum[1][2]) : (b3 ? ssum[1][1] : ssum[1][0]);
    const float rinv = 1.f / (b5 ? s_g1 : s_g0);
    const int hsel = (b5 ? 4 : 0) + (b4 ? 2 : 0) + (b3 ? 1 : 0);
    const int col = hsel * 64 + dc * 8;
    uint4 zz = *(const uint4*)(p.P + tq * PW + C_ATZ + col);
    uint4 ov;
    ov.x = pk2(o8[0] * rinv * siluf_(bflo(zz.x)), o8[1] * rinv * siluf_(bfhi(zz.x)));
    ov.y = pk2(o8[2] * rinv * siluf_(bflo(zz.y)), o8[3] * rinv * siluf_(bfhi(zz.y)));
    ov.z = pk2(o8[4] * rinv * siluf_(bflo(zz.z)), o8[5] * rinv * siluf_(bfhi(zz.z)));
    ov.w = pk2(o8[6] * rinv * siluf_(bflo(zz.w)), o8[7] * rinv * siluf_(bfhi(zz.w)));
    *(uint4*)(p.Y + tq * YW + Y_ATT + col) = ov;
  }
}

__device__ __forceinline__ void phaseB(const Params& p, int layer, char* sm0) {
  const int total = 512 + 2048 + 2048;
  char* sm = sm0 + HB * HALF_LDS;
  for (int t = VB; t < total; t += G2) {
    if (t < 512) ssd_pass1(p, layer, t, sm);
    else if (t < 2560) s5_pass1(p, layer, t - 512, sm);
    else mem_attn(p, layer, t - 2560);
  }
}
__device__ __forceinline__ void phaseC(const Params& p, int layer, char* sm0, bool dsa_only) {
  const int G = G2;
  const int total = dsa_only ? 1024 : 1024 + 256 + 16;
  char* sm = sm0 + HB * HALF_LDS;
  int rr = 0;
  for (int i = VB; i < total; i += G, rr++) {
    if (i < 1024) {
      int pos = i - rr * G; int idx = i;
      if ((rr & 1) && (rr * G + G <= 1024)) idx = rr * G + (G - 1 - pos);
      __syncthreads();
      dsa_wave(p, idx * 4 + (otid() >> 6), sm);
    } else if (i < 1280) ssd_statepass(p, i - 1024);
    else s5_carry(p, layer, i - 1280);
  }
}
__device__ __forceinline__ void phaseD(const Params& p, int layer, char* sm0) {
  const int total = 256 + 1024;
  char* sm = sm0 + HB * HALF_LDS;
  const int vb = VB;
  if (G2 == 512) {
    if (vb < 256) { s5_pass2(p, layer, vb, sm); ssd_pass2(p, layer, vb, sm); }
    else {
#pragma unroll 1
      for (int k = 0; k < 3; k++) ssd_pass2(p, layer, 256 + (vb - 256) * 3 + k, sm);
    }
  } else {
    for (int t = vb; t < total; t += G2) {
      if (t < 256) s5_pass2(p, layer, t, sm);
      else ssd_pass2(p, layer, t - 256, sm);
    }
  }
}

__device__ __forceinline__ void phaseE(const Params& p, int layer) {
  const int tidf = otid_full();
  const int wid = __builtin_amdgcn_readfirstlane(tidf >> 6), lane = tidf & 63, wr = wid >> 2, wc = wid & 3, fr = lane & 15, fq = lane >> 4;
  const bf* Wl = p.WinT + (size_t)layer * INW * 2048;
  const bf* Wb = p.WbrT + (size_t)layer * 2048 * YW;
  bf* merged = p.P;
  char* gsb = (char*)p.GS + (size_t)blockIdx.x * 131072;
  const unsigned gs_lane0 = (unsigned)tidf * 16u, lane_c40 = (unsigned)fq * 16u, lane_m0 = (unsigned)(fr * 2048 + fq * 4) * 2u;
  for (int L = blockIdx.x; L < 1024; L += gridDim.x) {
    int pm, pn; tile_order(L, 128, 8, pm, pn);
    const int brow = pm * 256, bcol = pn * 256;
#pragma unroll 1
    for (int s = 0; s < 8; s++) {
      const int br = s >> 1; const bool isBr = (s & 1) != 0;
      const int koff = br == 0 ? 0 : (br == 1 ? 512 : (br == 2 ? 1024 : 2048));
      const int kb = br == 2 ? 1024 : (br == 3 ? 256 : 512);
      const bf* A_ = isBr ? p.Y + koff : p.xb; const int lda_ = isBr ? YW : 2048;
      const bf* B_ = isBr ? Wb + koff : Wl + (size_t)(5716 + br * 2048) * 2048; const int ldb_ = isBr ? YW : 2048;
      const int K_ = isBr ? kb : 2048;
      f32x4 acc[2][2][4][2]; ZERO_ACC8(acc);
      gemm256(A_, lda_, B_, ldb_, K_, brow, bcol, acc);
      unsigned gs_lane = gs_lane0, lane_c4 = lane_c40, lane_m = lane_m0;
      asm volatile("" : "+v"(gs_lane), "+v"(lane_c4), "+v"(lane_m));
      if (!isBr) {
        const char* bgb = (const char*)(p.b_gate + (size_t)layer * 8192 + br * 2048 + bcol + wc * 32);
        float4 bgv[2][2];
#pragma unroll
        for (int bj = 0; bj < 2; bj++)
#pragma unroll
          for (int n = 0; n < 2; n++) bgv[bj][n] = *(const float4*)(bgb + (bj * 128 + n * 16) * 4 + lane_c4);
#pragma unroll
        for (int ai = 0; ai < 2; ai++)
#pragma unroll
          for (int bj = 0; bj < 2; bj++)
#pragma unroll
            for (int m = 0; m < 4; m++) {
              unsigned q[4];
#pragma unroll
              for (int n = 0; n < 2; n++) {
                const float4 bg = bgv[bj][n];
                f32x4 v = acc[ai][bj][m][n];
                q[2 * n] = pk2(sigmoidf_(v[0] + bg.x), sigmoidf_(v[1] + bg.y));
                q[2 * n + 1] = pk2(sigmoidf_(v[2] + bg.z), sigmoidf_(v[3] + bg.w));
              }
              *(uint4*)(gsb + ((ai * 2 + bj) * 4 + m) * 8192 + gs_lane) = make_uint4(q[0], q[1], q[2], q[3]);
              __builtin_amdgcn_sched_barrier(0);
            }
      } else {
        char* mb = (char*)merged + ((size_t)(brow + wr * 64) * 2048 + bcol + wc * 32) * 2;
#pragma unroll
        for (int ai = 0; ai < 2; ai++)
#pragma unroll
          for (int bj = 0; bj < 2; bj++) {
#pragma unroll
            for (int mh = 0; mh < 2; mh++) {
              uint4 g4[2]; uint2 old[2][2];
#pragma unroll
              for (int mm = 0; mm < 2; mm++) {
                const int m = mh * 2 + mm;
                g4[mm] = *(const uint4*)(gsb + ((ai * 2 + bj) * 4 + m) * 8192 + gs_lane);
                if (br) {
#pragma unroll
                  for (int n = 0; n < 2; n++)
                    old[mm][n] = *(const uint2*)(mb + ((size_t)(ai * 128 + m * 16) * 2048 + bj * 128 + n * 16) * 2 + lane_m);
                }
              }
#pragma unroll
              for (int mm = 0; mm < 2; mm++) {
                const int m = mh * 2 + mm;
                const unsigned gq[4] = {g4[mm].x, g4[mm].y, g4[mm].z, g4[mm].w};
#pragma unroll
                for (int n = 0; n < 2; n++) {
                  f32x4 v = acc[ai][bj][m][n];
                  float o0 = bflo(gq[2 * n]) * v[0], o1 = bfhi(gq[2 * n]) * v[1], o2 = bflo(gq[2 * n + 1]) * v[2], o3 = bfhi(gq[2 * n + 1]) * v[3];
                  char* mp = mb + ((size_t)(ai * 128 + m * 16) * 2048 + bj * 128 + n * 16) * 2 + lane_m;
                  if (br) { o0 += bflo(old[mm][n].x); o1 += bfhi(old[mm][n].x); o2 += bflo(old[mm][n].y); o3 += bfhi(old[mm][n].y); }
                  *(uint2*)mp = make_uint2(pk2(o0, o1), pk2(o2, o3));
                }
              }
            }
            __builtin_amdgcn_sched_barrier(0);
          }
      }
    }
  }
}

__device__ __forceinline__ void phaseF(const Params& p, int layer) {
  const int tidf = otid_full();
  const int wid = __builtin_amdgcn_readfirstlane(tidf >> 6), lane = tidf & 63, wr = wid >> 2, wc = wid & 3, fr = lane & 15, fq = lane >> 4;
  const bf* merged = p.P;
  const float* xres = layer == 0 ? p.x : p.out;
  for (int L = blockIdx.x; L < 1024; L += gridDim.x) {
    int pm, pn; tile_order(L, 128, 8, pm, pn);
    const int brow = pm * 256, bcol = pn * 256;
    f32x4 acc[2][2][4][2]; ZERO_ACC8(acc);
    gemm256(merged, 2048, p.WoutT + (size_t)layer * 2048 * 2048, 2048, 2048, brow, bcol, acc);
#pragma unroll
    for (int ai = 0; ai < 2; ai++)
#pragma unroll
      for (int m = 0; m < 4; m++) {
        const size_t tok = brow + ai * 128 + wr * 64 + m * 16 + fr;
#pragma unroll
        for (int bj = 0; bj < 2; bj++)
#pragma unroll
          for (int n = 0; n < 2; n++) {
            const int col = bcol + bj * 128 + wc * 32 + n * 16 + fq * 4;
            float4 xr = *(const float4*)(xres + tok * 2048 + col);
            f32x4 v = acc[ai][bj][m][n];
            float4 o;
            o.x = 1.41421356237f * xr.x + v[0]; o.y = 1.41421356237f * xr.y + v[1];
            o.z = 1.41421356237f * xr.z + v[2]; o.w = 1.41421356237f * xr.w + v[3];
            *(float4*)(p.out + tok * 2048 + col) = o;
          }
      }
  }
}

__device__ __forceinline__ void phaseG(const Params& p, int layer) {
  const int lane = otid() & 63, w = otid() >> 6;
  const float* g = p.ln_g + layer * 2048; const float* bb = p.ln_b + layer * 2048;
  float4 gg[8], bv[8];
#pragma unroll
  for (int i = 0; i < 8; i++) { gg[i] = *(const float4*)(g + (i * 64 + lane) * 4); bv[i] = *(const float4*)(bb + (i * 64 + lane) * 4); }
  for (int t = VB; t < TT / 8; t += G2) {
    float4 v[2][8];
#pragma unroll
    for (int rr = 0; rr < 2; rr++) {
      const float* xp = p.out + ((size_t)t * 8 + w * 2 + rr) * 2048;
#pragma unroll
      for (int i = 0; i < 8; i++) v[rr][i] = *(const float4*)(xp + (i * 64 + lane) * 4);
    }
#pragma unroll
    for (int rr = 0; rr < 2; rr++) {
      const size_t row = (size_t)t * 8 + w * 2 + rr;
      float* xp = p.out + row * 2048;
      float s = 0.f;
#pragma unroll
      for (int i = 0; i < 8; i++) s += v[rr][i].x + v[rr][i].y + v[rr][i].z + v[rr][i].w;
#pragma unroll
      for (int off = 1; off < 64; off <<= 1) s += __shfl_xor(s, off);
      const float mu = s * (1.f / 2048.f);
      float q = 0.f;
#pragma unroll
      for (int i = 0; i < 8; i++) {
        float a = v[rr][i].x - mu, b = v[rr][i].y - mu, c = v[rr][i].z - mu, d = v[rr][i].w - mu; q += a * a + b * b + c * c + d * d;
      }
#pragma unroll
      for (int off = 1; off < 64; off <<= 1) q += __shfl_xor(q, off);
      const float rs = rsqrtf(q * (1.f / 2048.f) + 1e-5f);
#pragma unroll
      for (int i = 0; i < 8; i++) {
        const int col = (i * 64 + lane) * 4;
        float4 o;
        o.x = (v[rr][i].x - mu) * rs * gg[i].x + bv[i].x; o.y = (v[rr][i].y - mu) * rs * gg[i].y + bv[i].y;
        o.z = (v[rr][i].z - mu) * rs * gg[i].z + bv[i].z; o.w = (v[rr][i].w - mu) * rs * gg[i].w + bv[i].w;
        *(float4*)(xp + col) = o;
        if (layer == 0) *(uint2*)(p.xb + row * 2048 + col) = make_uint2(pk2(o.x, o.y), pk2(o.z, o.w));
      }
    }
  }
}

__global__ void __launch_bounds__(512, 2) mega_kernel(Params p) {
  char* sm = dynsm;
  cg::grid_group grid = cg::this_grid();
  phase0(p, sm); grid.sync();
#pragma unroll 1
  for (int layer = 0; layer < 2; layer++) {
    int nA = (PROBE_MASK & 1) ? 2 : 1, nB = (PROBE_MASK & 2) ? 2 : 1, nC = (PROBE_MASK & 4) ? 2 : 1, nD = (PROBE_MASK & 8) ? 2 : 1, nE = (PROBE_MASK & 16) ? 2 : 1;
    asm volatile("" : "+s"(nA), "+s"(nB), "+s"(nC), "+s"(nD), "+s"(nE));
#pragma unroll 1
    for (int r = 0; r < nA; r++) phaseA(p, layer);
    grid.sync();
#pragma unroll 1
    for (int r = 0; r < nB; r++) phaseB(p, layer, sm);
    grid.sync();
#pragma unroll 1
    for (int r = 0; r < nC; r++) phaseC(p, layer, sm, r + 1 < nC);
    grid.sync();
#pragma unroll 1
    for (int r = 0; r < nD; r++) phaseD(p, layer, sm);
    grid.sync();
#pragma unroll 1
    for (int r = 0; r < nE; r++) phaseE(p, layer);
    grid.sync();
    phaseF(p, layer); grid.sync();
    phaseG(p, layer);
    if (layer == 0) grid.sync();
  }
}

extern "C" void kernel_launch(void* const* d_in, const int* in_sizes, int n_in, void* d_out, int out_size, void* d_ws,
                              size_t ws_size, hipStream_t stream) {
  Params p{};
  p.x = (const float*)d_in[0]; p.mem = (const float*)d_in[1]; p.pos = (const int*)d_in[2];
  p.w_in = (const float*)d_in[3]; p.b_gate = (const float*)d_in[4]; p.lam_re = (const float*)d_in[5];
  p.lam_im = (const float*)d_in[6]; p.log_dt = (const float*)d_in[7]; p.b_re = (const float*)d_in[8];
  p.b_im = (const float*)d_in[9]; p.c_re = (const float*)d_in[10]; p.c_im = (const float*)d_in[11];
  p.s5_d = (const float*)d_in[12]; p.w_glu = (const float*)d_in[13]; p.b_glu = (const float*)d_in[14];
  p.conv_w = (const float*)d_in[15]; p.conv_b = (const float*)d_in[16]; p.dt_bias = (const float*)d_in[17];
  p.a_log = (const float*)d_in[18]; p.ssd_d = (const float*)d_in[19]; p.norm_g = (const float*)d_in[20];
  p.mem_w_kv = (const float*)d_in[21]; p.w_br_s5 = (const float*)d_in[22]; p.w_br_attn = (const float*)d_in[23];
  p.w_br_ssd = (const float*)d_in[24]; p.w_br_mem = (const float*)d_in[25]; p.w_out = (const float*)d_in[26];
  p.ln_g = (const float*)d_in[27]; p.ln_b = (const float*)d_in[28];
  p.out = (float*)d_out;
  char* ws = (char*)d_ws; size_t off = 0;
  auto carve = [&](size_t bytes) { char* r = ws + off; off += (bytes + 255) & ~(size_t)255; return r; };
  p.WinT = (bf*)carve((size_t)2 * INW * 2048 * 2);
  p.WbrT = (bf*)carve((size_t)2 * 2048 * YW * 2);
  p.WoutT = (bf*)carve((size_t)2 * 2048 * 2048 * 2);
  p.WgluT = (bf*)carve((size_t)2 * 512 * 512 * 2);
  p.WmemT = (bf*)carve((size_t)2 * 512 * 2048 * 2);
  p.memb = (bf*)carve((size_t)512 * 2048 * 2);
  p.xb = (bf*)carve((size_t)TT * 2048 * 2);
  p.P = (bf*)carve((size_t)TT * PW * 2);
  p.Y = (bf*)carve((size_t)TT * YW * 2);
  p.YG = (bf*)carve((size_t)TT * 512 * 2);
  p.KIF = (bf*)carve((size_t)TT * 64 * 2);
  p.MK = (bf*)carve((size_t)2 * 2 * 4 * 256 * 64 * 2);
  p.MVT = (bf*)carve((size_t)2 * 2 * 4 * 256 * 64 * 2);
  p.CM = (bf*)carve((size_t)2 * 32 * 16 * 128 * 2);
  p.ST = (float*)carve((size_t)2 * 128 * 131072 * 4);
  p.CS = (float*)carve((size_t)TT * 16 * 4);
  p.END = (float*)carve((size_t)2 * 128 * 32 * 64 * 2 * 4);
  p.CD = (float*)carve((size_t)2 * 128 * 16 * 4);
  p.SB = (float*)carve((size_t)2 * 32 * 64 * 32 * 4);
  p.SA = (float*)carve((size_t)2 * 32 * 64 * 4 * 4);
  p.KVC = (bf*)carve((size_t)TT * 256 * 2);
  p.GS = (bf*)carve((size_t)256 * 16 * 512 * 16);
  if (off > ws_size) { fprintf(stderr, "workspace too small: need %zu have %zu\n", off, ws_size); return; }
  for (int j = 0; j < 8; j++) p.inv[j] = (float)pow(500000.0, -(double)j / 8.0);
  const size_t kDynLds = 2 * HALF_LDS;
  static int grid_blocks = 0;
  if (!grid_blocks) {
    int dev = 0, cus = 0, per_cu = 0;
    (void)hipGetDevice(&dev);
    (void)hipDeviceGetAttribute(&cus, hipDeviceAttributeMultiprocessorCount, dev);
    (void)hipFuncSetAttribute((const void*)mega_kernel, hipFuncAttributeMaxDynamicSharedMemorySize, (int)kDynLds);
    (void)hipOccupancyMaxActiveBlocksPerMultiprocessor(&per_cu, mega_kernel, 512, kDynLds);
    if (per_cu > 1) per_cu = 1;
    grid_blocks = cus * per_cu;
    if (grid_blocks > 256) grid_blocks = 256;
    grid_blocks -= grid_blocks % 8;
  }
  void* args[] = {&p};
  hipError_t e = hipLaunchCooperativeKernel((void*)mega_kernel, dim3(grid_blocks), dim3(512), args, kDynLds, stream);
  if (e != hipSuccess) fprintf(stderr, "cooperative launch failed: %s (grid %d)\n", hipGetErrorString(e), grid_blocks);
}
```
